# Optimizing an MI355X kernel written in HIP

```python
import jax, jax.numpy as jnp
from jax import lax
import numpy as np

D_MODEL = 1024
BATCH = 32
SEQ = 2048
DEPTH = 1

NORM_EPS = 1e-6
HG_HEADS = 4
HG_DK = 128
HG_DV = 128
HG_F = HG_HEADS * HG_DK
HG_WIDTH = HG_HEADS * HG_DV
HG_CHUNK = 64
MLA_HEADS = 4
MLA_NOPE = 128
MLA_ROPE = 64
MLA_V = 128
MLA_QK = MLA_NOPE + MLA_ROPE
Q_LORA = 384
KV_LORA = 256
MLA_WIDTH = MLA_HEADS * MLA_V
ROPE_THETA = 10000.0
Q_BLOCK = 128
D_MIX = HG_WIDTH + MLA_WIDTH
D_FF = 4 * D_MODEL
IN_SIZES = (HG_F, HG_F, HG_F, HG_WIDTH, HG_WIDTH, Q_LORA, KV_LORA, MLA_ROPE)
D_IN = HG_F * 3 + HG_WIDTH * 2 + Q_LORA + KV_LORA + MLA_ROPE

kernel_name = 'hymba_hgrn2_mla_sqrelu_encoder'


def rms_norm(t, gain):
    tf = t.astype(jnp.float32)
    y = tf * lax.rsqrt(jnp.mean(tf * tf, axis=-1, keepdims=True) + NORM_EPS)
    return (y * gain.astype(jnp.float32)).astype(t.dtype)


def apply_rope(t, cos, sin):
    half = t.shape[-1] // 2
    t1, t2 = t[..., :half], t[..., half:]
    cos = cos.astype(t.dtype)
    sin = sin.astype(t.dtype)
    return jnp.concatenate([t1 * cos - t2 * sin, t2 * cos + t1 * sin], axis=-1)


def rope_tables(positions):
    inv_freq = ROPE_THETA ** (-jnp.arange(0, MLA_ROPE, 2, dtype=jnp.float32) / MLA_ROPE)
    ang = positions.astype(jnp.float32)[..., None] * inv_freq
    return jnp.cos(ang), jnp.sin(ang)


def hgrn2_direction(q, k, v, log_f):
    b_, s_, h_, dk = q.shape
    dv = v.shape[-1]
    nc = s_ // HG_CHUNK

    def to_chunks(t):
        return t.reshape(b_, nc, HG_CHUNK, h_, t.shape[-1]).transpose(1, 0, 3, 2, 4)

    order_mask = jnp.tril(jnp.ones((HG_CHUNK, HG_CHUNK), dtype=bool))

    def step(state, inp):
        q_c, k_c, v_c, g_c = inp
        b = jnp.cumsum(g_c, axis=2)
        o_inter = jnp.einsum('bhtd,bhde->bhte', q_c * jnp.exp(b), state)
        diff = b[:, :, :, None, :] - b[:, :, None, :, :]
        decay = jnp.exp(jnp.where(order_mask[:, :, None], diff, -jnp.inf))
        scores = jnp.einsum('bhtsd,bhsd->bhts', q_c[:, :, :, None, :] * decay, k_c)
        o_intra = jnp.einsum('bhts,bhse->bhte', scores, v_c)
        b_last = b[:, :, -1:, :]
        new_state = (jnp.exp(b_last[:, :, 0, :, None]) * state
                     + jnp.einsum('bhsd,bhse->bhde', k_c * jnp.exp(b_last - b), v_c))
        return new_state, o_inter + o_intra

    state0 = jnp.zeros((b_, h_, dk, dv), jnp.float32)
    _, o = lax.scan(step, state0, (to_chunks(q), to_chunks(k), to_chunks(v), to_chunks(log_f)))
    return o.transpose(1, 0, 3, 2, 4).reshape(b_, s_, h_, dv)


def hgrn2_group(q_lin, ff_lin, fb_lin, i_lin, g_lin, lb, out_gain):
    b_, s_, _ = q_lin.shape
    dtype = q_lin.dtype
    heads_k = lambda t: t.astype(jnp.float32).reshape(b_, s_, HG_HEADS, HG_DK)
    q = heads_k(q_lin)
    v = i_lin.astype(jnp.float32).reshape(b_, s_, HG_HEADS, HG_DV)

    def gate(logit, lb_dir):
        f = lb_dir + (1.0 - lb_dir) * jax.nn.sigmoid(logit.astype(jnp.float32))
        return heads_k(jnp.log(f)), heads_k(1.0 - f)

    logf_f, k_f = gate(ff_lin, lb[0])
    logf_b, k_b = gate(fb_lin, lb[1])
    flip = lambda t: jnp.flip(t, axis=1)
    o_fwd = hgrn2_direction(q, k_f, v, logf_f)
    o_bwd = flip(hgrn2_direction(flip(q), flip(k_b), flip(v), flip(logf_b)))
    o = rms_norm(o_fwd + o_bwd, out_gain)
    o = o.reshape(b_, s_, HG_WIDTH) * jax.nn.silu(g_lin.astype(jnp.float32))
    return o.astype(dtype)


def blocked_attention(q, k, v):
    b_, s_, h_, d_ = q.shape
    nb = s_ // Q_BLOCK
    qb = (q * (MLA_QK ** -0.5)).reshape(b_, nb, Q_BLOCK, h_, d_).transpose(1, 0, 2, 3, 4)

    def one_block(qi):
        s = jnp.einsum('bqhd,bkhd->bhqk', qi, k).astype(jnp.float32)
        p = jax.nn.softmax(s, axis=-1).astype(v.dtype)
        return jnp.einsum('bhqk,bkhe->bqhe', p, v)

    o = lax.map(one_block, qb)
    return o.transpose(1, 0, 2, 3, 4).reshape(b_, s_, h_, v.shape[-1])


def mla_group(c_q, c_kv, k_rope, cos, sin, g_cq, w_q_up, g_ckv, w_kv_up, g_q_norm, g_k_norm, g_out):
    b_, s_, _ = c_q.shape
    q = (rms_norm(c_q, g_cq) @ w_q_up).reshape(b_, s_, MLA_HEADS, MLA_QK)
    kv = (rms_norm(c_kv, g_ckv) @ w_kv_up).reshape(b_, s_, MLA_HEADS, MLA_NOPE + MLA_V)
    k_nope, v = kv[..., :MLA_NOPE], kv[..., MLA_NOPE:]
    k_pe = jnp.broadcast_to(k_rope[:, :, None, :], (b_, s_, MLA_HEADS, MLA_ROPE))
    k = jnp.concatenate([k_nope, k_pe], axis=-1)
    q = rms_norm(q, g_q_norm)
    k = rms_norm(k, g_k_norm)
    cos_h, sin_h = cos[:, :, None, :], sin[:, :, None, :]
    q = jnp.concatenate([q[..., :MLA_NOPE], apply_rope(q[..., MLA_NOPE:], cos_h, sin_h)], axis=-1)
    k = jnp.concatenate([k[..., :MLA_NOPE], apply_rope(k[..., MLA_NOPE:], cos_h, sin_h)], axis=-1)
    o = blocked_attention(q, k, v).reshape(b_, s_, MLA_WIDTH)
    return rms_norm(o, g_out)


def setup_inputs(seed: int = 0) -> dict:
    key = jax.random.key(seed)
    ks = jax.random.split(key, 20)
    f32 = jnp.float32
    nrm = lambda k, shape, fan_in: jax.random.normal(k, shape, f32) * (fan_in ** -0.5)
    gain = lambda k, shape: 1.0 + 0.1 * jax.random.normal(k, shape, f32)
    x = jax.random.normal(ks[0], (BATCH, SEQ, D_MODEL), f32)
    offsets = jax.random.randint(ks[1], (BATCH, 1), 0, 512, dtype=jnp.int32)
    positions = jnp.arange(SEQ, dtype=jnp.int32)[None, :] + offsets
    return {
        'x': x,
        'positions': positions,
        'g_mix_norm': gain(ks[2], (DEPTH, D_MODEL)),
        'w_in': nrm(ks[3], (DEPTH, D_MODEL, D_IN), D_MODEL),
        'lb_param': jax.random.normal(ks[4], (2, DEPTH + 1, HG_F), f32),
        'g_hgrn_out': gain(ks[5], (DEPTH, HG_HEADS, HG_DV)),
        'g_cq': gain(ks[6], (DEPTH, Q_LORA)),
        'w_q_up': nrm(ks[7], (DEPTH, Q_LORA, MLA_HEADS * MLA_QK), Q_LORA),
        'g_ckv': gain(ks[8], (DEPTH, KV_LORA)),
        'w_kv_up': nrm(ks[9], (DEPTH, KV_LORA, MLA_HEADS * (MLA_NOPE + MLA_V)), KV_LORA),
        'g_q_norm': gain(ks[10], (DEPTH, MLA_QK)),
        'g_k_norm': gain(ks[11], (DEPTH, MLA_QK)),
        'g_mla_out': gain(ks[12], (DEPTH, MLA_WIDTH)),
        'w_out': nrm(ks[13], (DEPTH, D_MIX, D_MODEL), D_MIX),
        'g_ffn_norm': gain(ks[14], (DEPTH, D_MODEL)),
        'w_up': nrm(ks[15], (DEPTH, D_MODEL, D_FF), D_MODEL),
        'w_down': nrm(ks[16], (DEPTH, D_FF, D_MODEL), D_FF),
    }


def reference(x, positions, g_mix_norm, w_in, lb_param, g_hgrn_out, g_cq, w_q_up, g_ckv,
              w_kv_up, g_q_norm, g_k_norm, g_mla_out, w_out, g_ffn_norm, w_up, w_down):
    cos, sin = rope_tables(positions)
    lb_table = jnp.cumsum(jax.nn.softmax(lb_param.astype(jnp.float32), axis=1), axis=1)
    for layer in range(DEPTH):
        h = rms_norm(x, g_mix_norm[layer])
        proj = h @ w_in[layer]
        parts = []
        start = 0
        for size in IN_SIZES:
            parts.append(proj[..., start:start + size])
            start += size
        q_hg, ff_hg, fb_hg, i_hg, g_hg, c_q, c_kv, k_rope = parts
        o_a = hgrn2_group(q_hg, ff_hg, fb_hg, i_hg, g_hg, lb_table[:, layer], g_hgrn_out[layer])
        o_b = mla_group(c_q, c_kv, k_rope, cos, sin, g_cq[layer], w_q_up[layer], g_ckv[layer],
                        w_kv_up[layer], g_q_norm[layer], g_k_norm[layer], g_mla_out[layer])
        x = x + jnp.concatenate([o_a, o_b], axis=-1) @ w_out[layer]
        hf = rms_norm(x, g_ffn_norm[layer]) @ w_up[layer]
        x = x + jnp.square(jax.nn.relu(hf)) @ w_down[layer]
    return x
```

```cpp
#include <hip/hip_runtime.h>
#include <hip/hip_cooperative_groups.h>
#include <cstdio>
#include <cstdint>

#define LAS __attribute__((address_space(3)))
typedef unsigned short bf16_t;
typedef short bf16x8 __attribute__((ext_vector_type(8)));
typedef short s16x4 __attribute__((ext_vector_type(4)));
typedef float f32x4 __attribute__((ext_vector_type(4)));
typedef float f32x16 __attribute__((ext_vector_type(16)));
typedef unsigned u32x4 __attribute__((ext_vector_type(4)));
typedef unsigned u32x2 __attribute__((ext_vector_type(2)));
typedef _Float16 h16x2 __attribute__((ext_vector_type(2)));

constexpr int BATCH = 32, SEQ = 2048, DM = 1024, M = BATCH * SEQ;
constexpr int DIN = 3264, DINP = 3328, DFF = 4096;
constexpr int C_Q = 0, C_FF = 512, C_I = 1536, C_G = 2048, C_CQ = 2560, C_CKV = 2944, C_KR = 3200;
constexpr int QLORA = 384, KVLORA = 256, NQ = 768, NKV = 1024;
constexpr float EPS = 1e-6f;
constexpr float QSCALE = 0.07216878364870322f * 1.4426950408889634f;

constexpr size_t MiB = 1u << 20;
constexpr size_t WS_CTL = 0;
constexpr size_t WS_RS0 = 1 * MiB, WS_RS1 = WS_RS0 + 256 * 1024, WS_LBT = WS_RS1 + 256 * 1024;
constexpr size_t WS_COS = 2 * MiB, WS_SIN = 10 * MiB;
constexpr size_t WS_WIN = 18 * MiB, WS_WQ = 25 * MiB, WS_WKV = 26 * MiB, WS_WOUT = 27 * MiB, WS_WUP = 29 * MiB, WS_WDN = 37 * MiB;
constexpr size_t WS_GQT = WS_LBT + 4096, WS_GKT = WS_GQT + 1024, WS_GHT = WS_GKT + 1024;
constexpr size_t WS_SSQ1 = 45 * MiB;
constexpr size_t WS_XB = 46 * MiB;
constexpr size_t WS_X1B = 718 * MiB;
constexpr size_t WS_PROJ = 174 * MiB;
constexpr size_t WS_HB = 174 * MiB;
constexpr size_t WS_MIX = 590 * MiB;
constexpr size_t WS_Q = 718 * MiB, WS_K = 814 * MiB, WS_V = 910 * MiB;
constexpr size_t WS_SSQP = 974 * MiB;
constexpr size_t WS_SSQA = 976 * MiB;
constexpr size_t WS_END = 977 * MiB;

__device__ __forceinline__ unsigned f2bf(float f) { unsigned u = __builtin_bit_cast(unsigned, f); return (u + 0x7fffu + ((u >> 16) & 1u)) >> 16; }
__device__ __forceinline__ unsigned pk2(float lo, float hi) { return f2bf(lo) | (f2bf(hi) << 16); }
__device__ __forceinline__ float bf2f(unsigned short b) { return __builtin_bit_cast(float, (unsigned)b << 16); }
__device__ __forceinline__ float bflo(unsigned w) { return __builtin_bit_cast(float, w << 16); }
__device__ __forceinline__ float bfhi(unsigned w) { return __builtin_bit_cast(float, w & 0xffff0000u); }
__device__ __forceinline__ float wave_sum(float v) {
#pragma unroll
    for (int o = 1; o < 64; o <<= 1) v += __shfl_xor(v, o);
    return v;
}
__device__ __forceinline__ int lane_id() { int l; asm volatile("v_mbcnt_lo_u32_b32 %0, -1, 0\n\tv_mbcnt_hi_u32_b32 %0, -1, %0" : "=v"(l)); return l; }
__device__ __forceinline__ float dpp_sum8(float v) {
    v += __builtin_bit_cast(float, __builtin_amdgcn_update_dpp(0, __builtin_bit_cast(int, v), 0xB1, 0xF, 0xF, true));
    v += __builtin_bit_cast(float, __builtin_amdgcn_update_dpp(0, __builtin_bit_cast(int, v), 0x4E, 0xF, 0xF, true));
    v += __builtin_bit_cast(float, __builtin_amdgcn_update_dpp(0, __builtin_bit_cast(int, v), 0x141, 0xF, 0xF, true));
    return v;
}
typedef float f32x2_t __attribute__((ext_vector_type(2))); typedef __bf16 bf16x2_t __attribute__((ext_vector_type(2)));
__device__ __forceinline__ unsigned cvtpk(float lo, float hi) { f32x2_t v = {lo, hi}; bf16x2_t b = __builtin_convertvector(v, bf16x2_t); return __builtin_bit_cast(unsigned, b); }
__device__ __forceinline__ unsigned cvt_pk_bf16(float lo, float hi) { unsigned r; asm volatile("v_cvt_pk_bf16_f32 %0, %1, %2" : "=v"(r) : "v"(lo), "v"(hi)); return r; }

namespace pg8 {
#define PG8_LAS __attribute__((address_space(3)))
constexpr int BM = 256, BK = 64, HALF = 128, HTB = HALF * BK * 2, STAGE_BYTES = 8 * HTB, NXCD = 8, WGM = 8;
__host__ __device__ __forceinline__ int lds_byte(int r, int c) { const int st = (r >> 4) * 2 + (c >> 5), rr = r & 15, cc = c & 31, ob = rr * 64 + cc * 2; return st * 1024 + (ob ^ (((ob >> 9) & 1) << 5)); }
__host__ __device__ __forceinline__ void stage_rc(int b, int& R, int& C) { const int st = b / 1024, sb = b % 1024, swz = sb ^ (((sb >> 9) & 1) << 5); R = (st >> 1) * 16 + swz / 64; C = (st & 1) * 32 + (swz % 64) / 2; }
__host__ __device__ __forceinline__ int perm32(int rho) { const int n = rho >> 4, i = rho & 15; return 8 * (i >> 2) + 4 * n + (i & 3); }
struct Unit { int pm, pn; };
struct Gemm { const bf16_t* A; const bf16_t* Bt; int M, N, K, lda; };
struct StaticOrder {
    int nM, nN, nwg, G, c;
    __host__ __device__ __forceinline__ void init(int M_, int N_, int G_, int c_) { nM = M_ / BM; nN = N_ / BM; nwg = nM * nN; G = G_; c = c_; }
    __host__ __device__ __forceinline__ bool next(int i, Unit& u) const {
        const long L = (long)i * G + c; if (L >= nwg) return false;
        int wgid = (int)L; { const int q = nwg / NXCD, r = nwg % NXCD, xcd = wgid % NXCD, off = wgid / NXCD; wgid = (xcd < r ? xcd * (q + 1) : r * (q + 1) + (xcd - r) * q) + off; }
        const int nig = WGM * nN, gid = wgid / nig, fm = gid * WGM, gsz = (nM - fm) < WGM ? (nM - fm) : WGM;
        u.pm = fm + ((wgid % nig) % gsz); u.pn = (wgid % nig) / gsz; return true;
    }
    __device__ __forceinline__ void a_ready(const Unit&) const {}
    __device__ __forceinline__ void done(const Unit&) const {}
};
typedef f32x4 Acc[2][2][4][2];

struct EpiBf16 {
    static constexpr bool PERM = true, AFTER_DRAIN = false; static constexpr int MIDK = 0;
    bf16_t* O; int ldc;
    __device__ __forceinline__ void operator()(const Acc& acc, const Unit& u, int wr, int wc, int fr, int fq, int ui) const {
        const int row0 = u.pm * BM + wr * 64 + fr, col0 = u.pn * BM + wc * 32 + 8 * fq;
#pragma unroll
        for (int ai = 0; ai < 2; ++ai)
#pragma unroll
            for (int m = 0; m < 4; ++m) { bf16_t* rowp = O + (size_t)(row0 + ai * HALF + m * 16) * ldc + col0;
#pragma unroll
                for (int bj = 0; bj < 2; ++bj) { const f32x4 v0 = acc[ai][bj][m][0], v1 = acc[ai][bj][m][1];
                    u32x4 w; w.x = cvt_pk_bf16(v0[0], v0[1]); w.y = cvt_pk_bf16(v0[2], v0[3]); w.z = cvt_pk_bf16(v1[0], v1[1]); w.w = cvt_pk_bf16(v1[2], v1[3]);
                    *(u32x4*)(rowp + bj * HALF) = w; } }
    }
};
struct EpiProj {
    static constexpr bool PERM = true, AFTER_DRAIN = false; static constexpr int MIDK = 0;
    bf16_t* O; int ldc; const PG8_LAS float* rsT; const float* lbt; float* ssqp; int Mrows; PG8_LAS float* red;
    __device__ __forceinline__ void operator()(const Acc& acc, const Unit& u, int wr, int wc, int fr, int fq, int ui) const {
        const int row0 = u.pm * BM + wr * 64 + fr, col0 = u.pn * BM + wc * 32 + 8 * fq;
        const bool gate = (u.pn >= 2 && u.pn < 6), stat = (u.pn >= 10);
        f32x4 lb[2][2];
#pragma unroll
        for (int bj = 0; bj < 2; ++bj)
#pragma unroll
            for (int n = 0; n < 2; ++n) lb[bj][n] = gate ? *(const f32x4*)(lbt + (col0 - 512) + bj * HALF + 4 * n) : (f32x4){0.f, 0.f, 0.f, 0.f};
#pragma unroll
        for (int ai = 0; ai < 2; ++ai)
#pragma unroll
            for (int m = 0; m < 4; ++m) { const int row = row0 + ai * HALF + m * 16; const float r = rsT[ui * BM + ai * HALF + wr * 64 + m * 16 + fr]; bf16_t* rowp = O + (size_t)row * ldc + col0; float sq[2];
#pragma unroll
                for (int bj = 0; bj < 2; ++bj) { f32x4 v0 = acc[ai][bj][m][0] * r, v1 = acc[ai][bj][m][1] * r; u32x4 w;
                    sq[bj] = ((v0[0] * v0[0] + v0[1] * v0[1]) + (v0[2] * v0[2] + v0[3] * v0[3])) + ((v1[0] * v1[0] + v1[1] * v1[1]) + (v1[2] * v1[2] + v1[3] * v1[3]));
                    if (gate) {
#pragma unroll
                        for (int e = 0; e < 4; ++e) { const float s0 = __builtin_amdgcn_rcpf(1.f + __builtin_amdgcn_exp2f(-1.4426950408889634f * v0[e])), s1 = __builtin_amdgcn_rcpf(1.f + __builtin_amdgcn_exp2f(-1.4426950408889634f * v1[e]));
                            v0[e] = __builtin_amdgcn_logf(lb[bj][0][e] + (1.f - lb[bj][0][e]) * s0); v1[e] = __builtin_amdgcn_logf(lb[bj][1][e] + (1.f - lb[bj][1][e]) * s1); }
                        h16x2 a = {(_Float16)v0[0], (_Float16)v0[1]}, b = {(_Float16)v0[2], (_Float16)v0[3]}, c = {(_Float16)v1[0], (_Float16)v1[1]}, d = {(_Float16)v1[2], (_Float16)v1[3]};
                        w.x = __builtin_bit_cast(unsigned, a); w.y = __builtin_bit_cast(unsigned, b); w.z = __builtin_bit_cast(unsigned, c); w.w = __builtin_bit_cast(unsigned, d);
                    } else { w.x = cvt_pk_bf16(v0[0], v0[1]); w.y = cvt_pk_bf16(v0[2], v0[3]); w.z = cvt_pk_bf16(v1[0], v1[1]); w.w = cvt_pk_bf16(v1[2], v1[3]); }
                    *(u32x4*)(rowp + bj * HALF) = w; }
                if (stat) { sq[0] += __shfl_xor(sq[0], 16); sq[0] += __shfl_xor(sq[0], 32); sq[1] += __shfl_xor(sq[1], 16); sq[1] += __shfl_xor(sq[1], 32);
                    if (fq == 0) { PG8_LAS float* rp = red + (ai * HALF + wr * 64 + m * 16 + fr) * 8 + wc * 2; rp[0] = sq[0]; rp[1] = sq[1]; } } }
        if (stat) {
            asm volatile("s_waitcnt lgkmcnt(0)" ::: "memory"); __builtin_amdgcn_s_barrier(); asm volatile("" ::: "memory");
            const int t = (wr * 4 + wc) * 64 + fq * 16 + fr;
            if (t < 256) { const f32x4 q0 = *(const PG8_LAS f32x4*)(red + t * 8), q1 = *(const PG8_LAS f32x4*)(red + t * 8 + 4);
                float* dst = ssqp + (size_t)((u.pn - 10) * 2) * Mrows + u.pm * BM + t; dst[0] = (q0[0] + q0[2]) + (q1[0] + q1[2]); dst[Mrows] = (q0[1] + q0[3]) + (q1[1] + q1[3]); }
            asm volatile("s_waitcnt lgkmcnt(0)" ::: "memory"); __builtin_amdgcn_s_barrier(); asm volatile("" ::: "memory");
        }
    }
};
struct EpiQ {
    static constexpr bool PERM = true, AFTER_DRAIN = false; static constexpr int MIDK = 0;
    bf16_t* Q; const PG8_LAS float* rsT; const float* gq; const float* cosT; const float* sinT; PG8_LAS float* red;
    __device__ __forceinline__ void operator()(const Acc& acc, const Unit& u, int wr, int wc, int fr, int fq, int ui) const {
        const int h = u.pn, cl = wc * 32 + 8 * fq, ic = 4 * wc + fq;
        f32x4 cs[2][4], sn[2][4];
        if (wc < 2) {
#pragma unroll
            for (int ai = 0; ai < 2; ++ai)
#pragma unroll
                for (int m = 0; m < 4; ++m) { const size_t row = (size_t)(u.pm * BM + ai * HALF + wr * 64 + m * 16 + fr);
                    cs[ai][m] = *(const f32x4*)(cosT + row * 32 + 4 * ic); sn[ai][m] = *(const f32x4*)(sinT + row * 32 + 4 * ic); }
        }
        const f32x4 g00 = *(const f32x4*)(gq + cl), g01 = *(const f32x4*)(gq + cl + 4), g10 = *(const f32x4*)(gq + 128 + cl), g11 = *(const f32x4*)(gq + 128 + cl + 4);
#pragma unroll
        for (int ai = 0; ai < 2; ++ai)
#pragma unroll
            for (int m = 0; m < 4; ++m) { float s = 0.f;
#pragma unroll
                for (int bj = 0; bj < 2; ++bj)
#pragma unroll
                    for (int n = 0; n < 2; ++n) { const f32x4 v = acc[ai][bj][m][n]; s += (v[0] * v[0] + v[1] * v[1]) + (v[2] * v[2] + v[3] * v[3]); }
                s += __shfl_xor(s, 16); s += __shfl_xor(s, 32);
                if (fq == 0) red[(ai * HALF + wr * 64 + m * 16 + fr) * 4 + wc] = s; }
        asm volatile("s_waitcnt lgkmcnt(0)" ::: "memory"); __builtin_amdgcn_s_barrier(); asm volatile("" ::: "memory");
#pragma unroll
        for (int ai = 0; ai < 2; ++ai)
#pragma unroll
            for (int m = 0; m < 4; ++m) { const int rowl = ai * HALF + wr * 64 + m * 16 + fr, row = u.pm * BM + rowl;
                const f32x4 q4 = *(const PG8_LAS f32x4*)(red + rowl * 4); const float ssx = (q4[0] + q4[1]) + (q4[2] + q4[3]);
                const float rs = rsT[ui * BM + rowl];
                const float sc = rs * __builtin_amdgcn_rsqf(rs * rs * ssx * (1.f / 192.f) + 1e-6f);
                bf16_t* dst = Q + ((size_t)((row >> 11) * 4 + h) * 2048 + (row & 2047)) * 192 + cl;
                { const f32x4 v0 = acc[ai][0][m][0] * sc * g00, v1 = acc[ai][0][m][1] * sc * g01; u32x4 w; w.x = cvt_pk_bf16(v0[0], v0[1]); w.y = cvt_pk_bf16(v0[2], v0[3]); w.z = cvt_pk_bf16(v1[0], v1[1]); w.w = cvt_pk_bf16(v1[2], v1[3]); *(u32x4*)dst = w; }
                if (wc < 2) { const f32x4 t1 = acc[ai][1][m][0] * sc * g10, t2 = acc[ai][1][m][1] * sc * g11;
                    const f32x4 o1 = t1 * cs[ai][m] - t2 * sn[ai][m], o2 = t2 * cs[ai][m] + t1 * sn[ai][m];
                    u32x4 w; w.x = cvt_pk_bf16(o1[0], o1[1]); w.y = cvt_pk_bf16(o1[2], o1[3]); w.z = cvt_pk_bf16(o2[0], o2[1]); w.w = cvt_pk_bf16(o2[2], o2[3]); *(u32x4*)(dst + 128) = w; } }
    }
};
struct EpiKV {
    static constexpr bool PERM = true, AFTER_DRAIN = false; static constexpr int MIDK = 0;
    bf16_t* K; bf16_t* V; const bf16_t* proj; int ldp; int ckr; const PG8_LAS float* rsT; const PG8_LAS float* skT; const float* gk; const float* cosT; const float* sinT; PG8_LAS float* red;
    __device__ __forceinline__ void operator()(const Acc& acc, const Unit& u, int wr, int wc, int fr, int fq, int ui) const {
        const int h = u.pn, cl = wc * 32 + 8 * fq, ic = 4 * wc + fq;
#pragma unroll
        for (int ai = 0; ai < 2; ++ai)
#pragma unroll
            for (int m = 0; m < 4; ++m) { float s = 0.f;
#pragma unroll
                for (int n = 0; n < 2; ++n) { const f32x4 v = acc[ai][0][m][n]; s += (v[0] * v[0] + v[1] * v[1]) + (v[2] * v[2] + v[3] * v[3]); }
                s += __shfl_xor(s, 16); s += __shfl_xor(s, 32);
                if (fq == 0) red[(ai * HALF + wr * 64 + m * 16 + fr) * 4 + wc] = s; }
        const f32x4 g0 = *(const f32x4*)(gk + cl), g1 = *(const f32x4*)(gk + cl + 4);
        f32x4 gr0 = {0.f, 0.f, 0.f, 0.f}, gr1 = {0.f, 0.f, 0.f, 0.f};
        if (wc < 2) { gr0 = *(const f32x4*)(gk + 128 + 8 * ic); gr1 = *(const f32x4*)(gk + 128 + 8 * ic + 4); }
        asm volatile("s_waitcnt lgkmcnt(0)" ::: "memory"); __builtin_amdgcn_s_barrier(); asm volatile("" ::: "memory");
#pragma unroll
        for (int ai = 0; ai < 2; ++ai) {
            u32x4 kr[4]; f32x4 cs[4], sn[4];
            if (wc < 2) {
#pragma unroll
                for (int m = 0; m < 4; ++m) { const size_t row = (size_t)(u.pm * BM + ai * HALF + wr * 64 + m * 16 + fr);
                    kr[m] = *(const u32x4*)(proj + row * ldp + ckr + 8 * ic); cs[m] = *(const f32x4*)(cosT + row * 32 + 4 * ic); sn[m] = *(const f32x4*)(sinT + row * 32 + 4 * ic); }
            }
#pragma unroll
            for (int m = 0; m < 4; ++m) { const int rowl = ai * HALF + wr * 64 + m * 16 + fr, row = u.pm * BM + rowl;
                const f32x4 q4 = *(const PG8_LAS f32x4*)(red + rowl * 4); const float ssk = (q4[0] + q4[1]) + (q4[2] + q4[3]);
                const float rsc = rsT[ui * BM + rowl], skr = skT[ui * BM + rowl];
                const float r = __builtin_amdgcn_rsqf((rsc * rsc * ssk + skr) * (1.f / 192.f) + 1e-6f);
                const size_t tok = (size_t)((row >> 11) * 4 + h) * 2048 + (row & 2047);
                bf16_t* kd = K + tok * 192; bf16_t* vd = V + tok * 128;
                { const float sc = rsc * r; const f32x4 v0 = acc[ai][0][m][0] * sc * g0, v1 = acc[ai][0][m][1] * sc * g1; u32x4 w; w.x = cvt_pk_bf16(v0[0], v0[1]); w.y = cvt_pk_bf16(v0[2], v0[3]); w.z = cvt_pk_bf16(v1[0], v1[1]); w.w = cvt_pk_bf16(v1[2], v1[3]); *(u32x4*)(kd + cl) = w; }
                { const f32x4 v0 = acc[ai][1][m][0] * rsc, v1 = acc[ai][1][m][1] * rsc; u32x4 w; w.x = cvt_pk_bf16(v0[0], v0[1]); w.y = cvt_pk_bf16(v0[2], v0[3]); w.z = cvt_pk_bf16(v1[0], v1[1]); w.w = cvt_pk_bf16(v1[2], v1[3]); *(u32x4*)(vd + cl) = w; }
                if (wc < 2) { const f32x4 t1 = (f32x4){bflo(kr[m].x), bfhi(kr[m].x), bflo(kr[m].y), bfhi(kr[m].y)} * gr0 * r, t2 = (f32x4){bflo(kr[m].z), bfhi(kr[m].z), bflo(kr[m].w), bfhi(kr[m].w)} * gr1 * r;
                    const f32x4 o1 = t1 * cs[m] - t2 * sn[m], o2 = t2 * cs[m] + t1 * sn[m];
                    u32x4 w; w.x = cvt_pk_bf16(o1[0], o1[1]); w.y = cvt_pk_bf16(o1[2], o1[3]); w.z = cvt_pk_bf16(o2[0], o2[1]); w.w = cvt_pk_bf16(o2[2], o2[3]); *(u32x4*)(kd + 128 + 8 * ic) = w; } }
        }
    }
};
struct EpiUp {
    static constexpr bool PERM = true, AFTER_DRAIN = false; static constexpr int MIDK = 0;
    bf16_t* O; int ldc; const PG8_LAS float* rsT;
    __device__ __forceinline__ void operator()(const Acc& acc, const Unit& u, int wr, int wc, int fr, int fq, int ui) const {
        const int row0 = u.pm * BM + wr * 64 + fr, col0 = u.pn * BM + wc * 32 + 8 * fq;
#pragma unroll
        for (int ai = 0; ai < 2; ++ai)
#pragma unroll
            for (int m = 0; m < 4; ++m) { const int row = row0 + ai * HALF + m * 16; const float r = rsT[ui * BM + ai * HALF + wr * 64 + m * 16 + fr]; bf16_t* rowp = O + (size_t)row * ldc + col0;
#pragma unroll
                for (int bj = 0; bj < 2; ++bj) { f32x4 v0 = acc[ai][bj][m][0] * r, v1 = acc[ai][bj][m][1] * r;
#pragma unroll
                    for (int e = 0; e < 4; ++e) { const float a = fmaxf(v0[e], 0.f), b = fmaxf(v1[e], 0.f); v0[e] = a * a; v1[e] = b * b; }
                    u32x4 w; w.x = cvt_pk_bf16(v0[0], v0[1]); w.y = cvt_pk_bf16(v0[2], v0[3]); w.z = cvt_pk_bf16(v1[0], v1[1]); w.w = cvt_pk_bf16(v1[2], v1[3]);
                    *(u32x4*)(rowp + bj * HALF) = w; } }
    }
};
struct EpiResid {
    static constexpr bool PERM = false, AFTER_DRAIN = false; static constexpr int MIDK = 0;
    const float* base; float* out; int ldc;
    __device__ __forceinline__ void operator()(const Acc& acc, const Unit& u, int wr, int wc, int fr, int fq, int ui) const {
        const int row0 = u.pm * BM + wr * 64 + fr, col0 = u.pn * BM + wc * 32 + 4 * fq;
#pragma unroll
        for (int ai = 0; ai < 2; ++ai)
#pragma unroll
            for (int m = 0; m < 4; ++m) { const size_t off = (size_t)(row0 + ai * HALF + m * 16) * ldc + col0;
#pragma unroll
                for (int bj = 0; bj < 2; ++bj)
#pragma unroll
                    for (int n = 0; n < 2; ++n) { const f32x4 bs = *(const f32x4*)(base + off + bj * HALF + n * 16); *(f32x4*)(out + off + bj * HALF + n * 16) = bs + acc[ai][bj][m][n]; } }
    }
};

struct EpiResidBf {
    static constexpr bool PERM = false, AFTER_DRAIN = false; static constexpr int MIDK = 0;
    const bf16_t* xb; float* out; int ldc;
    __device__ __forceinline__ void operator()(const Acc& acc, const Unit& u, int wr, int wc, int fr, int fq, int ui) const {
        const int row0 = u.pm * BM + wr * 64 + fr, col0 = u.pn * BM + wc * 32 + 4 * fq;
        u32x2 w[2][4][2][2];
#pragma unroll
        for (int ai = 0; ai < 2; ++ai)
#pragma unroll
            for (int m = 0; m < 4; ++m) { const size_t off = (size_t)(row0 + ai * HALF + m * 16) * ldc + col0;
#pragma unroll
                for (int bj = 0; bj < 2; ++bj)
#pragma unroll
                    for (int n = 0; n < 2; ++n) w[ai][m][bj][n] = *(const u32x2*)(xb + off + bj * HALF + n * 16); }
        __builtin_amdgcn_sched_barrier(0);
#pragma unroll
        for (int ai = 0; ai < 2; ++ai) {
#pragma unroll
            for (int m = 0; m < 4; ++m) { const size_t off = (size_t)(row0 + ai * HALF + m * 16) * ldc + col0;
#pragma unroll
                for (int bj = 0; bj < 2; ++bj)
#pragma unroll
                    for (int n = 0; n < 2; ++n) { const u32x2 ww = w[ai][m][bj][n]; const f32x4 bs = {bflo(ww.x), bfhi(ww.x), bflo(ww.y), bfhi(ww.y)}; *(f32x4*)(out + off + bj * HALF + n * 16) = bs + acc[ai][bj][m][n]; } }
        }
    }
};
struct EpiResidX1 {
    static constexpr bool PERM = false, AFTER_DRAIN = false; static constexpr int MIDK = 8;
    const bf16_t* base; bf16_t* xb; float* ssq; int ldc; int Mrows; PG8_LAS float* red; const PG8_LAS float* rsb;
    __device__ __forceinline__ void mid(Acc& acc, int ui, int wr, int fr) const {
#pragma unroll
        for (int ai = 0; ai < 2; ++ai)
#pragma unroll
            for (int m = 0; m < 4; ++m) { const float r = rsb[ui * BM + ai * HALF + wr * 64 + m * 16 + fr];
#pragma unroll
                for (int bj = 0; bj < 2; ++bj)
#pragma unroll
                    for (int n = 0; n < 2; ++n) acc[ai][bj][m][n] *= r; }
    }
    __device__ __forceinline__ void operator()(const Acc& acc, const Unit& u, int wr, int wc, int fr, int fq, int ui) const {
        const int row0 = u.pm * BM + wr * 64 + fr, col0 = u.pn * BM + wc * 32 + 4 * fq;
        u32x2 xr[2][4][2][2];
#pragma unroll
        for (int ai = 0; ai < 2; ++ai)
#pragma unroll
            for (int m = 0; m < 4; ++m) { const size_t off = (size_t)(row0 + ai * HALF + m * 16) * ldc + col0;
#pragma unroll
                for (int bj = 0; bj < 2; ++bj)
#pragma unroll
                    for (int n = 0; n < 2; ++n) xr[ai][m][bj][n] = *(const u32x2*)(base + off + bj * HALF + n * 16); }
        __builtin_amdgcn_sched_barrier(0);
#pragma unroll
        for (int ai = 0; ai < 2; ++ai) {
#pragma unroll
            for (int m = 0; m < 4; ++m) { const size_t off = (size_t)(row0 + ai * HALF + m * 16) * ldc + col0; float s = 0.f;
#pragma unroll
                for (int bj = 0; bj < 2; ++bj)
#pragma unroll
                    for (int n = 0; n < 2; ++n) { const u32x2 xw = xr[ai][m][bj][n]; const f32x4 v = (f32x4){bflo(xw.x), bfhi(xw.x), bflo(xw.y), bfhi(xw.y)} + acc[ai][bj][m][n];
                        u32x2 w; w.x = cvt_pk_bf16(v[0], v[1]); w.y = cvt_pk_bf16(v[2], v[3]); *(u32x2*)(xb + off + bj * HALF + n * 16) = w;
                        s += (v[0] * v[0] + v[1] * v[1]) + (v[2] * v[2] + v[3] * v[3]); }
                s += __shfl_xor(s, 16); s += __shfl_xor(s, 32);
                if (fq == 0) red[(ai * HALF + wr * 64 + m * 16 + fr) * 4 + wc] = s; }
        }
        asm volatile("s_waitcnt lgkmcnt(0)" ::: "memory"); __builtin_amdgcn_s_barrier(); asm volatile("" ::: "memory");
        const int t = (wr * 4 + wc) * 64 + fq * 16 + fr;
        if (t < 256) { const f32x4 q = *(const PG8_LAS f32x4*)(red + t * 4); ssq[(size_t)u.pn * Mrows + u.pm * BM + t] = (q[0] + q[1]) + (q[2] + q[3]); }
        asm volatile("s_waitcnt lgkmcnt(0)" ::: "memory"); __builtin_amdgcn_s_barrier(); asm volatile("" ::: "memory");
    }
};
template <class Epi, class Sched, bool ALIGN_EPI = false, bool SP2 = false>
__device__ __forceinline__ void gemm_phase(PG8_LAS unsigned char* lds, const Gemm g, const Sched& S, const Epi& E, int wv) {
    int lane = lane_id(); asm volatile("" : "+v"(lane));
    const int wid = wv, tid = wv * 64 + lane, wr = wid >> 2, wc = wid & 3, fr = lane & 15, fq = lane >> 4;
    const int K = g.K, nt = K / BK, lda = g.lda;
    unsigned voffA[2], voffB[2];
#pragma unroll
    for (int i = 0; i < 2; ++i) { int R, C; stage_rc(tid * 16 + i * 8192, R, C); const int Rb = Epi::PERM ? ((R & ~31) + perm32(R & 31)) : R;
        voffA[i] = (unsigned)(R * lda + C) * 2u; voffB[i] = (unsigned)(Rb * K + C) * 2u; }
    const size_t kstep = (size_t)(BK * 2);
    const size_t hstepA = (size_t)HALF * lda * 2, hstepB = (size_t)HALF * K * 2;
    const size_t tstepA = 2 * hstepA, tstepB = 2 * hstepB;
    const unsigned ldsw = (unsigned)wid * 1024u;
    const int aoff = lds_byte(wr * 64 + fr, fq * 8), boff = lds_byte(wc * 32 + fr, fq * 8);
#define PG8_SA(b, h) (((b) * 2 + (h)) * HTB)
#define PG8_SB(b, h) ((4 + (b) * 2 + (h)) * HTB)
#define PG8_STAGE(bufoff, gbase, voff) do { _Pragma("unroll") for (int _i = 0; _i < 2; ++_i) \
        __builtin_amdgcn_global_load_lds((const unsigned*)((const char*)(gbase) + (voff)[_i]), (PG8_LAS unsigned*)(lds + (bufoff) + ldsw + _i * 8192), 16, 0, 0); } while (0)
#define PG8_LDA(dst, b, h) do { _Pragma("unroll") for (int m = 0; m < 4; ++m) _Pragma("unroll") for (int k = 0; k < 2; ++k) dst[m][k] = *(const PG8_LAS bf16x8*)(lds + PG8_SA(b, h) + aoff + m * 2048 + k * 1024); } while (0)
#define PG8_LDB(dst, b, h) do { _Pragma("unroll") for (int n = 0; n < 2; ++n) _Pragma("unroll") for (int k = 0; k < 2; ++k) dst[n][k] = *(const PG8_LAS bf16x8*)(lds + PG8_SB(b, h) + boff + n * 2048 + k * 1024); } while (0)
#define PG8_MMA(ai, bj, At, Bt) do { __builtin_amdgcn_s_setprio(1); _Pragma("unroll") for (int m = 0; m < 4; ++m) _Pragma("unroll") for (int n = 0; n < 2; ++n) _Pragma("unroll") for (int k = 0; k < 2; ++k) \
        acc[ai][bj][m][n] = __builtin_amdgcn_mfma_f32_16x16x32_bf16(Bt[n][k], At[m][k], acc[ai][bj][m][n], 0, 0, 0); __builtin_amdgcn_s_setprio(0); } while (0)
#define PG8_WAIT_V(n) asm volatile("s_waitcnt vmcnt(" #n ")" ::: "memory")
#define PG8_WAIT_L(n) asm volatile("s_waitcnt lgkmcnt(" #n ")" ::: "memory")
#define PG8_BAR __builtin_amdgcn_s_barrier()
#define PG8_SCHED __builtin_amdgcn_sched_barrier(0)
    Unit cur, nxt; int ui = 0;
    if (!S.next(0, cur)) return;
    Acc acc;
#pragma unroll
    for (int a = 0; a < 2; ++a)
#pragma unroll
        for (int b = 0; b < 2; ++b)
#pragma unroll
            for (int m = 0; m < 4; ++m)
#pragma unroll
                for (int n = 0; n < 2; ++n) acc[a][b][m][n] = (f32x4){0.f, 0.f, 0.f, 0.f};
    bf16x8 At[4][2], B0[2][2], B1[2][2];
    const char* cA = (const char*)g.A + (size_t)cur.pm * tstepA; const char* cB = (const char*)g.Bt + (size_t)cur.pn * tstepB;
    S.a_ready(cur);
    if constexpr (SP2) {
        PG8_STAGE(PG8_SB(0, 0), cB, voffB); PG8_STAGE(PG8_SB(0, 1), cB + hstepB, voffB); PG8_STAGE(PG8_SA(0, 0), cA, voffA); PG8_STAGE(PG8_SA(0, 1), cA + hstepA, voffA);
        if (wr == 1) PG8_BAR;
        PG8_WAIT_V(2); PG8_BAR;
        PG8_STAGE(PG8_SB(1, 0), cB + kstep, voffB); PG8_STAGE(PG8_SA(1, 0), cA + kstep, voffA); PG8_STAGE(PG8_SB(1, 1), cB + hstepB + kstep, voffB);
        PG8_WAIT_V(6); PG8_BAR;
    } else {
        PG8_STAGE(PG8_SB(0, 0), cB, voffB); PG8_STAGE(PG8_SA(0, 0), cA, voffA); PG8_STAGE(PG8_SB(0, 1), cB + hstepB, voffB); PG8_STAGE(PG8_SA(0, 1), cA + hstepA, voffA);
        if (wr == 1) PG8_BAR;
        PG8_WAIT_V(4); PG8_BAR;
        PG8_STAGE(PG8_SB(1, 0), cB + kstep, voffB); PG8_STAGE(PG8_SA(1, 0), cA + kstep, voffA); PG8_STAGE(PG8_SB(1, 1), cB + hstepB + kstep, voffB);
        PG8_WAIT_V(6); PG8_BAR;
    }
    for (;;) {
        const bool has_next = S.next(ui + 1, nxt);
        const char* nA = has_next ? (const char*)g.A + (size_t)nxt.pm * tstepA : cA; const char* nB = has_next ? (const char*)g.Bt + (size_t)nxt.pn * tstepB : cB;
#pragma nounroll
        for (int t = 0; t < nt; t += 2) {
            const bool last = (t == nt - 2);
            const char* a1 = cA + (size_t)(t + 1) * kstep;
            const char* a2 = last ? nA : cA + (size_t)(t + 2) * kstep; const char* b2 = last ? nB : cB + (size_t)(t + 2) * kstep;
            const char* a3 = a2 + kstep; const char* b3 = b2 + kstep;
            if (last && has_next) S.a_ready(nxt);
            if constexpr (SP2) {
            PG8_LDB(B0, 0, 0); PG8_LDB(B1, 0, 1); PG8_SCHED; PG8_LDA(At, 0, 0); PG8_STAGE(PG8_SA(1, 1), a1 + hstepA, voffA);
            PG8_WAIT_V(8); PG8_WAIT_L(0); PG8_BAR; PG8_MMA(0, 0, At, B0); PG8_MMA(0, 1, At, B1); PG8_BAR; PG8_SCHED;
            PG8_LDA(At, 0, 1); PG8_STAGE(PG8_SB(0, 0), b2, voffB); PG8_STAGE(PG8_SB(0, 1), b2 + hstepB, voffB); PG8_STAGE(PG8_SA(0, 0), a2, voffA);
            PG8_WAIT_V(8); PG8_WAIT_L(0); PG8_BAR; PG8_MMA(1, 0, At, B0); PG8_MMA(1, 1, At, B1); PG8_BAR; PG8_SCHED;
            PG8_LDB(B0, 1, 0); PG8_LDB(B1, 1, 1); PG8_SCHED; PG8_LDA(At, 1, 0); PG8_STAGE(PG8_SA(0, 1), a2 + hstepA, voffA);
            PG8_WAIT_V(8); PG8_WAIT_L(0); PG8_BAR; PG8_MMA(0, 0, At, B0); PG8_MMA(0, 1, At, B1); PG8_BAR; PG8_SCHED;
            PG8_LDA(At, 1, 1); PG8_STAGE(PG8_SB(1, 0), b3, voffB); PG8_STAGE(PG8_SB(1, 1), b3 + hstepB, voffB); PG8_STAGE(PG8_SA(1, 0), a3, voffA);
            PG8_WAIT_V(8); PG8_WAIT_L(0); PG8_BAR; PG8_MMA(1, 0, At, B0); PG8_MMA(1, 1, At, B1); PG8_BAR; PG8_SCHED;
            if constexpr (Epi::MIDK > 0) { if (t + 2 == Epi::MIDK) { E.mid(acc, ui, wr, fr); PG8_SCHED; } }
            } else {
            PG8_LDB(B0, 0, 0); PG8_SCHED; PG8_LDA(At, 0, 0); PG8_STAGE(PG8_SA(1, 1), a1 + hstepA, voffA);
            PG8_WAIT_L(8); PG8_BAR; PG8_WAIT_L(0); PG8_MMA(0, 0, At, B0); PG8_BAR; PG8_SCHED;
            PG8_LDB(B1, 0, 1); PG8_STAGE(PG8_SB(0, 0), b2, voffB);
            PG8_BAR; PG8_WAIT_L(0); PG8_MMA(0, 1, At, B1); PG8_BAR;
            PG8_LDA(At, 0, 1); PG8_STAGE(PG8_SA(0, 0), a2, voffA);
            PG8_BAR; PG8_WAIT_L(0); PG8_MMA(1, 0, At, B0); PG8_BAR; PG8_SCHED;
            PG8_STAGE(PG8_SB(0, 1), b2 + hstepB, voffB);
            PG8_WAIT_V(6); PG8_BAR; PG8_MMA(1, 1, At, B1); PG8_BAR;
            PG8_LDB(B0, 1, 0); PG8_SCHED; PG8_LDA(At, 1, 0); PG8_STAGE(PG8_SA(0, 1), a2 + hstepA, voffA);
            PG8_WAIT_L(8); PG8_BAR; PG8_WAIT_L(0); PG8_MMA(0, 0, At, B0); PG8_BAR; PG8_SCHED;
            PG8_LDB(B1, 1, 1); PG8_STAGE(PG8_SB(1, 0), b3, voffB);
            PG8_BAR; PG8_WAIT_L(0); PG8_MMA(0, 1, At, B1); PG8_BAR;
            PG8_LDA(At, 1, 1); PG8_STAGE(PG8_SA(1, 0), a3, voffA);
            PG8_BAR; PG8_WAIT_L(0); PG8_MMA(1, 0, At, B0); PG8_BAR; PG8_SCHED;
            PG8_STAGE(PG8_SB(1, 1), b3 + hstepB, voffB);
            PG8_WAIT_V(6); PG8_BAR; PG8_MMA(1, 1, At, B1); PG8_BAR;
            }
        }
        if constexpr (ALIGN_EPI) { if (wr == 0) PG8_BAR; }
        if constexpr (!Epi::AFTER_DRAIN) { E(acc, cur, wr, wc, fr, fq, ui); S.done(cur); }
        if (!has_next) break;
#pragma unroll
        for (int a = 0; a < 2; ++a)
#pragma unroll
            for (int b = 0; b < 2; ++b)
#pragma unroll
                for (int m = 0; m < 4; ++m)
#pragma unroll
                    for (int n = 0; n < 2; ++n) acc[a][b][m][n] = (f32x4){0.f, 0.f, 0.f, 0.f};
        cur = nxt; cA = nA; cB = nB; ++ui;
        if constexpr (ALIGN_EPI) { if (wr == 1) PG8_BAR; }
    }
    PG8_WAIT_V(0);
    if constexpr (!ALIGN_EPI) { if (wr == 0) PG8_BAR; }
    PG8_BAR;
#undef PG8_SA
#undef PG8_SB
#undef PG8_STAGE
#undef PG8_LDA
#undef PG8_LDB
#undef PG8_MMA
#undef PG8_WAIT_V
#undef PG8_WAIT_L
#undef PG8_BAR
#undef PG8_SCHED
}
}

namespace att {
constexpr int DQK = 192, DV = 128, NW = 8, QBLK = 32, KVBLK = 64;
constexpr int SHM_V = KVBLK * DV * 2, SHM_K = KVBLK * DQK * 2, SHM_ATTN = 2 * SHM_V + 2 * SHM_K + NW * 64 * 4;
constexpr float THRL = 11.5f;
#define KSWZ(row, colB) ((row) * 384 + ((colB) ^ ((((row) >> 1) & 7) << 4)))
#define SBAR() __builtin_amdgcn_sched_barrier(0)
__device__ __forceinline__ int crow(int r, int hi) { return (r & 3) + 8 * (r >> 2) + 4 * hi; }
__device__ __forceinline__ void partialSM(f32x16& p0, f32x16& p1, float& m_reg, float& mn, float& alpha) {
    float pmax = p0[0];
#pragma unroll
    for (int r = 1; r < 16; ++r) pmax = fmaxf(pmax, p0[r]);
#pragma unroll
    for (int r = 0; r < 16; ++r) pmax = fmaxf(pmax, p1[r]);
    { auto rr = __builtin_amdgcn_permlane32_swap(__float_as_uint(pmax), __float_as_uint(pmax), false, false);
      pmax = fmaxf(__uint_as_float(rr[0]), __uint_as_float(rr[1])); }
    if (__builtin_expect(__all(pmax - m_reg <= THRL), 1)) { mn = m_reg; alpha = 1.f; }
    else { mn = fmaxf(m_reg, pmax); alpha = __builtin_amdgcn_exp2f(m_reg - mn); m_reg = mn; }
#pragma unroll
    for (int r = 0; r < 16; ++r) p0[r] = p0[r] - mn;
#pragma unroll
    for (int r = 0; r < 16; ++r) p1[r] = p1[r] - mn;
#pragma unroll
    for (int r = 0; r < 16; ++r) p0[r] = __builtin_amdgcn_exp2f(p0[r]);
}
__device__ __forceinline__ void finishSM(f32x16& p0, f32x16& p1, float alpha, float& l_reg, bf16x8& pa0, bf16x8& pa1, bf16x8& pa2, bf16x8& pa3) {
#pragma unroll
    for (int r = 0; r < 16; ++r) p1[r] = __builtin_amdgcn_exp2f(p1[r]);
    float ps = 0;
#pragma unroll
    for (int r = 0; r < 16; ++r) ps += p0[r];
#pragma unroll
    for (int r = 0; r < 16; ++r) ps += p1[r];
    { auto rr = __builtin_amdgcn_permlane32_swap(__float_as_uint(ps), __float_as_uint(ps), false, false);
      ps = __uint_as_float(rr[0]) + __uint_as_float(rr[1]); }
    l_reg = l_reg * alpha + ps;
#define PK4(P, BASE, OUT) do { unsigned a0 = cvt_pk_bf16(P[BASE + 0], P[BASE + 1]), a1 = cvt_pk_bf16(P[BASE + 2], P[BASE + 3]);   \
    unsigned b0 = cvt_pk_bf16(P[BASE + 4], P[BASE + 5]), b1 = cvt_pk_bf16(P[BASE + 6], P[BASE + 7]);                              \
    auto r0 = __builtin_amdgcn_permlane32_swap(a0, b0, false, false); auto r1 = __builtin_amdgcn_permlane32_swap(a1, b1, false, false); \
    u32x4 w = {r0[0], r1[0], r0[1], r1[1]}; OUT = __builtin_bit_cast(bf16x8, w); } while (0)
    PK4(p0, 0, pa0); PK4(p0, 8, pa1); PK4(p1, 0, pa2); PK4(p1, 8, pa3);
#undef PK4
}
__device__ __forceinline__ void qkt(f32x16& p0, f32x16& p1, const char* Ks, const bf16x8* qr, int r32, int hi) {
    p0 = f32x16{}; p1 = f32x16{};
    const char* k0p = Ks + KSWZ(r32, 0); const char* k1p = Ks + KSWZ(32 + r32, 0);
    const int key = ((r32 >> 1) & 7) << 4;
    bf16x8 ka[2], kb[2];
#define KRD(d0, slot) do { const int cb_ = (((d0) * 16 + hi * 8) * 2) ^ key; ka[slot] = *reinterpret_cast<const bf16x8*>(k0p + cb_); kb[slot] = *reinterpret_cast<const bf16x8*>(k1p + cb_); } while (0)
    KRD(0, 0); KRD(1, 1);
#pragma unroll
    for (int d0 = 0; d0 < 12; ++d0) {
        const bf16x8 a = ka[d0 & 1], b = kb[d0 & 1];
        p0 = __builtin_amdgcn_mfma_f32_32x32x16_bf16(a, qr[d0], p0, 0, 0, 0);
        p1 = __builtin_amdgcn_mfma_f32_32x32x16_bf16(b, qr[d0], p1, 0, 0, 0);
        if (d0 + 2 < 12) KRD(d0 + 2, d0 & 1);
    }
#undef KRD
}
__device__ __forceinline__ int v_st(int k, int c) { const int kk = (k & ~0xC) | ((k & 4) << 1) | ((k & 8) >> 1); return ((kk >> 3) * 4 + (c >> 5)) * 512 + ((kk & 7) * 32 + (c & 31)) * 2; }
__device__ __forceinline__ int v_rd_base(int lane) { return ((lane & 3) << 3) | (((lane >> 2) & 3) << 6) | (((lane >> 4) & 1) << 5) | (((lane >> 5) & 1) << 8); }
constexpr int v_rd_off(int d0, int ks, int half) { return d0 * 512 + ks * 4096 + half * 2048; }
template <int OFF> __device__ __forceinline__ s16x4 tr_read(int vb) {
    s16x4 r; asm volatile("ds_read_b64_tr_b16 %0, %1 offset:%2" : "=&v"(r) : "v"(vb), "i"(OFF) : "memory"); return r;
}
#define PKLH(L, H) (bf16x8){L[0], L[1], L[2], L[3], H[0], H[1], H[2], H[3]}
template <int D0> __device__ __forceinline__ void pv_one(f32x16& od, int vb, bf16x8 pa0, bf16x8 pa1, bf16x8 pa2, bf16x8 pa3) {
    const s16x4 l0 = tr_read<v_rd_off(D0, 0, 0)>(vb), h0 = tr_read<v_rd_off(D0, 0, 1)>(vb), l1 = tr_read<v_rd_off(D0, 1, 0)>(vb), h1 = tr_read<v_rd_off(D0, 1, 1)>(vb);
    const s16x4 l2 = tr_read<v_rd_off(D0, 2, 0)>(vb), h2 = tr_read<v_rd_off(D0, 2, 1)>(vb), l3 = tr_read<v_rd_off(D0, 3, 0)>(vb), h3 = tr_read<v_rd_off(D0, 3, 1)>(vb);
    asm volatile("s_waitcnt lgkmcnt(0)" ::: "memory"); SBAR();
    od = __builtin_amdgcn_mfma_f32_32x32x16_bf16(pa0, PKLH(l0, h0), od, 0, 0, 0);
    od = __builtin_amdgcn_mfma_f32_32x32x16_bf16(pa1, PKLH(l1, h1), od, 0, 0, 0);
    od = __builtin_amdgcn_mfma_f32_32x32x16_bf16(pa2, PKLH(l2, h2), od, 0, 0, 0);
    od = __builtin_amdgcn_mfma_f32_32x32x16_bf16(pa3, PKLH(l3, h3), od, 0, 0, 0);
}
__device__ __forceinline__ void pv_d0(f32x16* o, int vb, bf16x8 pa0, bf16x8 pa1, bf16x8 pa2, bf16x8 pa3) {
    pv_one<0>(o[0], vb, pa0, pa1, pa2, pa3); pv_one<1>(o[1], vb, pa0, pa1, pa2, pa3); pv_one<2>(o[2], vb, pa0, pa1, pa2, pa3); pv_one<3>(o[3], vb, pa0, pa1, pa2, pa3);
}
#define PK4S(P, BASE, OUT) do { unsigned a0 = cvt_pk_bf16(P[BASE + 0], P[BASE + 1]), a1 = cvt_pk_bf16(P[BASE + 2], P[BASE + 3]);   \
    unsigned b0 = cvt_pk_bf16(P[BASE + 4], P[BASE + 5]), b1 = cvt_pk_bf16(P[BASE + 6], P[BASE + 7]);                              \
    auto r0 = __builtin_amdgcn_permlane32_swap(a0, b0, false, false); auto r1 = __builtin_amdgcn_permlane32_swap(a1, b1, false, false); \
    u32x4 w = {r0[0], r1[0], r0[1], r1[1]}; OUT = __builtin_bit_cast(bf16x8, w); } while (0)
template <bool FIN>
__device__ __forceinline__ void seg_x(f32x16& n0, f32x16& n1, const LAS char* Ks, const bf16x8* qr, const LAS char* ql, int r32, int hi,
                                      f32x16& f0, f32x16& f1, float alpha, float& l_reg, bf16x8& pa0, bf16x8& pa1, bf16x8& pa2, bf16x8& pa3) {
    n0 = f32x16{}; n1 = f32x16{};
    const LAS char* k0p = Ks + r32 * 384;
    const int key = ((r32 >> 1) & 7) << 4;
    bf16x8 ka[2], kb[2]; float ps = 0.f;
#define KRD(d0, slot) do { const int cb_ = (((d0) * 16 + hi * 8) * 2) ^ key; ka[slot] = *reinterpret_cast<const LAS bf16x8*>(k0p + cb_); kb[slot] = *reinterpret_cast<const LAS bf16x8*>(k0p + 32 * 384 + cb_); } while (0)
    KRD(0, 0); KRD(1, 1); SBAR();
    bf16x8 qlv = qr[0];
#pragma unroll
    for (int d0 = 0; d0 < 12; ++d0) {
        const bf16x8 qv = (d0 < 8) ? qr[d0 < 8 ? d0 : 0] : qlv;
        n0 = __builtin_amdgcn_mfma_f32_32x32x16_bf16(ka[d0 & 1], qv, n0, 0, 0, 0);
        n1 = __builtin_amdgcn_mfma_f32_32x32x16_bf16(kb[d0 & 1], qv, n1, 0, 0, 0);
        SBAR();
        if (d0 + 2 < 12) KRD(d0 + 2, d0 & 1);
        if (d0 + 1 >= 8 && d0 + 1 < 12) qlv = *reinterpret_cast<const LAS bf16x8*>(ql + (d0 + 1 - 8) * 1024);
        if constexpr (FIN) {
            if (d0 < 4) {
#pragma unroll
                for (int r = 0; r < 4; ++r) f1[4 * d0 + r] = __builtin_amdgcn_exp2f(f1[4 * d0 + r]);
            } else if (d0 == 4) {
#pragma unroll
                for (int r = 0; r < 16; ++r) ps += f0[r];
            } else if (d0 == 5) {
#pragma unroll
                for (int r = 0; r < 16; ++r) ps += f1[r];
            } else if (d0 == 6) {
                auto rr = __builtin_amdgcn_permlane32_swap(__float_as_uint(ps), __float_as_uint(ps), false, false);
                ps = __uint_as_float(rr[0]) + __uint_as_float(rr[1]); l_reg = l_reg * alpha + ps;
            } else if (d0 == 7) { PK4S(f0, 0, pa0); } else if (d0 == 8) { PK4S(f0, 8, pa1); } else if (d0 == 9) { PK4S(f1, 0, pa2); } else if (d0 == 10) { PK4S(f1, 8, pa3); }
        }
        SBAR();
    }
#undef KRD
}
__device__ __forceinline__ void seg_y(f32x16* o, int vb, bf16x8 pa0, bf16x8 pa1, bf16x8 pa2, bf16x8 pa3, f32x16& p0, f32x16& p1, float& m_reg, float& mn, float& alpha) {
    pv_one<0>(o[0], vb, pa0, pa1, pa2, pa3); SBAR();
    { float a = fmaxf(p0[0], p0[1]), b = fmaxf(p0[2], p0[3]);
#pragma unroll
      for (int r = 4; r < 16; r += 2) { a = fmaxf(a, p0[r]); b = fmaxf(b, p0[r + 1]); }
#pragma unroll
      for (int r = 0; r < 16; r += 2) { a = fmaxf(a, p1[r]); b = fmaxf(b, p1[r + 1]); }
      float pmax = fmaxf(a, b);
      auto rr = __builtin_amdgcn_permlane32_swap(__float_as_uint(pmax), __float_as_uint(pmax), false, false);
      pmax = fmaxf(__uint_as_float(rr[0]), __uint_as_float(rr[1]));
      if (__builtin_expect(__all(pmax - m_reg <= THRL), 1)) { mn = m_reg; alpha = 1.f; }
      else { mn = fmaxf(m_reg, pmax); alpha = __builtin_amdgcn_exp2f(m_reg - mn); m_reg = mn; } }
    SBAR();
    pv_one<1>(o[1], vb, pa0, pa1, pa2, pa3); SBAR();
#pragma unroll
    for (int r = 0; r < 16; ++r) { p0[r] = p0[r] - mn; p1[r] = p1[r] - mn; }
    SBAR();
    pv_one<2>(o[2], vb, pa0, pa1, pa2, pa3); SBAR();
#pragma unroll
    for (int r = 0; r < 8; ++r) p0[r] = __builtin_amdgcn_exp2f(p0[r]);
    SBAR();
    pv_one<3>(o[3], vb, pa0, pa1, pa2, pa3); SBAR();
#pragma unroll
    for (int r = 8; r < 16; ++r) p0[r] = __builtin_amdgcn_exp2f(p0[r]);
    SBAR();
}
constexpr int L_K = 0, L_VV = 3 * SHM_K, L_WS = L_VV + 3 * SHM_V, L_QL = L_WS + NW * 64 * 4, ATT_LDS = L_QL + NW * 4096;
__device__ __forceinline__ void attn_unit(const bf16_t* __restrict__ Qb, const bf16_t* __restrict__ Kh, const bf16_t* __restrict__ Vh, bf16_t* __restrict__ Ob, int ldo, float* __restrict__ ssq, int seq, char* lds, int wv) {
    int lane = lane_id(); asm volatile("" : "+v"(lane));
    const int wid = wv, tid = wv * 64 + lane, r32 = lane & 31, hi = lane >> 5;
    LAS unsigned char* l3 = (LAS unsigned char*)lds;
    const LAS char* K_lds = (const LAS char*)l3 + L_K;
    float* ws = (float*)(lds + L_WS) + wid * 64; float* li_l = ws; float* al_l = ws + 32;
    float m_reg = -1e30f, l_reg = 0; f32x16 o[4] = {}; bf16x8 qr[8];
    const LAS char* ql = (const LAS char*)l3 + L_QL + wid * 4096 + lane * 16;
#define KSRC(i_) ({ const int p_ = (wid + 8 * (i_)) * 64 + lane, row_ = p_ / 24, cpos_ = p_ - row_ * 24; (unsigned)(row_ * 24 + ((cpos_ & ~7) | ((cpos_ ^ (row_ >> 1)) & 7))) * 16u; })
#define VSRC(i_) ({ const int p16_ = (wid + 8 * (i_)) * 64 + lane, sub_ = p16_ >> 5, idx_ = p16_ & 31, kk_ = (sub_ >> 2) * 8 + (idx_ >> 2), c_ = (sub_ & 3) * 32 + (idx_ & 3) * 8; \
    (unsigned)((((kk_ & ~0xC) | ((kk_ & 4) << 1) | ((kk_ & 8) >> 1))) * DV + c_) * 2u; })
#define DMA_K(t, kboff) do { const char* kt_ = (const char*)Kh + (size_t)(t) * SHM_K; \
    _Pragma("unroll") for (int i_ = 0; i_ < 3; ++i_) __builtin_amdgcn_global_load_lds((const unsigned*)(kt_ + KSRC(i_)), (LAS unsigned*)(l3 + L_K + (kboff) + (wid + 8 * i_) * 1024), 16, 0, 0); } while (0)
#define DMA_V(t, vboff) do { const char* vt_ = (const char*)Vh + (size_t)(t) * SHM_V; \
    _Pragma("unroll") for (int i_ = 0; i_ < 2; ++i_) __builtin_amdgcn_global_load_lds((const unsigned*)(vt_ + VSRC(i_)), (LAS unsigned*)(l3 + L_VV + (vboff) + (wid + 8 * i_) * 1024), 16, 0, 0); } while (0)
#define TOP(j, KB) do { if ((j) + 2 >= NT) asm volatile("s_waitcnt vmcnt(0) lgkmcnt(0)" ::: "memory"); else asm volatile("s_waitcnt vmcnt(5) lgkmcnt(0)" ::: "memory"); \
    __builtin_amdgcn_s_barrier(); asm volatile("" ::: "memory"); \
    if ((j) + 2 < NT) DMA_K((j) + 2, (((KB) + 2) % 3) * SHM_K); if ((j) + 1 < NT) DMA_V((j) + 1, (((KB) + 1) % 3) * SHM_V); } while (0)
#define RESC(a) do { if (__any((a) < 1.f)) { if (hi == 0) al_l[r32] = (a); asm volatile("s_waitcnt lgkmcnt(0)" ::: "memory"); \
    _Pragma("unroll") for (int d = 0; d < 4; ++d) _Pragma("unroll") for (int r = 0; r < 16; ++r) o[d][r] *= al_l[crow(r, hi)]; } } while (0)
#define TILE(j, KB, PN0, PN1, MNN, ALN, PF0, PF1, AF) do { TOP(j, KB); \
    seg_x<true>(PN0, PN1, K_lds + (KB) * SHM_K, qr, ql, r32, hi, PF0, PF1, AF, l_reg, pa0, pa1, pa2, pa3); \
    seg_y(o, vb0 + (((KB) + 2) % 3) * SHM_V, pa0, pa1, pa2, pa3, PN0, PN1, m_reg, MNN, ALN); RESC(ALN); } while (0)
    const bf16_t* Qw = Qb + (long)(wid * QBLK + r32) * DQK + hi * 8;
#pragma unroll
    for (int d0 = 0; d0 < 8; ++d0) qr[d0] = *reinterpret_cast<const bf16x8*>(Qw + d0 * 16);
#pragma unroll
    for (int d0 = 8; d0 < 12; ++d0) *(LAS bf16x8*)((LAS char*)l3 + L_QL + wid * 4096 + lane * 16 + (d0 - 8) * 1024) = *reinterpret_cast<const bf16x8*>(Qw + d0 * 16);
    const int vb0 = (int)(uintptr_t)(lds + L_VV) + v_rd_base(lane);
    f32x16 pA0, pA1, pB0, pB1; float mnA, mnB, alA, alB; bf16x8 pa0, pa1, pa2, pa3; const int NT = seq / KVBLK;
    DMA_K(0, 0); DMA_V(0, 0); DMA_K(1, SHM_K);
    TOP(0, 0);
    seg_x<false>(pA0, pA1, K_lds, qr, ql, r32, hi, pA0, pA1, 1.f, l_reg, pa0, pa1, pa2, pa3); partialSM(pA0, pA1, m_reg, mnA, alA);
    for (int j = 1; j + 6 < NT; j += 6) {
        TILE(j,     1, pB0, pB1, mnB, alB, pA0, pA1, alA);
        TILE(j + 1, 2, pA0, pA1, mnA, alA, pB0, pB1, alB);
        TILE(j + 2, 0, pB0, pB1, mnB, alB, pA0, pA1, alA);
        TILE(j + 3, 1, pA0, pA1, mnA, alA, pB0, pB1, alB);
        TILE(j + 4, 2, pB0, pB1, mnB, alB, pA0, pA1, alA);
        TILE(j + 5, 0, pA0, pA1, mnA, alA, pB0, pB1, alB);
    }
    TILE(NT - 1, 1, pB0, pB1, mnB, alB, pA0, pA1, alA);
    finishSM(pB0, pB1, alB, l_reg, pa0, pa1, pa2, pa3); SBAR();
    pv_d0(o, vb0 + 1 * SHM_V, pa0, pa1, pa2, pa3);
    if (hi == 0) li_l[r32] = l_reg; asm volatile("s_waitcnt lgkmcnt(0)" ::: "memory");
    float rli[16];
#pragma unroll
    for (int r = 0; r < 16; ++r) rli[r] = __builtin_amdgcn_rcpf(li_l[crow(r, hi)]);
    bf16_t* Ow = Ob + (long)(wid * QBLK) * ldo;
    float myss = 0.f;
#pragma unroll
    for (int r = 0; r < 16; ++r) { const int orow = crow(r, hi); float sq = 0.f;
#pragma unroll
        for (int d0 = 0; d0 < 4; ++d0) { const float v = o[d0][r] * rli[r]; sq += v * v; Ow[(long)orow * ldo + d0 * 32 + r32] = (bf16_t)f2bf(v); }
        sq = dpp_sum8(sq);
        sq += __builtin_bit_cast(float, __builtin_amdgcn_update_dpp(0, __builtin_bit_cast(int, sq), 0x128, 0xF, 0xF, true));
        sq += __shfl_xor(sq, 16);
        if (r32 == r) myss = sq; }
    if (r32 < 16) ssq[wid * QBLK + crow(r32, hi)] = myss;
    asm volatile("s_waitcnt vmcnt(0) lgkmcnt(0)" ::: "memory"); __builtin_amdgcn_s_barrier(); asm volatile("" ::: "memory");
#undef DMA_K
#undef DMA_V
#undef TOP
#undef TILE
#undef RESC
}
}

namespace hg {
using att::crow; using att::v_st; using att::v_rd_base; using att::v_rd_off; using att::tr_read;
constexpr int L_QE = 0, L_QT = 16384, L_KT = 32768, L_OT = 120832  , L_KE = 73728, L_V = 90112, L_P = 106496, L_SEG = 114688, L_DV = 118784, L_GN = 119296  , L_END = 153600;
__device__ __forceinline__ int swzA(int row, int cb) { return row * 256 + (cb ^ ((row & 15) << 4) ^ (((row >> 4) & 1) << 3)); }
__device__ __forceinline__ int swzB(int row, int cb) { return row * 256 + (cb ^ ((row & 15) << 4)); }
__device__ __forceinline__ int swzP(int row, int cb) { return row * 128 + (cb ^ ((row & 7) << 4)); }
template <int D0> __device__ __forceinline__ void tr_frag4(int vb, bf16x8& f0, bf16x8& f1, bf16x8& f2, bf16x8& f3) {
    const s16x4 l0 = tr_read<v_rd_off(D0, 0, 0)>(vb), h0 = tr_read<v_rd_off(D0, 0, 1)>(vb), l1 = tr_read<v_rd_off(D0, 1, 0)>(vb), h1 = tr_read<v_rd_off(D0, 1, 1)>(vb);
    const s16x4 l2 = tr_read<v_rd_off(D0, 2, 0)>(vb), h2 = tr_read<v_rd_off(D0, 2, 1)>(vb), l3 = tr_read<v_rd_off(D0, 3, 0)>(vb), h3 = tr_read<v_rd_off(D0, 3, 1)>(vb);
    asm volatile("s_waitcnt lgkmcnt(0)" ::: "memory"); SBAR();
    f0 = PKLH(l0, h0); f1 = PKLH(l1, h1); f2 = PKLH(l2, h2); f3 = PKLH(l3, h3);
}
struct Pre { unsigned q2[8], l2[8], v2[8]; };
__device__ __forceinline__ void load_chunk(Pre& P, const bf16_t* pbase, int h, int dir, int cs, int seg, int dp) {
    const int cq = C_Q + h * 128 + 2 * dp, cf = C_FF + dir * 512 + h * 128 + 2 * dp, ci = C_I + h * 128 + 2 * dp;
#pragma unroll
    for (int i = 0; i < 8; ++i) { const int j = 8 * seg + i, pos = dir ? (64 * cs + 63 - j) : (64 * cs + j); const bf16_t* rp = pbase + (size_t)pos * DINP;
        P.q2[i] = *(const unsigned*)(rp + cq); P.l2[i] = *(const unsigned*)(rp + cf); P.v2[i] = *(const unsigned*)(rp + ci); }
}
__device__ __forceinline__ void stage_c(char* lds, f32x16 (&S)[4], f32x16 (&o)[2]  , _Float16* ofp  , int rstride  , bool second, int eb, int lane_, int part  ) {
    int lane = lane_; asm volatile("" : "+v"(lane));
    const int r32 = lane & 31, hi = lane >> 5;
    _Float16* p0 = ofp + r32 + 4 * hi * rstride;
    const int vbV = (int)(uintptr_t)(lds + L_V) + v_rd_base(lane) + eb * 512, vbK = (int)(uintptr_t)(lds + L_KE) + v_rd_base(lane);
    if (part == 0) {
#pragma unroll
    for (int db = 0; db < 4; ++db)
#pragma unroll
        for (int s = 0; s < 2; ++s) {
            u32x4 sw; sw.x = cvtpk(S[db][8 * s + 0], S[db][8 * s + 1]); sw.y = cvtpk(S[db][8 * s + 2], S[db][8 * s + 3]);
            sw.z = cvtpk(S[db][8 * s + 4], S[db][8 * s + 5]); sw.w = cvtpk(S[db][8 * s + 6], S[db][8 * s + 7]);
            const bf16x8 sf = __builtin_bit_cast(bf16x8, sw);
#pragma unroll
            for (int jb = 0; jb < 2; ++jb) { const int row = 32 * jb + r32, d0 = 32 * db + 16 * s + 4 * hi;
                const u32x2 a0 = *(const u32x2*)(lds + L_QE + swzA(row, d0 * 2)), a1 = *(const u32x2*)(lds + L_QE + swzA(row, (d0 + 8) * 2));
                const u32x4 aw = {a0.x, a0.y, a1.x, a1.y};
                o[jb] = __builtin_amdgcn_mfma_f32_32x32x16_bf16(__builtin_bit_cast(bf16x8, aw), sf, o[jb], 0, 0, 0); }
        }
    return; }
    bf16x8 vf0, vf1, vf2, vf3; tr_frag4<0>(vbV, vf0, vf1, vf2, vf3);
#define PFR(jb, ks) (*(const bf16x8*)(lds + L_P + swzP(32 * (jb) + r32, 32 * (ks) + 16 * hi)))
    o[0] = __builtin_amdgcn_mfma_f32_32x32x16_bf16(PFR(0, 0), vf0, o[0], 0, 0, 0);
    o[0] = __builtin_amdgcn_mfma_f32_32x32x16_bf16(PFR(0, 1), vf1, o[0], 0, 0, 0);
    o[1] = __builtin_amdgcn_mfma_f32_32x32x16_bf16(PFR(1, 0), vf0, o[1], 0, 0, 0);
    o[1] = __builtin_amdgcn_mfma_f32_32x32x16_bf16(PFR(1, 1), vf1, o[1], 0, 0, 0);
    o[1] = __builtin_amdgcn_mfma_f32_32x32x16_bf16(PFR(1, 2), vf2, o[1], 0, 0, 0);
    o[1] = __builtin_amdgcn_mfma_f32_32x32x16_bf16(PFR(1, 3), vf3, o[1], 0, 0, 0);
#undef PFR
    if (second) {
        float* ot = (float*)(lds + L_OT) + 32 * eb + r32 + 4 * hi * 128;
#pragma unroll
        for (int jb = 0; jb < 2; ++jb)
#pragma unroll
            for (int r = 0; r < 16; ++r) ot[(32 * jb + 8 * (r >> 2) + (r & 3)) * 128] = o[jb][r];
    } else {
#pragma unroll
        for (int jb = 0; jb < 2; ++jb)
#pragma unroll
            for (int g = 0; g < 4; ++g) { _Float16* pg = p0 + (32 * jb + 8 * g) * rstride;
#pragma unroll
                for (int e = 0; e < 4; ++e) pg[e * rstride] = (_Float16)o[jb][4 * g + e];
                asm volatile("" ::: "memory"); }
    }
    const float* dv = (const float*)(lds + L_DV);
#define SUPD(DB) do { bf16x8 k0_, k1_, k2_, k3_; tr_frag4<DB>(vbK, k0_, k1_, k2_, k3_); \
        { const float* dvp = dv + 32 * DB + 4 * hi; _Pragma("unroll") for (int g = 0; g < 4; ++g) { const f32x4 d4 = *(const f32x4*)(dvp + 8 * g); \
            S[DB][4 * g] *= d4[0]; S[DB][4 * g + 1] *= d4[1]; S[DB][4 * g + 2] *= d4[2]; S[DB][4 * g + 3] *= d4[3]; } } \
        S[DB] = __builtin_amdgcn_mfma_f32_32x32x16_bf16(k0_, vf0, S[DB], 0, 0, 0); S[DB] = __builtin_amdgcn_mfma_f32_32x32x16_bf16(k1_, vf1, S[DB], 0, 0, 0); \
        S[DB] = __builtin_amdgcn_mfma_f32_32x32x16_bf16(k2_, vf2, S[DB], 0, 0, 0); S[DB] = __builtin_amdgcn_mfma_f32_32x32x16_bf16(k3_, vf3, S[DB], 0, 0, 0); } while (0)
    SUPD(0); SUPD(1); SUPD(2); SUPD(3);
#undef SUPD
}
__device__ __forceinline__ void hgrn_bh(int b, int h, const bf16_t* proj, bf16_t* MIXp, const float* __restrict__ gain, char* lds, int wv) {
    int lane = lane_id(); asm volatile("" : "+v"(lane));
    const int wid = wv, tid = wv * 64 + lane, dp_ = lane, seg = wid;
    for (int i = tid; i < 8192 / 4; i += 512) ((unsigned*)(lds + L_P))[i] = 0u;
    f32x16 S[4] = {};
    const bf16_t* pbase = proj + (size_t)b * SEQ * DINP;
    float* segtot = (float*)(lds + L_SEG);
    if (tid < 128) ((float*)(lds + L_GN))[tid] = gain[tid];
    Pre pre; load_chunk(pre, pbase, h, 0, 0, seg, dp_);
    __syncthreads();
    const int cB = (4 * dp_) ^ ((seg & 1) << 7), cA = cB ^ (((seg >> 1) & 1) << 3), rowb = seg * 2048;
    const int gV = ((2 * dp_) >> 5) * 512 + ((2 * dp_) & 31) * 2, fVs = ((seg >> 1) << 1) * 2048 + ((seg & 1) << 2) * 64;
    const int drow = tid >> 3, dseg = tid & 7;
#define POST_SEGTOT() do { float a0_ = 0.f, a1_ = 0.f; \
        _Pragma("unroll") for (int t_ = 0; t_ < 8; ++t_) { const h16x2 hh_ = __builtin_bit_cast(h16x2, pre.l2[t_]); a0_ += (float)hh_[0]; a1_ += (float)hh_[1]; } \
        *(f32x2_t*)(segtot + seg * 128 + 2 * dp_) = (f32x2_t){a0_, a1_}; } while (0)
    POST_SEGTOT();
    asm volatile("s_waitcnt lgkmcnt(0)" ::: "memory"); __builtin_amdgcn_s_barrier(); asm volatile("" ::: "memory");
    for (int k = 0; k < 64; ++k) {
        const int i = k >> 1, dir = k & 1, cs = dir ? 31 - i : i; const bool second = (i >= 16);
        const long row0 = (long)b * SEQ + (dir ? 64 * cs + 63 : 64 * cs);
        const int rstride = dir ? -DINP : DINP; const bool mine = ((wid >> 2) == dir);
        _Float16* rawp = (_Float16*)proj + (size_t)row0 * DINP + C_CQ + h * 128 + 32 * (wid & 3);
        f32x16 o[2]; u32x4 gq0, gq1;
        if (second) {
            if (mine) { const _Float16* p0 = rawp + (lane & 31) + 4 * (lane >> 5) * rstride;
#pragma unroll
                for (int jb = 0; jb < 2; ++jb)
#pragma unroll
                    for (int r = 0; r < 16; ++r) o[jb][r] = (float)p0[(32 * jb + 8 * (r >> 2) + (r & 3)) * rstride]; }
            const long grow = row0 + (dir ? -drow : drow); const bf16_t* gp = proj + (size_t)grow * DINP + C_G + h * 128 + 16 * dseg;
            gq0 = *(const u32x4*)gp; gq1 = *(const u32x4*)(gp + 8);
        } else { o[0] = f32x16{}; o[1] = f32x16{}; }
        float run[2], tot[2], rr[2][4];
        { float a0 = 0.f, a1 = 0.f; run[0] = 0.f; run[1] = 0.f;
#pragma unroll
          for (int sg = 0; sg < 8; ++sg) { if (sg == seg) { run[0] = a0; run[1] = a1; } if ((sg & 1) == 0) { rr[0][sg >> 1] = a0; rr[1][sg >> 1] = a1; }
              const f32x2_t st = *(const f32x2_t*)(segtot + sg * 128 + 2 * dp_); a0 += st.x; a1 += st.y; }
          tot[0] = a0; tot[1] = a1; }
        const int I = seg >> 1;
        float rI[2], eI[2], eT[2], rat[2][4];
#pragma unroll
        for (int ch = 0; ch < 2; ++ch) { rI[ch] = (I == 0) ? rr[ch][0] : (I == 1) ? rr[ch][1] : (I == 2) ? rr[ch][2] : rr[ch][3];
            eI[ch] = __builtin_amdgcn_exp2f(rI[ch]); eT[ch] = __builtin_amdgcn_exp2f(tot[ch] - rI[ch]);
#pragma unroll
            for (int sg = 0; sg < 4; ++sg) rat[ch][sg] = __builtin_amdgcn_exp2f(fminf(rr[ch][sg] - rI[ch], 0.f)); }
        if (seg == 0) *(f32x2_t*)((float*)(lds + L_DV) + 2 * dp_) = (f32x2_t){__builtin_amdgcn_exp2f(tot[0]), __builtin_amdgcn_exp2f(tot[1])};
#pragma unroll
        for (int t = 0; t < 8; ++t) {
            const h16x2 hh = __builtin_bit_cast(h16x2, pre.l2[t]);
            float qe[2], qt[2], ke[2], kI[2];
#pragma unroll
            for (int ch = 0; ch < 2; ++ch) { const float q = ch ? bfhi(pre.q2[t]) : bflo(pre.q2[t]); const float lfv = (float)hh[ch];
                run[ch] += lfv; const float dlt = run[ch] - rI[ch];
                const float kk = 1.f - __builtin_amdgcn_exp2f(lfv);
                qt[ch] = q * __builtin_amdgcn_exp2f(dlt); qe[ch] = qt[ch] * eI[ch];
                kI[ch] = kk * __builtin_amdgcn_exp2f(fminf(-dlt, 115.f)); ke[ch] = kI[ch] * eT[ch]; }
            const int aB = (cB ^ (t << 4)) + rowb + t * 256, aA = (cA ^ (t << 4)) + rowb + t * 256, aV = gV + fVs + (t >> 2) * 2048 + (t & 3) * 64;
            *(unsigned*)(lds + L_QE + aA) = cvtpk(qe[0], qe[1]);
            *(unsigned*)(lds + L_QT + aB) = cvtpk(qt[0], qt[1]);
            *(unsigned*)(lds + L_KE + aV) = cvtpk(ke[0], ke[1]);
            *(unsigned*)(lds + L_V + aV) = pre.v2[t];
            if (I == 0) { *(unsigned*)(lds + L_KT + aB) = cvtpk(kI[0], kI[1]); *(unsigned*)(lds + L_KT + 16 * 256 + aB) = cvtpk(kI[0] * rat[0][1], kI[1] * rat[1][1]);
                          *(unsigned*)(lds + L_KT + 48 * 256 + aB) = cvtpk(kI[0] * rat[0][2], kI[1] * rat[1][2]); *(unsigned*)(lds + L_KT + 96 * 256 + aB) = cvtpk(kI[0] * rat[0][3], kI[1] * rat[1][3]); }
            else if (I == 1) { *(unsigned*)(lds + L_KT + 16 * 256 + aB) = cvtpk(kI[0], kI[1]);
                          *(unsigned*)(lds + L_KT + 48 * 256 + aB) = cvtpk(kI[0] * rat[0][2], kI[1] * rat[1][2]); *(unsigned*)(lds + L_KT + 96 * 256 + aB) = cvtpk(kI[0] * rat[0][3], kI[1] * rat[1][3]); }
            else if (I == 2) { *(unsigned*)(lds + L_KT + 48 * 256 + aB) = cvtpk(kI[0], kI[1]); *(unsigned*)(lds + L_KT + 96 * 256 + aB) = cvtpk(kI[0] * rat[0][3], kI[1] * rat[1][3]); }
            else { *(unsigned*)(lds + L_KT + 96 * 256 + aB) = cvtpk(kI[0], kI[1]); }
        }
        asm volatile("s_waitcnt lgkmcnt(0)" ::: "memory"); __builtin_amdgcn_s_barrier(); asm volatile("" ::: "memory");
        if (k + 1 < 64) { const int k1 = k + 1, i1 = k1 >> 1, d1 = k1 & 1; load_chunk(pre, pbase, h, d1, d1 ? 31 - i1 : i1, seg, dp_); }
        if (mine) stage_c(lds, S, o, rawp, rstride, second, wid & 3, lane, 0);
        else for (int blk = (wid & 3); blk < 10; blk += 4) {
            int bi, bjj; if (blk == 0) { bi = 0; bjj = 0; } else if (blk < 3) { bi = 1; bjj = blk - 1; } else if (blk < 6) { bi = 2; bjj = blk - 3; } else { bi = 3; bjj = blk - 6; }
            const int base = (bi == 0) ? 0 : (bi == 1) ? 16 : (bi == 2) ? 48 : 96;
            const int xm = ((lane & 15) << 4), cq4 = 16 * (lane >> 4);
            const char* ap = lds + L_QT + (16 * bi + (lane & 15)) * 256; const char* bp = lds + L_KT + (base + 16 * bjj + (lane & 15)) * 256;
            bf16x8 av[4], bv[4];
#pragma unroll
            for (int ks = 0; ks < 4; ++ks) { const int cb = (64 * ks + cq4) ^ xm; av[ks] = *(const bf16x8*)(ap + cb); bv[ks] = *(const bf16x8*)(bp + cb); }
            f32x4 acc = {0.f, 0.f, 0.f, 0.f};
#pragma unroll
            for (int ks = 0; ks < 4; ++ks) acc = __builtin_amdgcn_mfma_f32_16x16x32_bf16(av[ks], bv[ks], acc, 0, 0, 0);
            const int sl = lane & 15;
#pragma unroll
            for (int r = 0; r < 4; ++r) { const int jl = (lane >> 4) * 4 + r; const float v = (bi != bjj || sl <= jl) ? acc[r] : 0.f;
                *(bf16_t*)(lds + L_P + swzP(16 * bi + jl, (16 * bjj + sl) * 2)) = (bf16_t)(cvtpk(v, v) & 0xffffu); }
        }
        asm volatile("s_waitcnt lgkmcnt(0)" ::: "memory"); __builtin_amdgcn_s_barrier(); asm volatile("" ::: "memory");
        if (mine) stage_c(lds, S, o, rawp, rstride, second, wid & 3, lane, 1);
        if (k + 1 < 64) POST_SEGTOT();
        if (k == 31) asm volatile("s_waitcnt vmcnt(0)" ::: "memory");
        asm volatile("s_waitcnt lgkmcnt(0)" ::: "memory"); __builtin_amdgcn_s_barrier(); asm volatile("" ::: "memory");
        if (second) {
            const float* otp = (const float*)(lds + L_OT) + drow * 128 + 16 * dseg;
            f32x4 v[4]; float ss = 0.f;
#pragma unroll
            for (int q = 0; q < 4; ++q) { v[q] = *(const f32x4*)(otp + 4 * q); ss += (v[q][0] * v[q][0] + v[q][1] * v[q][1]) + (v[q][2] * v[q][2] + v[q][3] * v[q][3]); }
            ss = dpp_sum8(ss);
            const float r = __builtin_amdgcn_rsqf(ss * (1.f / 128.f) + EPS);
            f32x4 gn[4];
#pragma unroll
            for (int q = 0; q < 4; ++q) gn[q] = *(const f32x4*)((const float*)(lds + L_GN) + 16 * dseg + 4 * q);
            const unsigned gw[8] = {gq0.x, gq0.y, gq0.z, gq0.w, gq1.x, gq1.y, gq1.z, gq1.w}; unsigned ow[8];
#pragma unroll
            for (int q = 0; q < 8; ++q) { const float g0 = bflo(gw[q]), g1 = bfhi(gw[q]);
                const float s0 = g0 * __builtin_amdgcn_rcpf(1.f + __builtin_amdgcn_exp2f(-1.4426950408889634f * g0)), s1 = g1 * __builtin_amdgcn_rcpf(1.f + __builtin_amdgcn_exp2f(-1.4426950408889634f * g1));
                ow[q] = cvtpk(v[q >> 1][2 * (q & 1)] * r * gn[q >> 1][2 * (q & 1)] * s0, v[q >> 1][2 * (q & 1) + 1] * r * gn[q >> 1][2 * (q & 1) + 1] * s1); }
            const long grow = row0 + (dir ? -drow : drow); bf16_t* mp = MIXp + (size_t)grow * DM + 512 + h * 128 + 16 * dseg;
            *(u32x4*)mp = (u32x4){ow[0], ow[1], ow[2], ow[3]}; *(u32x4*)(mp + 8) = (u32x4){ow[4], ow[5], ow[6], ow[7]};
        }
    }
    __syncthreads();
}
}

#define XB_TMO      128
#define XB_XCNT(j)  (256  + 64 * (j))
#define XB_XSUB(j)  (1280 + 64 * (j))
#define XB_XGEN(j)  (2304 + 64 * (j))
#define XB_TOP      3328
#define XB_TOPGEN   3392
#define XCD_BAR_WORDS 3456
#define XB_SPIN_CAP (1u << 18)

__device__ __forceinline__ unsigned xb_ld(unsigned* p)              { return __hip_atomic_load(p, __ATOMIC_RELAXED, __HIP_MEMORY_SCOPE_AGENT); }
__device__ __forceinline__ unsigned xb_add(unsigned* p, unsigned v) { return __hip_atomic_fetch_add(p, v, __ATOMIC_RELAXED, __HIP_MEMORY_SCOPE_AGENT); }
__device__ __forceinline__ unsigned xb_xcc_id() { return (unsigned)__builtin_amdgcn_s_getreg((3 << 11) | 20) & 0xFu; }
#define XB_SPIN(cond, bar) do { unsigned _sp = 0; while (cond) { __builtin_amdgcn_s_sleep(1); \
    if ((++_sp & 255u) == 0u) { if (xb_ld(&(bar)[XB_TMO])) break; if (_sp > XB_SPIN_CAP) { atomicAdd(&(bar)[XB_TMO], 1u); break; } } } } while (0)

struct XcdBarrier {
    unsigned* bar; unsigned x;
    volatile LAS unsigned* st;
};

__device__ __forceinline__ XcdBarrier xcd_barrier_post(unsigned* bar, volatile LAS unsigned* st, bool leader  ) {
    XcdBarrier b; b.bar = bar; b.x = xb_xcc_id(); b.st = st;
    if (leader) (void)xb_add(&bar[XB_XCNT(b.x)], 1u);
    return b;
}
__device__ __forceinline__ void xcd_barrier_complete(unsigned* bar, unsigned x, unsigned& nloc, unsigned& nx) {
    const unsigned G = gridDim.x * gridDim.y * gridDim.z;
    unsigned sum, cnt, mine, sp = 0u;
    for (;;) {
        sum = 0u; cnt = 0u; mine = 0u;
#pragma unroll
        for (unsigned j = 0; j < 16; ++j) { const unsigned c = xb_ld(&bar[XB_XCNT(j)]); sum += c; cnt += (c > 0u) ? 1u : 0u; mine = (j == x) ? c : mine; }
        if (sum == G) break;
        __builtin_amdgcn_s_sleep(1);
        if ((++sp & 255u) == 0u) { if (xb_ld(&bar[XB_TMO])) break; if (sp > XB_SPIN_CAP) { atomicAdd(&bar[XB_TMO], 1u); break; } }
    }
    nloc = mine > 0u ? mine : 1u; nx = cnt > 0u ? cnt : 1u;
}

__device__ __forceinline__ void xcd_barrier(const XcdBarrier& b, bool leader  ) {
    asm volatile("s_waitcnt vmcnt(0)" ::: "memory");
    __syncthreads();
    if (leader) {
        unsigned* bar = b.bar;
        __builtin_amdgcn_s_waitcnt(0);
        unsigned nloc = b.st[0], nx = b.st[1];
        if (nloc == 0u) { xcd_barrier_complete(bar, b.x, nloc, nx); b.st[0] = nloc; b.st[1] = nx; }
        const unsigned old = xb_add(&bar[XB_XSUB(b.x)], 1u);
        const unsigned gen = old / nloc;
        if (old + 1u == (gen + 1u) * nloc) {
            __builtin_amdgcn_fence(__ATOMIC_RELEASE, "agent");
            asm volatile("s_waitcnt vmcnt(0)" ::: "memory");
            const unsigned og = xb_add(&bar[XB_TOP], 1u);
            const unsigned tg = og / nx;
            if (og + 1u == (tg + 1u) * nx) xb_add(&bar[XB_TOPGEN], 1u);
            else XB_SPIN(xb_ld(&bar[XB_TOPGEN]) == tg, bar);
            __builtin_amdgcn_fence(__ATOMIC_ACQUIRE, "agent");
            xb_add(&bar[XB_XGEN(b.x)], 1u);
            asm volatile("s_waitcnt vmcnt(0)" ::: "memory");
        } else {
            XB_SPIN(xb_ld(&bar[XB_XGEN(b.x)]) == gen, bar);
            __builtin_amdgcn_fence(__ATOMIC_ACQUIRE, "agent");
            asm volatile("s_waitcnt vmcnt(0)" ::: "memory");
        }
    }
    __syncthreads();
}


constexpr int NWAVES = 8;
constexpr int LDS_BYTES = 160 * 1024;
constexpr int RING_BYTES = 131072, EPI_OFF = RING_BYTES  , TAB_OFF = RING_BYTES + 8192  , MISC_OFF = 160 * 1024 - 1024;
constexpr size_t CTL_ZERO_BYTES = 65536;
struct Args { const float* in[17]; float* out; unsigned char* ws; int ph_lo, ph_hi; };

__device__ __forceinline__ int rope_perm(int cp) { const int i = cp >> 3, j = cp & 7; return (j < 4) ? 4 * i + j : 32 + 4 * i + (j - 4); }
__device__ __forceinline__ void tr_item(const float* W, int ldw, int ksrc0, int srccol, const float* gain, int goff, bf16_t* WT, int Kd, int kd0, int nd0, LAS float* scr, int lane) {
    float wv_[32], gv_[32];
#pragma unroll
    for (int i = 0; i < 32; ++i) { const int kk = 2 * i + (lane >> 5); wv_[i] = (srccol >= 0) ? W[(size_t)(ksrc0 + kk) * ldw + srccol] : 0.f; gv_[i] = gain ? gain[ksrc0 + kk - goff] : 1.f; }
#pragma unroll
    for (int i = 0; i < 32; ++i) { const int kk = 2 * i + (lane >> 5); scr[kk * 33 + (lane & 31)] = wv_[i] * gv_[i]; }
    asm volatile("s_waitcnt lgkmcnt(0)" ::: "memory");
    const int c = lane & 7;
#pragma unroll
    for (int j = 0; j < 4; ++j) { const int n = (lane >> 3) + 8 * j; const LAS float* sp = scr + (8 * c) * 33 + n;
        u32x4 o; o.x = pk2(sp[0 * 33], sp[1 * 33]); o.y = pk2(sp[2 * 33], sp[3 * 33]); o.z = pk2(sp[4 * 33], sp[5 * 33]); o.w = pk2(sp[6 * 33], sp[7 * 33]);
        *(u32x4*)(WT + (size_t)(nd0 + n) * Kd + kd0 + 8 * c) = o; }
    asm volatile("s_waitcnt lgkmcnt(0)" ::: "memory");
}
template <int R>
__device__ __forceinline__ void rows_to_bf16_rs(const float* x0, bf16_t* o0, float* rs0, size_t rstep, int lane) {
    f32x4 v[R][4]; float s[R];
#pragma unroll
    for (int r = 0; r < R; ++r) { const f32x4* xr = (const f32x4*)(x0 + (size_t)r * rstep * DM) + lane;
#pragma unroll
        for (int j = 0; j < 4; ++j) v[r][j] = xr[64 * j]; }
#pragma unroll
    for (int r = 0; r < R; ++r) { float a = 0.f;
#pragma unroll
        for (int j = 0; j < 4; ++j) a += (v[r][j].x * v[r][j].x + v[r][j].y * v[r][j].y) + (v[r][j].z * v[r][j].z + v[r][j].w * v[r][j].w);
        s[r] = a; }
#pragma unroll
    for (int o = 1; o < 64; o <<= 1) {
#pragma unroll
        for (int r = 0; r < R; ++r) s[r] += __shfl_xor(s[r], o); }
#pragma unroll
    for (int r = 0; r < R; ++r) { if (lane == 0) rs0[(size_t)r * rstep] = 1.f / sqrtf(s[r] * (1.f / DM) + EPS);
        u32x2* o8 = (u32x2*)(o0 + (size_t)r * rstep * DM) + lane;
#pragma unroll
        for (int j = 0; j < 4; ++j) { u32x2 w; w.x = cvtpk(v[r][j].x, v[r][j].y); w.y = cvtpk(v[r][j].z, v[r][j].w); o8[64 * j] = w; } }
}
__device__ __forceinline__ void sincos_acc(float ang, float& c, float& s) {
    const double x = (double)ang; const double kq = __builtin_rint(x * 0.6366197723675814); const double y = x - kq * 1.5707963267948966 - kq * 6.123233995736766e-17;
    const double y2 = y * y;
    double sp = -7.6471637318198164759e-13; sp = sp * y2 + 1.6059043836821614599e-10; sp = sp * y2 - 2.5052108385441718775e-8; sp = sp * y2 + 2.7557319223985890653e-6; sp = sp * y2 - 1.9841269841269841270e-4; sp = sp * y2 + 8.3333333333333333333e-3; sp = sp * y2 - 1.6666666666666666667e-1; sp = y + y * y2 * sp;
    double cp = 4.7794773323873852974e-14; cp = cp * y2 - 1.1470745597729724714e-11; cp = cp * y2 + 2.0876756987868098979e-9; cp = cp * y2 - 2.7557319223985890653e-7; cp = cp * y2 + 2.4801587301587301587e-5; cp = cp * y2 - 1.3888888888888888889e-3; cp = cp * y2 + 4.1666666666666666667e-2; cp = cp * y2 - 0.5; cp = 1.0 + y2 * cp;
    const int q = ((int)(long long)kq) & 3;
    const double sv = (q == 0) ? sp : (q == 1) ? cp : (q == 2) ? -sp : -cp;
    const double cv = (q == 0) ? cp : (q == 1) ? -sp : (q == 2) ? -cp : sp;
    c = (float)cv; s = (float)sv;
}

__global__ void __launch_bounds__(NWAVES * 64, 2) mk_fwd(Args args) {
    extern __shared__ __attribute__((aligned(16))) unsigned char lds[];
    const int g_wv = __builtin_amdgcn_readfirstlane(threadIdx.x >> 6);
#define TIDV() ({ int t_ = g_wv * 64 + lane_id(); asm volatile("" : "+v"(t_)); t_; })
    const int G = gridDim.x, bx = blockIdx.x;
    unsigned char* ws = args.ws;
    const float* x = args.in[0]; const int* positions = (const int*)args.in[1];
    const float* g_mix = args.in[2]; const float* w_in = args.in[3]; const float* lb_param = args.in[4]; const float* g_hgrn = args.in[5];
    const float* g_cq = args.in[6]; const float* w_q_up = args.in[7]; const float* g_ckv = args.in[8]; const float* w_kv_up = args.in[9];
    const float* g_qn = args.in[10]; const float* g_kn = args.in[11]; const float* g_mla_out = args.in[12]; const float* w_out = args.in[13];
    const float* g_ffn = args.in[14]; const float* w_up = args.in[15]; const float* w_down = args.in[16];
    float* out = args.out;
    float* RS0 = (float*)(ws + WS_RS0); float* SSQ1 = (float*)(ws + WS_SSQ1); float* SSQP = (float*)(ws + WS_SSQP); float* GQT = (float*)(ws + WS_GQT); float* GKT = (float*)(ws + WS_GKT); float* LBT = (float*)(ws + WS_LBT);
    float* COS = (float*)(ws + WS_COS); float* SIN = (float*)(ws + WS_SIN);
    bf16_t* WIN = (bf16_t*)(ws + WS_WIN); bf16_t* WQ = (bf16_t*)(ws + WS_WQ); bf16_t* WKV = (bf16_t*)(ws + WS_WKV); bf16_t* WOUT = (bf16_t*)(ws + WS_WOUT);
    bf16_t* WUP = (bf16_t*)(ws + WS_WUP); bf16_t* WDN = (bf16_t*)(ws + WS_WDN);
    bf16_t* XB = (bf16_t*)(ws + WS_XB); bf16_t* VB = (bf16_t*)(ws + WS_V); bf16_t* X1B = (bf16_t*)(ws + WS_X1B);
    bf16_t* PROJ = (bf16_t*)(ws + WS_PROJ); bf16_t* HB = (bf16_t*)(ws + WS_HB);
    bf16_t* MIX = (bf16_t*)(ws + WS_MIX); float* SSQA = (float*)(ws + WS_SSQA);
    bf16_t* QB = (bf16_t*)(ws + WS_Q); bf16_t* KB = (bf16_t*)(ws + WS_K);
    const int lo = args.ph_lo, hi = args.ph_hi;
    cooperative_groups::grid_group grid = cooperative_groups::this_grid();
    volatile LAS unsigned* MISC = (volatile LAS unsigned*)((LAS unsigned char*)lds + MISC_OFF);
    { const int tid = TIDV(); if (tid < 32) MISC[tid] = 0u; }
    __syncthreads();
    XcdBarrier bar = xcd_barrier_post((unsigned*)(ws + WS_CTL) + 4096, MISC + 8, TIDV() == 0);
    if (args.ph_hi > 1000) grid.sync();
#define SEAM(k) do { if (lo <= (k) && (k) + 1 < hi) xcd_barrier(bar, TIDV() == 0); } while (0)
#ifndef PHMASK
#define PHMASK 0xFFF
#endif
#define IN(k) (((PHMASK >> (k)) & 1) && lo <= (k) && (k) < hi)
#ifndef REPMASK
#define REPMASK 0
#endif
#define REPS(k) for (int rep_ = 0; rep_ < ((((REPMASK) >> (k)) & 1) ? 2 : 1); ++rep_)

    if (IN(0)) REPS(0) {
        const int tid = TIDV(), lane = tid & 63, wave = g_wv;
        const int vcu = (G % 8 == 0) ? (bx % 8) * (G / 8) + bx / 8 : bx;
        const int gw = vcu * NWAVES + wave, NGW = G * NWAVES;
        LAS float* scr = (LAS float*)((LAS unsigned char*)lds + wave * 16384);
        constexpr int I_IN = 16 * 104, I_Q = 6 * 32, I_KV = 4 * 32, I_OUT = 16 * 32, I_UP = 16 * 128, I_DN = 64 * 32;
        constexpr int NITEMS = I_IN + I_Q + I_KV + I_OUT + I_UP + I_DN;
        const int l31 = lane & 31;
        for (int it = gw; it < NITEMS; it += NGW) {
            int r = it;
            if (r < I_IN) { const int kb = r / 104, nb = r % 104, nd = 32 * nb + l31; const int sc = nd < C_KR ? nd : (nd < DIN ? C_KR + rope_perm(nd - C_KR) : -1);
                tr_item(w_in, DIN, 64 * kb, sc, g_mix, 0, WIN, DM, 64 * kb, 32 * nb, scr, lane); continue; } r -= I_IN;
            if (r < I_Q) { const int kb = r / 32, nb = r % 32, nd = 32 * nb + l31, hh = nd >> 8, c = nd & 255; const int sc = c < 128 ? hh * 192 + c : (c < 192 ? hh * 192 + 128 + rope_perm(c - 128) : -1);
                tr_item(w_q_up, NQ, 64 * kb, sc, g_cq, 0, WQ, QLORA, 64 * kb, 32 * nb, scr, lane); continue; } r -= I_Q;
            if (r < I_KV) { const int kb = r / 32, nb = r % 32; tr_item(w_kv_up, NKV, 64 * kb, 32 * nb + l31, g_ckv, 0, WKV, KVLORA, 64 * kb, 32 * nb, scr, lane); continue; } r -= I_KV;
            if (r < I_OUT) { const int kb = r / 32, nb = r % 32; const int kd0 = 64 * kb, ks0 = kd0 < 512 ? kd0 + 512 : kd0 - 512;
                tr_item(w_out, DM, ks0, 32 * nb + l31, kd0 < 512 ? g_mla_out : nullptr, 512, WOUT, DM, kd0, 32 * nb, scr, lane); continue; } r -= I_OUT;
            if (r < I_UP) { const int kb = r / 128, nb = r % 128; tr_item(w_up, DFF, 64 * kb, 32 * nb + l31, g_ffn, 0, WUP, DM, 64 * kb, 32 * nb, scr, lane); continue; } r -= I_UP;
            { const int kb = r / 32, nb = r % 32; tr_item(w_down, DM, 64 * kb, 32 * nb + l31, nullptr, 0, WDN, DFF, 64 * kb, 32 * nb, scr, lane); }
        }
        for (int i = bx * 512 + tid; i < 512; i += G * 512) ((float*)(ws + WS_GHT))[i] = g_hgrn[i];
        for (int i = bx * 512 + tid; i < 512; i += G * 512) {
            if (i < 256) GQT[i] = i < 128 ? g_qn[i] * QSCALE : (i < 192 ? g_qn[128 + rope_perm(i - 128)] * QSCALE : 0.f);
            else { const int c = i - 256; if (c < 192) GKT[c] = c < 128 ? g_kn[c] : g_kn[128 + rope_perm(c - 128)]; } }
        for (int m = gw; m < M; m += 4 * NGW) rows_to_bf16_rs<4>(x + (size_t)m * DM, XB + (size_t)m * DM, RS0 + m, (size_t)NGW, lane);
        for (int i = bx * 512 + tid; i < 1024; i += G * 512) { const int dir = i >> 9, c = i & 511; const float p0 = lb_param[dir * 1024 + c], p1 = lb_param[dir * 1024 + 512 + c];
            LBT[i] = 1.f / (1.f + expf(p1 - p0)); }
        { const int j = tid & 31; const float invf = powf(10000.0f, -(float)(2 * j) / 64.0f);
          for (int i = bx * 512 + tid; i < M * 32; i += G * 512) { const int row = i >> 5; const float ang = (float)positions[row] * invf; float c, sn; sincos_acc(ang, c, sn); COS[i] = c; SIN[i] = sn; } }
    }
    SEAM(0);
    if (IN(1)) REPS(1) {
        pg8::Gemm g{XB, WIN, M, DINP, DM, DM}; pg8::StaticOrder S; S.init(M, DINP, G, bx);
        LAS float* rsT = (LAS float*)((LAS unsigned char*)lds + TAB_OFF);
        for (int ui = 0; ui < 16; ++ui) { pg8::Unit uu; if (!S.next(ui, uu)) break; const int tid = TIDV(); if (tid < 256) rsT[ui * 256 + tid] = RS0[uu.pm * 256 + tid]; }
        __syncthreads();
        pg8::EpiProj E{PROJ, DINP, rsT, LBT, SSQP, M, (LAS float*)((LAS unsigned char*)lds + EPI_OFF)};
        pg8::gemm_phase<pg8::EpiProj, pg8::StaticOrder, true, true>((LAS unsigned char*)lds, g, S, E, g_wv);
    }
    SEAM(1);
    if (IN(2)) REPS(2) {
        pg8::Gemm g{PROJ + C_CQ, WQ, M, 1024, QLORA, DINP}; pg8::StaticOrder S; S.init(M, 1024, G, bx);
        LAS float* rsT = (LAS float*)((LAS unsigned char*)lds + TAB_OFF);
        for (int ui = 0; ui < 4; ++ui) { pg8::Unit uu; if (!S.next(ui, uu)) break;
            const int tid = TIDV(); if (tid < 256) { const int row = uu.pm * 256 + tid; rsT[ui * 256 + tid] = __builtin_amdgcn_rsqf(((SSQP[row] + SSQP[M + row]) + SSQP[2 * (size_t)M + row]) * (1.f / 384.f) + EPS); } }
        __syncthreads();
        pg8::EpiQ E{QB, rsT, GQT, COS, SIN, (LAS float*)((LAS unsigned char*)lds + EPI_OFF)};
        pg8::gemm_phase<pg8::EpiQ, pg8::StaticOrder, true, true>((LAS unsigned char*)lds, g, S, E, g_wv);
    }
    if (IN(3)) REPS(3) {
        pg8::Gemm g{PROJ + C_CKV, WKV, M, NKV, KVLORA, DINP}; pg8::StaticOrder S; S.init(M, NKV, G, bx);
        LAS float* rsT = (LAS float*)((LAS unsigned char*)lds + TAB_OFF + 8192); LAS float* skT = rsT + 1024;
        for (int ui = 0; ui < 4; ++ui) { pg8::Unit uu; if (!S.next(ui, uu)) break;
            const int tid = TIDV(); if (tid < 256) { const int row = uu.pm * 256 + tid; rsT[ui * 256 + tid] = __builtin_amdgcn_rsqf((SSQP[3 * (size_t)M + row] + SSQP[4 * (size_t)M + row]) * (1.f / 256.f) + EPS); skT[ui * 256 + tid] = SSQP[5 * (size_t)M + row]; } }
        __syncthreads();
        pg8::EpiKV E{KB, VB, PROJ, DINP, C_KR, rsT, skT, GKT, COS, SIN, (LAS float*)((LAS unsigned char*)lds + EPI_OFF)};
        pg8::gemm_phase<pg8::EpiKV, pg8::StaticOrder, true, true>((LAS unsigned char*)lds, g, S, E, g_wv);
    }
    SEAM(4);
    if (IN(5)) {
        if (bx < BATCH * 4) hg::hgrn_bh(bx >> 2, bx & 3, PROJ, MIX, (const float*)(ws + WS_GHT) + (bx & 3) * 128, (char*)lds, g_wv);
        unsigned* ctr = (unsigned*)(ws + WS_CTL) + 64;
        for (;;) {
            __syncthreads();
            if (TIDV() == 0) MISC[16] = __hip_atomic_fetch_add(ctr, 1u, __ATOMIC_RELAXED, __HIP_MEMORY_SCOPE_AGENT);
            __syncthreads();
            const unsigned u = MISC[16];
            if (u >= (unsigned)(BATCH * 4 * 8)) break;
            const int bh = u >> 3, qb = u & 7, b = bh >> 2, h = bh & 3;
            att::attn_unit(QB + ((size_t)bh * SEQ + qb * 256) * 192, KB + (size_t)bh * SEQ * 192, VB + (size_t)bh * SEQ * 128,
                           MIX + ((size_t)b * SEQ + qb * 256) * DM + h * 128, DM, SSQA + (size_t)h * M + (size_t)b * SEQ + qb * 256, SEQ, (char*)lds, g_wv);
        }
    }
    SEAM(7);
    if (IN(8)) REPS(8) {
        pg8::Gemm g{MIX, WOUT, M, DM, DM, DM}; pg8::StaticOrder S; S.init(M, DM, G, bx);
        LAS float* rsbT = (LAS float*)((LAS unsigned char*)lds + EPI_OFF + 4096);
        for (int ui = 0; ui < 4; ++ui) { pg8::Unit uu; if (!S.next(ui, uu)) break;
            const int tid = TIDV(); if (tid < 256) { const int row = uu.pm * 256 + tid; rsbT[ui * 256 + tid] = 1.f / sqrtf(((SSQA[row] + SSQA[M + row]) + (SSQA[2 * (size_t)M + row] + SSQA[3 * (size_t)M + row])) * (1.f / 512.f) + EPS); } }
        __syncthreads();
        pg8::EpiResidX1 E{XB, X1B, SSQ1, DM, M, (LAS float*)((LAS unsigned char*)lds + EPI_OFF), rsbT};
        pg8::gemm_phase<pg8::EpiResidX1, pg8::StaticOrder, true, true>((LAS unsigned char*)lds, g, S, E, g_wv);
    }
    SEAM(8);
    if (IN(10)) REPS(10) {
        pg8::Gemm g{X1B, WUP, M, DFF, DM, DM}; pg8::StaticOrder S; S.init(M, DFF, G, bx);
        LAS float* rsT = (LAS float*)((LAS unsigned char*)lds + TAB_OFF);
        for (int ui = 0; ui < 16; ++ui) { pg8::Unit uu; if (!S.next(ui, uu)) break;
            const int tid = TIDV(); if (tid < 256) { const int row = uu.pm * 256 + tid; rsT[ui * 256 + tid] = __builtin_amdgcn_rsqf(((SSQ1[row] + SSQ1[M + row]) + (SSQ1[2 * (size_t)M + row] + SSQ1[3 * (size_t)M + row])) * (1.f / 1024.f) + EPS); } }
        __syncthreads();
        pg8::EpiUp E{HB, DFF, rsT};
        pg8::gemm_phase<pg8::EpiUp, pg8::StaticOrder, true, true>((LAS unsigned char*)lds, g, S, E, g_wv);
    }
    SEAM(10);
    if (IN(11)) {
        pg8::Gemm g{HB, WDN, M, DM, DFF, DFF}; pg8::StaticOrder S; S.init(M, DM, G, bx);
        pg8::EpiResidBf E{X1B, out, DM};
        pg8::gemm_phase<pg8::EpiResidBf, pg8::StaticOrder, true, true>((LAS unsigned char*)lds, g, S, E, g_wv);
    }
#undef IN
}

extern "C" void kernel_launch(void* const* d_in, const int* in_sizes, int n_in, void* d_out, int out_size, void* d_ws, size_t ws_size, hipStream_t stream) {
    static int ok = 0, grid_blocks = 0;
    if (ok == 0) {
        if (n_in != 17 || in_sizes[0] != M * DM || out_size != M * DM || ws_size < WS_END) {
            fprintf(stderr, "kernel_launch: shape mismatch n_in %d in0 %d out %d ws %zu (need %zu)\n", n_in, n_in > 0 ? in_sizes[0] : -1, out_size, ws_size, (size_t)WS_END); ok = -1; return; }
        if (hipFuncSetAttribute((const void*)mk_fwd, hipFuncAttributeMaxDynamicSharedMemorySize, LDS_BYTES) != hipSuccess) { fprintf(stderr, "kernel_launch: hipFuncSetAttribute failed\n"); ok = -1; return; }
        int dev = 0, cus = 0, per_cu = 0;
        (void)hipGetDevice(&dev); (void)hipDeviceGetAttribute(&cus, hipDeviceAttributeMultiprocessorCount, dev);
        (void)hipOccupancyMaxActiveBlocksPerMultiprocessor(&per_cu, (const void*)mk_fwd, NWAVES * 64, LDS_BYTES);
        if (per_cu < 1 || cus < 1) { fprintf(stderr, "kernel_launch: occupancy query gave %d blocks/CU on %d CUs\n", per_cu, cus); ok = -1; return; }
        grid_blocks = cus * (per_cu > 1 ? 1 : per_cu);
        ok = 1;
    }
    if (ok < 0) return;
    (void)hipMemsetAsync((char*)d_ws + WS_CTL, 0, CTL_ZERO_BYTES, stream);
    Args a{};
    for (int i = 0; i < 17; ++i) a.in[i] = (const float*)d_in[i];
    a.out = (float*)d_out; a.ws = (unsigned char*)d_ws;
    a.ph_lo = 0; a.ph_hi = 12;
    void* kargs[] = {&a};
    (void)hipLaunchCooperativeKernel((const void*)mk_fwd, dim3(grid_blocks), dim3(NWAVES * 64), kargs, LDS_BYTES, stream);
    const hipError_t le = hipPeekAtLastError();
    if (le != hipSuccess) fprintf(stderr, "kernel_launch: launch failed: %s\n", hipGetErrorName(le));
}
```

```cpp
#include <hip/hip_runtime.h>
#include <hip/hip_cooperative_groups.h>
#include <cstdio>
#include <cstdint>

#define LAS __attribute__((address_space(3)))
typedef unsigned short bf16_t;
typedef short bf16x8 __attribute__((ext_vector_type(8)));
typedef short s16x4 __attribute__((ext_vector_type(4)));
typedef float f32x4 __attribute__((ext_vector_type(4)));
typedef float f32x16 __attribute__((ext_vector_type(16)));
typedef unsigned u32x4 __attribute__((ext_vector_type(4)));
typedef unsigned u32x2 __attribute__((ext_vector_type(2)));
typedef _Float16 h16x2 __attribute__((ext_vector_type(2)));

constexpr int BATCH = 32, SEQ = 2048, DM = 1024, M = BATCH * SEQ;
constexpr int DIN = 3264, DINP = 3328, DFF = 4096;
constexpr int C_Q = 0, C_FF = 512, C_I = 1536, C_G = 2048, C_CQ = 2560, C_CKV = 2944, C_KR = 3200;
constexpr int QLORA = 384, KVLORA = 256, NQ = 768, NKV = 1024;
constexpr float EPS = 1e-6f;
constexpr float QSCALE = 0.07216878364870322f * 1.4426950408889634f;

constexpr size_t MiB = 1u << 20;
constexpr size_t WS_CTL = 0;
constexpr size_t WS_RS0 = 1 * MiB, WS_RS1 = WS_RS0 + 256 * 1024, WS_LBT = WS_RS1 + 256 * 1024;
constexpr size_t WS_COS = 2 * MiB, WS_SIN = 10 * MiB;
constexpr size_t WS_WIN = 18 * MiB, WS_WQ = 25 * MiB, WS_WKV = 26 * MiB, WS_WOUT = 27 * MiB, WS_WUP = 29 * MiB, WS_WDN = 37 * MiB;
constexpr size_t WS_GQT = WS_LBT + 4096, WS_GKT = WS_GQT + 1024, WS_GHT = WS_GKT + 1024;
constexpr size_t WS_SSQ1 = 45 * MiB;
constexpr size_t WS_XB = 46 * MiB;
constexpr size_t WS_X1B = 718 * MiB;
constexpr size_t WS_PROJ = 174 * MiB;
constexpr size_t WS_HB = 174 * MiB;
constexpr size_t WS_MIX = 590 * MiB;
constexpr size_t WS_Q = 718 * MiB, WS_K = 814 * MiB, WS_V = 910 * MiB;
constexpr size_t WS_SSQP = 974 * MiB;
constexpr size_t WS_SSQA = 976 * MiB;
constexpr size_t WS_END = 977 * MiB;

__device__ __forceinline__ unsigned f2bf(float f) { unsigned u = __builtin_bit_cast(unsigned, f); return (u + 0x7fffu + ((u >> 16) & 1u)) >> 16; }
__device__ __forceinline__ unsigned pk2(float lo, float hi) { return f2bf(lo) | (f2bf(hi) << 16); }
__device__ __forceinline__ float bf2f(unsigned short b) { return __builtin_bit_cast(float, (unsigned)b << 16); }
__device__ __forceinline__ float bflo(unsigned w) { return __builtin_bit_cast(float, w << 16); }
__device__ __forceinline__ float bfhi(unsigned w) { return __builtin_bit_cast(float, w & 0xffff0000u); }
__device__ __forceinline__ float wave_sum(float v) {
#pragma unroll
    for (int o = 1; o < 64; o <<= 1) v += __shfl_xor(v, o);
    return v;
}
__device__ __forceinline__ int lane_id() { int l; asm volatile("v_mbcnt_lo_u32_b32 %0, -1, 0\n\tv_mbcnt_hi_u32_b32 %0, -1, %0" : "=v"(l)); return l; }
__device__ __forceinline__ float dpp_sum8(float v) {
    v += __builtin_bit_cast(float, __builtin_amdgcn_update_dpp(0, __builtin_bit_cast(int, v), 0xB1, 0xF, 0xF, true));
    v += __builtin_bit_cast(float, __builtin_amdgcn_update_dpp(0, __builtin_bit_cast(int, v), 0x4E, 0xF, 0xF, true));
    v += __builtin_bit_cast(float, __builtin_amdgcn_update_dpp(0, __builtin_bit_cast(int, v), 0x141, 0xF, 0xF, true));
    return v;
}
typedef float f32x2_t __attribute__((ext_vector_type(2))); typedef __bf16 bf16x2_t __attribute__((ext_vector_type(2)));
__device__ __forceinline__ unsigned cvtpk(float lo, float hi) { f32x2_t v = {lo, hi}; bf16x2_t b = __builtin_convertvector(v, bf16x2_t); return __builtin_bit_cast(unsigned, b); }
__device__ __forceinline__ unsigned cvt_pk_bf16(float lo, float hi) { unsigned r; asm volatile("v_cvt_pk_bf16_f32 %0, %1, %2" : "=v"(r) : "v"(lo), "v"(hi)); return r; }

namespace pg8 {
#define PG8_LAS __attribute__((address_space(3)))
constexpr int BM = 256, BK = 64, HALF = 128, HTB = HALF * BK * 2, STAGE_BYTES = 8 * HTB, NXCD = 8, WGM = 8;
__host__ __device__ __forceinline__ int lds_byte(int r, int c) { const int st = (r >> 4) * 2 + (c >> 5), rr = r & 15, cc = c & 31, ob = rr * 64 + cc * 2; return st * 1024 + (ob ^ (((ob >> 9) & 1) << 5)); }
__host__ __device__ __forceinline__ void stage_rc(int b, int& R, int& C) { const int st = b / 1024, sb = b % 1024, swz = sb ^ (((sb >> 9) & 1) << 5); R = (st >> 1) * 16 + swz / 64; C = (st & 1) * 32 + (swz % 64) / 2; }
__host__ __device__ __forceinline__ int perm32(int rho) { const int n = rho >> 4, i = rho & 15; return 8 * (i >> 2) + 4 * n + (i & 3); }
struct Unit { int pm, pn; };
struct Gemm { const bf16_t* A; const bf16_t* Bt; int M, N, K, lda; };
struct StaticOrder {
    int nM, nN, nwg, G, c;
    __host__ __device__ __forceinline__ void init(int M_, int N_, int G_, int c_) { nM = M_ / BM; nN = N_ / BM; nwg = nM * nN; G = G_; c = c_; }
    __host__ __device__ __forceinline__ bool next(int i, Unit& u) const {
        const long L = (long)i * G + c; if (L >= nwg) return false;
        int wgid = (int)L; { const int q = nwg / NXCD, r = nwg % NXCD, xcd = wgid % NXCD, off = wgid / NXCD; wgid = (xcd < r ? xcd * (q + 1) : r * (q + 1) + (xcd - r) * q) + off; }
        const int nig = WGM * nN, gid = wgid / nig, fm = gid * WGM, gsz = (nM - fm) < WGM ? (nM - fm) : WGM;
        u.pm = fm + ((wgid % nig) % gsz); u.pn = (wgid % nig) / gsz; return true;
    }
    __device__ __forceinline__ void a_ready(const Unit&) const {}
    __device__ __forceinline__ void done(const Unit&) const {}
};
typedef f32x4 Acc[2][2][4][2];

struct EpiBf16 {
    static constexpr bool PERM = true, AFTER_DRAIN = false; static constexpr int MIDK = 0;
    bf16_t* O; int ldc;
    __device__ __forceinline__ void operator()(const Acc& acc, const Unit& u, int wr, int wc, int fr, int fq, int ui) const {
        const int row0 = u.pm * BM + wr * 64 + fr, col0 = u.pn * BM + wc * 32 + 8 * fq;
#pragma unroll
        for (int ai = 0; ai < 2; ++ai)
#pragma unroll
            for (int m = 0; m < 4; ++m) { bf16_t* rowp = O + (size_t)(row0 + ai * HALF + m * 16) * ldc + col0;
#pragma unroll
                for (int bj = 0; bj < 2; ++bj) { const f32x4 v0 = acc[ai][bj][m][0], v1 = acc[ai][bj][m][1];
                    u32x4 w; w.x = cvt_pk_bf16(v0[0], v0[1]); w.y = cvt_pk_bf16(v0[2], v0[3]); w.z = cvt_pk_bf16(v1[0], v1[1]); w.w = cvt_pk_bf16(v1[2], v1[3]);
                    *(u32x4*)(rowp + bj * HALF) = w; } }
    }
};
struct EpiProj {
    static constexpr bool PERM = true, AFTER_DRAIN = false; static constexpr int MIDK = 0;
    bf16_t* O; int ldc; const PG8_LAS float* rsT; const float* lbt; float* ssqp; int Mrows; PG8_LAS float* red;
    __device__ __forceinline__ void operator()(const Acc& acc, const Unit& u, int wr, int wc, int fr, int fq, int ui) const {
        const int row0 = u.pm * BM + wr * 64 + fr, col0 = u.pn * BM + wc * 32 + 8 * fq;
        const bool gate = (u.pn >= 2 && u.pn < 6), stat = (u.pn >= 10);
        f32x4 lb[2][2];
#pragma unroll
        for (int bj = 0; bj < 2; ++bj)
#pragma unroll
            for (int n = 0; n < 2; ++n) lb[bj][n] = gate ? *(const f32x4*)(lbt + (col0 - 512) + bj * HALF + 4 * n) : (f32x4){0.f, 0.f, 0.f, 0.f};
#pragma unroll
        for (int ai = 0; ai < 2; ++ai)
#pragma unroll
            for (int m = 0; m < 4; ++m) { const int row = row0 + ai * HALF + m * 16; const float r = rsT[ui * BM + ai * HALF + wr * 64 + m * 16 + fr]; bf16_t* rowp = O + (size_t)row * ldc + col0; float sq[2];
#pragma unroll
                for (int bj = 0; bj < 2; ++bj) { f32x4 v0 = acc[ai][bj][m][0] * r, v1 = acc[ai][bj][m][1] * r; u32x4 w;
                    sq[bj] = ((v0[0] * v0[0] + v0[1] * v0[1]) + (v0[2] * v0[2] + v0[3] * v0[3])) + ((v1[0] * v1[0] + v1[1] * v1[1]) + (v1[2] * v1[2] + v1[3] * v1[3]));
                    if (gate) {
#pragma unroll
                        for (int e = 0; e < 4; ++e) { const float s0 = __builtin_amdgcn_rcpf(1.f + __builtin_amdgcn_exp2f(-1.4426950408889634f * v0[e])), s1 = __builtin_amdgcn_rcpf(1.f + __builtin_amdgcn_exp2f(-1.4426950408889634f * v1[e]));
                            v0[e] = __builtin_amdgcn_logf(lb[bj][0][e] + (1.f - lb[bj][0][e]) * s0); v1[e] = __builtin_amdgcn_logf(lb[bj][1][e] + (1.f - lb[bj][1][e]) * s1); }
                        h16x2 a = {(_Float16)v0[0], (_Float16)v0[1]}, b = {(_Float16)v0[2], (_Float16)v0[3]}, c = {(_Float16)v1[0], (_Float16)v1[1]}, d = {(_Float16)v1[2], (_Float16)v1[3]};
                        w.x = __builtin_bit_cast(unsigned, a); w.y = __builtin_bit_cast(unsigned, b); w.z = __builtin_bit_cast(unsigned, c); w.w = __builtin_bit_cast(unsigned, d);
                    } else { w.x = cvt_pk_bf16(v0[0], v0[1]); w.y = cvt_pk_bf16(v0[2], v0[3]); w.z = cvt_pk_bf16(v1[0], v1[1]); w.w = cvt_pk_bf16(v1[2], v1[3]); }
                    *(u32x4*)(rowp + bj * HALF) = w; }
                if (stat) { sq[0] += __shfl_xor(sq[0], 16); sq[0] += __shfl_xor(sq[0], 32); sq[1] += __shfl_xor(sq[1], 16); sq[1] += __shfl_xor(sq[1], 32);
                    if (fq == 0) { PG8_LAS float* rp = red + (ai * HALF + wr * 64 + m * 16 + fr) * 8 + wc * 2; rp[0] = sq[0]; rp[1] = sq[1]; } } }
        if (stat) {
            asm volatile("s_waitcnt lgkmcnt(0)" ::: "memory"); __builtin_amdgcn_s_barrier(); asm volatile("" ::: "memory");
            const int t = (wr * 4 + wc) * 64 + fq * 16 + fr;
            if (t < 256) { const f32x4 q0 = *(const PG8_LAS f32x4*)(red + t * 8), q1 = *(const PG8_LAS f32x4*)(red + t * 8 + 4);
                float* dst = ssqp + (size_t)((u.pn - 10) * 2) * Mrows + u.pm * BM + t; dst[0] = (q0[0] + q0[2]) + (q1[0] + q1[2]); dst[Mrows] = (q0[1] + q0[3]) + (q1[1] + q1[3]); }
            asm volatile("s_waitcnt lgkmcnt(0)" ::: "memory"); __builtin_amdgcn_s_barrier(); asm volatile("" ::: "memory");
        }
    }
};
struct EpiQ {
    static constexpr bool PERM = true, AFTER_DRAIN = false; static constexpr int MIDK = 0;
    bf16_t* Q; const PG8_LAS float* rsT; const float* gq; const float* cosT; const float* sinT; PG8_LAS float* red;
    __device__ __forceinline__ void operator()(const Acc& acc, const Unit& u, int wr, int wc, int fr, int fq, int ui) const {
        const int h = u.pn, cl = wc * 32 + 8 * fq, ic = 4 * wc + fq;
        f32x4 cs[2][4], sn[2][4];
        if (wc < 2) {
#pragma unroll
            for (int ai = 0; ai < 2; ++ai)
#pragma unroll
                for (int m = 0; m < 4; ++m) { const size_t row = (size_t)(u.pm * BM + ai * HALF + wr * 64 + m * 16 + fr);
                    cs[ai][m] = *(const f32x4*)(cosT + row * 32 + 4 * ic); sn[ai][m] = *(const f32x4*)(sinT + row * 32 + 4 * ic); }
        }
        const f32x4 g00 = *(const f32x4*)(gq + cl), g01 = *(const f32x4*)(gq + cl + 4), g10 = *(const f32x4*)(gq + 128 + cl), g11 = *(const f32x4*)(gq + 128 + cl + 4);
#pragma unroll
        for (int ai = 0; ai < 2; ++ai)
#pragma unroll
            for (int m = 0; m < 4; ++m) { float s = 0.f;
#pragma unroll
                for (int bj = 0; bj < 2; ++bj)
#pragma unroll
                    for (int n = 0; n < 2; ++n) { const f32x4 v = acc[ai][bj][m][n]; s += (v[0] * v[0] + v[1] * v[1]) + (v[2] * v[2] + v[3] * v[3]); }
                s += __shfl_xor(s, 16); s += __shfl_xor(s, 32);
                if (fq == 0) red[(ai * HALF + wr * 64 + m * 16 + fr) * 4 + wc] = s; }
        asm volatile("s_waitcnt lgkmcnt(0)" ::: "memory"); __builtin_amdgcn_s_barrier(); asm volatile("" ::: "memory");
#pragma unroll
        for (int ai = 0; ai < 2; ++ai)
#pragma unroll
            for (int m = 0; m < 4; ++m) { const int rowl = ai * HALF + wr * 64 + m * 16 + fr, row = u.pm * BM + rowl;
                const f32x4 q4 = *(const PG8_LAS f32x4*)(red + rowl * 4); const float ssx = (q4[0] + q4[1]) + (q4[2] + q4[3]);
                const float rs = rsT[ui * BM + rowl];
                const float sc = rs * __builtin_amdgcn_rsqf(rs * rs * ssx * (1.f / 192.f) + 1e-6f);
                bf16_t* dst = Q + ((size_t)((row >> 11) * 4 + h) * 2048 + (row & 2047)) * 192 + cl;
                { const f32x4 v0 = acc[ai][0][m][0] * sc * g00, v1 = acc[ai][0][m][1] * sc * g01; u32x4 w; w.x = cvt_pk_bf16(v0[0], v0[1]); w.y = cvt_pk_bf16(v0[2], v0[3]); w.z = cvt_pk_bf16(v1[0], v1[1]); w.w = cvt_pk_bf16(v1[2], v1[3]); *(u32x4*)dst = w; }
                if (wc < 2) { const f32x4 t1 = acc[ai][1][m][0] * sc * g10, t2 = acc[ai][1][m][1] * sc * g11;
                    const f32x4 o1 = t1 * cs[ai][m] - t2 * sn[ai][m], o2 = t2 * cs[ai][m] + t1 * sn[ai][m];
                    u32x4 w; w.x = cvt_pk_bf16(o1[0], o1[1]); w.y = cvt_pk_bf16(o1[2], o1[3]); w.z = cvt_pk_bf16(o2[0], o2[1]); w.w = cvt_pk_bf16(o2[2], o2[3]); *(u32x4*)(dst + 128) = w; } }
    }
};
struct EpiKV {
    static constexpr bool PERM = true, AFTER_DRAIN = false; static constexpr int MIDK = 0;
    bf16_t* K; bf16_t* V; const bf16_t* proj; int ldp; int ckr; const PG8_LAS float* rsT; const PG8_LAS float* skT; const float* gk; const float* cosT; const float* sinT; PG8_LAS float* red;
    __device__ __forceinline__ void operator()(const Acc& acc, const Unit& u, int wr, int wc, int fr, int fq, int ui) const {
        const int h = u.pn, cl = wc * 32 + 8 * fq, ic = 4 * wc + fq;
#pragma unroll
        for (int ai = 0; ai < 2; ++ai)
#pragma unroll
            for (int m = 0; m < 4; ++m) { float s = 0.f;
#pragma unroll
                for (int n = 0; n < 2; ++n) { const f32x4 v = acc[ai][0][m][n]; s += (v[0] * v[0] + v[1] * v[1]) + (v[2] * v[2] + v[3] * v[3]); }
                s += __shfl_xor(s, 16); s += __shfl_xor(s, 32);
                if (fq == 0) red[(ai * HALF + wr * 64 + m * 16 + fr) * 4 + wc] = s; }
        const f32x4 g0 = *(const f32x4*)(gk + cl), g1 = *(const f32x4*)(gk + cl + 4);
        f32x4 gr0 = {0.f, 0.f, 0.f, 0.f}, gr1 = {0.f, 0.f, 0.f, 0.f};
        if (wc < 2) { gr0 = *(const f32x4*)(gk + 128 + 8 * ic); gr1 = *(const f32x4*)(gk + 128 + 8 * ic + 4); }
        asm volatile("s_waitcnt lgkmcnt(0)" ::: "memory"); __builtin_amdgcn_s_barrier(); asm volatile("" ::: "memory");
#pragma unroll
        for (int ai = 0; ai < 2; ++ai) {
            u32x4 kr[4]; f32x4 cs[4], sn[4];
            if (wc < 2) {
#pragma unroll
                for (int m = 0; m < 4; ++m) { const size_t row = (size_t)(u.pm * BM + ai * HALF + wr * 64 + m * 16 + fr);
                    kr[m] = *(const u32x4*)(proj + row * ldp + ckr + 8 * ic); cs[m] = *(const f32x4*)(cosT + row * 32 + 4 * ic); sn[m] = *(const f32x4*)(sinT + row * 32 + 4 * ic); }
            }
#pragma unroll
            for (int m = 0; m < 4; ++m) { const int rowl = ai * HALF + wr * 64 + m * 16 + fr, row = u.pm * BM + rowl;
                const f32x4 q4 = *(const PG8_LAS f32x4*)(red + rowl * 4); const float ssk = (q4[0] + q4[1]) + (q4[2] + q4[3]);
                const float rsc = rsT[ui * BM + rowl], skr = skT[ui * BM + rowl];
                const float r = __builtin_amdgcn_rsqf((rsc * rsc * ssk + skr) * (1.f / 192.f) + 1e-6f);
                const size_t tok = (size_t)((row >> 11) * 4 + h) * 2048 + (row & 2047);
                bf16_t* kd = K + tok * 192; bf16_t* vd = V + tok * 128;
                { const float sc = rsc * r; const f32x4 v0 = acc[ai][0][m][0] * sc * g0, v1 = acc[ai][0][m][1] * sc * g1; u32x4 w; w.x = cvt_pk_bf16(v0[0], v0[1]); w.y = cvt_pk_bf16(v0[2], v0[3]); w.z = cvt_pk_bf16(v1[0], v1[1]); w.w = cvt_pk_bf16(v1[2], v1[3]); *(u32x4*)(kd + cl) = w; }
                { const f32x4 v0 = acc[ai][1][m][0] * rsc, v1 = acc[ai][1][m][1] * rsc; u32x4 w; w.x = cvt_pk_bf16(v0[0], v0[1]); w.y = cvt_pk_bf16(v0[2], v0[3]); w.z = cvt_pk_bf16(v1[0], v1[1]); w.w = cvt_pk_bf16(v1[2], v1[3]); *(u32x4*)(vd + cl) = w; }
                if (wc < 2) { const f32x4 t1 = (f32x4){bflo(kr[m].x), bfhi(kr[m].x), bflo(kr[m].y), bfhi(kr[m].y)} * gr0 * r, t2 = (f32x4){bflo(kr[m].z), bfhi(kr[m].z), bflo(kr[m].w), bfhi(kr[m].w)} * gr1 * r;
                    const f32x4 o1 = t1 * cs[m] - t2 * sn[m], o2 = t2 * cs[m] + t1 * sn[m];
                    u32x4 w; w.x = cvt_pk_bf16(o1[0], o1[1]); w.y = cvt_pk_bf16(o1[2], o1[3]); w.z = cvt_pk_bf16(o2[0], o2[1]); w.w = cvt_pk_bf16(o2[2], o2[3]); *(u32x4*)(kd + 128 + 8 * ic) = w; } }
        }
    }
};
struct EpiUp {
    static constexpr bool PERM = true, AFTER_DRAIN = false; static constexpr int MIDK = 0;
    bf16_t* O; int ldc; const PG8_LAS float* rsT;
    __device__ __forceinline__ void operator()(const Acc& acc, const Unit& u, int wr, int wc, int fr, int fq, int ui) const {
        const int row0 = u.pm * BM + wr * 64 + fr, col0 = u.pn * BM + wc * 32 + 8 * fq;
#pragma unroll
        for (int ai = 0; ai < 2; ++ai)
#pragma unroll
            for (int m = 0; m < 4; ++m) { const int row = row0 + ai * HALF + m * 16; const float r = rsT[ui * BM + ai * HALF + wr * 64 + m * 16 + fr]; bf16_t* rowp = O + (size_t)row * ldc + col0;
#pragma unroll
                for (int bj = 0; bj < 2; ++bj) { f32x4 v0 = acc[ai][bj][m][0] * r, v1 = acc[ai][bj][m][1] * r;
#pragma unroll
                    for (int e = 0; e < 4; ++e) { const float a = fmaxf(v0[e], 0.f), b = fmaxf(v1[e], 0.f); v0[e] = a * a; v1[e] = b * b; }
                    u32x4 w; w.x = cvt_pk_bf16(v0[0], v0[1]); w.y = cvt_pk_bf16(v0[2], v0[3]); w.z = cvt_pk_bf16(v1[0], v1[1]); w.w = cvt_pk_bf16(v1[2], v1[3]);
                    *(u32x4*)(rowp + bj * HALF) = w; } }
    }
};
struct EpiResid {
    static constexpr bool PERM = false, AFTER_DRAIN = false; static constexpr int MIDK = 0;
    const float* base; float* out; int ldc;
    __device__ __forceinline__ void operator()(const Acc& acc, const Unit& u, int wr, int wc, int fr, int fq, int ui) const {
        const int row0 = u.pm * BM + wr * 64 + fr, col0 = u.pn * BM + wc * 32 + 4 * fq;
#pragma unroll
        for (int ai = 0; ai < 2; ++ai)
#pragma unroll
            for (int m = 0; m < 4; ++m) { const size_t off = (size_t)(row0 + ai * HALF + m * 16) * ldc + col0;
#pragma unroll
                for (int bj = 0; bj < 2; ++bj)
#pragma unroll
                    for (int n = 0; n < 2; ++n) { const f32x4 bs = *(const f32x4*)(base + off + bj * HALF + n * 16); *(f32x4*)(out + off + bj * HALF + n * 16) = bs + acc[ai][bj][m][n]; } }
    }
};

struct EpiResidBf {
    static constexpr bool PERM = false, AFTER_DRAIN = false; static constexpr int MIDK = 0;
    const bf16_t* xb; float* out; int ldc;
    __device__ __forceinline__ void operator()(const Acc& acc, const Unit& u, int wr, int wc, int fr, int fq, int ui) const {
        const int row0 = u.pm * BM + wr * 64 + fr, col0 = u.pn * BM + wc * 32 + 4 * fq;
        u32x2 w[2][4][2][2];
#pragma unroll
        for (int ai = 0; ai < 2; ++ai)
#pragma unroll
            for (int m = 0; m < 4; ++m) { const size_t off = (size_t)(row0 + ai * HALF + m * 16) * ldc + col0;
#pragma unroll
                for (int bj = 0; bj < 2; ++bj)
#pragma unroll
                    for (int n = 0; n < 2; ++n) w[ai][m][bj][n] = *(const u32x2*)(xb + off + bj * HALF + n * 16); }
        __builtin_amdgcn_sched_barrier(0);
#pragma unroll
        for (int ai = 0; ai < 2; ++ai) {
#pragma unroll
            for (int m = 0; m < 4; ++m) { const size_t off = (size_t)(row0 + ai * HALF + m * 16) * ldc + col0;
#pragma unroll
                for (int bj = 0; bj < 2; ++bj)
#pragma unroll
                    for (int n = 0; n < 2; ++n) { const u32x2 ww = w[ai][m][bj][n]; const f32x4 bs = {bflo(ww.x), bfhi(ww.x), bflo(ww.y), bfhi(ww.y)}; *(f32x4*)(out + off + bj * HALF + n * 16) = bs + acc[ai][bj][m][n]; } }
        }
    }
};
struct EpiResidX1 {
    static constexpr bool PERM = false, AFTER_DRAIN = false; static constexpr int MIDK = 8;
    const bf16_t* base; bf16_t* xb; float* ssq; int ldc; int Mrows; PG8_LAS float* red; const PG8_LAS float* rsb;
    __device__ __forceinline__ void mid(Acc& acc, int ui, int wr, int fr) const {
#pragma unroll
        for (int ai = 0; ai < 2; ++ai)
#pragma unroll
            for (int m = 0; m < 4; ++m) { const float r = rsb[ui * BM + ai * HALF + wr * 64 + m * 16 + fr];
#pragma unroll
                for (int bj = 0; bj < 2; ++bj)
#pragma unroll
                    for (int n = 0; n < 2; ++n) acc[ai][bj][m][n] *= r; }
    }
    __device__ __forceinline__ void operator()(const Acc& acc, const Unit& u, int wr, int wc, int fr, int fq, int ui) const {
        const int row0 = u.pm * BM + wr * 64 + fr, col0 = u.pn * BM + wc * 32 + 4 * fq;
        u32x2 xr[2][4][2][2];
#pragma unroll
        for (int ai = 0; ai < 2; ++ai)
#pragma unroll
            for (int m = 0; m < 4; ++m) { const size_t off = (size_t)(row0 + ai * HALF + m * 16) * ldc + col0;
#pragma unroll
                for (int bj = 0; bj < 2; ++bj)
#pragma unroll
                    for (int n = 0; n < 2; ++n) xr[ai][m][bj][n] = *(const u32x2*)(base + off + bj * HALF + n * 16); }
        __builtin_amdgcn_sched_barrier(0);
#pragma unroll
        for (int ai = 0; ai < 2; ++ai) {
#pragma unroll
            for (int m = 0; m < 4; ++m) { const size_t off = (size_t)(row0 + ai * HALF + m * 16) * ldc + col0; float s = 0.f;
#pragma unroll
                for (int bj = 0; bj < 2; ++bj)
#pragma unroll
                    for (int n = 0; n < 2; ++n) { const u32x2 xw = xr[ai][m][bj][n]; const f32x4 v = (f32x4){bflo(xw.x), bfhi(xw.x), bflo(xw.y), bfhi(xw.y)} + acc[ai][bj][m][n];
                        u32x2 w; w.x = cvt_pk_bf16(v[0], v[1]); w.y = cvt_pk_bf16(v[2], v[3]); *(u32x2*)(xb + off + bj * HALF + n * 16) = w;
                        s += (v[0] * v[0] + v[1] * v[1]) + (v[2] * v[2] + v[3] * v[3]); }
                s += __shfl_xor(s, 16); s += __shfl_xor(s, 32);
                if (fq == 0) red[(ai * HALF + wr * 64 + m * 16 + fr) * 4 + wc] = s; }
        }
        asm volatile("s_waitcnt lgkmcnt(0)" ::: "memory"); __builtin_amdgcn_s_barrier(); asm volatile("" ::: "memory");
        const int t = (wr * 4 + wc) * 64 + fq * 16 + fr;
        if (t < 256) { const f32x4 q = *(const PG8_LAS f32x4*)(red + t * 4); ssq[(size_t)u.pn * Mrows + u.pm * BM + t] = (q[0] + q[1]) + (q[2] + q[3]); }
        asm volatile("s_waitcnt lgkmcnt(0)" ::: "memory"); __builtin_amdgcn_s_barrier(); asm volatile("" ::: "memory");
    }
};
template <class Epi, class Sched, bool ALIGN_EPI = false, bool SP2 = false>
__device__ __forceinline__ void gemm_phase(PG8_LAS unsigned char* lds, const Gemm g, const Sched& S, const Epi& E, int wv) {
    int lane = lane_id(); asm volatile("" : "+v"(lane));
    const int wid = wv, tid = wv * 64 + lane, wr = wid >> 2, wc = wid & 3, fr = lane & 15, fq = lane >> 4;
    const int K = g.K, nt = K / BK, lda = g.lda;
    unsigned voffA[2], voffB[2];
#pragma unroll
    for (int i = 0; i < 2; ++i) { int R, C; stage_rc(tid * 16 + i * 8192, R, C); const int Rb = Epi::PERM ? ((R & ~31) + perm32(R & 31)) : R;
        voffA[i] = (unsigned)(R * lda + C) * 2u; voffB[i] = (unsigned)(Rb * K + C) * 2u; }
    const size_t kstep = (size_t)(BK * 2);
    const size_t hstepA = (size_t)HALF * lda * 2, hstepB = (size_t)HALF * K * 2;
    const size_t tstepA = 2 * hstepA, tstepB = 2 * hstepB;
    const unsigned ldsw = (unsigned)wid * 1024u;
    const int aoff = lds_byte(wr * 64 + fr, fq * 8), boff = lds_byte(wc * 32 + fr, fq * 8);
#define PG8_SA(b, h) (((b) * 2 + (h)) * HTB)
#define PG8_SB(b, h) ((4 + (b) * 2 + (h)) * HTB)
#define PG8_STAGE(bufoff, gbase, voff) do { _Pragma("unroll") for (int _i = 0; _i < 2; ++_i) \
        __builtin_amdgcn_global_load_lds((const unsigned*)((const char*)(gbase) + (voff)[_i]), (PG8_LAS unsigned*)(lds + (bufoff) + ldsw + _i * 8192), 16, 0, 0); } while (0)
#define PG8_LDA(dst, b, h) do { _Pragma("unroll") for (int m = 0; m < 4; ++m) _Pragma("unroll") for (int k = 0; k < 2; ++k) dst[m][k] = *(const PG8_LAS bf16x8*)(lds + PG8_SA(b, h) + aoff + m * 2048 + k * 1024); } while (0)
#define PG8_LDB(dst, b, h) do { _Pragma("unroll") for (int n = 0; n < 2; ++n) _Pragma("unroll") for (int k = 0; k < 2; ++k) dst[n][k] = *(const PG8_LAS bf16x8*)(lds + PG8_SB(b, h) + boff + n * 2048 + k * 1024); } while (0)
#define PG8_MMA(ai, bj, At, Bt) do { __builtin_amdgcn_s_setprio(1); _Pragma("unroll") for (int m = 0; m < 4; ++m) _Pragma("unroll") for (int n = 0; n < 2; ++n) _Pragma("unroll") for (int k = 0; k < 2; ++k) \
        acc[ai][bj][m][n] = __builtin_amdgcn_mfma_f32_16x16x32_bf16(Bt[n][k], At[m][k], acc[ai][bj][m][n], 0, 0, 0); __builtin_amdgcn_s_setprio(0); } while (0)
#define PG8_WAIT_V(n) asm volatile("s_waitcnt vmcnt(" #n ")" ::: "memory")
#define PG8_WAIT_L(n) asm volatile("s_waitcnt lgkmcnt(" #n ")" ::: "memory")
#define PG8_BAR __builtin_amdgcn_s_barrier()
#define PG8_SCHED __builtin_amdgcn_sched_barrier(0)
    Unit cur, nxt; int ui = 0;
    if (!S.next(0, cur)) return;
    Acc acc;
#pragma unroll
    for (int a = 0; a < 2; ++a)
#pragma unroll
        for (int b = 0; b < 2; ++b)
#pragma unroll
            for (int m = 0; m < 4; ++m)
#pragma unroll
                for (int n = 0; n < 2; ++n) acc[a][b][m][n] = (f32x4){0.f, 0.f, 0.f, 0.f};
    bf16x8 At[4][2], B0[2][2], B1[2][2];
    const char* cA = (const char*)g.A + (size_t)cur.pm * tstepA; const char* cB = (const char*)g.Bt + (size_t)cur.pn * tstepB;
    S.a_ready(cur);
    if constexpr (SP2) {
        PG8_STAGE(PG8_SB(0, 0), cB, voffB); PG8_STAGE(PG8_SB(0, 1), cB + hstepB, voffB); PG8_STAGE(PG8_SA(0, 0), cA, voffA); PG8_STAGE(PG8_SA(0, 1), cA + hstepA, voffA);
        if (wr == 1) PG8_BAR;
        PG8_WAIT_V(2); PG8_BAR;
        PG8_STAGE(PG8_SB(1, 0), cB + kstep, voffB); PG8_STAGE(PG8_SA(1, 0), cA + kstep, voffA); PG8_STAGE(PG8_SB(1, 1), cB + hstepB + kstep, voffB);
        PG8_WAIT_V(6); PG8_BAR;
    } else {
        PG8_STAGE(PG8_SB(0, 0), cB, voffB); PG8_STAGE(PG8_SA(0, 0), cA, voffA); PG8_STAGE(PG8_SB(0, 1), cB + hstepB, voffB); PG8_STAGE(PG8_SA(0, 1), cA + hstepA, voffA);
        if (wr == 1) PG8_BAR;
        PG8_WAIT_V(4); PG8_BAR;
        PG8_STAGE(PG8_SB(1, 0), cB + kstep, voffB); PG8_STAGE(PG8_SA(1, 0), cA + kstep, voffA); PG8_STAGE(PG8_SB(1, 1), cB + hstepB + kstep, voffB);
        PG8_WAIT_V(6); PG8_BAR;
    }
    for (;;) {
        const bool has_next = S.next(ui + 1, nxt);
        const char* nA = has_next ? (const char*)g.A + (size_t)nxt.pm * tstepA : cA; const char* nB = has_next ? (const char*)g.Bt + (size_t)nxt.pn * tstepB : cB;
#pragma nounroll
        for (int t = 0; t < nt; t += 2) {
            const bool last = (t == nt - 2);
            const char* a1 = cA + (size_t)(t + 1) * kstep;
            const char* a2 = last ? nA : cA + (size_t)(t + 2) * kstep; const char* b2 = last ? nB : cB + (size_t)(t + 2) * kstep;
            const char* a3 = a2 + kstep; const char* b3 = b2 + kstep;
            if (last && has_next) S.a_ready(nxt);
            if constexpr (SP2) {
            PG8_LDB(B0, 0, 0); PG8_LDB(B1, 0, 1); PG8_SCHED; PG8_LDA(At, 0, 0); PG8_STAGE(PG8_SA(1, 1), a1 + hstepA, voffA);
            PG8_WAIT_V(8); PG8_WAIT_L(0); PG8_BAR; PG8_MMA(0, 0, At, B0); PG8_MMA(0, 1, At, B1); PG8_BAR; PG8_SCHED;
            PG8_LDA(At, 0, 1); PG8_STAGE(PG8_SB(0, 0), b2, voffB); PG8_STAGE(PG8_SB(0, 1), b2 + hstepB, voffB); PG8_STAGE(PG8_SA(0, 0), a2, voffA);
            PG8_WAIT_V(8); PG8_WAIT_L(0); PG8_BAR; PG8_MMA(1, 0, At, B0); PG8_MMA(1, 1, At, B1); PG8_BAR; PG8_SCHED;
            PG8_LDB(B0, 1, 0); PG8_LDB(B1, 1, 1); PG8_SCHED; PG8_LDA(At, 1, 0); PG8_STAGE(PG8_SA(0, 1), a2 + hstepA, voffA);
            PG8_WAIT_V(8); PG8_WAIT_L(0); PG8_BAR; PG8_MMA(0, 0, At, B0); PG8_MMA(0, 1, At, B1); PG8_BAR; PG8_SCHED;
            PG8_LDA(At, 1, 1); PG8_STAGE(PG8_SB(1, 0), b3, voffB); PG8_STAGE(PG8_SB(1, 1), b3 + hstepB, voffB); PG8_STAGE(PG8_SA(1, 0), a3, voffA);
            PG8_WAIT_V(8); PG8_WAIT_L(0); PG8_BAR; PG8_MMA(1, 0, At, B0); PG8_MMA(1, 1, At, B1); PG8_BAR; PG8_SCHED;
            if constexpr (Epi::MIDK > 0) { if (t + 2 == Epi::MIDK) { E.mid(acc, ui, wr, fr); PG8_SCHED; } }
            } else {
            PG8_LDB(B0, 0, 0); PG8_SCHED; PG8_LDA(At, 0, 0); PG8_STAGE(PG8_SA(1, 1), a1 + hstepA, voffA);
            PG8_WAIT_L(8); PG8_BAR; PG8_WAIT_L(0); PG8_MMA(0, 0, At, B0); PG8_BAR; PG8_SCHED;
            PG8_LDB(B1, 0, 1); PG8_STAGE(PG8_SB(0, 0), b2, voffB);
            PG8_BAR; PG8_WAIT_L(0); PG8_MMA(0, 1, At, B1); PG8_BAR;
            PG8_LDA(At, 0, 1); PG8_STAGE(PG8_SA(0, 0), a2, voffA);
            PG8_BAR; PG8_WAIT_L(0); PG8_MMA(1, 0, At, B0); PG8_BAR; PG8_SCHED;
            PG8_STAGE(PG8_SB(0, 1), b2 + hstepB, voffB);
            PG8_WAIT_V(6); PG8_BAR; PG8_MMA(1, 1, At, B1); PG8_BAR;
            PG8_LDB(B0, 1, 0); PG8_SCHED; PG8_LDA(At, 1, 0); PG8_STAGE(PG8_SA(0, 1), a2 + hstepA, voffA);
            PG8_WAIT_L(8); PG8_BAR; PG8_WAIT_L(0); PG8_MMA(0, 0, At, B0); PG8_BAR; PG8_SCHED;
            PG8_LDB(B1, 1, 1); PG8_STAGE(PG8_SB(1, 0), b3, voffB);
            PG8_BAR; PG8_WAIT_L(0); PG8_MMA(0, 1, At, B1); PG8_BAR;
            PG8_LDA(At, 1, 1); PG8_STAGE(PG8_SA(1, 0), a3, voffA);
            PG8_BAR; PG8_WAIT_L(0); PG8_MMA(1, 0, At, B0); PG8_BAR; PG8_SCHED;
            PG8_STAGE(PG8_SB(1, 1), b3 + hstepB, voffB);
            PG8_WAIT_V(6); PG8_BAR; PG8_MMA(1, 1, At, B1); PG8_BAR;
            }
        }
        if constexpr (ALIGN_EPI) { if (wr == 0) PG8_BAR; }
        if constexpr (!Epi::AFTER_DRAIN) { E(acc, cur, wr, wc, fr, fq, ui); S.done(cur); }
        if (!has_next) break;
#pragma unroll
        for (int a = 0; a < 2; ++a)
#pragma unroll
            for (int b = 0; b < 2; ++b)
#pragma unroll
                for (int m = 0; m < 4; ++m)
#pragma unroll
                    for (int n = 0; n < 2; ++n) acc[a][b][m][n] = (f32x4){0.f, 0.f, 0.f, 0.f};
        cur = nxt; cA = nA; cB = nB; ++ui;
        if constexpr (ALIGN_EPI) { if (wr == 1) PG8_BAR; }
    }
    PG8_WAIT_V(0);
    if constexpr (!ALIGN_EPI) { if (wr == 0) PG8_BAR; }
    PG8_BAR;
#undef PG8_SA
#undef PG8_SB
#undef PG8_STAGE
#undef PG8_LDA
#undef PG8_LDB
#undef PG8_MMA
#undef PG8_WAIT_V
#undef PG8_WAIT_L
#undef PG8_BAR
#undef PG8_SCHED
}
}

namespace att {
constexpr int DQK = 192, DV = 128, NW = 8, QBLK = 32, KVBLK = 64;
constexpr int SHM_V = KVBLK * DV * 2, SHM_K = KVBLK * DQK * 2, SHM_ATTN = 2 * SHM_V + 2 * SHM_K + NW * 64 * 4;
constexpr float THRL = 11.5f;
#define KSWZ(row, colB) ((row) * 384 + ((colB) ^ ((((row) >> 1) & 7) << 4)))
#define SBAR() __builtin_amdgcn_sched_barrier(0)
__device__ __forceinline__ int crow(int r, int hi) { return (r & 3) + 8 * (r >> 2) + 4 * hi; }
__device__ __forceinline__ void partialSM(f32x16& p0, f32x16& p1, float& m_reg, float& mn, float& alpha) {
    float pmax = p0[0];
#pragma unroll
    for (int r = 1; r < 16; ++r) pmax = fmaxf(pmax, p0[r]);
#pragma unroll
    for (int r = 0; r < 16; ++r) pmax = fmaxf(pmax, p1[r]);
    { auto rr = __builtin_amdgcn_permlane32_swap(__float_as_uint(pmax), __float_as_uint(pmax), false, false);
      pmax = fmaxf(__uint_as_float(rr[0]), __uint_as_float(rr[1])); }
    if (__builtin_expect(__all(pmax - m_reg <= THRL), 1)) { mn = m_reg; alpha = 1.f; }
    else { mn = fmaxf(m_reg, pmax); alpha = __builtin_amdgcn_exp2f(m_reg - mn); m_reg = mn; }
#pragma unroll
    for (int r = 0; r < 16; ++r) p0[r] = p0[r] - mn;
#pragma unroll
    for (int r = 0; r < 16; ++r) p1[r] = p1[r] - mn;
#pragma unroll
    for (int r = 0; r < 16; ++r) p0[r] = __builtin_amdgcn_exp2f(p0[r]);
}
__device__ __forceinline__ void finishSM(f32x16& p0, f32x16& p1, float alpha, float& l_reg, bf16x8& pa0, bf16x8& pa1, bf16x8& pa2, bf16x8& pa3) {
#pragma unroll
    for (int r = 0; r < 16; ++r) p1[r] = __builtin_amdgcn_exp2f(p1[r]);
    float ps = 0;
#pragma unroll
    for (int r = 0; r < 16; ++r) ps += p0[r];
#pragma unroll
    for (int r = 0; r < 16; ++r) ps += p1[r];
    { auto rr = __builtin_amdgcn_permlane32_swap(__float_as_uint(ps), __float_as_uint(ps), false, false);
      ps = __uint_as_float(rr[0]) + __uint_as_float(rr[1]); }
    l_reg = l_reg * alpha + ps;
#define PK4(P, BASE, OUT) do { unsigned a0 = cvt_pk_bf16(P[BASE + 0], P[BASE + 1]), a1 = cvt_pk_bf16(P[BASE + 2], P[BASE + 3]);   \
    unsigned b0 = cvt_pk_bf16(P[BASE + 4], P[BASE + 5]), b1 = cvt_pk_bf16(P[BASE + 6], P[BASE + 7]);                              \
    auto r0 = __builtin_amdgcn_permlane32_swap(a0, b0, false, false); auto r1 = __builtin_amdgcn_permlane32_swap(a1, b1, false, false); \
    u32x4 w = {r0[0], r1[0], r0[1], r1[1]}; OUT = __builtin_bit_cast(bf16x8, w); } while (0)
    PK4(p0, 0, pa0); PK4(p0, 8, pa1); PK4(p1, 0, pa2); PK4(p1, 8, pa3);
#undef PK4
}
__device__ __forceinline__ void qkt(f32x16& p0, f32x16& p1, const char* Ks, const bf16x8* qr, int r32, int hi) {
    p0 = f32x16{}; p1 = f32x16{};
    const char* k0p = Ks + KSWZ(r32, 0); const char* k1p = Ks + KSWZ(32 + r32, 0);
    const int key = ((r32 >> 1) & 7) << 4;
    bf16x8 ka[2], kb[2];
#define KRD(d0, slot) do { const int cb_ = (((d0) * 16 + hi * 8) * 2) ^ key; ka[slot] = *reinterpret_cast<const bf16x8*>(k0p + cb_); kb[slot] = *reinterpret_cast<const bf16x8*>(k1p + cb_); } while (0)
    KRD(0, 0); KRD(1, 1);
#pragma unroll
    for (int d0 = 0; d0 < 12; ++d0) {
        const bf16x8 a = ka[d0 & 1], b = kb[d0 & 1];
        p0 = __builtin_amdgcn_mfma_f32_32x32x16_bf16(a, qr[d0], p0, 0, 0, 0);
        p1 = __builtin_amdgcn_mfma_f32_32x32x16_bf16(b, qr[d0], p1, 0, 0, 0);
        if (d0 + 2 < 12) KRD(d0 + 2, d0 & 1);
    }
#undef KRD
}
__device__ __forceinline__ int v_st(int k, int c) { const int kk = (k & ~0xC) | ((k & 4) << 1) | ((k & 8) >> 1); return ((kk >> 3) * 4 + (c >> 5)) * 512 + ((kk & 7) * 32 + (c & 31)) * 2; }
__device__ __forceinline__ int v_rd_base(int lane) { return ((lane & 3) << 3) | (((lane >> 2) & 3) << 6) | (((lane >> 4) & 1) << 5) | (((lane >> 5) & 1) << 8); }
constexpr int v_rd_off(int d0, int ks, int half) { return d0 * 512 + ks * 4096 + half * 2048; }
template <int OFF> __device__ __forceinline__ s16x4 tr_read(int vb) {
    s16x4 r; asm volatile("ds_read_b64_tr_b16 %0, %1 offset:%2" : "=&v"(r) : "v"(vb), "i"(OFF) : "memory"); return r;
}
#define PKLH(L, H) (bf16x8){L[0], L[1], L[2], L[3], H[0], H[1], H[2], H[3]}
template <int D0> __device__ __forceinline__ void pv_one(f32x16& od, int vb, bf16x8 pa0, bf16x8 pa1, bf16x8 pa2, bf16x8 pa3) {
    const s16x4 l0 = tr_read<v_rd_off(D0, 0, 0)>(vb), h0 = tr_read<v_rd_off(D0, 0, 1)>(vb), l1 = tr_read<v_rd_off(D0, 1, 0)>(vb), h1 = tr_read<v_rd_off(D0, 1, 1)>(vb);
    const s16x4 l2 = tr_read<v_rd_off(D0, 2, 0)>(vb), h2 = tr_read<v_rd_off(D0, 2, 1)>(vb), l3 = tr_read<v_rd_off(D0, 3, 0)>(vb), h3 = tr_read<v_rd_off(D0, 3, 1)>(vb);
    asm volatile("s_waitcnt lgkmcnt(0)" ::: "memory"); SBAR();
    od = __builtin_amdgcn_mfma_f32_32x32x16_bf16(pa0, PKLH(l0, h0), od, 0, 0, 0);
    od = __builtin_amdgcn_mfma_f32_32x32x16_bf16(pa1, PKLH(l1, h1), od, 0, 0, 0);
    od = __builtin_amdgcn_mfma_f32_32x32x16_bf16(pa2, PKLH(l2, h2), od, 0, 0, 0);
    od = __builtin_amdgcn_mfma_f32_32x32x16_bf16(pa3, PKLH(l3, h3), od, 0, 0, 0);
}
__device__ __forceinline__ void pv_d0(f32x16* o, int vb, bf16x8 pa0, bf16x8 pa1, bf16x8 pa2, bf16x8 pa3) {
    pv_one<0>(o[0], vb, pa0, pa1, pa2, pa3); pv_one<1>(o[1], vb, pa0, pa1, pa2, pa3); pv_one<2>(o[2], vb, pa0, pa1, pa2, pa3); pv_one<3>(o[3], vb, pa0, pa1, pa2, pa3);
}
#define PK4S(P, BASE, OUT) do { unsigned a0 = cvt_pk_bf16(P[BASE + 0], P[BASE + 1]), a1 = cvt_pk_bf16(P[BASE + 2], P[BASE + 3]);   \
    unsigned b0 = cvt_pk_bf16(P[BASE + 4], P[BASE + 5]), b1 = cvt_pk_bf16(P[BASE + 6], P[BASE + 7]);                              \
    auto r0 = __builtin_amdgcn_permlane32_swap(a0, b0, false, false); auto r1 = __builtin_amdgcn_permlane32_swap(a1, b1, false, false); \
    u32x4 w = {r0[0], r1[0], r0[1], r1[1]}; OUT = __builtin_bit_cast(bf16x8, w); } while (0)
template <bool FIN>
__device__ __forceinline__ void seg_x(f32x16& n0, f32x16& n1, const LAS char* Ks, const bf16x8* qr, const LAS char* ql, int r32, int hi,
                                      f32x16& f0, f32x16& f1, float alpha, float& l_reg, bf16x8& pa0, bf16x8& pa1, bf16x8& pa2, bf16x8& pa3) {
    n0 = f32x16{}; n1 = f32x16{};
    const LAS char* k0p = Ks + r32 * 384;
    const int key = ((r32 >> 1) & 7) << 4;
    bf16x8 ka[2], kb[2]; float ps = 0.f;
#define KRD(d0, slot) do { const int cb_ = (((d0) * 16 + hi * 8) * 2) ^ key; ka[slot] = *reinterpret_cast<const LAS bf16x8*>(k0p + cb_); kb[slot] = *reinterpret_cast<const LAS bf16x8*>(k0p + 32 * 384 + cb_); } while (0)
    KRD(0, 0); KRD(1, 1); SBAR();
    bf16x8 qlv = qr[0];
#pragma unroll
    for (int d0 = 0; d0 < 12; ++d0) {
        const bf16x8 qv = (d0 < 8) ? qr[d0 < 8 ? d0 : 0] : qlv;
        n0 = __builtin_amdgcn_mfma_f32_32x32x16_bf16(ka[d0 & 1], qv, n0, 0, 0, 0);
        n1 = __builtin_amdgcn_mfma_f32_32x32x16_bf16(kb[d0 & 1], qv, n1, 0, 0, 0);
        SBAR();
        if (d0 + 2 < 12) KRD(d0 + 2, d0 & 1);
        if (d0 + 1 >= 8 && d0 + 1 < 12) qlv = *reinterpret_cast<const LAS bf16x8*>(ql + (d0 + 1 - 8) * 1024);
        if constexpr (FIN) {
            if (d0 < 4) {
#pragma unroll
                for (int r = 0; r < 4; ++r) f1[4 * d0 + r] = __builtin_amdgcn_exp2f(f1[4 * d0 + r]);
            } else if (d0 == 4) {
#pragma unroll
                for (int r = 0; r < 16; ++r) ps += f0[r];
            } else if (d0 == 5) {
#pragma unroll
                for (int r = 0; r < 16; ++r) ps += f1[r];
            } else if (d0 == 6) {
                auto rr = __builtin_amdgcn_permlane32_swap(__float_as_uint(ps), __float_as_uint(ps), false, false);
                ps = __uint_as_float(rr[0]) + __uint_as_float(rr[1]); l_reg = l_reg * alpha + ps;
            } else if (d0 == 7) { PK4S(f0, 0, pa0); } else if (d0 == 8) { PK4S(f0, 8, pa1); } else if (d0 == 9) { PK4S(f1, 0, pa2); } else if (d0 == 10) { PK4S(f1, 8, pa3); }
        }
        SBAR();
    }
#undef KRD
}
__device__ __forceinline__ void seg_y(f32x16* o, int vb, bf16x8 pa0, bf16x8 pa1, bf16x8 pa2, bf16x8 pa3, f32x16& p0, f32x16& p1, float& m_reg, float& mn, float& alpha) {
    pv_one<0>(o[0], vb, pa0, pa1, pa2, pa3); SBAR();
    { float a = fmaxf(p0[0], p0[1]), b = fmaxf(p0[2], p0[3]);
#pragma unroll
      for (int r = 4; r < 16; r += 2) { a = fmaxf(a, p0[r]); b = fmaxf(b, p0[r + 1]); }
#pragma unroll
      for (int r = 0; r < 16; r += 2) { a = fmaxf(a, p1[r]); b = fmaxf(b, p1[r + 1]); }
      float pmax = fmaxf(a, b);
      auto rr = __builtin_amdgcn_permlane32_swap(__float_as_uint(pmax), __float_as_uint(pmax), false, false);
      pmax = fmaxf(__uint_as_float(rr[0]), __uint_as_float(rr[1]));
      if (__builtin_expect(__all(pmax - m_reg <= THRL), 1)) { mn = m_reg; alpha = 1.f; }
      else { mn = fmaxf(m_reg, pmax); alpha = __builtin_amdgcn_exp2f(m_reg - mn); m_reg = mn; } }
    SBAR();
    pv_one<1>(o[1], vb, pa0, pa1, pa2, pa3); SBAR();
#pragma unroll
    for (int r = 0; r < 16; ++r) { p0[r] = p0[r] - mn; p1[r] = p1[r] - mn; }
    SBAR();
    pv_one<2>(o[2], vb, pa0, pa1, pa2, pa3); SBAR();
#pragma unroll
    for (int r = 0; r < 8; ++r) p0[r] = __builtin_amdgcn_exp2f(p0[r]);
    SBAR();
    pv_one<3>(o[3], vb, pa0, pa1, pa2, pa3); SBAR();
#pragma unroll
    for (int r = 8; r < 16; ++r) p0[r] = __builtin_amdgcn_exp2f(p0[r]);
    SBAR();
}
constexpr int L_K = 0, L_VV = 3 * SHM_K, L_WS = L_VV + 3 * SHM_V, L_QL = L_WS + NW * 64 * 4, ATT_LDS = L_QL + NW * 4096;
__device__ __forceinline__ void attn_unit(const bf16_t* __restrict__ Qb, const bf16_t* __restrict__ Kh, const bf16_t* __restrict__ Vh, bf16_t* __restrict__ Ob, int ldo, float* __restrict__ ssq, int seq, char* lds, int wv) {
    int lane = lane_id(); asm volatile("" : "+v"(lane));
    const int wid = wv, tid = wv * 64 + lane, r32 = lane & 31, hi = lane >> 5;
    LAS unsigned char* l3 = (LAS unsigned char*)lds;
    const LAS char* K_lds = (const LAS char*)l3 + L_K;
    float* ws = (float*)(lds + L_WS) + wid * 64; float* li_l = ws; float* al_l = ws + 32;
    float m_reg = -1e30f, l_reg = 0; f32x16 o[4] = {}; bf16x8 qr[8];
    const LAS char* ql = (const LAS char*)l3 + L_QL + wid * 4096 + lane * 16;
#define KSRC(i_) ({ const int p_ = (wid + 8 * (i_)) * 64 + lane, row_ = p_ / 24, cpos_ = p_ - row_ * 24; (unsigned)(row_ * 24 + ((cpos_ & ~7) | ((cpos_ ^ (row_ >> 1)) & 7))) * 16u; })
#define VSRC(i_) ({ const int p16_ = (wid + 8 * (i_)) * 64 + lane, sub_ = p16_ >> 5, idx_ = p16_ & 31, kk_ = (sub_ >> 2) * 8 + (idx_ >> 2), c_ = (sub_ & 3) * 32 + (idx_ & 3) * 8; \
    (unsigned)((((kk_ & ~0xC) | ((kk_ & 4) << 1) | ((kk_ & 8) >> 1))) * DV + c_) * 2u; })
#define DMA_K(t, kboff) do { const char* kt_ = (const char*)Kh + (size_t)(t) * SHM_K; \
    _Pragma("unroll") for (int i_ = 0; i_ < 3; ++i_) __builtin_amdgcn_global_load_lds((const unsigned*)(kt_ + KSRC(i_)), (LAS unsigned*)(l3 + L_K + (kboff) + (wid + 8 * i_) * 1024), 16, 0, 0); } while (0)
#define DMA_V(t, vboff) do { const char* vt_ = (const char*)Vh + (size_t)(t) * SHM_V; \
    _Pragma("unroll") for (int i_ = 0; i_ < 2; ++i_) __builtin_amdgcn_global_load_lds((const unsigned*)(vt_ + VSRC(i_)), (LAS unsigned*)(l3 + L_VV + (vboff) + (wid + 8 * i_) * 1024), 16, 0, 0); } while (0)
#define TOP(j, KB) do { if ((j) + 2 >= NT) asm volatile("s_waitcnt vmcnt(0) lgkmcnt(0)" ::: "memory"); else asm volatile("s_waitcnt vmcnt(5) lgkmcnt(0)" ::: "memory"); \
    __builtin_amdgcn_s_barrier(); asm volatile("" ::: "memory"); \
    if ((j) + 2 < NT) DMA_K((j) + 2, (((KB) + 2) % 3) * SHM_K); if ((j) + 1 < NT) DMA_V((j) + 1, (((KB) + 1) % 3) * SHM_V); } while (0)
#define RESC(a) do { if (__any((a) < 1.f)) { if (hi == 0) al_l[r32] = (a); asm volatile("s_waitcnt lgkmcnt(0)" ::: "memory"); \
    _Pragma("unroll") for (int d = 0; d < 4; ++d) _Pragma("unroll") for (int r = 0; r < 16; ++r) o[d][r] *= al_l[crow(r, hi)]; } } while (0)
#define TILE(j, KB, PN0, PN1, MNN, ALN, PF0, PF1, AF) do { TOP(j, KB); \
    seg_x<true>(PN0, PN1, K_lds + (KB) * SHM_K, qr, ql, r32, hi, PF0, PF1, AF, l_reg, pa0, pa1, pa2, pa3); \
    seg_y(o, vb0 + (((KB) + 2) % 3) * SHM_V, pa0, pa1, pa2, pa3, PN0, PN1, m_reg, MNN, ALN); RESC(ALN); } while (0)
    const bf16_t* Qw = Qb + (long)(wid * QBLK + r32) * DQK + hi * 8;
#pragma unroll
    for (int d0 = 0; d0 < 8; ++d0) qr[d0] = *reinterpret_cast<const bf16x8*>(Qw + d0 * 16);
#pragma unroll
    for (int d0 = 8; d0 < 12; ++d0) *(LAS bf16x8*)((LAS char*)l3 + L_QL + wid * 4096 + lane * 16 + (d0 - 8) * 1024) = *reinterpret_cast<const bf16x8*>(Qw + d0 * 16);
    const int vb0 = (int)(uintptr_t)(lds + L_VV) + v_rd_base(lane);
    f32x16 pA0, pA1, pB0, pB1; float mnA, mnB, alA, alB; bf16x8 pa0, pa1, pa2, pa3; const int NT = seq / KVBLK;
    DMA_K(0, 0); DMA_V(0, 0); DMA_K(1, SHM_K);
    TOP(0, 0);
    seg_x<false>(pA0, pA1, K_lds, qr, ql, r32, hi, pA0, pA1, 1.f, l_reg, pa0, pa1, pa2, pa3); partialSM(pA0, pA1, m_reg, mnA, alA);
    for (int j = 1; j + 6 < NT; j += 6) {
        TILE(j,     1, pB0, pB1, mnB, alB, pA0, pA1, alA);
        TILE(j + 1, 2, pA0, pA1, mnA, alA, pB0, pB1, alB);
        TILE(j + 2, 0, pB0, pB1, mnB, alB, pA0, pA1, alA);
        TILE(j + 3, 1, pA0, pA1, mnA, alA, pB0, pB1, alB);
        TILE(j + 4, 2, pB0, pB1, mnB, alB, pA0, pA1, alA);
        TILE(j + 5, 0, pA0, pA1, mnA, alA, pB0, pB1, alB);
    }
    TILE(NT - 1, 1, pB0, pB1, mnB, alB, pA0, pA1, alA);
    finishSM(pB0, pB1, alB, l_reg, pa0, pa1, pa2, pa3); SBAR();
    pv_d0(o, vb0 + 1 * SHM_V, pa0, pa1, pa2, pa3);
    if (hi == 0) li_l[r32] = l_reg; asm volatile("s_waitcnt lgkmcnt(0)" ::: "memory");
    float rli[16];
#pragma unroll
    for (int r = 0; r < 16; ++r) rli[r] = __builtin_amdgcn_rcpf(li_l[crow(r, hi)]);
    bf16_t* Ow = Ob + (long)(wid * QBLK) * ldo;
    float myss = 0.f;
#pragma unroll
    for (int r = 0; r < 16; ++r) { const int orow = crow(r, hi); float sq = 0.f;
#pragma unroll
        for (int d0 = 0; d0 < 4; ++d0) { const float v = o[d0][r] * rli[r]; sq += v * v; Ow[(long)orow * ldo + d0 * 32 + r32] = (bf16_t)f2bf(v); }
        sq = dpp_sum8(sq);
        sq += __builtin_bit_cast(float, __builtin_amdgcn_update_dpp(0, __builtin_bit_cast(int, sq), 0x128, 0xF, 0xF, true));
        sq += __shfl_xor(sq, 16);
        if (r32 == r) myss = sq; }
    if (r32 < 16) ssq[wid * QBLK + crow(r32, hi)] = myss;
    asm volatile("s_waitcnt vmcnt(0) lgkmcnt(0)" ::: "memory"); __builtin_amdgcn_s_barrier(); asm volatile("" ::: "memory");
#undef DMA_K
#undef DMA_V
#undef TOP
#undef TILE
#undef RESC
}
}

namespace hg {
using att::crow; using att::v_st; using att::v_rd_base; using att::v_rd_off; using att::tr_read;
constexpr int L_QE = 0, L_QT = 16384, L_KT = 32768, L_OT = 122880  , L_KE = 73728, L_V = 90112, L_P = 106496, L_SEG = 114688  , L_DV = 155648, L_GN = 156160  , L_END = 156672;
__device__ __forceinline__ int swzA(int row, int cb) { return row * 256 + (cb ^ ((row & 15) << 4) ^ (((row >> 4) & 1) << 3)); }
__device__ __forceinline__ int swzB(int row, int cb) { return row * 256 + (cb ^ ((row & 15) << 4)); }
__device__ __forceinline__ int swzP(int row, int cb) { return row * 128 + (cb ^ ((row & 7) << 4)); }
template <int D0> __device__ __forceinline__ void tr_frag4(int vb, bf16x8& f0, bf16x8& f1, bf16x8& f2, bf16x8& f3) {
    const s16x4 l0 = tr_read<v_rd_off(D0, 0, 0)>(vb), h0 = tr_read<v_rd_off(D0, 0, 1)>(vb), l1 = tr_read<v_rd_off(D0, 1, 0)>(vb), h1 = tr_read<v_rd_off(D0, 1, 1)>(vb);
    const s16x4 l2 = tr_read<v_rd_off(D0, 2, 0)>(vb), h2 = tr_read<v_rd_off(D0, 2, 1)>(vb), l3 = tr_read<v_rd_off(D0, 3, 0)>(vb), h3 = tr_read<v_rd_off(D0, 3, 1)>(vb);
    asm volatile("s_waitcnt lgkmcnt(0)" ::: "memory"); SBAR();
    f0 = PKLH(l0, h0); f1 = PKLH(l1, h1); f2 = PKLH(l2, h2); f3 = PKLH(l3, h3);
}
struct Pre { u32x2 q4[4], l4[4], v4[4]; };
__device__ __forceinline__ void load_chunk(Pre& P, const bf16_t* pbase, int h, int dir, int cs, int wid, int lane) {
    const int c4 = 4 * (lane & 31), j0 = 8 * wid + 4 * (lane >> 5);
    const int cq = C_Q + h * 128 + c4, cf = C_FF + dir * 512 + h * 128 + c4, ci = C_I + h * 128 + c4;
#pragma unroll
    for (int i = 0; i < 4; ++i) { const int j = j0 + i, pos = dir ? (64 * cs + 63 - j) : (64 * cs + j); const bf16_t* rp = pbase + (size_t)pos * DINP;
        P.q4[i] = *(const u32x2*)(rp + cq); P.l4[i] = *(const u32x2*)(rp + cf); P.v4[i] = *(const u32x2*)(rp + ci); }
}
__device__ __forceinline__ void stage_c(char* lds, f32x16 (&S)[4], f32x16 (&o)[2]  , _Float16* ofp  , int rstride  , bool second, int eb, int lane_, int part  ) {
    int lane = lane_; asm volatile("" : "+v"(lane));
    const int r32 = lane & 31, hi = lane >> 5;
    _Float16* p0 = ofp + r32 + 4 * hi * rstride;
    const int vbV = (int)(uintptr_t)(lds + L_V) + v_rd_base(lane) + eb * 512, vbK = (int)(uintptr_t)(lds + L_KE) + v_rd_base(lane);
    if (part == 0) {
#pragma unroll
    for (int db = 0; db < 4; ++db)
#pragma unroll
        for (int s = 0; s < 2; ++s) {
            u32x4 sw; sw.x = cvtpk(S[db][8 * s + 0], S[db][8 * s + 1]); sw.y = cvtpk(S[db][8 * s + 2], S[db][8 * s + 3]);
            sw.z = cvtpk(S[db][8 * s + 4], S[db][8 * s + 5]); sw.w = cvtpk(S[db][8 * s + 6], S[db][8 * s + 7]);
            const bf16x8 sf = __builtin_bit_cast(bf16x8, sw);
#pragma unroll
            for (int jb = 0; jb < 2; ++jb) { const int row = 32 * jb + r32, d0 = 32 * db + 16 * s + 4 * hi;
                const u32x2 a0 = *(const u32x2*)(lds + L_QE + swzA(row, d0 * 2)), a1 = *(const u32x2*)(lds + L_QE + swzA(row, (d0 + 8) * 2));
                const u32x4 aw = {a0.x, a0.y, a1.x, a1.y};
                o[jb] = __builtin_amdgcn_mfma_f32_32x32x16_bf16(__builtin_bit_cast(bf16x8, aw), sf, o[jb], 0, 0, 0); }
        }
    return; }
    bf16x8 vf0, vf1, vf2, vf3; tr_frag4<0>(vbV, vf0, vf1, vf2, vf3);
#define PFR(jb, ks) (*(const bf16x8*)(lds + L_P + swzP(32 * (jb) + r32, 32 * (ks) + 16 * hi)))
    o[0] = __builtin_amdgcn_mfma_f32_32x32x16_bf16(PFR(0, 0), vf0, o[0], 0, 0, 0);
    o[0] = __builtin_amdgcn_mfma_f32_32x32x16_bf16(PFR(0, 1), vf1, o[0], 0, 0, 0);
    o[1] = __builtin_amdgcn_mfma_f32_32x32x16_bf16(PFR(1, 0), vf0, o[1], 0, 0, 0);
    o[1] = __builtin_amdgcn_mfma_f32_32x32x16_bf16(PFR(1, 1), vf1, o[1], 0, 0, 0);
    o[1] = __builtin_amdgcn_mfma_f32_32x32x16_bf16(PFR(1, 2), vf2, o[1], 0, 0, 0);
    o[1] = __builtin_amdgcn_mfma_f32_32x32x16_bf16(PFR(1, 3), vf3, o[1], 0, 0, 0);
#undef PFR
    if (second) {
        float* ot = (float*)(lds + L_OT) + 32 * eb + r32 + 4 * hi * 128;
#pragma unroll
        for (int jb = 0; jb < 2; ++jb)
#pragma unroll
            for (int r = 0; r < 16; ++r) ot[(32 * jb + 8 * (r >> 2) + (r & 3)) * 128] = o[jb][r];
    } else {
#pragma unroll
        for (int jb = 0; jb < 2; ++jb)
#pragma unroll
            for (int g = 0; g < 4; ++g) { _Float16* pg = p0 + (32 * jb + 8 * g) * rstride;
#pragma unroll
                for (int e = 0; e < 4; ++e) pg[e * rstride] = (_Float16)o[jb][4 * g + e];
                asm volatile("" ::: "memory"); }
    }
    const float* dv = (const float*)(lds + L_DV);
#define SUPD(DB) do { bf16x8 k0_, k1_, k2_, k3_; tr_frag4<DB>(vbK, k0_, k1_, k2_, k3_); \
        { const float* dvp = dv + 32 * DB + 4 * hi; _Pragma("unroll") for (int g = 0; g < 4; ++g) { const f32x4 d4 = *(const f32x4*)(dvp + 8 * g); \
            S[DB][4 * g] *= d4[0]; S[DB][4 * g + 1] *= d4[1]; S[DB][4 * g + 2] *= d4[2]; S[DB][4 * g + 3] *= d4[3]; } } \
        S[DB] = __builtin_amdgcn_mfma_f32_32x32x16_bf16(k0_, vf0, S[DB], 0, 0, 0); S[DB] = __builtin_amdgcn_mfma_f32_32x32x16_bf16(k1_, vf1, S[DB], 0, 0, 0); \
        S[DB] = __builtin_amdgcn_mfma_f32_32x32x16_bf16(k2_, vf2, S[DB], 0, 0, 0); S[DB] = __builtin_amdgcn_mfma_f32_32x32x16_bf16(k3_, vf3, S[DB], 0, 0, 0); } while (0)
    SUPD(0); SUPD(1); SUPD(2); SUPD(3);
#undef SUPD
}
__device__ __forceinline__ void hgrn_bh(int b, int h, const bf16_t* proj, bf16_t* MIXp, const float* __restrict__ gain, char* lds, int wv) {
    int lane = lane_id(); asm volatile("" : "+v"(lane));
    const int wid = wv, tid = wv * 64 + lane, dp_ = lane, seg = wid;
    for (int i = tid; i < 8192 / 4; i += 512) ((unsigned*)(lds + L_P))[i] = 0u;
    f32x16 S[4] = {};
    const bf16_t* pbase = proj + (size_t)b * SEQ * DINP;
    float* segtot = (float*)(lds + L_SEG);
    if (tid < 128) ((float*)(lds + L_GN))[tid] = gain[tid];
    Pre pre; load_chunk(pre, pbase, h, 0, 0, wid, lane);
    __syncthreads();
    const int hw = lane >> 5, cq4 = lane & 31, sg16 = 2 * wid + hw;
    const int cB = (8 * cq4) ^ ((wid & 1) << 7) ^ (hw << 6), cA = cB ^ (((wid >> 1) & 1) << 3), rowb = wid * 2048 + hw * 1024;
    const int gV = (cq4 >> 3) * 512 + (cq4 & 7) * 8 + (wid >> 1) * 4096 + hw * 2048 + (wid & 1) * 256;
    const int drow = tid >> 3, dseg = tid & 7;
#define POST_SEGTOT() do { float a0_ = 0.f, a1_ = 0.f, a2_ = 0.f, a3_ = 0.f; \
        _Pragma("unroll") for (int t_ = 0; t_ < 4; ++t_) { const unsigned lx_ = pre.l4[t_].x, ly_ = pre.l4[t_].y; const h16x2 h0_ = __builtin_bit_cast(h16x2, lx_), h1_ = __builtin_bit_cast(h16x2, ly_); \
            a0_ += (float)h0_[0]; a1_ += (float)h0_[1]; a2_ += (float)h1_[0]; a3_ += (float)h1_[1]; } \
        *(f32x4*)(segtot + sg16 * 128 + 4 * cq4) = (f32x4){a0_, a1_, a2_, a3_}; } while (0)
    POST_SEGTOT();
    asm volatile("s_waitcnt lgkmcnt(0)" ::: "memory"); __builtin_amdgcn_s_barrier(); asm volatile("" ::: "memory");
    for (int k = 0; k < 64; ++k) {
        const int i = k >> 1, dir = k & 1, cs = dir ? 31 - i : i; const bool second = (i >= 16);
        const long row0 = (long)b * SEQ + (dir ? 64 * cs + 63 : 64 * cs);
        const int rstride = dir ? -DINP : DINP; const bool mine = ((wid >> 2) == dir);
        _Float16* rawp = (_Float16*)proj + (size_t)row0 * DINP + C_CQ + h * 128 + 32 * (wid & 3);
        f32x16 o[2]; u32x4 gq0, gq1;
        if (second) {
            if (mine) { const _Float16* p0 = rawp + (lane & 31) + 4 * (lane >> 5) * rstride;
#pragma unroll
                for (int jb = 0; jb < 2; ++jb)
#pragma unroll
                    for (int r = 0; r < 16; ++r) o[jb][r] = (float)p0[(32 * jb + 8 * (r >> 2) + (r & 3)) * rstride]; }
            const long grow = row0 + (dir ? -drow : drow); const bf16_t* gp = proj + (size_t)grow * DINP + C_G + h * 128 + 16 * dseg;
            gq0 = *(const u32x4*)gp; gq1 = *(const u32x4*)(gp + 8);
        } else { o[0] = f32x16{}; o[1] = f32x16{}; }
        const int I = wid >> 1;
        f32x4 rr[5];
        { f32x4 a = {0.f, 0.f, 0.f, 0.f};
#pragma unroll
          for (int sg = 0; sg < 16; ++sg) { if ((sg & 3) == 0) rr[sg >> 2] = a; a += *(const f32x4*)(segtot + sg * 128 + 4 * cq4); }
          rr[4] = a; }
        const f32x4 rI = (I == 0) ? rr[0] : (I == 1) ? rr[1] : (I == 2) ? rr[2] : rr[3];
        f32x4 run = rI;
#pragma unroll
        for (int q = 0; q < 3; ++q) { const f32x4 st = *(const f32x4*)(segtot + (4 * I + q) * 128 + 4 * cq4); if (4 * I + q < sg16) run += st; }
        f32x4 eI, eT, rat[4];
#pragma unroll
        for (int c = 0; c < 4; ++c) { eI[c] = __builtin_amdgcn_exp2f(rI[c]); eT[c] = __builtin_amdgcn_exp2f(rr[4][c] - rI[c]);
#pragma unroll
            for (int sg = 0; sg < 4; ++sg) rat[sg][c] = __builtin_amdgcn_exp2f(fminf(rr[sg][c] - rI[c], 0.f)); }
        if (sg16 == 0) { f32x4 d4;
#pragma unroll
            for (int c = 0; c < 4; ++c) d4[c] = __builtin_amdgcn_exp2f(rr[4][c]);
            *(f32x4*)((float*)(lds + L_DV) + 4 * cq4) = d4; }
#pragma unroll
        for (int t = 0; t < 4; ++t) {
            const unsigned lx = pre.l4[t].x, ly = pre.l4[t].y; const h16x2 h0 = __builtin_bit_cast(h16x2, lx), h1 = __builtin_bit_cast(h16x2, ly);
            const f32x4 lf = {(float)h0[0], (float)h0[1], (float)h1[0], (float)h1[1]};
            const f32x4 q = {bflo(pre.q4[t].x), bfhi(pre.q4[t].x), bflo(pre.q4[t].y), bfhi(pre.q4[t].y)};
            run += lf;
            f32x4 qt, qe, kI, ke;
#pragma unroll
            for (int c = 0; c < 4; ++c) { const float dlt = run[c] - rI[c];
                const float kk = 1.f - __builtin_amdgcn_exp2f(lf[c]);
                qt[c] = q[c] * __builtin_amdgcn_exp2f(dlt); kI[c] = kk * __builtin_amdgcn_exp2f(fminf(-dlt, 115.f)); }
            qe = qt * eI; ke = kI * eT;
            const int aB = (cB ^ (t << 4)) + rowb + t * 256, aA = (cA ^ (t << 4)) + rowb + t * 256, aV = gV + t * 64;
            *(u32x2*)(lds + L_QE + aA) = (u32x2){cvtpk(qe[0], qe[1]), cvtpk(qe[2], qe[3])};
            *(u32x2*)(lds + L_QT + aB) = (u32x2){cvtpk(qt[0], qt[1]), cvtpk(qt[2], qt[3])};
            *(u32x2*)(lds + L_KE + aV) = (u32x2){cvtpk(ke[0], ke[1]), cvtpk(ke[2], ke[3])};
            *(u32x2*)(lds + L_V + aV) = pre.v4[t];
#define KTW(base, SG) do { const f32x4 kv_ = kI * rat[SG]; *(u32x2*)(lds + L_KT + (base) * 256 + aB) = (u32x2){cvtpk(kv_[0], kv_[1]), cvtpk(kv_[2], kv_[3])}; } while (0)
#define KTD(base) do { *(u32x2*)(lds + L_KT + (base) * 256 + aB) = (u32x2){cvtpk(kI[0], kI[1]), cvtpk(kI[2], kI[3])}; } while (0)
            if (I == 0) { KTD(0); KTW(16, 1); KTW(48, 2); KTW(96, 3); }
            else if (I == 1) { KTD(16); KTW(48, 2); KTW(96, 3); }
            else if (I == 2) { KTD(48); KTW(96, 3); }
            else { KTD(96); }
#undef KTW
#undef KTD
        }
        asm volatile("s_waitcnt lgkmcnt(0)" ::: "memory"); __builtin_amdgcn_s_barrier(); asm volatile("" ::: "memory");
        if (k + 1 < 64) { const int k1 = k + 1, i1 = k1 >> 1, d1 = k1 & 1; load_chunk(pre, pbase, h, d1, d1 ? 31 - i1 : i1, wid, lane); }
        if (mine) stage_c(lds, S, o, rawp, rstride, second, wid & 3, lane, 0);
        else for (int blk = (wid & 3); blk < 10; blk += 4) {
            int bi, bjj; if (blk == 0) { bi = 0; bjj = 0; } else if (blk < 3) { bi = 1; bjj = blk - 1; } else if (blk < 6) { bi = 2; bjj = blk - 3; } else { bi = 3; bjj = blk - 6; }
            const int base = (bi == 0) ? 0 : (bi == 1) ? 16 : (bi == 2) ? 48 : 96;
            const int xm = ((lane & 15) << 4), cq4 = 16 * (lane >> 4);
            const char* ap = lds + L_QT + (16 * bi + (lane & 15)) * 256; const char* bp = lds + L_KT + (base + 16 * bjj + (lane & 15)) * 256;
            bf16x8 av[4], bv[4];
#pragma unroll
            for (int ks = 0; ks < 4; ++ks) { const int cb = (64 * ks + cq4) ^ xm; av[ks] = *(const bf16x8*)(ap + cb); bv[ks] = *(const bf16x8*)(bp + cb); }
            f32x4 acc = {0.f, 0.f, 0.f, 0.f};
#pragma unroll
            for (int ks = 0; ks < 4; ++ks) acc = __builtin_amdgcn_mfma_f32_16x16x32_bf16(av[ks], bv[ks], acc, 0, 0, 0);
            const int sl = lane & 15;
#pragma unroll
            for (int r = 0; r < 4; ++r) { const int jl = (lane >> 4) * 4 + r; const float v = (bi != bjj || sl <= jl) ? acc[r] : 0.f;
                *(bf16_t*)(lds + L_P + swzP(16 * bi + jl, (16 * bjj + sl) * 2)) = (bf16_t)(cvtpk(v, v) & 0xffffu); }
        }
        asm volatile("s_waitcnt lgkmcnt(0)" ::: "memory"); __builtin_amdgcn_s_barrier(); asm volatile("" ::: "memory");
        if (mine) stage_c(lds, S, o, rawp, rstride, second, wid & 3, lane, 1);
        if (k + 1 < 64) POST_SEGTOT();
        if (k == 31) asm volatile("s_waitcnt vmcnt(0)" ::: "memory");
        asm volatile("s_waitcnt lgkmcnt(0)" ::: "memory"); __builtin_amdgcn_s_barrier(); asm volatile("" ::: "memory");
        if (second) {
            const float* otp = (const float*)(lds + L_OT) + drow * 128 + 16 * dseg;
            f32x4 v[4]; float ss = 0.f;
#pragma unroll
            for (int q = 0; q < 4; ++q) { v[q] = *(const f32x4*)(otp + 4 * q); ss += (v[q][0] * v[q][0] + v[q][1] * v[q][1]) + (v[q][2] * v[q][2] + v[q][3] * v[q][3]); }
            ss = dpp_sum8(ss);
            const float r = __builtin_amdgcn_rsqf(ss * (1.f / 128.f) + EPS);
            f32x4 gn[4];
#pragma unroll
            for (int q = 0; q < 4; ++q) gn[q] = *(const f32x4*)((const float*)(lds + L_GN) + 16 * dseg + 4 * q);
            const unsigned gw[8] = {gq0.x, gq0.y, gq0.z, gq0.w, gq1.x, gq1.y, gq1.z, gq1.w}; unsigned ow[8];
#pragma unroll
            for (int q = 0; q < 8; ++q) { const float g0 = bflo(gw[q]), g1 = bfhi(gw[q]);
                const float s0 = g0 * __builtin_amdgcn_rcpf(1.f + __builtin_amdgcn_exp2f(-1.4426950408889634f * g0)), s1 = g1 * __builtin_amdgcn_rcpf(1.f + __builtin_amdgcn_exp2f(-1.4426950408889634f * g1));
                ow[q] = cvtpk(v[q >> 1][2 * (q & 1)] * r * gn[q >> 1][2 * (q & 1)] * s0, v[q >> 1][2 * (q & 1) + 1] * r * gn[q >> 1][2 * (q & 1) + 1] * s1); }
            const long grow = row0 + (dir ? -drow : drow); bf16_t* mp = MIXp + (size_t)grow * DM + 512 + h * 128 + 16 * dseg;
            *(u32x4*)mp = (u32x4){ow[0], ow[1], ow[2], ow[3]}; *(u32x4*)(mp + 8) = (u32x4){ow[4], ow[5], ow[6], ow[7]};
        }
    }
    __syncthreads();
}
}

#define XB_TMO      128
#define XB_XCNT(j)  (256  + 64 * (j))
#define XB_XSUB(j)  (1280 + 64 * (j))
#define XB_XGEN(j)  (2304 + 64 * (j))
#define XB_TOP      3328
#define XB_TOPGEN   3392
#define XCD_BAR_WORDS 3456
#define XB_SPIN_CAP (1u << 18)

__device__ __forceinline__ unsigned xb_ld(unsigned* p)              { return __hip_atomic_load(p, __ATOMIC_RELAXED, __HIP_MEMORY_SCOPE_AGENT); }
__device__ __forceinline__ unsigned xb_add(unsigned* p, unsigned v) { return __hip_atomic_fetch_add(p, v, __ATOMIC_RELAXED, __HIP_MEMORY_SCOPE_AGENT); }
__device__ __forceinline__ unsigned xb_xcc_id() { return (unsigned)__builtin_amdgcn_s_getreg((3 << 11) | 20) & 0xFu; }
#define XB_SPIN(cond, bar) do { unsigned _sp = 0; while (cond) { __builtin_amdgcn_s_sleep(1); \
    if ((++_sp & 255u) == 0u) { if (xb_ld(&(bar)[XB_TMO])) break; if (_sp > XB_SPIN_CAP) { atomicAdd(&(bar)[XB_TMO], 1u); break; } } } } while (0)

struct XcdBarrier {
    unsigned* bar; unsigned x;
    volatile LAS unsigned* st;
};

__device__ __forceinline__ XcdBarrier xcd_barrier_post(unsigned* bar, volatile LAS unsigned* st, bool leader  ) {
    XcdBarrier b; b.bar = bar; b.x = xb_xcc_id(); b.st = st;
    if (leader) (void)xb_add(&bar[XB_XCNT(b.x)], 1u);
    return b;
}
__device__ __forceinline__ void xcd_barrier_complete(unsigned* bar, unsigned x, unsigned& nloc, unsigned& nx) {
    const unsigned G = gridDim.x * gridDim.y * gridDim.z;
    unsigned sum, cnt, mine, sp = 0u;
    for (;;) {
        sum = 0u; cnt = 0u; mine = 0u;
#pragma unroll
        for (unsigned j = 0; j < 16; ++j) { const unsigned c = xb_ld(&bar[XB_XCNT(j)]); sum += c; cnt += (c > 0u) ? 1u : 0u; mine = (j == x) ? c : mine; }
        if (sum == G) break;
        __builtin_amdgcn_s_sleep(1);
        if ((++sp & 255u) == 0u) { if (xb_ld(&bar[XB_TMO])) break; if (sp > XB_SPIN_CAP) { atomicAdd(&bar[XB_TMO], 1u); break; } }
    }
    nloc = mine > 0u ? mine : 1u; nx = cnt > 0u ? cnt : 1u;
}

__device__ __forceinline__ void xcd_barrier(const XcdBarrier& b, bool leader  ) {
    asm volatile("s_waitcnt vmcnt(0)" ::: "memory");
    __syncthreads();
    if (leader) {
        unsigned* bar = b.bar;
        __builtin_amdgcn_s_waitcnt(0);
        unsigned nloc = b.st[0], nx = b.st[1];
        if (nloc == 0u) { xcd_barrier_complete(bar, b.x, nloc, nx); b.st[0] = nloc; b.st[1] = nx; }
        const unsigned old = xb_add(&bar[XB_XSUB(b.x)], 1u);
        const unsigned gen = old / nloc;
        if (old + 1u == (gen + 1u) * nloc) {
            __builtin_amdgcn_fence(__ATOMIC_RELEASE, "agent");
            asm volatile("s_waitcnt vmcnt(0)" ::: "memory");
            const unsigned og = xb_add(&bar[XB_TOP], 1u);
            const unsigned tg = og / nx;
            if (og + 1u == (tg + 1u) * nx) xb_add(&bar[XB_TOPGEN], 1u);
            else XB_SPIN(xb_ld(&bar[XB_TOPGEN]) == tg, bar);
            __builtin_amdgcn_fence(__ATOMIC_ACQUIRE, "agent");
            xb_add(&bar[XB_XGEN(b.x)], 1u);
            asm volatile("s_waitcnt vmcnt(0)" ::: "memory");
        } else {
            XB_SPIN(xb_ld(&bar[XB_XGEN(b.x)]) == gen, bar);
            __builtin_amdgcn_fence(__ATOMIC_ACQUIRE, "agent");
            asm volatile("s_waitcnt vmcnt(0)" ::: "memory");
        }
    }
    __syncthreads();
}


constexpr int NWAVES = 8;
constexpr int LDS_BYTES = 160 * 1024;
constexpr int RING_BYTES = 131072, EPI_OFF = RING_BYTES  , TAB_OFF = RING_BYTES + 8192  , MISC_OFF = 160 * 1024 - 1024;
constexpr size_t CTL_ZERO_BYTES = 65536;
struct Args { const float* in[17]; float* out; unsigned char* ws; int ph_lo, ph_hi; };

__device__ __forceinline__ int rope_perm(int cp) { const int i = cp >> 3, j = cp & 7; return (j < 4) ? 4 * i + j : 32 + 4 * i + (j - 4); }
__device__ __forceinline__ void tr_item(const float* W, int ldw, int ksrc0, int srccol, const float* gain, int goff, bf16_t* WT, int Kd, int kd0, int nd0, LAS float* scr, int lane) {
    float wv_[32], gv_[32];
#pragma unroll
    for (int i = 0; i < 32; ++i) { const int kk = 2 * i + (lane >> 5); wv_[i] = (srccol >= 0) ? W[(size_t)(ksrc0 + kk) * ldw + srccol] : 0.f; gv_[i] = gain ? gain[ksrc0 + kk - goff] : 1.f; }
#pragma unroll
    for (int i = 0; i < 32; ++i) { const int kk = 2 * i + (lane >> 5); scr[kk * 33 + (lane & 31)] = wv_[i] * gv_[i]; }
    asm volatile("s_waitcnt lgkmcnt(0)" ::: "memory");
    const int c = lane & 7;
#pragma unroll
    for (int j = 0; j < 4; ++j) { const int n = (lane >> 3) + 8 * j; const LAS float* sp = scr + (8 * c) * 33 + n;
        u32x4 o; o.x = pk2(sp[0 * 33], sp[1 * 33]); o.y = pk2(sp[2 * 33], sp[3 * 33]); o.z = pk2(sp[4 * 33], sp[5 * 33]); o.w = pk2(sp[6 * 33], sp[7 * 33]);
        *(u32x4*)(WT + (size_t)(nd0 + n) * Kd + kd0 + 8 * c) = o; }
    asm volatile("s_waitcnt lgkmcnt(0)" ::: "memory");
}
template <int R>
__device__ __forceinline__ void rows_to_bf16_rs(const float* x0, bf16_t* o0, float* rs0, size_t rstep, int lane) {
    f32x4 v[R][4]; float s[R];
#pragma unroll
    for (int r = 0; r < R; ++r) { const f32x4* xr = (const f32x4*)(x0 + (size_t)r * rstep * DM) + lane;
#pragma unroll
        for (int j = 0; j < 4; ++j) v[r][j] = xr[64 * j]; }
#pragma unroll
    for (int r = 0; r < R; ++r) { float a = 0.f;
#pragma unroll
        for (int j = 0; j < 4; ++j) a += (v[r][j].x * v[r][j].x + v[r][j].y * v[r][j].y) + (v[r][j].z * v[r][j].z + v[r][j].w * v[r][j].w);
        s[r] = a; }
#pragma unroll
    for (int o = 1; o < 64; o <<= 1) {
#pragma unroll
        for (int r = 0; r < R; ++r) s[r] += __shfl_xor(s[r], o); }
#pragma unroll
    for (int r = 0; r < R; ++r) { if (lane == 0) rs0[(size_t)r * rstep] = 1.f / sqrtf(s[r] * (1.f / DM) + EPS);
        u32x2* o8 = (u32x2*)(o0 + (size_t)r * rstep * DM) + lane;
#pragma unroll
        for (int j = 0; j < 4; ++j) { u32x2 w; w.x = cvtpk(v[r][j].x, v[r][j].y); w.y = cvtpk(v[r][j].z, v[r][j].w); o8[64 * j] = w; } }
}
__device__ __forceinline__ void sincos_acc(float ang, float& c, float& s) {
    const double x = (double)ang; const double kq = __builtin_rint(x * 0.6366197723675814); const double y = x - kq * 1.5707963267948966 - kq * 6.123233995736766e-17;
    const double y2 = y * y;
    double sp = -7.6471637318198164759e-13; sp = sp * y2 + 1.6059043836821614599e-10; sp = sp * y2 - 2.5052108385441718775e-8; sp = sp * y2 + 2.7557319223985890653e-6; sp = sp * y2 - 1.9841269841269841270e-4; sp = sp * y2 + 8.3333333333333333333e-3; sp = sp * y2 - 1.6666666666666666667e-1; sp = y + y * y2 * sp;
    double cp = 4.7794773323873852974e-14; cp = cp * y2 - 1.1470745597729724714e-11; cp = cp * y2 + 2.0876756987868098979e-9; cp = cp * y2 - 2.7557319223985890653e-7; cp = cp * y2 + 2.4801587301587301587e-5; cp = cp * y2 - 1.3888888888888888889e-3; cp = cp * y2 + 4.1666666666666666667e-2; cp = cp * y2 - 0.5; cp = 1.0 + y2 * cp;
    const int q = ((int)(long long)kq) & 3;
    const double sv = (q == 0) ? sp : (q == 1) ? cp : (q == 2) ? -sp : -cp;
    const double cv = (q == 0) ? cp : (q == 1) ? -sp : (q == 2) ? -cp : sp;
    c = (float)cv; s = (float)sv;
}

__global__ void __launch_bounds__(NWAVES * 64, 2) mk_fwd(Args args) {
    extern __shared__ __attribute__((aligned(16))) unsigned char lds[];
    const int g_wv = __builtin_amdgcn_readfirstlane(threadIdx.x >> 6);
#define TIDV() ({ int t_ = g_wv * 64 + lane_id(); asm volatile("" : "+v"(t_)); t_; })
    const int G = gridDim.x, bx = blockIdx.x;
    unsigned char* ws = args.ws;
    const float* x = args.in[0]; const int* positions = (const int*)args.in[1];
    const float* g_mix = args.in[2]; const float* w_in = args.in[3]; const float* lb_param = args.in[4]; const float* g_hgrn = args.in[5];
    const float* g_cq = args.in[6]; const float* w_q_up = args.in[7]; const float* g_ckv = args.in[8]; const float* w_kv_up = args.in[9];
    const float* g_qn = args.in[10]; const float* g_kn = args.in[11]; const float* g_mla_out = args.in[12]; const float* w_out = args.in[13];
    const float* g_ffn = args.in[14]; const float* w_up = args.in[15]; const float* w_down = args.in[16];
    float* out = args.out;
    float* RS0 = (float*)(ws + WS_RS0); float* SSQ1 = (float*)(ws + WS_SSQ1); float* SSQP = (float*)(ws + WS_SSQP); float* GQT = (float*)(ws + WS_GQT); float* GKT = (float*)(ws + WS_GKT); float* LBT = (float*)(ws + WS_LBT);
    float* COS = (float*)(ws + WS_COS); float* SIN = (float*)(ws + WS_SIN);
    bf16_t* WIN = (bf16_t*)(ws + WS_WIN); bf16_t* WQ = (bf16_t*)(ws + WS_WQ); bf16_t* WKV = (bf16_t*)(ws + WS_WKV); bf16_t* WOUT = (bf16_t*)(ws + WS_WOUT);
    bf16_t* WUP = (bf16_t*)(ws + WS_WUP); bf16_t* WDN = (bf16_t*)(ws + WS_WDN);
    bf16_t* XB = (bf16_t*)(ws + WS_XB); bf16_t* VB = (bf16_t*)(ws + WS_V); bf16_t* X1B = (bf16_t*)(ws + WS_X1B);
    bf16_t* PROJ = (bf16_t*)(ws + WS_PROJ); bf16_t* HB = (bf16_t*)(ws + WS_HB);
    bf16_t* MIX = (bf16_t*)(ws + WS_MIX); float* SSQA = (float*)(ws + WS_SSQA);
    bf16_t* QB = (bf16_t*)(ws + WS_Q); bf16_t* KB = (bf16_t*)(ws + WS_K);
    const int lo = args.ph_lo, hi = args.ph_hi;
    cooperative_groups::grid_group grid = cooperative_groups::this_grid();
    volatile LAS unsigned* MISC = (volatile LAS unsigned*)((LAS unsigned char*)lds + MISC_OFF);
    { const int tid = TIDV(); if (tid < 32) MISC[tid] = 0u; }
    __syncthreads();
    XcdBarrier bar = xcd_barrier_post((unsigned*)(ws + WS_CTL) + 4096, MISC + 8, TIDV() == 0);
    if (args.ph_hi > 1000) grid.sync();
#define SEAM(k) do { if (lo <= (k) && (k) + 1 < hi) xcd_barrier(bar, TIDV() == 0); } while (0)
#ifndef PHMASK
#define PHMASK 0xFFF
#endif
#define IN(k) (((PHMASK >> (k)) & 1) && lo <= (k) && (k) < hi)
#ifndef REPMASK
#define REPMASK 0
#endif
#define REPS(k) for (int rep_ = 0; rep_ < ((((REPMASK) >> (k)) & 1) ? 2 : 1); ++rep_)

    if (IN(0)) REPS(0) {
        const int tid = TIDV(), lane = tid & 63, wave = g_wv;
        const int vcu = (G % 8 == 0) ? (bx % 8) * (G / 8) + bx / 8 : bx;
        const int gw = vcu * NWAVES + wave, NGW = G * NWAVES;
        LAS float* scr = (LAS float*)((LAS unsigned char*)lds + wave * 16384);
        constexpr int I_IN = 16 * 104, I_Q = 6 * 32, I_KV = 4 * 32, I_OUT = 16 * 32, I_UP = 16 * 128, I_DN = 64 * 32;
        constexpr int NITEMS = I_IN + I_Q + I_KV + I_OUT + I_UP + I_DN;
        const int l31 = lane & 31;
        for (int it = gw; it < NITEMS; it += NGW) {
            int r = it;
            if (r < I_IN) { const int kb = r / 104, nb = r % 104, nd = 32 * nb + l31; const int sc = nd < C_KR ? nd : (nd < DIN ? C_KR + rope_perm(nd - C_KR) : -1);
                tr_item(w_in, DIN, 64 * kb, sc, g_mix, 0, WIN, DM, 64 * kb, 32 * nb, scr, lane); continue; } r -= I_IN;
            if (r < I_Q) { const int kb = r / 32, nb = r % 32, nd = 32 * nb + l31, hh = nd >> 8, c = nd & 255; const int sc = c < 128 ? hh * 192 + c : (c < 192 ? hh * 192 + 128 + rope_perm(c - 128) : -1);
                tr_item(w_q_up, NQ, 64 * kb, sc, g_cq, 0, WQ, QLORA, 64 * kb, 32 * nb, scr, lane); continue; } r -= I_Q;
            if (r < I_KV) { const int kb = r / 32, nb = r % 32; tr_item(w_kv_up, NKV, 64 * kb, 32 * nb + l31, g_ckv, 0, WKV, KVLORA, 64 * kb, 32 * nb, scr, lane); continue; } r -= I_KV;
            if (r < I_OUT) { const int kb = r / 32, nb = r % 32; const int kd0 = 64 * kb, ks0 = kd0 < 512 ? kd0 + 512 : kd0 - 512;
                tr_item(w_out, DM, ks0, 32 * nb + l31, kd0 < 512 ? g_mla_out : nullptr, 512, WOUT, DM, kd0, 32 * nb, scr, lane); continue; } r -= I_OUT;
            if (r < I_UP) { const int kb = r / 128, nb = r % 128; tr_item(w_up, DFF, 64 * kb, 32 * nb + l31, g_ffn, 0, WUP, DM, 64 * kb, 32 * nb, scr, lane); continue; } r -= I_UP;
            { const int kb = r / 32, nb = r % 32; tr_item(w_down, DM, 64 * kb, 32 * nb + l31, nullptr, 0, WDN, DFF, 64 * kb, 32 * nb, scr, lane); }
        }
        for (int i = bx * 512 + tid; i < 512; i += G * 512) ((float*)(ws + WS_GHT))[i] = g_hgrn[i];
        for (int i = bx * 512 + tid; i < 512; i += G * 512) {
            if (i < 256) GQT[i] = i < 128 ? g_qn[i] * QSCALE : (i < 192 ? g_qn[128 + rope_perm(i - 128)] * QSCALE : 0.f);
            else { const int c = i - 256; if (c < 192) GKT[c] = c < 128 ? g_kn[c] : g_kn[128 + rope_perm(c - 128)]; } }
        for (int m = gw; m < M; m += 4 * NGW) rows_to_bf16_rs<4>(x + (size_t)m * DM, XB + (size_t)m * DM, RS0 + m, (size_t)NGW, lane);
        for (int i = bx * 512 + tid; i < 1024; i += G * 512) { const int dir = i >> 9, c = i & 511; const float p0 = lb_param[dir * 1024 + c], p1 = lb_param[dir * 1024 + 512 + c];
            LBT[i] = 1.f / (1.f + expf(p1 - p0)); }
        { const int j = tid & 31; const float invf = powf(10000.0f, -(float)(2 * j) / 64.0f);
          for (int i = bx * 512 + tid; i < M * 32; i += G * 512) { const int row = i >> 5; const float ang = (float)positions[row] * invf; float c, sn; sincos_acc(ang, c, sn); COS[i] = c; SIN[i] = sn; } }
    }
    SEAM(0);
    if (IN(1)) REPS(1) {
        pg8::Gemm g{XB, WIN, M, DINP, DM, DM}; pg8::StaticOrder S; S.init(M, DINP, G, bx);
        LAS float* rsT = (LAS float*)((LAS unsigned char*)lds + TAB_OFF);
        for (int ui = 0; ui < 16; ++ui) { pg8::Unit uu; if (!S.next(ui, uu)) break; const int tid = TIDV(); if (tid < 256) rsT[ui * 256 + tid] = RS0[uu.pm * 256 + tid]; }
        __syncthreads();
        pg8::EpiProj E{PROJ, DINP, rsT, LBT, SSQP, M, (LAS float*)((LAS unsigned char*)lds + EPI_OFF)};
        pg8::gemm_phase<pg8::EpiProj, pg8::StaticOrder, true, true>((LAS unsigned char*)lds, g, S, E, g_wv);
    }
    SEAM(1);
    if (IN(2)) REPS(2) {
        pg8::Gemm g{PROJ + C_CQ, WQ, M, 1024, QLORA, DINP}; pg8::StaticOrder S; S.init(M, 1024, G, bx);
        LAS float* rsT = (LAS float*)((LAS unsigned char*)lds + TAB_OFF);
        for (int ui = 0; ui < 4; ++ui) { pg8::Unit uu; if (!S.next(ui, uu)) break;
            const int tid = TIDV(); if (tid < 256) { const int row = uu.pm * 256 + tid; rsT[ui * 256 + tid] = __builtin_amdgcn_rsqf(((SSQP[row] + SSQP[M + row]) + SSQP[2 * (size_t)M + row]) * (1.f / 384.f) + EPS); } }
        __syncthreads();
        pg8::EpiQ E{QB, rsT, GQT, COS, SIN, (LAS float*)((LAS unsigned char*)lds + EPI_OFF)};
        pg8::gemm_phase<pg8::EpiQ, pg8::StaticOrder, true, true>((LAS unsigned char*)lds, g, S, E, g_wv);
    }
    if (IN(3)) REPS(3) {
        pg8::Gemm g{PROJ + C_CKV, WKV, M, NKV, KVLORA, DINP}; pg8::StaticOrder S; S.init(M, NKV, G, bx);
        LAS float* rsT = (LAS float*)((LAS unsigned char*)lds + TAB_OFF + 8192); LAS float* skT = rsT + 1024;
        for (int ui = 0; ui < 4; ++ui) { pg8::Unit uu; if (!S.next(ui, uu)) break;
            const int tid = TIDV(); if (tid < 256) { const int row = uu.pm * 256 + tid; rsT[ui * 256 + tid] = __builtin_amdgcn_rsqf((SSQP[3 * (size_t)M + row] + SSQP[4 * (size_t)M + row]) * (1.f / 256.f) + EPS); skT[ui * 256 + tid] = SSQP[5 * (size_t)M + row]; } }
        __syncthreads();
        pg8::EpiKV E{KB, VB, PROJ, DINP, C_KR, rsT, skT, GKT, COS, SIN, (LAS float*)((LAS unsigned char*)lds + EPI_OFF)};
        pg8::gemm_phase<pg8::EpiKV, pg8::StaticOrder, true, true>((LAS unsigned char*)lds, g, S, E, g_wv);
    }
    SEAM(4);
    if (IN(5)) {
        if (bx < BATCH * 4) hg::hgrn_bh(bx >> 2, bx & 3, PROJ, MIX, (const float*)(ws + WS_GHT) + (bx & 3) * 128, (char*)lds, g_wv);
        unsigned* ctr = (unsigned*)(ws + WS_CTL) + 64;
        for (;;) {
            __syncthreads();
            if (TIDV() == 0) MISC[16] = __hip_atomic_fetch_add(ctr, 1u, __ATOMIC_RELAXED, __HIP_MEMORY_SCOPE_AGENT);
            __syncthreads();
            const unsigned u = MISC[16];
            if (u >= (unsigned)(BATCH * 4 * 8)) break;
            const int bh = u >> 3, qb = u & 7, b = bh >> 2, h = bh & 3;
            att::attn_unit(QB + ((size_t)bh * SEQ + qb * 256) * 192, KB + (size_t)bh * SEQ * 192, VB + (size_t)bh * SEQ * 128,
                           MIX + ((size_t)b * SEQ + qb * 256) * DM + h * 128, DM, SSQA + (size_t)h * M + (size_t)b * SEQ + qb * 256, SEQ, (char*)lds, g_wv);
        }
    }
    SEAM(7);
    if (IN(8)) REPS(8) {
        pg8::Gemm g{MIX, WOUT, M, DM, DM, DM}; pg8::StaticOrder S; S.init(M, DM, G, bx);
        LAS float* rsbT = (LAS float*)((LAS unsigned char*)lds + EPI_OFF + 4096);
        for (int ui = 0; ui < 4; ++ui) { pg8::Unit uu; if (!S.next(ui, uu)) break;
            const int tid = TIDV(); if (tid < 256) { const int row = uu.pm * 256 + tid; rsbT[ui * 256 + tid] = 1.f / sqrtf(((SSQA[row] + SSQA[M + row]) + (SSQA[2 * (size_t)M + row] + SSQA[3 * (size_t)M + row])) * (1.f / 512.f) + EPS); } }
        __syncthreads();
        pg8::EpiResidX1 E{XB, X1B, SSQ1, DM, M, (LAS float*)((LAS unsigned char*)lds + EPI_OFF), rsbT};
        pg8::gemm_phase<pg8::EpiResidX1, pg8::StaticOrder, true, true>((LAS unsigned char*)lds, g, S, E, g_wv);
    }
    SEAM(8);
    if (IN(10)) REPS(10) {
        pg8::Gemm g{X1B, WUP, M, DFF, DM, DM}; pg8::StaticOrder S; S.init(M, DFF, G, bx);
        LAS float* rsT = (LAS float*)((LAS unsigned char*)lds + TAB_OFF);
        for (int ui = 0; ui < 16; ++ui) { pg8::Unit uu; if (!S.next(ui, uu)) break;
            const int tid = TIDV(); if (tid < 256) { const int row = uu.pm * 256 + tid; rsT[ui * 256 + tid] = __builtin_amdgcn_rsqf(((SSQ1[row] + SSQ1[M + row]) + (SSQ1[2 * (size_t)M + row] + SSQ1[3 * (size_t)M + row])) * (1.f / 1024.f) + EPS); } }
        __syncthreads();
        pg8::EpiUp E{HB, DFF, rsT};
        pg8::gemm_phase<pg8::EpiUp, pg8::StaticOrder, true, true>((LAS unsigned char*)lds, g, S, E, g_wv);
    }
    SEAM(10);
    if (IN(11)) {
        pg8::Gemm g{HB, WDN, M, DM, DFF, DFF}; pg8::StaticOrder S; S.init(M, DM, G, bx);
        pg8::EpiResidBf E{X1B, out, DM};
        pg8::gemm_phase<pg8::EpiResidBf, pg8::StaticOrder, true, true>((LAS unsigned char*)lds, g, S, E, g_wv);
    }
#undef IN
}

extern "C" void kernel_launch(void* const* d_in, const int* in_sizes, int n_in, void* d_out, int out_size, void* d_ws, size_t ws_size, hipStream_t stream) {
    static int ok = 0, grid_blocks = 0;
    if (ok == 0) {
        if (n_in != 17 || in_sizes[0] != M * DM || out_size != M * DM || ws_size < WS_END) {
            fprintf(stderr, "kernel_launch: shape mismatch n_in %d in0 %d out %d ws %zu (need %zu)\n", n_in, n_in > 0 ? in_sizes[0] : -1, out_size, ws_size, (size_t)WS_END); ok = -1; return; }
        if (hipFuncSetAttribute((const void*)mk_fwd, hipFuncAttributeMaxDynamicSharedMemorySize, LDS_BYTES) != hipSuccess) { fprintf(stderr, "kernel_launch: hipFuncSetAttribute failed\n"); ok = -1; return; }
        int dev = 0, cus = 0, per_cu = 0;
        (void)hipGetDevice(&dev); (void)hipDeviceGetAttribute(&cus, hipDeviceAttributeMultiprocessorCount, dev);
        (void)hipOccupancyMaxActiveBlocksPerMultiprocessor(&per_cu, (const void*)mk_fwd, NWAVES * 64, LDS_BYTES);
        if (per_cu < 1 || cus < 1) { fprintf(stderr, "kernel_launch: occupancy query gave %d blocks/CU on %d CUs\n", per_cu, cus); ok = -1; return; }
        grid_blocks = cus * (per_cu > 1 ? 1 : per_cu);
        ok = 1;
    }
    if (ok < 0) return;
    (void)hipMemsetAsync((char*)d_ws + WS_CTL, 0, CTL_ZERO_BYTES, stream);
    Args a{};
    for (int i = 0; i < 17; ++i) a.in[i] = (const float*)d_in[i];
    a.out = (float*)d_out; a.ws = (unsigned char*)d_ws;
    a.ph_lo = 0; a.ph_hi = 12;
    void* kargs[] = {&a};
    (void)hipLaunchCooperativeKernel((const void*)mk_fwd, dim3(grid_blocks), dim3(NWAVES * 64), kargs, LDS_BYTES, stream);
    const hipError_t le = hipPeekAtLastError();
    if (le != hipSuccess) fprintf(stderr, "kernel_launch: launch failed: %s\n", hipGetErrorName(le));
}
```

```cpp
#include <hip/hip_runtime.h>
#include <hip/hip_cooperative_groups.h>
#include <cstdio>
#include <cstdint>

#define LAS __attribute__((address_space(3)))
typedef unsigned short bf16_t;
typedef short bf16x8 __attribute__((ext_vector_type(8)));
typedef short s16x4 __attribute__((ext_vector_type(4)));
typedef float f32x4 __attribute__((ext_vector_type(4)));
typedef float f32x16 __attribute__((ext_vector_type(16)));
typedef unsigned u32x4 __attribute__((ext_vector_type(4)));
typedef unsigned u32x2 __attribute__((ext_vector_type(2)));
typedef _Float16 h16x2 __attribute__((ext_vector_type(2)));

constexpr int BATCH = 32, SEQ = 2048, DM = 1024, M = BATCH * SEQ;
constexpr int DIN = 3264, DINP = 3328, DFF = 4096;
constexpr int C_Q = 0, C_FF = 512, C_I = 1536, C_G = 2048, C_CQ = 2560, C_CKV = 2944, C_KR = 3200;
constexpr int QLORA = 384, KVLORA = 256, NQ = 768, NKV = 1024;
constexpr float EPS = 1e-6f;
constexpr float QSCALE = 0.07216878364870322f * 1.4426950408889634f;

constexpr size_t MiB = 1u << 20;
constexpr size_t WS_CTL = 0;
constexpr size_t WS_RS0 = 1 * MiB, WS_RS1 = WS_RS0 + 256 * 1024, WS_LBT = WS_RS1 + 256 * 1024;
constexpr size_t WS_COS = 2 * MiB, WS_SIN = 10 * MiB;
constexpr size_t WS_WIN = 18 * MiB, WS_WQ = 25 * MiB, WS_WKV = 26 * MiB, WS_WOUT = 27 * MiB, WS_WUP = 29 * MiB, WS_WDN = 37 * MiB;
constexpr size_t WS_GQT = WS_LBT + 4096, WS_GKT = WS_GQT + 1024, WS_GHT = WS_GKT + 1024;
constexpr size_t WS_SSQ1 = 45 * MiB;
constexpr size_t WS_XB = 46 * MiB;
constexpr size_t WS_X1B = 718 * MiB;
constexpr size_t WS_PROJ = 174 * MiB;
constexpr size_t WS_HB = 174 * MiB;
constexpr size_t WS_MIX = 590 * MiB;
constexpr size_t WS_Q = 718 * MiB, WS_K = 814 * MiB, WS_V = 910 * MiB;
constexpr size_t WS_SSQP = 974 * MiB;
constexpr size_t WS_SSQA = 976 * MiB;
constexpr size_t WS_END = 977 * MiB;

__device__ __forceinline__ unsigned f2bf(float f) { unsigned u = __builtin_bit_cast(unsigned, f); return (u + 0x7fffu + ((u >> 16) & 1u)) >> 16; }
__device__ __forceinline__ unsigned pk2(float lo, float hi) { return f2bf(lo) | (f2bf(hi) << 16); }
__device__ __forceinline__ float bf2f(unsigned short b) { return __builtin_bit_cast(float, (unsigned)b << 16); }
__device__ __forceinline__ float bflo(unsigned w) { return __builtin_bit_cast(float, w << 16); }
__device__ __forceinline__ float bfhi(unsigned w) { return __builtin_bit_cast(float, w & 0xffff0000u); }
__device__ __forceinline__ float wave_sum(float v) {
#pragma unroll
    for (int o = 1; o < 64; o <<= 1) v += __shfl_xor(v, o);
    return v;
}
__device__ __forceinline__ int lane_id() { int l; asm volatile("v_mbcnt_lo_u32_b32 %0, -1, 0\n\tv_mbcnt_hi_u32_b32 %0, -1, %0" : "=v"(l)); return l; }
__device__ __forceinline__ float dpp_sum8(float v) {
    v += __builtin_bit_cast(float, __builtin_amdgcn_update_dpp(0, __builtin_bit_cast(int, v), 0xB1, 0xF, 0xF, true));
    v += __builtin_bit_cast(float, __builtin_amdgcn_update_dpp(0, __builtin_bit_cast(int, v), 0x4E, 0xF, 0xF, true));
    v += __builtin_bit_cast(float, __builtin_amdgcn_update_dpp(0, __builtin_bit_cast(int, v), 0x141, 0xF, 0xF, true));
    return v;
}
typedef float f32x2_t __attribute__((ext_vector_type(2))); typedef __bf16 bf16x2_t __attribute__((ext_vector_type(2)));
__device__ __forceinline__ unsigned cvtpk(float lo, float hi) { f32x2_t v = {lo, hi}; bf16x2_t b = __builtin_convertvector(v, bf16x2_t); return __builtin_bit_cast(unsigned, b); }
__device__ __forceinline__ unsigned cvt_pk_bf16(float lo, float hi) { unsigned r; asm volatile("v_cvt_pk_bf16_f32 %0, %1, %2" : "=v"(r) : "v"(lo), "v"(hi)); return r; }

namespace pg8 {
#define PG8_LAS __attribute__((address_space(3)))
constexpr int BM = 256, BK = 64, HALF = 128, HTB = HALF * BK * 2, STAGE_BYTES = 8 * HTB, NXCD = 8, WGM = 8;
__host__ __device__ __forceinline__ int lds_byte(int r, int c) { const int st = (r >> 4) * 2 + (c >> 5), rr = r & 15, cc = c & 31, ob = rr * 64 + cc * 2; return st * 1024 + (ob ^ (((ob >> 9) & 1) << 5)); }
__host__ __device__ __forceinline__ void stage_rc(int b, int& R, int& C) { const int st = b / 1024, sb = b % 1024, swz = sb ^ (((sb >> 9) & 1) << 5); R = (st >> 1) * 16 + swz / 64; C = (st & 1) * 32 + (swz % 64) / 2; }
__host__ __device__ __forceinline__ int perm32(int rho) { const int n = rho >> 4, i = rho & 15; return 8 * (i >> 2) + 4 * n + (i & 3); }
struct Unit { int pm, pn; };
struct Gemm { const bf16_t* A; const bf16_t* Bt; int M, N, K, lda; };
struct StaticOrder {
    int nM, nN, nwg, G, c;
    __host__ __device__ __forceinline__ void init(int M_, int N_, int G_, int c_) { nM = M_ / BM; nN = N_ / BM; nwg = nM * nN; G = G_; c = c_; }
    __host__ __device__ __forceinline__ bool next(int i, Unit& u) const {
        const long L = (long)i * G + c; if (L >= nwg) return false;
        int wgid = (int)L; { const int q = nwg / NXCD, r = nwg % NXCD, xcd = wgid % NXCD, off = wgid / NXCD; wgid = (xcd < r ? xcd * (q + 1) : r * (q + 1) + (xcd - r) * q) + off; }
        const int nig = WGM * nN, gid = wgid / nig, fm = gid * WGM, gsz = (nM - fm) < WGM ? (nM - fm) : WGM;
        u.pm = fm + ((wgid % nig) % gsz); u.pn = (wgid % nig) / gsz; return true;
    }
    __device__ __forceinline__ void a_ready(const Unit&) const {}
    __device__ __forceinline__ void done(const Unit&) const {}
};
typedef f32x4 Acc[2][2][4][2];

struct EpiBf16 {
    static constexpr bool PERM = true, AFTER_DRAIN = false; static constexpr int MIDK = 0;
    bf16_t* O; int ldc;
    __device__ __forceinline__ void operator()(const Acc& acc, const Unit& u, int wr, int wc, int fr, int fq, int ui) const {
        const int row0 = u.pm * BM + wr * 64 + fr, col0 = u.pn * BM + wc * 32 + 8 * fq;
#pragma unroll
        for (int ai = 0; ai < 2; ++ai)
#pragma unroll
            for (int m = 0; m < 4; ++m) { bf16_t* rowp = O + (size_t)(row0 + ai * HALF + m * 16) * ldc + col0;
#pragma unroll
                for (int bj = 0; bj < 2; ++bj) { const f32x4 v0 = acc[ai][bj][m][0], v1 = acc[ai][bj][m][1];
                    u32x4 w; w.x = cvt_pk_bf16(v0[0], v0[1]); w.y = cvt_pk_bf16(v0[2], v0[3]); w.z = cvt_pk_bf16(v1[0], v1[1]); w.w = cvt_pk_bf16(v1[2], v1[3]);
                    *(u32x4*)(rowp + bj * HALF) = w; } }
    }
};
struct EpiProj {
    static constexpr bool PERM = true, AFTER_DRAIN = false; static constexpr int MIDK = 0;
    bf16_t* O; int ldc; const PG8_LAS float* rsT; const float* lbt; float* ssqp; int Mrows; PG8_LAS float* red;
    __device__ __forceinline__ void operator()(const Acc& acc, const Unit& u, int wr, int wc, int fr, int fq, int ui) const {
        const int row0 = u.pm * BM + wr * 64 + fr, col0 = u.pn * BM + wc * 32 + 8 * fq;
        const bool gate = (u.pn >= 2 && u.pn < 6), stat = (u.pn >= 10);
        f32x4 lb[2][2];
#pragma unroll
        for (int bj = 0; bj < 2; ++bj)
#pragma unroll
            for (int n = 0; n < 2; ++n) lb[bj][n] = gate ? *(const f32x4*)(lbt + (col0 - 512) + bj * HALF + 4 * n) : (f32x4){0.f, 0.f, 0.f, 0.f};
#pragma unroll
        for (int ai = 0; ai < 2; ++ai)
#pragma unroll
            for (int m = 0; m < 4; ++m) { const int row = row0 + ai * HALF + m * 16; const float r = rsT[ui * BM + ai * HALF + wr * 64 + m * 16 + fr]; bf16_t* rowp = O + (size_t)row * ldc + col0; float sq[2];
#pragma unroll
                for (int bj = 0; bj < 2; ++bj) { f32x4 v0 = acc[ai][bj][m][0] * r, v1 = acc[ai][bj][m][1] * r; u32x4 w;
                    sq[bj] = ((v0[0] * v0[0] + v0[1] * v0[1]) + (v0[2] * v0[2] + v0[3] * v0[3])) + ((v1[0] * v1[0] + v1[1] * v1[1]) + (v1[2] * v1[2] + v1[3] * v1[3]));
                    if (gate) {
#pragma unroll
                        for (int e = 0; e < 4; ++e) { const float s0 = __builtin_amdgcn_rcpf(1.f + __builtin_amdgcn_exp2f(-1.4426950408889634f * v0[e])), s1 = __builtin_amdgcn_rcpf(1.f + __builtin_amdgcn_exp2f(-1.4426950408889634f * v1[e]));
                            v0[e] = __builtin_amdgcn_logf(lb[bj][0][e] + (1.f - lb[bj][0][e]) * s0); v1[e] = __builtin_amdgcn_logf(lb[bj][1][e] + (1.f - lb[bj][1][e]) * s1); }
                        h16x2 a = {(_Float16)v0[0], (_Float16)v0[1]}, b = {(_Float16)v0[2], (_Float16)v0[3]}, c = {(_Float16)v1[0], (_Float16)v1[1]}, d = {(_Float16)v1[2], (_Float16)v1[3]};
                        w.x = __builtin_bit_cast(unsigned, a); w.y = __builtin_bit_cast(unsigned, b); w.z = __builtin_bit_cast(unsigned, c); w.w = __builtin_bit_cast(unsigned, d);
                    } else { w.x = cvt_pk_bf16(v0[0], v0[1]); w.y = cvt_pk_bf16(v0[2], v0[3]); w.z = cvt_pk_bf16(v1[0], v1[1]); w.w = cvt_pk_bf16(v1[2], v1[3]); }
                    *(u32x4*)(rowp + bj * HALF) = w; }
                if (stat) { sq[0] += __shfl_xor(sq[0], 16); sq[0] += __shfl_xor(sq[0], 32); sq[1] += __shfl_xor(sq[1], 16); sq[1] += __shfl_xor(sq[1], 32);
                    if (fq == 0) { PG8_LAS float* rp = red + (ai * HALF + wr * 64 + m * 16 + fr) * 8 + wc * 2; rp[0] = sq[0]; rp[1] = sq[1]; } } }
        if (stat) {
            asm volatile("s_waitcnt lgkmcnt(0)" ::: "memory"); __builtin_amdgcn_s_barrier(); asm volatile("" ::: "memory");
            const int t = (wr * 4 + wc) * 64 + fq * 16 + fr;
            if (t < 256) { const f32x4 q0 = *(const PG8_LAS f32x4*)(red + t * 8), q1 = *(const PG8_LAS f32x4*)(red + t * 8 + 4);
                float* dst = ssqp + (size_t)((u.pn - 10) * 2) * Mrows + u.pm * BM + t; dst[0] = (q0[0] + q0[2]) + (q1[0] + q1[2]); dst[Mrows] = (q0[1] + q0[3]) + (q1[1] + q1[3]); }
            asm volatile("s_waitcnt lgkmcnt(0)" ::: "memory"); __builtin_amdgcn_s_barrier(); asm volatile("" ::: "memory");
        }
    }
};
struct EpiQ {
    static constexpr bool PERM = true, AFTER_DRAIN = false; static constexpr int MIDK = 0;
    bf16_t* Q; const PG8_LAS float* rsT; const float* gq; const float* cosT; const float* sinT; PG8_LAS float* red;
    __device__ __forceinline__ void operator()(const Acc& acc, const Unit& u, int wr, int wc, int fr, int fq, int ui) const {
        const int h = u.pn, cl = wc * 32 + 8 * fq, ic = 4 * wc + fq;
        f32x4 cs[2][4], sn[2][4];
        if (wc < 2) {
#pragma unroll
            for (int ai = 0; ai < 2; ++ai)
#pragma unroll
                for (int m = 0; m < 4; ++m) { const size_t row = (size_t)(u.pm * BM + ai * HALF + wr * 64 + m * 16 + fr);
                    cs[ai][m] = *(const f32x4*)(cosT + row * 32 + 4 * ic); sn[ai][m] = *(const f32x4*)(sinT + row * 32 + 4 * ic); }
        }
        const f32x4 g00 = *(const f32x4*)(gq + cl), g01 = *(const f32x4*)(gq + cl + 4), g10 = *(const f32x4*)(gq + 128 + cl), g11 = *(const f32x4*)(gq + 128 + cl + 4);
#pragma unroll
        for (int ai = 0; ai < 2; ++ai)
#pragma unroll
            for (int m = 0; m < 4; ++m) { float s = 0.f;
#pragma unroll
                for (int bj = 0; bj < 2; ++bj)
#pragma unroll
                    for (int n = 0; n < 2; ++n) { const f32x4 v = acc[ai][bj][m][n]; s += (v[0] * v[0] + v[1] * v[1]) + (v[2] * v[2] + v[3] * v[3]); }
                s += __shfl_xor(s, 16); s += __shfl_xor(s, 32);
                if (fq == 0) red[(ai * HALF + wr * 64 + m * 16 + fr) * 4 + wc] = s; }
        asm volatile("s_waitcnt lgkmcnt(0)" ::: "memory"); __builtin_amdgcn_s_barrier(); asm volatile("" ::: "memory");
#pragma unroll
        for (int ai = 0; ai < 2; ++ai)
#pragma unroll
            for (int m = 0; m < 4; ++m) { const int rowl = ai * HALF + wr * 64 + m * 16 + fr, row = u.pm * BM + rowl;
                const f32x4 q4 = *(const PG8_LAS f32x4*)(red + rowl * 4); const float ssx = (q4[0] + q4[1]) + (q4[2] + q4[3]);
                const float rs = rsT[ui * BM + rowl];
                const float sc = rs * __builtin_amdgcn_rsqf(rs * rs * ssx * (1.f / 192.f) + 1e-6f);
                bf16_t* dst = Q + ((size_t)((row >> 11) * 4 + h) * 2048 + (row & 2047)) * 192 + cl;
                { const f32x4 v0 = acc[ai][0][m][0] * sc * g00, v1 = acc[ai][0][m][1] * sc * g01; u32x4 w; w.x = cvt_pk_bf16(v0[0], v0[1]); w.y = cvt_pk_bf16(v0[2], v0[3]); w.z = cvt_pk_bf16(v1[0], v1[1]); w.w = cvt_pk_bf16(v1[2], v1[3]); *(u32x4*)dst = w; }
                if (wc < 2) { const f32x4 t1 = acc[ai][1][m][0] * sc * g10, t2 = acc[ai][1][m][1] * sc * g11;
                    const f32x4 o1 = t1 * cs[ai][m] - t2 * sn[ai][m], o2 = t2 * cs[ai][m] + t1 * sn[ai][m];
                    u32x4 w; w.x = cvt_pk_bf16(o1[0], o1[1]); w.y = cvt_pk_bf16(o1[2], o1[3]); w.z = cvt_pk_bf16(o2[0], o2[1]); w.w = cvt_pk_bf16(o2[2], o2[3]); *(u32x4*)(dst + 128) = w; } }
    }
};
struct EpiKV {
    static constexpr bool PERM = true, AFTER_DRAIN = false; static constexpr int MIDK = 0;
    bf16_t* K; bf16_t* V; const bf16_t* proj; int ldp; int ckr; const PG8_LAS float* rsT; const PG8_LAS float* skT; const float* gk; const float* cosT; const float* sinT; PG8_LAS float* red;
    __device__ __forceinline__ void operator()(const Acc& acc, const Unit& u, int wr, int wc, int fr, int fq, int ui) const {
        const int h = u.pn, cl = wc * 32 + 8 * fq, ic = 4 * wc + fq;
#pragma unroll
        for (int ai = 0; ai < 2; ++ai)
#pragma unroll
            for (int m = 0; m < 4; ++m) { float s = 0.f;
#pragma unroll
                for (int n = 0; n < 2; ++n) { const f32x4 v = acc[ai][0][m][n]; s += (v[0] * v[0] + v[1] * v[1]) + (v[2] * v[2] + v[3] * v[3]); }
                s += __shfl_xor(s, 16); s += __shfl_xor(s, 32);
                if (fq == 0) red[(ai * HALF + wr * 64 + m * 16 + fr) * 4 + wc] = s; }
        const f32x4 g0 = *(const f32x4*)(gk + cl), g1 = *(const f32x4*)(gk + cl + 4);
        f32x4 gr0 = {0.f, 0.f, 0.f, 0.f}, gr1 = {0.f, 0.f, 0.f, 0.f};
        if (wc < 2) { gr0 = *(const f32x4*)(gk + 128 + 8 * ic); gr1 = *(const f32x4*)(gk + 128 + 8 * ic + 4); }
        asm volatile("s_waitcnt lgkmcnt(0)" ::: "memory"); __builtin_amdgcn_s_barrier(); asm volatile("" ::: "memory");
#pragma unroll
        for (int ai = 0; ai < 2; ++ai) {
            u32x4 kr[4]; f32x4 cs[4], sn[4];
            if (wc < 2) {
#pragma unroll
                for (int m = 0; m < 4; ++m) { const size_t row = (size_t)(u.pm * BM + ai * HALF + wr * 64 + m * 16 + fr);
                    kr[m] = *(const u32x4*)(proj + row * ldp + ckr + 8 * ic); cs[m] = *(const f32x4*)(cosT + row * 32 + 4 * ic); sn[m] = *(const f32x4*)(sinT + row * 32 + 4 * ic); }
            }
#pragma unroll
            for (int m = 0; m < 4; ++m) { const int rowl = ai * HALF + wr * 64 + m * 16 + fr, row = u.pm * BM + rowl;
                const f32x4 q4 = *(const PG8_LAS f32x4*)(red + rowl * 4); const float ssk = (q4[0] + q4[1]) + (q4[2] + q4[3]);
                const float rsc = rsT[ui * BM + rowl], skr = skT[ui * BM + rowl];
                const float r = __builtin_amdgcn_rsqf((rsc * rsc * ssk + skr) * (1.f / 192.f) + 1e-6f);
                const size_t tok = (size_t)((row >> 11) * 4 + h) * 2048 + (row & 2047);
                bf16_t* kd = K + tok * 192; bf16_t* vd = V + tok * 128;
                { const float sc = rsc * r; const f32x4 v0 = acc[ai][0][m][0] * sc * g0, v1 = acc[ai][0][m][1] * sc * g1; u32x4 w; w.x = cvt_pk_bf16(v0[0], v0[1]); w.y = cvt_pk_bf16(v0[2], v0[3]); w.z = cvt_pk_bf16(v1[0], v1[1]); w.w = cvt_pk_bf16(v1[2], v1[3]); *(u32x4*)(kd + cl) = w; }
                { const f32x4 v0 = acc[ai][1][m][0] * rsc, v1 = acc[ai][1][m][1] * rsc; u32x4 w; w.x = cvt_pk_bf16(v0[0], v0[1]); w.y = cvt_pk_bf16(v0[2], v0[3]); w.z = cvt_pk_bf16(v1[0], v1[1]); w.w = cvt_pk_bf16(v1[2], v1[3]); *(u32x4*)(vd + cl) = w; }
                if (wc < 2) { const f32x4 t1 = (f32x4){bflo(kr[m].x), bfhi(kr[m].x), bflo(kr[m].y), bfhi(kr[m].y)} * gr0 * r, t2 = (f32x4){bflo(kr[m].z), bfhi(kr[m].z), bflo(kr[m].w), bfhi(kr[m].w)} * gr1 * r;
                    const f32x4 o1 = t1 * cs[m] - t2 * sn[m], o2 = t2 * cs[m] + t1 * sn[m];
                    u32x4 w; w.x = cvt_pk_bf16(o1[0], o1[1]); w.y = cvt_pk_bf16(o1[2], o1[3]); w.z = cvt_pk_bf16(o2[0], o2[1]); w.w = cvt_pk_bf16(o2[2], o2[3]); *(u32x4*)(kd + 128 + 8 * ic) = w; } }
        }
    }
};
struct EpiUp {
    static constexpr bool PERM = true, AFTER_DRAIN = false; static constexpr int MIDK = 0;
    bf16_t* O; int ldc; const PG8_LAS float* rsT;
    __device__ __forceinline__ void operator()(const Acc& acc, const Unit& u, int wr, int wc, int fr, int fq, int ui) const {
        const int row0 = u.pm * BM + wr * 64 + fr, col0 = u.pn * BM + wc * 32 + 8 * fq;
#pragma unroll
        for (int ai = 0; ai < 2; ++ai)
#pragma unroll
            for (int m = 0; m < 4; ++m) { const int row = row0 + ai * HALF + m * 16; const float r = rsT[ui * BM + ai * HALF + wr * 64 + m * 16 + fr]; bf16_t* rowp = O + (size_t)row * ldc + col0;
#pragma unroll
                for (int bj = 0; bj < 2; ++bj) { f32x4 v0 = acc[ai][bj][m][0] * r, v1 = acc[ai][bj][m][1] * r;
#pragma unroll
                    for (int e = 0; e < 4; ++e) { const float a = fmaxf(v0[e], 0.f), b = fmaxf(v1[e], 0.f); v0[e] = a * a; v1[e] = b * b; }
                    u32x4 w; w.x = cvt_pk_bf16(v0[0], v0[1]); w.y = cvt_pk_bf16(v0[2], v0[3]); w.z = cvt_pk_bf16(v1[0], v1[1]); w.w = cvt_pk_bf16(v1[2], v1[3]);
                    *(u32x4*)(rowp + bj * HALF) = w; } }
    }
};
struct EpiResid {
    static constexpr bool PERM = false, AFTER_DRAIN = false; static constexpr int MIDK = 0;
    const float* base; float* out; int ldc;
    __device__ __forceinline__ void operator()(const Acc& acc, const Unit& u, int wr, int wc, int fr, int fq, int ui) const {
        const int row0 = u.pm * BM + wr * 64 + fr, col0 = u.pn * BM + wc * 32 + 4 * fq;
#pragma unroll
        for (int ai = 0; ai < 2; ++ai)
#pragma unroll
            for (int m = 0; m < 4; ++m) { const size_t off = (size_t)(row0 + ai * HALF + m * 16) * ldc + col0;
#pragma unroll
                for (int bj = 0; bj < 2; ++bj)
#pragma unroll
                    for (int n = 0; n < 2; ++n) { const f32x4 bs = *(const f32x4*)(base + off + bj * HALF + n * 16); *(f32x4*)(out + off + bj * HALF + n * 16) = bs + acc[ai][bj][m][n]; } }
    }
};

struct EpiResidBf {
    static constexpr bool PERM = false, AFTER_DRAIN = false; static constexpr int MIDK = 0;
    const bf16_t* xb; float* out; int ldc;
    __device__ __forceinline__ void operator()(const Acc& acc, const Unit& u, int wr, int wc, int fr, int fq, int ui) const {
        const int row0 = u.pm * BM + wr * 64 + fr, col0 = u.pn * BM + wc * 32 + 4 * fq;
        u32x2 w[2][4][2][2];
#pragma unroll
        for (int ai = 0; ai < 2; ++ai)
#pragma unroll
            for (int m = 0; m < 4; ++m) { const size_t off = (size_t)(row0 + ai * HALF + m * 16) * ldc + col0;
#pragma unroll
                for (int bj = 0; bj < 2; ++bj)
#pragma unroll
                    for (int n = 0; n < 2; ++n) w[ai][m][bj][n] = *(const u32x2*)(xb + off + bj * HALF + n * 16); }
        __builtin_amdgcn_sched_barrier(0);
#pragma unroll
        for (int ai = 0; ai < 2; ++ai) {
#pragma unroll
            for (int m = 0; m < 4; ++m) { const size_t off = (size_t)(row0 + ai * HALF + m * 16) * ldc + col0;
#pragma unroll
                for (int bj = 0; bj < 2; ++bj)
#pragma unroll
                    for (int n = 0; n < 2; ++n) { const u32x2 ww = w[ai][m][bj][n]; const f32x4 bs = {bflo(ww.x), bfhi(ww.x), bflo(ww.y), bfhi(ww.y)}; *(f32x4*)(out + off + bj * HALF + n * 16) = bs + acc[ai][bj][m][n]; } }
        }
    }
};
struct EpiResidX1 {
    static constexpr bool PERM = false, AFTER_DRAIN = false; static constexpr int MIDK = 8;
    const bf16_t* base; bf16_t* xb; float* ssq; int ldc; int Mrows; PG8_LAS float* red; const PG8_LAS float* rsb;
    __device__ __forceinline__ void mid(Acc& acc, int ui, int wr, int fr) const {
#pragma unroll
        for (int ai = 0; ai < 2; ++ai)
#pragma unroll
            for (int m = 0; m < 4; ++m) { const float r = rsb[ui * BM + ai * HALF + wr * 64 + m * 16 + fr];
#pragma unroll
                for (int bj = 0; bj < 2; ++bj)
#pragma unroll
                    for (int n = 0; n < 2; ++n) acc[ai][bj][m][n] *= r; }
    }
    __device__ __forceinline__ void operator()(const Acc& acc, const Unit& u, int wr, int wc, int fr, int fq, int ui) const {
        const int row0 = u.pm * BM + wr * 64 + fr, col0 = u.pn * BM + wc * 32 + 4 * fq;
        u32x2 xr[2][4][2][2];
#pragma unroll
        for (int ai = 0; ai < 2; ++ai)
#pragma unroll
            for (int m = 0; m < 4; ++m) { const size_t off = (size_t)(row0 + ai * HALF + m * 16) * ldc + col0;
#pragma unroll
                for (int bj = 0; bj < 2; ++bj)
#pragma unroll
                    for (int n = 0; n < 2; ++n) xr[ai][m][bj][n] = *(const u32x2*)(base + off + bj * HALF + n * 16); }
        __builtin_amdgcn_sched_barrier(0);
#pragma unroll
        for (int ai = 0; ai < 2; ++ai) {
#pragma unroll
            for (int m = 0; m < 4; ++m) { const size_t off = (size_t)(row0 + ai * HALF + m * 16) * ldc + col0; float s = 0.f;
#pragma unroll
                for (int bj = 0; bj < 2; ++bj)
#pragma unroll
                    for (int n = 0; n < 2; ++n) { const u32x2 xw = xr[ai][m][bj][n]; const f32x4 v = (f32x4){bflo(xw.x), bfhi(xw.x), bflo(xw.y), bfhi(xw.y)} + acc[ai][bj][m][n];
                        u32x2 w; w.x = cvt_pk_bf16(v[0], v[1]); w.y = cvt_pk_bf16(v[2], v[3]); *(u32x2*)(xb + off + bj * HALF + n * 16) = w;
                        s += (v[0] * v[0] + v[1] * v[1]) + (v[2] * v[2] + v[3] * v[3]); }
                s += __shfl_xor(s, 16); s += __shfl_xor(s, 32);
                if (fq == 0) red[(ai * HALF + wr * 64 + m * 16 + fr) * 4 + wc] = s; }
        }
        asm volatile("s_waitcnt lgkmcnt(0)" ::: "memory"); __builtin_amdgcn_s_barrier(); asm volatile("" ::: "memory");
        const int t = (wr * 4 + wc) * 64 + fq * 16 + fr;
        if (t < 256) { const f32x4 q = *(const PG8_LAS f32x4*)(red + t * 4); ssq[(size_t)u.pn * Mrows + u.pm * BM + t] = (q[0] + q[1]) + (q[2] + q[3]); }
        asm volatile("s_waitcnt lgkmcnt(0)" ::: "memory"); __builtin_amdgcn_s_barrier(); asm volatile("" ::: "memory");
    }
};
template <class Epi, class Sched, bool ALIGN_EPI = false, bool SP2 = false>
__device__ __forceinline__ void gemm_phase(PG8_LAS unsigned char* lds, const Gemm g, const Sched& S, const Epi& E, int wv) {
    int lane = lane_id(); asm volatile("" : "+v"(lane));
    const int wid = wv, tid = wv * 64 + lane, wr = wid >> 2, wc = wid & 3, fr = lane & 15, fq = lane >> 4;
    const int K = g.K, nt = K / BK, lda = g.lda;
    unsigned voffA[2], voffB[2];
#pragma unroll
    for (int i = 0; i < 2; ++i) { int R, C; stage_rc(tid * 16 + i * 8192, R, C); const int Rb = Epi::PERM ? ((R & ~31) + perm32(R & 31)) : R;
        voffA[i] = (unsigned)(R * lda + C) * 2u; voffB[i] = (unsigned)(Rb * K + C) * 2u; }
    const size_t kstep = (size_t)(BK * 2);
    const size_t hstepA = (size_t)HALF * lda * 2, hstepB = (size_t)HALF * K * 2;
    const size_t tstepA = 2 * hstepA, tstepB = 2 * hstepB;
    const unsigned ldsw = (unsigned)wid * 1024u;
    const int aoff = lds_byte(wr * 64 + fr, fq * 8), boff = lds_byte(wc * 32 + fr, fq * 8);
#define PG8_SA(b, h) (((b) * 2 + (h)) * HTB)
#define PG8_SB(b, h) ((4 + (b) * 2 + (h)) * HTB)
#define PG8_STAGE(bufoff, gbase, voff) do { _Pragma("unroll") for (int _i = 0; _i < 2; ++_i) \
        __builtin_amdgcn_global_load_lds((const unsigned*)((const char*)(gbase) + (voff)[_i]), (PG8_LAS unsigned*)(lds + (bufoff) + ldsw + _i * 8192), 16, 0, 0); } while (0)
#define PG8_LDA(dst, b, h) do { _Pragma("unroll") for (int m = 0; m < 4; ++m) _Pragma("unroll") for (int k = 0; k < 2; ++k) dst[m][k] = *(const PG8_LAS bf16x8*)(lds + PG8_SA(b, h) + aoff + m * 2048 + k * 1024); } while (0)
#define PG8_LDB(dst, b, h) do { _Pragma("unroll") for (int n = 0; n < 2; ++n) _Pragma("unroll") for (int k = 0; k < 2; ++k) dst[n][k] = *(const PG8_LAS bf16x8*)(lds + PG8_SB(b, h) + boff + n * 2048 + k * 1024); } while (0)
#define PG8_MMA(ai, bj, At, Bt) do { __builtin_amdgcn_s_setprio(1); _Pragma("unroll") for (int m = 0; m < 4; ++m) _Pragma("unroll") for (int n = 0; n < 2; ++n) _Pragma("unroll") for (int k = 0; k < 2; ++k) \
        acc[ai][bj][m][n] = __builtin_amdgcn_mfma_f32_16x16x32_bf16(Bt[n][k], At[m][k], acc[ai][bj][m][n], 0, 0, 0); __builtin_amdgcn_s_setprio(0); } while (0)
#define PG8_WAIT_V(n) asm volatile("s_waitcnt vmcnt(" #n ")" ::: "memory")
#define PG8_WAIT_L(n) asm volatile("s_waitcnt lgkmcnt(" #n ")" ::: "memory")
#define PG8_BAR __builtin_amdgcn_s_barrier()
#define PG8_SCHED __builtin_amdgcn_sched_barrier(0)
    Unit cur, nxt; int ui = 0;
    if (!S.next(0, cur)) return;
    Acc acc;
#pragma unroll
    for (int a = 0; a < 2; ++a)
#pragma unroll
        for (int b = 0; b < 2; ++b)
#pragma unroll
            for (int m = 0; m < 4; ++m)
#pragma unroll
                for (int n = 0; n < 2; ++n) acc[a][b][m][n] = (f32x4){0.f, 0.f, 0.f, 0.f};
    bf16x8 At[4][2], B0[2][2], B1[2][2];
    const char* cA = (const char*)g.A + (size_t)cur.pm * tstepA; const char* cB = (const char*)g.Bt + (size_t)cur.pn * tstepB;
    S.a_ready(cur);
    if constexpr (SP2) {
        PG8_STAGE(PG8_SB(0, 0), cB, voffB); PG8_STAGE(PG8_SB(0, 1), cB + hstepB, voffB); PG8_STAGE(PG8_SA(0, 0), cA, voffA); PG8_STAGE(PG8_SA(0, 1), cA + hstepA, voffA);
        if (wr == 1) PG8_BAR;
        PG8_WAIT_V(2); PG8_BAR;
        PG8_STAGE(PG8_SB(1, 0), cB + kstep, voffB); PG8_STAGE(PG8_SA(1, 0), cA + kstep, voffA); PG8_STAGE(PG8_SB(1, 1), cB + hstepB + kstep, voffB);
        PG8_WAIT_V(6); PG8_BAR;
    } else {
        PG8_STAGE(PG8_SB(0, 0), cB, voffB); PG8_STAGE(PG8_SA(0, 0), cA, voffA); PG8_STAGE(PG8_SB(0, 1), cB + hstepB, voffB); PG8_STAGE(PG8_SA(0, 1), cA + hstepA, voffA);
        if (wr == 1) PG8_BAR;
        PG8_WAIT_V(4); PG8_BAR;
        PG8_STAGE(PG8_SB(1, 0), cB + kstep, voffB); PG8_STAGE(PG8_SA(1, 0), cA + kstep, voffA); PG8_STAGE(PG8_SB(1, 1), cB + hstepB + kstep, voffB);
        PG8_WAIT_V(6); PG8_BAR;
    }
    for (;;) {
        const bool has_next = S.next(ui + 1, nxt);
        const char* nA = has_next ? (const char*)g.A + (size_t)nxt.pm * tstepA : cA; const char* nB = has_next ? (const char*)g.Bt + (size_t)nxt.pn * tstepB : cB;
#pragma nounroll
        for (int t = 0; t < nt; t += 2) {
            const bool last = (t == nt - 2);
            const char* a1 = cA + (size_t)(t + 1) * kstep;
            const char* a2 = last ? nA : cA + (size_t)(t + 2) * kstep; const char* b2 = last ? nB : cB + (size_t)(t + 2) * kstep;
            const char* a3 = a2 + kstep; const char* b3 = b2 + kstep;
            if (last && has_next) S.a_ready(nxt);
            if constexpr (SP2) {
            PG8_LDB(B0, 0, 0); PG8_LDB(B1, 0, 1); PG8_SCHED; PG8_LDA(At, 0, 0); PG8_STAGE(PG8_SA(1, 1), a1 + hstepA, voffA);
            PG8_WAIT_V(8); PG8_WAIT_L(0); PG8_BAR; PG8_MMA(0, 0, At, B0); PG8_MMA(0, 1, At, B1); PG8_BAR; PG8_SCHED;
            PG8_LDA(At, 0, 1); PG8_STAGE(PG8_SB(0, 0), b2, voffB); PG8_STAGE(PG8_SB(0, 1), b2 + hstepB, voffB); PG8_STAGE(PG8_SA(0, 0), a2, voffA);
            PG8_WAIT_V(8); PG8_WAIT_L(0); PG8_BAR; PG8_MMA(1, 0, At, B0); PG8_MMA(1, 1, At, B1); PG8_BAR; PG8_SCHED;
            PG8_LDB(B0, 1, 0); PG8_LDB(B1, 1, 1); PG8_SCHED; PG8_LDA(At, 1, 0); PG8_STAGE(PG8_SA(0, 1), a2 + hstepA, voffA);
            PG8_WAIT_V(8); PG8_WAIT_L(0); PG8_BAR; PG8_MMA(0, 0, At, B0); PG8_MMA(0, 1, At, B1); PG8_BAR; PG8_SCHED;
            PG8_LDA(At, 1, 1); PG8_STAGE(PG8_SB(1, 0), b3, voffB); PG8_STAGE(PG8_SB(1, 1), b3 + hstepB, voffB); PG8_STAGE(PG8_SA(1, 0), a3, voffA);
            PG8_WAIT_V(8); PG8_WAIT_L(0); PG8_BAR; PG8_MMA(1, 0, At, B0); PG8_MMA(1, 1, At, B1); PG8_BAR; PG8_SCHED;
            if constexpr (Epi::MIDK > 0) { if (t + 2 == Epi::MIDK) { E.mid(acc, ui, wr, fr); PG8_SCHED; } }
            } else {
            PG8_LDB(B0, 0, 0); PG8_SCHED; PG8_LDA(At, 0, 0); PG8_STAGE(PG8_SA(1, 1), a1 + hstepA, voffA);
            PG8_WAIT_L(8); PG8_BAR; PG8_WAIT_L(0); PG8_MMA(0, 0, At, B0); PG8_BAR; PG8_SCHED;
            PG8_LDB(B1, 0, 1); PG8_STAGE(PG8_SB(0, 0), b2, voffB);
            PG8_BAR; PG8_WAIT_L(0); PG8_MMA(0, 1, At, B1); PG8_BAR;
            PG8_LDA(At, 0, 1); PG8_STAGE(PG8_SA(0, 0), a2, voffA);
            PG8_BAR; PG8_WAIT_L(0); PG8_MMA(1, 0, At, B0); PG8_BAR; PG8_SCHED;
            PG8_STAGE(PG8_SB(0, 1), b2 + hstepB, voffB);
            PG8_WAIT_V(6); PG8_BAR; PG8_MMA(1, 1, At, B1); PG8_BAR;
            PG8_LDB(B0, 1, 0); PG8_SCHED; PG8_LDA(At, 1, 0); PG8_STAGE(PG8_SA(0, 1), a2 + hstepA, voffA);
            PG8_WAIT_L(8); PG8_BAR; PG8_WAIT_L(0); PG8_MMA(0, 0, At, B0); PG8_BAR; PG8_SCHED;
            PG8_LDB(B1, 1, 1); PG8_STAGE(PG8_SB(1, 0), b3, voffB);
            PG8_BAR; PG8_WAIT_L(0); PG8_MMA(0, 1, At, B1); PG8_BAR;
            PG8_LDA(At, 1, 1); PG8_STAGE(PG8_SA(1, 0), a3, voffA);
            PG8_BAR; PG8_WAIT_L(0); PG8_MMA(1, 0, At, B0); PG8_BAR; PG8_SCHED;
            PG8_STAGE(PG8_SB(1, 1), b3 + hstepB, voffB);
            PG8_WAIT_V(6); PG8_BAR; PG8_MMA(1, 1, At, B1); PG8_BAR;
            }
        }
        if constexpr (ALIGN_EPI) { if (wr == 0) PG8_BAR; }
        if constexpr (!Epi::AFTER_DRAIN) { E(acc, cur, wr, wc, fr, fq, ui); S.done(cur); }
        if (!has_next) break;
#pragma unroll
        for (int a = 0; a < 2; ++a)
#pragma unroll
            for (int b = 0; b < 2; ++b)
#pragma unroll
                for (int m = 0; m < 4; ++m)
#pragma unroll
                    for (int n = 0; n < 2; ++n) acc[a][b][m][n] = (f32x4){0.f, 0.f, 0.f, 0.f};
        cur = nxt; cA = nA; cB = nB; ++ui;
        if constexpr (ALIGN_EPI) { if (wr == 1) PG8_BAR; }
    }
    PG8_WAIT_V(0);
    if constexpr (!ALIGN_EPI) { if (wr == 0) PG8_BAR; }
    PG8_BAR;
#undef PG8_SA
#undef PG8_SB
#undef PG8_STAGE
#undef PG8_LDA
#undef PG8_LDB
#undef PG8_MMA
#undef PG8_WAIT_V
#undef PG8_WAIT_L
#undef PG8_BAR
#undef PG8_SCHED
}
}

namespace att {
constexpr int DQK = 192, DV = 128, NW = 8, QBLK = 32, KVBLK = 64;
constexpr int SHM_V = KVBLK * DV * 2, SHM_K = KVBLK * DQK * 2, SHM_ATTN = 2 * SHM_V + 2 * SHM_K + NW * 64 * 4;
constexpr float THRL = 11.5f;
#define KSWZ(row, colB) ((row) * 384 + ((colB) ^ ((((row) >> 1) & 7) << 4)))
#define SBAR() __builtin_amdgcn_sched_barrier(0)
__device__ __forceinline__ int crow(int r, int hi) { return (r & 3) + 8 * (r >> 2) + 4 * hi; }
__device__ __forceinline__ void partialSM(f32x16& p0, f32x16& p1, float& m_reg, float& mn, float& alpha) {
    float pmax = p0[0];
#pragma unroll
    for (int r = 1; r < 16; ++r) pmax = fmaxf(pmax, p0[r]);
#pragma unroll
    for (int r = 0; r < 16; ++r) pmax = fmaxf(pmax, p1[r]);
    { auto rr = __builtin_amdgcn_permlane32_swap(__float_as_uint(pmax), __float_as_uint(pmax), false, false);
      pmax = fmaxf(__uint_as_float(rr[0]), __uint_as_float(rr[1])); }
    if (__builtin_expect(__all(pmax - m_reg <= THRL), 1)) { mn = m_reg; alpha = 1.f; }
    else { mn = fmaxf(m_reg, pmax); alpha = __builtin_amdgcn_exp2f(m_reg - mn); m_reg = mn; }
#pragma unroll
    for (int r = 0; r < 16; ++r) p0[r] = p0[r] - mn;
#pragma unroll
    for (int r = 0; r < 16; ++r) p1[r] = p1[r] - mn;
#pragma unroll
    for (int r = 0; r < 16; ++r) p0[r] = __builtin_amdgcn_exp2f(p0[r]);
}
__device__ __forceinline__ void finishSM(f32x16& p0, f32x16& p1, float alpha, float& l_reg, bf16x8& pa0, bf16x8& pa1, bf16x8& pa2, bf16x8& pa3) {
#pragma unroll
    for (int r = 0; r < 16; ++r) p1[r] = __builtin_amdgcn_exp2f(p1[r]);
    float ps = 0;
#pragma unroll
    for (int r = 0; r < 16; ++r) ps += p0[r];
#pragma unroll
    for (int r = 0; r < 16; ++r) ps += p1[r];
    { auto rr = __builtin_amdgcn_permlane32_swap(__float_as_uint(ps), __float_as_uint(ps), false, false);
      ps = __uint_as_float(rr[0]) + __uint_as_float(rr[1]); }
    l_reg = l_reg * alpha + ps;
#define PK4(P, BASE, OUT) do { unsigned a0 = cvt_pk_bf16(P[BASE + 0], P[BASE + 1]), a1 = cvt_pk_bf16(P[BASE + 2], P[BASE + 3]);   \
    unsigned b0 = cvt_pk_bf16(P[BASE + 4], P[BASE + 5]), b1 = cvt_pk_bf16(P[BASE + 6], P[BASE + 7]);                              \
    auto r0 = __builtin_amdgcn_permlane32_swap(a0, b0, false, false); auto r1 = __builtin_amdgcn_permlane32_swap(a1, b1, false, false); \
    u32x4 w = {r0[0], r1[0], r0[1], r1[1]}; OUT = __builtin_bit_cast(bf16x8, w); } while (0)
    PK4(p0, 0, pa0); PK4(p0, 8, pa1); PK4(p1, 0, pa2); PK4(p1, 8, pa3);
#undef PK4
}
__device__ __forceinline__ void qkt(f32x16& p0, f32x16& p1, const char* Ks, const bf16x8* qr, int r32, int hi) {
    p0 = f32x16{}; p1 = f32x16{};
    const char* k0p = Ks + KSWZ(r32, 0); const char* k1p = Ks + KSWZ(32 + r32, 0);
    const int key = ((r32 >> 1) & 7) << 4;
    bf16x8 ka[2], kb[2];
#define KRD(d0, slot) do { const int cb_ = (((d0) * 16 + hi * 8) * 2) ^ key; ka[slot] = *reinterpret_cast<const bf16x8*>(k0p + cb_); kb[slot] = *reinterpret_cast<const bf16x8*>(k1p + cb_); } while (0)
    KRD(0, 0); KRD(1, 1);
#pragma unroll
    for (int d0 = 0; d0 < 12; ++d0) {
        const bf16x8 a = ka[d0 & 1], b = kb[d0 & 1];
        p0 = __builtin_amdgcn_mfma_f32_32x32x16_bf16(a, qr[d0], p0, 0, 0, 0);
        p1 = __builtin_amdgcn_mfma_f32_32x32x16_bf16(b, qr[d0], p1, 0, 0, 0);
        if (d0 + 2 < 12) KRD(d0 + 2, d0 & 1);
    }
#undef KRD
}
__device__ __forceinline__ int v_st(int k, int c) { const int kk = (k & ~0xC) | ((k & 4) << 1) | ((k & 8) >> 1); return ((kk >> 3) * 4 + (c >> 5)) * 512 + ((kk & 7) * 32 + (c & 31)) * 2; }
__device__ __forceinline__ int v_rd_base(int lane) { return ((lane & 3) << 3) | (((lane >> 2) & 3) << 6) | (((lane >> 4) & 1) << 5) | (((lane >> 5) & 1) << 8); }
constexpr int v_rd_off(int d0, int ks, int half) { return d0 * 512 + ks * 4096 + half * 2048; }
template <int OFF> __device__ __forceinline__ s16x4 tr_read(int vb) {
    s16x4 r; asm volatile("ds_read_b64_tr_b16 %0, %1 offset:%2" : "=&v"(r) : "v"(vb), "i"(OFF) : "memory"); return r;
}
#define PKLH(L, H) (bf16x8){L[0], L[1], L[2], L[3], H[0], H[1], H[2], H[3]}
template <int D0> __device__ __forceinline__ void pv_one(f32x16& od, int vb, bf16x8 pa0, bf16x8 pa1, bf16x8 pa2, bf16x8 pa3) {
    const s16x4 l0 = tr_read<v_rd_off(D0, 0, 0)>(vb), h0 = tr_read<v_rd_off(D0, 0, 1)>(vb), l1 = tr_read<v_rd_off(D0, 1, 0)>(vb), h1 = tr_read<v_rd_off(D0, 1, 1)>(vb);
    const s16x4 l2 = tr_read<v_rd_off(D0, 2, 0)>(vb), h2 = tr_read<v_rd_off(D0, 2, 1)>(vb), l3 = tr_read<v_rd_off(D0, 3, 0)>(vb), h3 = tr_read<v_rd_off(D0, 3, 1)>(vb);
    asm volatile("s_waitcnt lgkmcnt(0)" ::: "memory"); SBAR();
    od = __builtin_amdgcn_mfma_f32_32x32x16_bf16(pa0, PKLH(l0, h0), od, 0, 0, 0);
    od = __builtin_amdgcn_mfma_f32_32x32x16_bf16(pa1, PKLH(l1, h1), od, 0, 0, 0);
    od = __builtin_amdgcn_mfma_f32_32x32x16_bf16(pa2, PKLH(l2, h2), od, 0, 0, 0);
    od = __builtin_amdgcn_mfma_f32_32x32x16_bf16(pa3, PKLH(l3, h3), od, 0, 0, 0);
}
__device__ __forceinline__ void pv_d0(f32x16* o, int vb, bf16x8 pa0, bf16x8 pa1, bf16x8 pa2, bf16x8 pa3) {
    pv_one<0>(o[0], vb, pa0, pa1, pa2, pa3); pv_one<1>(o[1], vb, pa0, pa1, pa2, pa3); pv_one<2>(o[2], vb, pa0, pa1, pa2, pa3); pv_one<3>(o[3], vb, pa0, pa1, pa2, pa3);
}
#define PK4S(P, BASE, OUT) do { unsigned a0 = cvt_pk_bf16(P[BASE + 0], P[BASE + 1]), a1 = cvt_pk_bf16(P[BASE + 2], P[BASE + 3]);   \
    unsigned b0 = cvt_pk_bf16(P[BASE + 4], P[BASE + 5]), b1 = cvt_pk_bf16(P[BASE + 6], P[BASE + 7]);                              \
    auto r0 = __builtin_amdgcn_permlane32_swap(a0, b0, false, false); auto r1 = __builtin_amdgcn_permlane32_swap(a1, b1, false, false); \
    u32x4 w = {r0[0], r1[0], r0[1], r1[1]}; OUT = __builtin_bit_cast(bf16x8, w); } while (0)
template <bool FIN>
__device__ __forceinline__ void seg_x(f32x16& n0, f32x16& n1, const LAS char* Ks, const bf16x8* qr, const LAS char* ql, int r32, int hi,
                                      f32x16& f0, f32x16& f1, float alpha, float& l_reg, bf16x8& pa0, bf16x8& pa1, bf16x8& pa2, bf16x8& pa3) {
    n0 = f32x16{}; n1 = f32x16{};
    const LAS char* k0p = Ks + r32 * 384;
    const int key = ((r32 >> 1) & 7) << 4;
    bf16x8 ka[2], kb[2]; float ps = 0.f;
#define KRD(d0, slot) do { const int cb_ = (((d0) * 16 + hi * 8) * 2) ^ key; ka[slot] = *reinterpret_cast<const LAS bf16x8*>(k0p + cb_); kb[slot] = *reinterpret_cast<const LAS bf16x8*>(k0p + 32 * 384 + cb_); } while (0)
    KRD(0, 0); KRD(1, 1); SBAR();
    bf16x8 qlv = qr[0];
#pragma unroll
    for (int d0 = 0; d0 < 12; ++d0) {
        const bf16x8 qv = (d0 < 8) ? qr[d0 < 8 ? d0 : 0] : qlv;
        n0 = __builtin_amdgcn_mfma_f32_32x32x16_bf16(ka[d0 & 1], qv, n0, 0, 0, 0);
        n1 = __builtin_amdgcn_mfma_f32_32x32x16_bf16(kb[d0 & 1], qv, n1, 0, 0, 0);
        SBAR();
        if (d0 + 2 < 12) KRD(d0 + 2, d0 & 1);
        if (d0 + 1 >= 8 && d0 + 1 < 12) qlv = *reinterpret_cast<const LAS bf16x8*>(ql + (d0 + 1 - 8) * 1024);
        if constexpr (FIN) {
            if (d0 < 4) {
#pragma unroll
                for (int r = 0; r < 4; ++r) f1[4 * d0 + r] = __builtin_amdgcn_exp2f(f1[4 * d0 + r]);
            } else if (d0 == 4) {
#pragma unroll
                for (int r = 0; r < 16; ++r) ps += f0[r];
            } else if (d0 == 5) {
#pragma unroll
                for (int r = 0; r < 16; ++r) ps += f1[r];
            } else if (d0 == 6) {
                auto rr = __builtin_amdgcn_permlane32_swap(__float_as_uint(ps), __float_as_uint(ps), false, false);
                ps = __uint_as_float(rr[0]) + __uint_as_float(rr[1]); l_reg = l_reg * alpha + ps;
            } else if (d0 == 7) { PK4S(f0, 0, pa0); } else if (d0 == 8) { PK4S(f0, 8, pa1); } else if (d0 == 9) { PK4S(f1, 0, pa2); } else if (d0 == 10) { PK4S(f1, 8, pa3); }
        }
        SBAR();
    }
#undef KRD
}
__device__ __forceinline__ void seg_y(f32x16* o, int vb, bf16x8 pa0, bf16x8 pa1, bf16x8 pa2, bf16x8 pa3, f32x16& p0, f32x16& p1, float& m_reg, float& mn, float& alpha) {
    pv_one<0>(o[0], vb, pa0, pa1, pa2, pa3); SBAR();
    { float a = fmaxf(p0[0], p0[1]), b = fmaxf(p0[2], p0[3]);
#pragma unroll
      for (int r = 4; r < 16; r += 2) { a = fmaxf(a, p0[r]); b = fmaxf(b, p0[r + 1]); }
#pragma unroll
      for (int r = 0; r < 16; r += 2) { a = fmaxf(a, p1[r]); b = fmaxf(b, p1[r + 1]); }
      float pmax = fmaxf(a, b);
      auto rr = __builtin_amdgcn_permlane32_swap(__float_as_uint(pmax), __float_as_uint(pmax), false, false);
      pmax = fmaxf(__uint_as_float(rr[0]), __uint_as_float(rr[1]));
      if (__builtin_expect(__all(pmax - m_reg <= THRL), 1)) { mn = m_reg; alpha = 1.f; }
      else { mn = fmaxf(m_reg, pmax); alpha = __builtin_amdgcn_exp2f(m_reg - mn); m_reg = mn; } }
    SBAR();
    pv_one<1>(o[1], vb, pa0, pa1, pa2, pa3); SBAR();
#pragma unroll
    for (int r = 0; r < 16; ++r) { p0[r] = p0[r] - mn; p1[r] = p1[r] - mn; }
    SBAR();
    pv_one<2>(o[2], vb, pa0, pa1, pa2, pa3); SBAR();
#pragma unroll
    for (int r = 0; r < 8; ++r) p0[r] = __builtin_amdgcn_exp2f(p0[r]);
    SBAR();
    pv_one<3>(o[3], vb, pa0, pa1, pa2, pa3); SBAR();
#pragma unroll
    for (int r = 8; r < 16; ++r) p0[r] = __builtin_amdgcn_exp2f(p0[r]);
    SBAR();
}
constexpr int L_K = 0, L_VV = 3 * SHM_K, L_WS = L_VV + 3 * SHM_V, L_QL = L_WS + NW * 64 * 4, ATT_LDS = L_QL + NW * 4096;
__device__ __forceinline__ void attn_chain(const bf16_t* __restrict__ QB, const bf16_t* __restrict__ KBp, const bf16_t* __restrict__ VBp, bf16_t* __restrict__ MIXp, int ldo, float* __restrict__ SSQAp,
                                           int bhs, int qb, int k0, int k1, int seq, int Mrows, char* lds, int wv) {
    int lane0 = lane_id(); asm volatile("" : "+v"(lane0));
    const int wid = wv;
    LAS unsigned char* l3 = (LAS unsigned char*)lds;
    const LAS char* K_lds = (const LAS char*)l3 + L_K;
    float* ws = (float*)(lds + L_WS) + wid * 64; float* li_l = ws; float* al_l = ws + 32;
    bf16x8 qr[8];
#define KSRC(i_) ({ const int p_ = (wid + 8 * (i_)) * 64 + lane, row_ = p_ / 24, cpos_ = p_ - row_ * 24; (unsigned)(row_ * 24 + ((cpos_ & ~7) | ((cpos_ ^ (row_ >> 1)) & 7))) * 16u; })
#define VSRC(i_) ({ const int p16_ = (wid + 8 * (i_)) * 64 + lane, sub_ = p16_ >> 5, idx_ = p16_ & 31, kk_ = (sub_ >> 2) * 8 + (idx_ >> 2), c_ = (sub_ & 3) * 32 + (idx_ & 3) * 8; \
    (unsigned)((((kk_ & ~0xC) | ((kk_ & 4) << 1) | ((kk_ & 8) >> 1))) * DV + c_) * 2u; })
#define DMA_KP(KP, t, kboff) do { const char* kt_ = (const char*)(KP) + (size_t)(t) * SHM_K; \
    _Pragma("unroll") for (int i_ = 0; i_ < 3; ++i_) __builtin_amdgcn_global_load_lds((const unsigned*)(kt_ + KSRC(i_)), (LAS unsigned*)(l3 + L_K + (kboff) + (wid + 8 * i_) * 1024), 16, 0, 0); } while (0)
#define DMA_VP(VP, t, vboff) do { const char* vt_ = (const char*)(VP) + (size_t)(t) * SHM_V; \
    _Pragma("unroll") for (int i_ = 0; i_ < 2; ++i_) __builtin_amdgcn_global_load_lds((const unsigned*)(vt_ + VSRC(i_)), (LAS unsigned*)(l3 + L_VV + (vboff) + (wid + 8 * i_) * 1024), 16, 0, 0); } while (0)
#define DMA_K(t, kboff) DMA_KP(Kh, t, kboff)
#define DMA_V(t, vboff) DMA_VP(Vh, t, vboff)
#define QLOAD(QP) do { const bf16_t* Qw_ = (QP) + (long)(wid * QBLK + r32) * DQK + hi * 8; \
    _Pragma("unroll") for (int d0 = 0; d0 < 8; ++d0) qr[d0] = *reinterpret_cast<const bf16x8*>(Qw_ + d0 * 16); \
    _Pragma("unroll") for (int d0 = 8; d0 < 12; ++d0) __builtin_amdgcn_global_load_lds((const unsigned*)(Qw_ + d0 * 16), (LAS unsigned*)(l3 + L_QL + wid * 4096 + (d0 - 8) * 1024), 16, 0, 0); } while (0)
#define TOP(j, KB) do { if ((j) + 2 >= NT) asm volatile("s_waitcnt vmcnt(0) lgkmcnt(0)" ::: "memory"); else asm volatile("s_waitcnt vmcnt(5) lgkmcnt(0)" ::: "memory"); \
    __builtin_amdgcn_s_barrier(); asm volatile("" ::: "memory"); \
    if ((j) + 2 < NT) DMA_K((j) + 2, (((KB) + 2) % 3) * SHM_K); if ((j) + 1 < NT) DMA_V((j) + 1, (((KB) + 1) % 3) * SHM_V); } while (0)
#define RESC(a) do { if (__any((a) < 1.f)) { if (hi == 0) al_l[r32] = (a); asm volatile("s_waitcnt lgkmcnt(0)" ::: "memory"); \
    _Pragma("unroll") for (int d = 0; d < 4; ++d) _Pragma("unroll") for (int r = 0; r < 16; ++r) o[d][r] *= al_l[crow(r, hi)]; } } while (0)
#define TILE(j, KB, PN0, PN1, MNN, ALN, PF0, PF1, AF) do { TOP(j, KB); \
    seg_x<true>(PN0, PN1, K_lds + (KB) * SHM_K, qr, ql, r32, hi, PF0, PF1, AF, l_reg, pa0, pa1, pa2, pa3); \
    seg_y(o, vb0 + (((KB) + 2) % 3) * SHM_V, pa0, pa1, pa2, pa3, PN0, PN1, m_reg, MNN, ALN); RESC(ALN); } while (0)
    const int NT = seq / KVBLK;
    {
        int lane = lane0; asm volatile("" : "+v"(lane)); const int r32 = lane & 31, hi = lane >> 5;
        const size_t bh0 = (size_t)(16 * k0 + bhs);
        QLOAD(QB + (bh0 * seq + qb * 256) * DQK); DMA_KP(KBp + bh0 * seq * DQK, 0, 0); DMA_VP(VBp + bh0 * seq * DV, 0, 0); DMA_KP(KBp + bh0 * seq * DQK, 1, SHM_K);
    }
    for (int k = k0; k < k1; ++k) {
        const size_t bh = (size_t)(16 * k + bhs); const bool has_next = (k + 1 < k1);
        int lane = lane0; asm volatile("" : "+v"(lane)); const int r32 = lane & 31, hi = lane >> 5;
        const LAS char* ql = (const LAS char*)l3 + L_QL + wid * 4096 + lane * 16;
        const int vb0 = (int)(uintptr_t)(lds + L_VV) + v_rd_base(lane);
        const bf16_t* Kh = KBp + bh * seq * DQK; const bf16_t* Vh = VBp + bh * seq * DV;
        float m_reg = -1e30f, l_reg = 0; f32x16 o[4] = {};
        f32x16 pA0, pA1, pB0, pB1; float mnA, mnB, alA, alB; bf16x8 pa0, pa1, pa2, pa3;
        TOP(0, 0);
        seg_x<false>(pA0, pA1, K_lds, qr, ql, r32, hi, pA0, pA1, 1.f, l_reg, pa0, pa1, pa2, pa3); partialSM(pA0, pA1, m_reg, mnA, alA);
        for (int j = 1; j + 6 < NT; j += 6) {
            TILE(j,     1, pB0, pB1, mnB, alB, pA0, pA1, alA);
            TILE(j + 1, 2, pA0, pA1, mnA, alA, pB0, pB1, alB);
            TILE(j + 2, 0, pB0, pB1, mnB, alB, pA0, pA1, alA);
            TILE(j + 3, 1, pA0, pA1, mnA, alA, pB0, pB1, alB);
            TILE(j + 4, 2, pB0, pB1, mnB, alB, pA0, pA1, alA);
            TILE(j + 5, 0, pA0, pA1, mnA, alA, pB0, pB1, alB);
        }
        const size_t bhn = bh + 16;
        TOP(NT - 1, 1);
        if (has_next) DMA_KP(KBp + bhn * seq * DQK, 0, 0);
        seg_x<true>(pB0, pB1, K_lds + 1 * SHM_K, qr, ql, r32, hi, pA0, pA1, alA, l_reg, pa0, pa1, pa2, pa3);
        asm volatile("" ::: "memory");
        if (has_next) QLOAD(QB + (bhn * seq + qb * 256) * DQK);
        seg_y(o, vb0 + 0 * SHM_V, pa0, pa1, pa2, pa3, pB0, pB1, m_reg, mnB, alB); RESC(alB);
        finishSM(pB0, pB1, alB, l_reg, pa0, pa1, pa2, pa3); SBAR();
        pv_d0(o, vb0 + 1 * SHM_V, pa0, pa1, pa2, pa3);
        if (hi == 0) li_l[r32] = l_reg; asm volatile("s_waitcnt lgkmcnt(0)" ::: "memory");
        float rli[16];
#pragma unroll
        for (int r = 0; r < 16; ++r) rli[r] = __builtin_amdgcn_rcpf(li_l[crow(r, hi)]);
        const int b = (int)(bh >> 2), h = (int)(bh & 3);
        bf16_t* Ow = MIXp + ((size_t)b * seq + qb * 256 + wid * QBLK) * ldo + h * 128;
        float* ssq = SSQAp + (size_t)h * Mrows + (size_t)b * seq + qb * 256;
        float myss = 0.f;
#pragma unroll
        for (int r = 0; r < 16; ++r) { const int orow = crow(r, hi); float sq = 0.f;
#pragma unroll
            for (int d0 = 0; d0 < 4; ++d0) { const float v = o[d0][r] * rli[r]; sq += v * v; Ow[(long)orow * ldo + d0 * 32 + r32] = (bf16_t)f2bf(v); }
            sq = dpp_sum8(sq);
            sq += __builtin_bit_cast(float, __builtin_amdgcn_update_dpp(0, __builtin_bit_cast(int, sq), 0x128, 0xF, 0xF, true));
            sq += __shfl_xor(sq, 16);
            if (r32 == r) myss = sq; }
        if (r32 < 16) ssq[wid * QBLK + crow(r32, hi)] = myss;
        if (has_next) { asm volatile("s_waitcnt lgkmcnt(0)" ::: "memory"); __builtin_amdgcn_s_barrier(); asm volatile("" ::: "memory");
            DMA_VP(VBp + bhn * seq * DV, 0, 0); DMA_KP(KBp + bhn * seq * DQK, 1, SHM_K); }
        else { asm volatile("s_waitcnt vmcnt(0) lgkmcnt(0)" ::: "memory"); __builtin_amdgcn_s_barrier(); asm volatile("" ::: "memory"); }
    }
#undef DMA_K
#undef DMA_V
#undef DMA_KP
#undef DMA_VP
#undef QLOAD
#undef TOP
#undef TILE
#undef RESC
}
}

namespace hg {
using att::crow; using att::v_st; using att::v_rd_base; using att::v_rd_off; using att::tr_read;
constexpr int L_QE = 0, L_QT = 16384, L_KT = 32768, L_OT = 122880  , L_KE = 73728, L_V = 90112, L_P = 106496, L_SEG = 114688  , L_DV = 155648, L_GN = 156160  , L_END = 156672;
__device__ __forceinline__ int swzA(int row, int cb) { return row * 256 + (cb ^ ((row & 15) << 4) ^ (((row >> 4) & 1) << 3)); }
__device__ __forceinline__ int swzB(int row, int cb) { return row * 256 + (cb ^ ((row & 15) << 4)); }
__device__ __forceinline__ int swzP(int row, int cb) { return row * 128 + (cb ^ ((row & 7) << 4)); }
template <int D0> __device__ __forceinline__ void tr_frag4(int vb, bf16x8& f0, bf16x8& f1, bf16x8& f2, bf16x8& f3) {
    const s16x4 l0 = tr_read<v_rd_off(D0, 0, 0)>(vb), h0 = tr_read<v_rd_off(D0, 0, 1)>(vb), l1 = tr_read<v_rd_off(D0, 1, 0)>(vb), h1 = tr_read<v_rd_off(D0, 1, 1)>(vb);
    const s16x4 l2 = tr_read<v_rd_off(D0, 2, 0)>(vb), h2 = tr_read<v_rd_off(D0, 2, 1)>(vb), l3 = tr_read<v_rd_off(D0, 3, 0)>(vb), h3 = tr_read<v_rd_off(D0, 3, 1)>(vb);
    asm volatile("s_waitcnt lgkmcnt(0)" ::: "memory"); SBAR();
    f0 = PKLH(l0, h0); f1 = PKLH(l1, h1); f2 = PKLH(l2, h2); f3 = PKLH(l3, h3);
}
struct Pre { u32x2 q4[4], l4[4], v4[4]; };
__device__ __forceinline__ void load_chunk(Pre& P, const bf16_t* pbase, int h, int dir, int cs, int wid, int lane) {
    const int c4 = 4 * (lane & 31), j0 = 8 * wid + 4 * (lane >> 5);
    const int cq = C_Q + h * 128 + c4, cf = C_FF + dir * 512 + h * 128 + c4, ci = C_I + h * 128 + c4;
#pragma unroll
    for (int i = 0; i < 4; ++i) { const int j = j0 + i, pos = dir ? (64 * cs + 63 - j) : (64 * cs + j); const bf16_t* rp = pbase + (size_t)pos * DINP;
        P.q4[i] = *(const u32x2*)(rp + cq); P.l4[i] = *(const u32x2*)(rp + cf); P.v4[i] = *(const u32x2*)(rp + ci); }
}
__device__ __forceinline__ void stage_c(char* lds, f32x16 (&S)[4], f32x16 (&o)[2]  , _Float16* ofp  , int rstride  , bool second, int eb, int lane_, int part  ) {
    int lane = lane_; asm volatile("" : "+v"(lane));
    const int r32 = lane & 31, hi = lane >> 5;
    _Float16* p0 = ofp + r32 + 4 * hi * rstride;
    const int vbV = (int)(uintptr_t)(lds + L_V) + v_rd_base(lane) + eb * 512, vbK = (int)(uintptr_t)(lds + L_KE) + v_rd_base(lane);
    if (part == 0) {
#pragma unroll
    for (int db = 0; db < 4; ++db)
#pragma unroll
        for (int s = 0; s < 2; ++s) {
            u32x4 sw; sw.x = cvtpk(S[db][8 * s + 0], S[db][8 * s + 1]); sw.y = cvtpk(S[db][8 * s + 2], S[db][8 * s + 3]);
            sw.z = cvtpk(S[db][8 * s + 4], S[db][8 * s + 5]); sw.w = cvtpk(S[db][8 * s + 6], S[db][8 * s + 7]);
            const bf16x8 sf = __builtin_bit_cast(bf16x8, sw);
#pragma unroll
            for (int jb = 0; jb < 2; ++jb) { const int row = 32 * jb + r32, d0 = 32 * db + 16 * s + 4 * hi;
                const u32x2 a0 = *(const u32x2*)(lds + L_QE + swzA(row, d0 * 2)), a1 = *(const u32x2*)(lds + L_QE + swzA(row, (d0 + 8) * 2));
                const u32x4 aw = {a0.x, a0.y, a1.x, a1.y};
                o[jb] = __builtin_amdgcn_mfma_f32_32x32x16_bf16(__builtin_bit_cast(bf16x8, aw), sf, o[jb], 0, 0, 0); }
        }
    return; }
    bf16x8 vf0, vf1, vf2, vf3; tr_frag4<0>(vbV, vf0, vf1, vf2, vf3);
#define PFR(jb, ks) (*(const bf16x8*)(lds + L_P + swzP(32 * (jb) + r32, 32 * (ks) + 16 * hi)))
    o[0] = __builtin_amdgcn_mfma_f32_32x32x16_bf16(PFR(0, 0), vf0, o[0], 0, 0, 0);
    o[0] = __builtin_amdgcn_mfma_f32_32x32x16_bf16(PFR(0, 1), vf1, o[0], 0, 0, 0);
    o[1] = __builtin_amdgcn_mfma_f32_32x32x16_bf16(PFR(1, 0), vf0, o[1], 0, 0, 0);
    o[1] = __builtin_amdgcn_mfma_f32_32x32x16_bf16(PFR(1, 1), vf1, o[1], 0, 0, 0);
    o[1] = __builtin_amdgcn_mfma_f32_32x32x16_bf16(PFR(1, 2), vf2, o[1], 0, 0, 0);
    o[1] = __builtin_amdgcn_mfma_f32_32x32x16_bf16(PFR(1, 3), vf3, o[1], 0, 0, 0);
#undef PFR
    if (second) {
        float* ot = (float*)(lds + L_OT) + 32 * eb + r32 + 4 * hi * 128;
#pragma unroll
        for (int jb = 0; jb < 2; ++jb)
#pragma unroll
            for (int r = 0; r < 16; ++r) ot[(32 * jb + 8 * (r >> 2) + (r & 3)) * 128] = o[jb][r];
    } else {
#pragma unroll
        for (int jb = 0; jb < 2; ++jb)
#pragma unroll
            for (int g = 0; g < 4; ++g) { _Float16* pg = p0 + (32 * jb + 8 * g) * rstride;
#pragma unroll
                for (int e = 0; e < 4; ++e) pg[e * rstride] = (_Float16)o[jb][4 * g + e];
                asm volatile("" ::: "memory"); }
    }
    const float* dv = (const float*)(lds + L_DV);
#define SUPD(DB) do { bf16x8 k0_, k1_, k2_, k3_; tr_frag4<DB>(vbK, k0_, k1_, k2_, k3_); \
        { const float* dvp = dv + 32 * DB + 4 * hi; _Pragma("unroll") for (int g = 0; g < 4; ++g) { const f32x4 d4 = *(const f32x4*)(dvp + 8 * g); \
            S[DB][4 * g] *= d4[0]; S[DB][4 * g + 1] *= d4[1]; S[DB][4 * g + 2] *= d4[2]; S[DB][4 * g + 3] *= d4[3]; } } \
        S[DB] = __builtin_amdgcn_mfma_f32_32x32x16_bf16(k0_, vf0, S[DB], 0, 0, 0); S[DB] = __builtin_amdgcn_mfma_f32_32x32x16_bf16(k1_, vf1, S[DB], 0, 0, 0); \
        S[DB] = __builtin_amdgcn_mfma_f32_32x32x16_bf16(k2_, vf2, S[DB], 0, 0, 0); S[DB] = __builtin_amdgcn_mfma_f32_32x32x16_bf16(k3_, vf3, S[DB], 0, 0, 0); } while (0)
    SUPD(0); SUPD(1); SUPD(2); SUPD(3);
#undef SUPD
}
__device__ __forceinline__ void hgrn_bh(int b, int h, const bf16_t* proj, bf16_t* MIXp, const float* __restrict__ gain, char* lds, int wv) {
    int lane = lane_id(); asm volatile("" : "+v"(lane));
    const int wid = wv, tid = wv * 64 + lane, dp_ = lane, seg = wid;
    for (int i = tid; i < 8192 / 4; i += 512) ((unsigned*)(lds + L_P))[i] = 0u;
    f32x16 S[4] = {};
    const bf16_t* pbase = proj + (size_t)b * SEQ * DINP;
    float* segtot = (float*)(lds + L_SEG);
    if (tid < 128) ((float*)(lds + L_GN))[tid] = gain[tid];
    Pre pre; load_chunk(pre, pbase, h, 0, 0, wid, lane);
    __syncthreads();
    const int hw = lane >> 5, cq4 = lane & 31, sg16 = 2 * wid + hw;
    const int cB = (8 * cq4) ^ ((wid & 1) << 7) ^ (hw << 6), cA = cB ^ (((wid >> 1) & 1) << 3), rowb = wid * 2048 + hw * 1024;
    const int gV = (cq4 >> 3) * 512 + (cq4 & 7) * 8 + (wid >> 1) * 4096 + hw * 2048 + (wid & 1) * 256;
    const int drow = tid >> 3, dseg = tid & 7;
#define POST_SEGTOT() do { float a0_ = 0.f, a1_ = 0.f, a2_ = 0.f, a3_ = 0.f; \
        _Pragma("unroll") for (int t_ = 0; t_ < 4; ++t_) { const unsigned lx_ = pre.l4[t_].x, ly_ = pre.l4[t_].y; const h16x2 h0_ = __builtin_bit_cast(h16x2, lx_), h1_ = __builtin_bit_cast(h16x2, ly_); \
            a0_ += (float)h0_[0]; a1_ += (float)h0_[1]; a2_ += (float)h1_[0]; a3_ += (float)h1_[1]; } \
        *(f32x4*)(segtot + sg16 * 128 + 4 * cq4) = (f32x4){a0_, a1_, a2_, a3_}; } while (0)
    POST_SEGTOT();
    asm volatile("s_waitcnt lgkmcnt(0)" ::: "memory"); __builtin_amdgcn_s_barrier(); asm volatile("" ::: "memory");
    for (int k = 0; k < 64; ++k) {
        const int i = k >> 1, dir = k & 1, cs = dir ? 31 - i : i; const bool second = (i >= 16);
        const long row0 = (long)b * SEQ + (dir ? 64 * cs + 63 : 64 * cs);
        const int rstride = dir ? -DINP : DINP; const bool mine = ((wid >> 2) == dir);
        _Float16* rawp = (_Float16*)proj + (size_t)row0 * DINP + C_CQ + h * 128 + 32 * (wid & 3);
        f32x16 o[2]; u32x4 gq0, gq1;
        if (second) {
            if (mine) { const _Float16* p0 = rawp + (lane & 31) + 4 * (lane >> 5) * rstride;
#pragma unroll
                for (int jb = 0; jb < 2; ++jb)
#pragma unroll
                    for (int r = 0; r < 16; ++r) o[jb][r] = (float)p0[(32 * jb + 8 * (r >> 2) + (r & 3)) * rstride]; }
            const long grow = row0 + (dir ? -drow : drow); const bf16_t* gp = proj + (size_t)grow * DINP + C_G + h * 128 + 16 * dseg;
            gq0 = *(const u32x4*)gp; gq1 = *(const u32x4*)(gp + 8);
        } else { o[0] = f32x16{}; o[1] = f32x16{}; }
        const int I = wid >> 1;
        f32x4 rr[5];
        { f32x4 a = {0.f, 0.f, 0.f, 0.f};
#pragma unroll
          for (int sg = 0; sg < 16; ++sg) { if ((sg & 3) == 0) rr[sg >> 2] = a; a += *(const f32x4*)(segtot + sg * 128 + 4 * cq4); }
          rr[4] = a; }
        const f32x4 rI = (I == 0) ? rr[0] : (I == 1) ? rr[1] : (I == 2) ? rr[2] : rr[3];
        f32x4 run = rI;
#pragma unroll
        for (int q = 0; q < 3; ++q) { const f32x4 st = *(const f32x4*)(segtot + (4 * I + q) * 128 + 4 * cq4); if (4 * I + q < sg16) run += st; }
        f32x4 eI, eT, rat[4];
#pragma unroll
        for (int c = 0; c < 4; ++c) { eI[c] = __builtin_amdgcn_exp2f(rI[c]); eT[c] = __builtin_amdgcn_exp2f(rr[4][c] - rI[c]);
#pragma unroll
            for (int sg = 0; sg < 4; ++sg) rat[sg][c] = __builtin_amdgcn_exp2f(fminf(rr[sg][c] - rI[c], 0.f)); }
        if (sg16 == 0) { f32x4 d4;
#pragma unroll
            for (int c = 0; c < 4; ++c) d4[c] = __builtin_amdgcn_exp2f(rr[4][c]);
            *(f32x4*)((float*)(lds + L_DV) + 4 * cq4) = d4; }
#pragma unroll
        for (int t = 0; t < 4; ++t) {
            const unsigned lx = pre.l4[t].x, ly = pre.l4[t].y; const h16x2 h0 = __builtin_bit_cast(h16x2, lx), h1 = __builtin_bit_cast(h16x2, ly);
            const f32x4 lf = {(float)h0[0], (float)h0[1], (float)h1[0], (float)h1[1]};
            const f32x4 q = {bflo(pre.q4[t].x), bfhi(pre.q4[t].x), bflo(pre.q4[t].y), bfhi(pre.q4[t].y)};
            run += lf;
            f32x4 qt, qe, kI, ke;
#pragma unroll
            for (int c = 0; c < 4; ++c) { const float dlt = run[c] - rI[c];
                const float kk = 1.f - __builtin_amdgcn_exp2f(lf[c]);
                qt[c] = q[c] * __builtin_amdgcn_exp2f(dlt); kI[c] = kk * __builtin_amdgcn_exp2f(fminf(-dlt, 115.f)); }
            qe = qt * eI; ke = kI * eT;
            const int aB = (cB ^ (t << 4)) + rowb + t * 256, aA = (cA ^ (t << 4)) + rowb + t * 256, aV = gV + t * 64;
            *(u32x2*)(lds + L_QE + aA) = (u32x2){cvtpk(qe[0], qe[1]), cvtpk(qe[2], qe[3])};
            *(u32x2*)(lds + L_QT + aB) = (u32x2){cvtpk(qt[0], qt[1]), cvtpk(qt[2], qt[3])};
            *(u32x2*)(lds + L_KE + aV) = (u32x2){cvtpk(ke[0], ke[1]), cvtpk(ke[2], ke[3])};
            *(u32x2*)(lds + L_V + aV) = pre.v4[t];
#define KTW(base, SG) do { const f32x4 kv_ = kI * rat[SG]; *(u32x2*)(lds + L_KT + (base) * 256 + aB) = (u32x2){cvtpk(kv_[0], kv_[1]), cvtpk(kv_[2], kv_[3])}; } while (0)
#define KTD(base) do { *(u32x2*)(lds + L_KT + (base) * 256 + aB) = (u32x2){cvtpk(kI[0], kI[1]), cvtpk(kI[2], kI[3])}; } while (0)
            if (I == 0) { KTD(0); KTW(16, 1); KTW(48, 2); KTW(96, 3); }
            else if (I == 1) { KTD(16); KTW(48, 2); KTW(96, 3); }
            else if (I == 2) { KTD(48); KTW(96, 3); }
            else { KTD(96); }
#undef KTW
#undef KTD
        }
        asm volatile("s_waitcnt lgkmcnt(0)" ::: "memory"); __builtin_amdgcn_s_barrier(); asm volatile("" ::: "memory");
        if (k + 1 < 64) { const int k1 = k + 1, i1 = k1 >> 1, d1 = k1 & 1; load_chunk(pre, pbase, h, d1, d1 ? 31 - i1 : i1, wid, lane); }
        if (mine) stage_c(lds, S, o, rawp, rstride, second, wid & 3, lane, 0);
        else for (int blk = (wid & 3); blk < 10; blk += 4) {
            int bi, bjj; if (blk == 0) { bi = 0; bjj = 0; } else if (blk < 3) { bi = 1; bjj = blk - 1; } else if (blk < 6) { bi = 2; bjj = blk - 3; } else { bi = 3; bjj = blk - 6; }
            const int base = (bi == 0) ? 0 : (bi == 1) ? 16 : (bi == 2) ? 48 : 96;
            const int xm = ((lane & 15) << 4), cq4 = 16 * (lane >> 4);
            const char* ap = lds + L_QT + (16 * bi + (lane & 15)) * 256; const char* bp = lds + L_KT + (base + 16 * bjj + (lane & 15)) * 256;
            bf16x8 av[4], bv[4];
#pragma unroll
            for (int ks = 0; ks < 4; ++ks) { const int cb = (64 * ks + cq4) ^ xm; av[ks] = *(const bf16x8*)(ap + cb); bv[ks] = *(const bf16x8*)(bp + cb); }
            f32x4 acc = {0.f, 0.f, 0.f, 0.f};
#pragma unroll
            for (int ks = 0; ks < 4; ++ks) acc = __builtin_amdgcn_mfma_f32_16x16x32_bf16(av[ks], bv[ks], acc, 0, 0, 0);
            const int sl = lane & 15;
#pragma unroll
            for (int r = 0; r < 4; ++r) { const int jl = (lane >> 4) * 4 + r; const float v = (bi != bjj || sl <= jl) ? acc[r] : 0.f;
                *(bf16_t*)(lds + L_P + swzP(16 * bi + jl, (16 * bjj + sl) * 2)) = (bf16_t)(cvtpk(v, v) & 0xffffu); }
        }
        asm volatile("s_waitcnt lgkmcnt(0)" ::: "memory"); __builtin_amdgcn_s_barrier(); asm volatile("" ::: "memory");
        if (mine) stage_c(lds, S, o, rawp, rstride, second, wid & 3, lane, 1);
        if (k + 1 < 64) POST_SEGTOT();
        if (k == 31) asm volatile("s_waitcnt vmcnt(0)" ::: "memory");
        asm volatile("s_waitcnt lgkmcnt(0)" ::: "memory"); __builtin_amdgcn_s_barrier(); asm volatile("" ::: "memory");
        if (second) {
            const float* otp = (const float*)(lds + L_OT) + drow * 128 + 16 * dseg;
            f32x4 v[4]; float ss = 0.f;
#pragma unroll
            for (int q = 0; q < 4; ++q) { v[q] = *(const f32x4*)(otp + 4 * q); ss += (v[q][0] * v[q][0] + v[q][1] * v[q][1]) + (v[q][2] * v[q][2] + v[q][3] * v[q][3]); }
            ss = dpp_sum8(ss);
            const float r = __builtin_amdgcn_rsqf(ss * (1.f / 128.f) + EPS);
            f32x4 gn[4];
#pragma unroll
            for (int q = 0; q < 4; ++q) gn[q] = *(const f32x4*)((const float*)(lds + L_GN) + 16 * dseg + 4 * q);
            const unsigned gw[8] = {gq0.x, gq0.y, gq0.z, gq0.w, gq1.x, gq1.y, gq1.z, gq1.w}; unsigned ow[8];
#pragma unroll
            for (int q = 0; q < 8; ++q) { const float g0 = bflo(gw[q]), g1 = bfhi(gw[q]);
                const float s0 = g0 * __builtin_amdgcn_rcpf(1.f + __builtin_amdgcn_exp2f(-1.4426950408889634f * g0)), s1 = g1 * __builtin_amdgcn_rcpf(1.f + __builtin_amdgcn_exp2f(-1.4426950408889634f * g1));
                ow[q] = cvtpk(v[q >> 1][2 * (q & 1)] * r * gn[q >> 1][2 * (q & 1)] * s0, v[q >> 1][2 * (q & 1) + 1] * r * gn[q >> 1][2 * (q & 1) + 1] * s1); }
            const long grow = row0 + (dir ? -drow : drow); bf16_t* mp = MIXp + (size_t)grow * DM + 512 + h * 128 + 16 * dseg;
            *(u32x4*)mp = (u32x4){ow[0], ow[1], ow[2], ow[3]}; *(u32x4*)(mp + 8) = (u32x4){ow[4], ow[5], ow[6], ow[7]};
        }
    }
    __syncthreads();
}
}

#define XB_TMO      128
#define XB_XCNT(j)  (256  + 64 * (j))
#define XB_XSUB(j)  (1280 + 64 * (j))
#define XB_XGEN(j)  (2304 + 64 * (j))
#define XB_TOP      3328
#define XB_TOPGEN   3392
#define XCD_BAR_WORDS 3456
#define XB_SPIN_CAP (1u << 18)

__device__ __forceinline__ unsigned xb_ld(unsigned* p)              { return __hip_atomic_load(p, __ATOMIC_RELAXED, __HIP_MEMORY_SCOPE_AGENT); }
__device__ __forceinline__ unsigned xb_add(unsigned* p, unsigned v) { return __hip_atomic_fetch_add(p, v, __ATOMIC_RELAXED, __HIP_MEMORY_SCOPE_AGENT); }
__device__ __forceinline__ unsigned xb_xcc_id() { return (unsigned)__builtin_amdgcn_s_getreg((3 << 11) | 20) & 0xFu; }
#define XB_SPIN(cond, bar) do { unsigned _sp = 0; while (cond) { __builtin_amdgcn_s_sleep(1); \
    if ((++_sp & 255u) == 0u) { if (xb_ld(&(bar)[XB_TMO])) break; if (_sp > XB_SPIN_CAP) { atomicAdd(&(bar)[XB_TMO], 1u); break; } } } } while (0)

struct XcdBarrier {
    unsigned* bar; unsigned x;
    volatile LAS unsigned* st;
};

__device__ __forceinline__ XcdBarrier xcd_barrier_post(unsigned* bar, volatile LAS unsigned* st, bool leader  ) {
    XcdBarrier b; b.bar = bar; b.x = xb_xcc_id(); b.st = st;
    if (leader) (void)xb_add(&bar[XB_XCNT(b.x)], 1u);
    return b;
}
__device__ __forceinline__ void xcd_barrier_complete(unsigned* bar, unsigned x, unsigned& nloc, unsigned& nx) {
    const unsigned G = gridDim.x * gridDim.y * gridDim.z;
    unsigned sum, cnt, mine, sp = 0u;
    for (;;) {
        sum = 0u; cnt = 0u; mine = 0u;
#pragma unroll
        for (unsigned j = 0; j < 16; ++j) { const unsigned c = xb_ld(&bar[XB_XCNT(j)]); sum += c; cnt += (c > 0u) ? 1u : 0u; mine = (j == x) ? c : mine; }
        if (sum == G) break;
        __builtin_amdgcn_s_sleep(1);
        if ((++sp & 255u) == 0u) { if (xb_ld(&bar[XB_TMO])) break; if (sp > XB_SPIN_CAP) { atomicAdd(&bar[XB_TMO], 1u); break; } }
    }
    nloc = mine > 0u ? mine : 1u; nx = cnt > 0u ? cnt : 1u;
}

__device__ __forceinline__ void xcd_barrier(const XcdBarrier& b, bool leader  ) {
    asm volatile("s_waitcnt vmcnt(0)" ::: "memory");
    __syncthreads();
    if (leader) {
        unsigned* bar = b.bar;
        __builtin_amdgcn_s_waitcnt(0);
        unsigned nloc = b.st[0], nx = b.st[1];
        if (nloc == 0u) { xcd_barrier_complete(bar, b.x, nloc, nx); b.st[0] = nloc; b.st[1] = nx; }
        const unsigned old = xb_add(&bar[XB_XSUB(b.x)], 1u);
        const unsigned gen = old / nloc;
        if (old + 1u == (gen + 1u) * nloc) {
            __builtin_amdgcn_fence(__ATOMIC_RELEASE, "agent");
            asm volatile("s_waitcnt vmcnt(0)" ::: "memory");
            const unsigned og = xb_add(&bar[XB_TOP], 1u);
            const unsigned tg = og / nx;
            if (og + 1u == (tg + 1u) * nx) xb_add(&bar[XB_TOPGEN], 1u);
            else XB_SPIN(xb_ld(&bar[XB_TOPGEN]) == tg, bar);
            __builtin_amdgcn_fence(__ATOMIC_ACQUIRE, "agent");
            xb_add(&bar[XB_XGEN(b.x)], 1u);
            asm volatile("s_waitcnt vmcnt(0)" ::: "memory");
        } else {
            XB_SPIN(xb_ld(&bar[XB_XGEN(b.x)]) == gen, bar);
            __builtin_amdgcn_fence(__ATOMIC_ACQUIRE, "agent");
            asm volatile("s_waitcnt vmcnt(0)" ::: "memory");
        }
    }
    __syncthreads();
}


constexpr int NWAVES = 8;
constexpr int LDS_BYTES = 160 * 1024;
constexpr int RING_BYTES = 131072, EPI_OFF = RING_BYTES  , TAB_OFF = RING_BYTES + 8192  , MISC_OFF = 160 * 1024 - 1024;
constexpr size_t CTL_ZERO_BYTES = 65536;
struct Args { const float* in[17]; float* out; unsigned char* ws; int ph_lo, ph_hi; };

__device__ __forceinline__ int rope_perm(int cp) { const int i = cp >> 3, j = cp & 7; return (j < 4) ? 4 * i + j : 32 + 4 * i + (j - 4); }
__device__ __forceinline__ void tr_item(const float* W, int ldw, int ksrc0, int srccol, const float* gain, int goff, bf16_t* WT, int Kd, int kd0, int nd0, LAS float* scr, int lane) {
    float wv_[32], gv_[32];
#pragma unroll
    for (int i = 0; i < 32; ++i) { const int kk = 2 * i + (lane >> 5); wv_[i] = (srccol >= 0) ? W[(size_t)(ksrc0 + kk) * ldw + srccol] : 0.f; gv_[i] = gain ? gain[ksrc0 + kk - goff] : 1.f; }
#pragma unroll
    for (int i = 0; i < 32; ++i) { const int kk = 2 * i + (lane >> 5); scr[kk * 33 + (lane & 31)] = wv_[i] * gv_[i]; }
    asm volatile("s_waitcnt lgkmcnt(0)" ::: "memory");
    const int c = lane & 7;
#pragma unroll
    for (int j = 0; j < 4; ++j) { const int n = (lane >> 3) + 8 * j; const LAS float* sp = scr + (8 * c) * 33 + n;
        u32x4 o; o.x = pk2(sp[0 * 33], sp[1 * 33]); o.y = pk2(sp[2 * 33], sp[3 * 33]); o.z = pk2(sp[4 * 33], sp[5 * 33]); o.w = pk2(sp[6 * 33], sp[7 * 33]);
        *(u32x4*)(WT + (size_t)(nd0 + n) * Kd + kd0 + 8 * c) = o; }
    asm volatile("s_waitcnt lgkmcnt(0)" ::: "memory");
}
template <int R>
__device__ __forceinline__ void rows_to_bf16_rs(const float* x0, bf16_t* o0, float* rs0, size_t rstep, int lane) {
    f32x4 v[R][4]; float s[R];
#pragma unroll
    for (int r = 0; r < R; ++r) { const f32x4* xr = (const f32x4*)(x0 + (size_t)r * rstep * DM) + lane;
#pragma unroll
        for (int j = 0; j < 4; ++j) v[r][j] = xr[64 * j]; }
#pragma unroll
    for (int r = 0; r < R; ++r) { float a = 0.f;
#pragma unroll
        for (int j = 0; j < 4; ++j) a += (v[r][j].x * v[r][j].x + v[r][j].y * v[r][j].y) + (v[r][j].z * v[r][j].z + v[r][j].w * v[r][j].w);
        s[r] = a; }
#pragma unroll
    for (int o = 1; o < 64; o <<= 1) {
#pragma unroll
        for (int r = 0; r < R; ++r) s[r] += __shfl_xor(s[r], o); }
#pragma unroll
    for (int r = 0; r < R; ++r) { if (lane == 0) rs0[(size_t)r * rstep] = 1.f / sqrtf(s[r] * (1.f / DM) + EPS);
        u32x2* o8 = (u32x2*)(o0 + (size_t)r * rstep * DM) + lane;
#pragma unroll
        for (int j = 0; j < 4; ++j) { u32x2 w; w.x = cvtpk(v[r][j].x, v[r][j].y); w.y = cvtpk(v[r][j].z, v[r][j].w); o8[64 * j] = w; } }
}
__device__ __forceinline__ void sincos_acc(float ang, float& c, float& s) {
    const double x = (double)ang; const double kq = __builtin_rint(x * 0.6366197723675814); const double y = x - kq * 1.5707963267948966 - kq * 6.123233995736766e-17;
    const double y2 = y * y;
    double sp = -7.6471637318198164759e-13; sp = sp * y2 + 1.6059043836821614599e-10; sp = sp * y2 - 2.5052108385441718775e-8; sp = sp * y2 + 2.7557319223985890653e-6; sp = sp * y2 - 1.9841269841269841270e-4; sp = sp * y2 + 8.3333333333333333333e-3; sp = sp * y2 - 1.6666666666666666667e-1; sp = y + y * y2 * sp;
    double cp = 4.7794773323873852974e-14; cp = cp * y2 - 1.1470745597729724714e-11; cp = cp * y2 + 2.0876756987868098979e-9; cp = cp * y2 - 2.7557319223985890653e-7; cp = cp * y2 + 2.4801587301587301587e-5; cp = cp * y2 - 1.3888888888888888889e-3; cp = cp * y2 + 4.1666666666666666667e-2; cp = cp * y2 - 0.5; cp = 1.0 + y2 * cp;
    const int q = ((int)(long long)kq) & 3;
    const double sv = (q == 0) ? sp : (q == 1) ? cp : (q == 2) ? -sp : -cp;
    const double cv = (q == 0) ? cp : (q == 1) ? -sp : (q == 2) ? -cp : sp;
    c = (float)cv; s = (float)sv;
}

__global__ void __launch_bounds__(NWAVES * 64, 2) mk_fwd(Args args) {
    extern __shared__ __attribute__((aligned(16))) unsigned char lds[];
    const int g_wv = __builtin_amdgcn_readfirstlane(threadIdx.x >> 6);
#define TIDV() ({ int t_ = g_wv * 64 + lane_id(); asm volatile("" : "+v"(t_)); t_; })
    const int G = gridDim.x, bx = blockIdx.x;
    unsigned char* ws = args.ws;
    const float* x = args.in[0]; const int* positions = (const int*)args.in[1];
    const float* g_mix = args.in[2]; const float* w_in = args.in[3]; const float* lb_param = args.in[4]; const float* g_hgrn = args.in[5];
    const float* g_cq = args.in[6]; const float* w_q_up = args.in[7]; const float* g_ckv = args.in[8]; const float* w_kv_up = args.in[9];
    const float* g_qn = args.in[10]; const float* g_kn = args.in[11]; const float* g_mla_out = args.in[12]; const float* w_out = args.in[13];
    const float* g_ffn = args.in[14]; const float* w_up = args.in[15]; const float* w_down = args.in[16];
    float* out = args.out;
    float* RS0 = (float*)(ws + WS_RS0); float* SSQ1 = (float*)(ws + WS_SSQ1); float* SSQP = (float*)(ws + WS_SSQP); float* GQT = (float*)(ws + WS_GQT); float* GKT = (float*)(ws + WS_GKT); float* LBT = (float*)(ws + WS_LBT);
    float* COS = (float*)(ws + WS_COS); float* SIN = (float*)(ws + WS_SIN);
    bf16_t* WIN = (bf16_t*)(ws + WS_WIN); bf16_t* WQ = (bf16_t*)(ws + WS_WQ); bf16_t* WKV = (bf16_t*)(ws + WS_WKV); bf16_t* WOUT = (bf16_t*)(ws + WS_WOUT);
    bf16_t* WUP = (bf16_t*)(ws + WS_WUP); bf16_t* WDN = (bf16_t*)(ws + WS_WDN);
    bf16_t* XB = (bf16_t*)(ws + WS_XB); bf16_t* VB = (bf16_t*)(ws + WS_V); bf16_t* X1B = (bf16_t*)(ws + WS_X1B);
    bf16_t* PROJ = (bf16_t*)(ws + WS_PROJ); bf16_t* HB = (bf16_t*)(ws + WS_HB);
    bf16_t* MIX = (bf16_t*)(ws + WS_MIX); float* SSQA = (float*)(ws + WS_SSQA);
    bf16_t* QB = (bf16_t*)(ws + WS_Q); bf16_t* KB = (bf16_t*)(ws + WS_K);
    const int lo = args.ph_lo, hi = args.ph_hi;
    cooperative_groups::grid_group grid = cooperative_groups::this_grid();
    volatile LAS unsigned* MISC = (volatile LAS unsigned*)((LAS unsigned char*)lds + MISC_OFF);
    { const int tid = TIDV(); if (tid < 32) MISC[tid] = 0u; }
    __syncthreads();
    XcdBarrier bar = xcd_barrier_post((unsigned*)(ws + WS_CTL) + 4096, MISC + 8, TIDV() == 0);
    if (args.ph_hi > 1000) grid.sync();
#define SEAM(k) do { if (lo <= (k) && (k) + 1 < hi) xcd_barrier(bar, TIDV() == 0); } while (0)
#ifndef PHMASK
#define PHMASK 0xFFF
#endif
#define IN(k) (((PHMASK >> (k)) & 1) && lo <= (k) && (k) < hi)
#ifndef REPMASK
#define REPMASK 0
#endif
#define REPS(k) for (int rep_ = 0; rep_ < ((((REPMASK) >> (k)) & 1) ? 2 : 1); ++rep_)

    if (IN(0)) REPS(0) {
        const int tid = TIDV(), lane = tid & 63, wave = g_wv;
        const int vcu = (G % 8 == 0) ? (bx % 8) * (G / 8) + bx / 8 : bx;
        const int gw = vcu * NWAVES + wave, NGW = G * NWAVES;
        LAS float* scr = (LAS float*)((LAS unsigned char*)lds + wave * 16384);
        constexpr int I_IN = 16 * 104, I_Q = 6 * 32, I_KV = 4 * 32, I_OUT = 16 * 32, I_UP = 16 * 128, I_DN = 64 * 32;
        constexpr int NITEMS = I_IN + I_Q + I_KV + I_OUT + I_UP + I_DN;
        const int l31 = lane & 31;
        for (int it = gw; it < NITEMS; it += NGW) {
            int r = it;
            if (r < I_IN) { const int kb = r / 104, nb = r % 104, nd = 32 * nb + l31; const int sc = nd < C_KR ? nd : (nd < DIN ? C_KR + rope_perm(nd - C_KR) : -1);
                tr_item(w_in, DIN, 64 * kb, sc, g_mix, 0, WIN, DM, 64 * kb, 32 * nb, scr, lane); continue; } r -= I_IN;
            if (r < I_Q) { const int kb = r / 32, nb = r % 32, nd = 32 * nb + l31, hh = nd >> 8, c = nd & 255; const int sc = c < 128 ? hh * 192 + c : (c < 192 ? hh * 192 + 128 + rope_perm(c - 128) : -1);
                tr_item(w_q_up, NQ, 64 * kb, sc, g_cq, 0, WQ, QLORA, 64 * kb, 32 * nb, scr, lane); continue; } r -= I_Q;
            if (r < I_KV) { const int kb = r / 32, nb = r % 32; tr_item(w_kv_up, NKV, 64 * kb, 32 * nb + l31, g_ckv, 0, WKV, KVLORA, 64 * kb, 32 * nb, scr, lane); continue; } r -= I_KV;
            if (r < I_OUT) { const int kb = r / 32, nb = r % 32; const int kd0 = 64 * kb, ks0 = kd0 < 512 ? kd0 + 512 : kd0 - 512;
                tr_item(w_out, DM, ks0, 32 * nb + l31, kd0 < 512 ? g_mla_out : nullptr, 512, WOUT, DM, kd0, 32 * nb, scr, lane); continue; } r -= I_OUT;
            if (r < I_UP) { const int kb = r / 128, nb = r % 128; tr_item(w_up, DFF, 64 * kb, 32 * nb + l31, g_ffn, 0, WUP, DM, 64 * kb, 32 * nb, scr, lane); continue; } r -= I_UP;
            { const int kb = r / 32, nb = r % 32; tr_item(w_down, DM, 64 * kb, 32 * nb + l31, nullptr, 0, WDN, DFF, 64 * kb, 32 * nb, scr, lane); }
        }
        for (int i = bx * 512 + tid; i < 512; i += G * 512) ((float*)(ws + WS_GHT))[i] = g_hgrn[i];
        for (int i = bx * 512 + tid; i < 512; i += G * 512) {
            if (i < 256) GQT[i] = i < 128 ? g_qn[i] * QSCALE : (i < 192 ? g_qn[128 + rope_perm(i - 128)] * QSCALE : 0.f);
            else { const int c = i - 256; if (c < 192) GKT[c] = c < 128 ? g_kn[c] : g_kn[128 + rope_perm(c - 128)]; } }
        for (int m = gw; m < M; m += 4 * NGW) rows_to_bf16_rs<4>(x + (size_t)m * DM, XB + (size_t)m * DM, RS0 + m, (size_t)NGW, lane);
        for (int i = bx * 512 + tid; i < 1024; i += G * 512) { const int dir = i >> 9, c = i & 511; const float p0 = lb_param[dir * 1024 + c], p1 = lb_param[dir * 1024 + 512 + c];
            LBT[i] = 1.f / (1.f + expf(p1 - p0)); }
        { const int j = tid & 31; const float invf = powf(10000.0f, -(float)(2 * j) / 64.0f);
          for (int i = bx * 512 + tid; i < M * 32; i += G * 512) { const int row = i >> 5; const float ang = (float)positions[row] * invf; float c, sn; sincos_acc(ang, c, sn); COS[i] = c; SIN[i] = sn; } }
    }
    SEAM(0);
    if (IN(1)) REPS(1) {
        pg8::Gemm g{XB, WIN, M, DINP, DM, DM}; pg8::StaticOrder S; S.init(M, DINP, G, bx);
        LAS float* rsT = (LAS float*)((LAS unsigned char*)lds + TAB_OFF);
        for (int ui = 0; ui < 16; ++ui) { pg8::Unit uu; if (!S.next(ui, uu)) break; const int tid = TIDV(); if (tid < 256) rsT[ui * 256 + tid] = RS0[uu.pm * 256 + tid]; }
        __syncthreads();
        pg8::EpiProj E{PROJ, DINP, rsT, LBT, SSQP, M, (LAS float*)((LAS unsigned char*)lds + EPI_OFF)};
        pg8::gemm_phase<pg8::EpiProj, pg8::StaticOrder, true, true>((LAS unsigned char*)lds, g, S, E, g_wv);
    }
    SEAM(1);
    if (IN(2)) REPS(2) {
        pg8::Gemm g{PROJ + C_CQ, WQ, M, 1024, QLORA, DINP}; pg8::StaticOrder S; S.init(M, 1024, G, bx);
        LAS float* rsT = (LAS float*)((LAS unsigned char*)lds + TAB_OFF);
        for (int ui = 0; ui < 4; ++ui) { pg8::Unit uu; if (!S.next(ui, uu)) break;
            const int tid = TIDV(); if (tid < 256) { const int row = uu.pm * 256 + tid; rsT[ui * 256 + tid] = __builtin_amdgcn_rsqf(((SSQP[row] + SSQP[M + row]) + SSQP[2 * (size_t)M + row]) * (1.f / 384.f) + EPS); } }
        __syncthreads();
        pg8::EpiQ E{QB, rsT, GQT, COS, SIN, (LAS float*)((LAS unsigned char*)lds + EPI_OFF)};
        pg8::gemm_phase<pg8::EpiQ, pg8::StaticOrder, true, true>((LAS unsigned char*)lds, g, S, E, g_wv);
    }
    if (IN(3)) REPS(3) {
        pg8::Gemm g{PROJ + C_CKV, WKV, M, NKV, KVLORA, DINP}; pg8::StaticOrder S; S.init(M, NKV, G, bx);
        LAS float* rsT = (LAS float*)((LAS unsigned char*)lds + TAB_OFF + 8192); LAS float* skT = rsT + 1024;
        for (int ui = 0; ui < 4; ++ui) { pg8::Unit uu; if (!S.next(ui, uu)) break;
            const int tid = TIDV(); if (tid < 256) { const int row = uu.pm * 256 + tid; rsT[ui * 256 + tid] = __builtin_amdgcn_rsqf((SSQP[3 * (size_t)M + row] + SSQP[4 * (size_t)M + row]) * (1.f / 256.f) + EPS); skT[ui * 256 + tid] = SSQP[5 * (size_t)M + row]; } }
        __syncthreads();
        pg8::EpiKV E{KB, VB, PROJ, DINP, C_KR, rsT, skT, GKT, COS, SIN, (LAS float*)((LAS unsigned char*)lds + EPI_OFF)};
        pg8::gemm_phase<pg8::EpiKV, pg8::StaticOrder, true, true>((LAS unsigned char*)lds, g, S, E, g_wv);
    }
    SEAM(4);
    if (IN(5)) {
        if (bx < BATCH * 4) hg::hgrn_bh(bx >> 2, bx & 3, PROJ, MIX, (const float*)(ws + WS_GHT) + (bx & 3) * 128, (char*)lds, g_wv);
        { const int a = bx & 127, bhs = (a >> 6) * 8 + (a & 7), qb = (a >> 3) & 7;
          att::attn_chain(QB, KB, VB, MIX, DM, SSQA, bhs, qb, bx < BATCH * 4 ? 7 : 0, bx < BATCH * 4 ? 8 : 7, SEQ, M, (char*)lds, g_wv); }
    }
    SEAM(7);
    if (IN(8)) REPS(8) {
        pg8::Gemm g{MIX, WOUT, M, DM, DM, DM}; pg8::StaticOrder S; S.init(M, DM, G, bx);
        LAS float* rsbT = (LAS float*)((LAS unsigned char*)lds + EPI_OFF + 4096);
        for (int ui = 0; ui < 4; ++ui) { pg8::Unit uu; if (!S.next(ui, uu)) break;
            const int tid = TIDV(); if (tid < 256) { const int row = uu.pm * 256 + tid; rsbT[ui * 256 + tid] = 1.f / sqrtf(((SSQA[row] + SSQA[M + row]) + (SSQA[2 * (size_t)M + row] + SSQA[3 * (size_t)M + row])) * (1.f / 512.f) + EPS); } }
        __syncthreads();
        pg8::EpiResidX1 E{XB, X1B, SSQ1, DM, M, (LAS float*)((LAS unsigned char*)lds + EPI_OFF), rsbT};
        pg8::gemm_phase<pg8::EpiResidX1, pg8::StaticOrder, true, true>((LAS unsigned char*)lds, g, S, E, g_wv);
    }
    SEAM(8);
    if (IN(10)) REPS(10) {
        pg8::Gemm g{X1B, WUP, M, DFF, DM, DM}; pg8::StaticOrder S; S.init(M, DFF, G, bx);
        LAS float* rsT = (LAS float*)((LAS unsigned char*)lds + TAB_OFF);
        for (int ui = 0; ui < 16; ++ui) { pg8::Unit uu; if (!S.next(ui, uu)) break;
            const int tid = TIDV(); if (tid < 256) { const int row = uu.pm * 256 + tid; rsT[ui * 256 + tid] = __builtin_amdgcn_rsqf(((SSQ1[row] + SSQ1[M + row]) + (SSQ1[2 * (size_t)M + row] + SSQ1[3 * (size_t)M + row])) * (1.f / 1024.f) + EPS); } }
        __syncthreads();
        pg8::EpiUp E{HB, DFF, rsT};
        pg8::gemm_phase<pg8::EpiUp, pg8::StaticOrder, true, true>((LAS unsigned char*)lds, g, S, E, g_wv);
    }
    SEAM(10);
    if (IN(11)) {
        pg8::Gemm g{HB, WDN, M, DM, DFF, DFF}; pg8::StaticOrder S; S.init(M, DM, G, bx);
        pg8::EpiResidBf E{X1B, out, DM};
        pg8::gemm_phase<pg8::EpiResidBf, pg8::StaticOrder, true, true>((LAS unsigned char*)lds, g, S, E, g_wv);
    }
#undef IN
}

extern "C" void kernel_launch(void* const* d_in, const int* in_sizes, int n_in, void* d_out, int out_size, void* d_ws, size_t ws_size, hipStream_t stream) {
    static int ok = 0, grid_blocks = 0;
    if (ok == 0) {
        if (n_in != 17 || in_sizes[0] != M * DM || out_size != M * DM || ws_size < WS_END) {
            fprintf(stderr, "kernel_launch: shape mismatch n_in %d in0 %d out %d ws %zu (need %zu)\n", n_in, n_in > 0 ? in_sizes[0] : -1, out_size, ws_size, (size_t)WS_END); ok = -1; return; }
        if (hipFuncSetAttribute((const void*)mk_fwd, hipFuncAttributeMaxDynamicSharedMemorySize, LDS_BYTES) != hipSuccess) { fprintf(stderr, "kernel_launch: hipFuncSetAttribute failed\n"); ok = -1; return; }
        int dev = 0, cus = 0, per_cu = 0;
        (void)hipGetDevice(&dev); (void)hipDeviceGetAttribute(&cus, hipDeviceAttributeMultiprocessorCount, dev);
        (void)hipOccupancyMaxActiveBlocksPerMultiprocessor(&per_cu, (const void*)mk_fwd, NWAVES * 64, LDS_BYTES);
        if (per_cu < 1 || cus < 1) { fprintf(stderr, "kernel_launch: occupancy query gave %d blocks/CU on %d CUs\n", per_cu, cus); ok = -1; return; }
        grid_blocks = cus * (per_cu > 1 ? 1 : per_cu);
        ok = 1;
    }
    if (ok < 0) return;
    (void)hipMemsetAsync((char*)d_ws + WS_CTL, 0, CTL_ZERO_BYTES, stream);
    Args a{};
    for (int i = 0; i < 17; ++i) a.in[i] = (const float*)d_in[i];
    a.out = (float*)d_out; a.ws = (unsigned char*)d_ws;
    a.ph_lo = 0; a.ph_hi = 12;
    void* kargs[] = {&a};
    (void)hipLaunchCooperativeKernel((const void*)mk_fwd, dim3(grid_blocks), dim3(NWAVES * 64), kargs, LDS_BYTES, stream);
    const hipError_t le = hipPeekAtLastError();
    if (le != hipSuccess) fprintf(stderr, "kernel_launch: launch failed: %s\n", hipGetErrorName(le));
}
```

```cpp
#include <hip/hip_runtime.h>
#include <hip/hip_cooperative_groups.h>
#include <cstdio>
#include <cstdint>

#define LAS __attribute__((address_space(3)))
typedef unsigned short bf16_t;
typedef short bf16x8 __attribute__((ext_vector_type(8)));
typedef short s16x4 __attribute__((ext_vector_type(4)));
typedef float f32x4 __attribute__((ext_vector_type(4)));
typedef float f32x16 __attribute__((ext_vector_type(16)));
typedef unsigned u32x4 __attribute__((ext_vector_type(4)));
typedef unsigned u32x2 __attribute__((ext_vector_type(2)));
typedef _Float16 h16x2 __attribute__((ext_vector_type(2)));

constexpr int BATCH = 32, SEQ = 2048, DM = 1024, M = BATCH * SEQ;
constexpr int DIN = 3264, DINP = 3328, DFF = 4096;
constexpr int C_Q = 0, C_FF = 512, C_I = 1536, C_G = 2048, C_CQ = 2560, C_CKV = 2944, C_KR = 3200;
constexpr int QLORA = 384, KVLORA = 256, NQ = 768, NKV = 1024;
constexpr float EPS = 1e-6f;
constexpr float QSCALE = 0.07216878364870322f * 1.4426950408889634f;

constexpr size_t MiB = 1u << 20;
constexpr size_t WS_CTL = 0;
constexpr size_t WS_RS0 = 1 * MiB, WS_RS1 = WS_RS0 + 256 * 1024, WS_LBT = WS_RS1 + 256 * 1024;
constexpr size_t WS_COS = 2 * MiB, WS_SIN = 10 * MiB;
constexpr size_t WS_WIN = 18 * MiB, WS_WQ = 25 * MiB, WS_WKV = 26 * MiB, WS_WOUT = 27 * MiB, WS_WUP = 29 * MiB, WS_WDN = 37 * MiB;
constexpr size_t WS_GQT = WS_LBT + 4096, WS_GKT = WS_GQT + 1024, WS_GHT = WS_GKT + 1024;
constexpr size_t WS_SSQ1 = 45 * MiB;
constexpr size_t WS_XB = 46 * MiB;
constexpr size_t WS_X1B = 718 * MiB;
constexpr size_t WS_PROJ = 174 * MiB;
constexpr size_t WS_HB = 174 * MiB;
constexpr size_t WS_MIX = 590 * MiB;
constexpr size_t WS_Q = 718 * MiB, WS_K = 814 * MiB, WS_V = 910 * MiB;
constexpr size_t WS_SSQP = 974 * MiB;
constexpr size_t WS_SSQA = 976 * MiB;
constexpr size_t WS_END = 977 * MiB;

__device__ __forceinline__ unsigned f2bf(float f) { unsigned u = __builtin_bit_cast(unsigned, f); return (u + 0x7fffu + ((u >> 16) & 1u)) >> 16; }
__device__ __forceinline__ unsigned pk2(float lo, float hi) { return f2bf(lo) | (f2bf(hi) << 16); }
__device__ __forceinline__ float bf2f(unsigned short b) { return __builtin_bit_cast(float, (unsigned)b << 16); }
__device__ __forceinline__ float bflo(unsigned w) { return __builtin_bit_cast(float, w << 16); }
__device__ __forceinline__ float bfhi(unsigned w) { return __builtin_bit_cast(float, w & 0xffff0000u); }
__device__ __forceinline__ float wave_sum(float v) {
#pragma unroll
    for (int o = 1; o < 64; o <<= 1) v += __shfl_xor(v, o);
    return v;
}
__device__ __forceinline__ int lane_id() { int l; asm volatile("v_mbcnt_lo_u32_b32 %0, -1, 0\n\tv_mbcnt_hi_u32_b32 %0, -1, %0" : "=v"(l)); return l; }
__device__ __forceinline__ float dpp_sum8(float v) {
    v += __builtin_bit_cast(float, __builtin_amdgcn_update_dpp(0, __builtin_bit_cast(int, v), 0xB1, 0xF, 0xF, true));
    v += __builtin_bit_cast(float, __builtin_amdgcn_update_dpp(0, __builtin_bit_cast(int, v), 0x4E, 0xF, 0xF, true));
    v += __builtin_bit_cast(float, __builtin_amdgcn_update_dpp(0, __builtin_bit_cast(int, v), 0x141, 0xF, 0xF, true));
    return v;
}
typedef float f32x2_t __attribute__((ext_vector_type(2))); typedef __bf16 bf16x2_t __attribute__((ext_vector_type(2)));
__device__ __forceinline__ unsigned cvtpk(float lo, float hi) { f32x2_t v = {lo, hi}; bf16x2_t b = __builtin_convertvector(v, bf16x2_t); return __builtin_bit_cast(unsigned, b); }
__device__ __forceinline__ unsigned cvt_pk_bf16(float lo, float hi) { unsigned r; asm volatile("v_cvt_pk_bf16_f32 %0, %1, %2" : "=v"(r) : "v"(lo), "v"(hi)); return r; }

namespace pg8 {
#define PG8_LAS __attribute__((address_space(3)))
constexpr int BM = 256, BK = 64, HALF = 128, HTB = HALF * BK * 2, STAGE_BYTES = 8 * HTB, NXCD = 8, WGM = 8;
__host__ __device__ __forceinline__ int lds_byte(int r, int c) { const int st = (r >> 4) * 2 + (c >> 5), rr = r & 15, cc = c & 31, ob = rr * 64 + cc * 2; return st * 1024 + (ob ^ (((ob >> 9) & 1) << 5)); }
__host__ __device__ __forceinline__ void stage_rc(int b, int& R, int& C) { const int st = b / 1024, sb = b % 1024, swz = sb ^ (((sb >> 9) & 1) << 5); R = (st >> 1) * 16 + swz / 64; C = (st & 1) * 32 + (swz % 64) / 2; }
__host__ __device__ __forceinline__ int perm32(int rho) { const int n = rho >> 4, i = rho & 15; return 8 * (i >> 2) + 4 * n + (i & 3); }
struct Unit { int pm, pn; };
struct Gemm { const bf16_t* A; const bf16_t* Bt; int M, N, K, lda; };
struct StaticOrder {
    int nM, nN, nwg, G, c;
    __host__ __device__ __forceinline__ void init(int M_, int N_, int G_, int c_) { nM = M_ / BM; nN = N_ / BM; nwg = nM * nN; G = G_; c = c_; }
    __host__ __device__ __forceinline__ bool next(int i, Unit& u) const {
        const long L = (long)i * G + c; if (L >= nwg) return false;
        int wgid = (int)L; { const int q = nwg / NXCD, r = nwg % NXCD, xcd = wgid % NXCD, off = wgid / NXCD; wgid = (xcd < r ? xcd * (q + 1) : r * (q + 1) + (xcd - r) * q) + off; }
        const int nig = WGM * nN, gid = wgid / nig, fm = gid * WGM, gsz = (nM - fm) < WGM ? (nM - fm) : WGM;
        u.pm = fm + ((wgid % nig) % gsz); u.pn = (wgid % nig) / gsz; return true;
    }
    __device__ __forceinline__ void a_ready(const Unit&) const {}
    __device__ __forceinline__ void done(const Unit&) const {}
};
typedef f32x4 Acc[2][2][4][2];

struct EpiBf16 {
    static constexpr bool PERM = true, AFTER_DRAIN = false; static constexpr int MIDK = 0;
    bf16_t* O; int ldc;
    __device__ __forceinline__ void operator()(const Acc& acc, const Unit& u, int wr, int wc, int fr, int fq, int ui) const {
        const int row0 = u.pm * BM + wr * 64 + fr, col0 = u.pn * BM + wc * 32 + 8 * fq;
#pragma unroll
        for (int ai = 0; ai < 2; ++ai)
#pragma unroll
            for (int m = 0; m < 4; ++m) { bf16_t* rowp = O + (size_t)(row0 + ai * HALF + m * 16) * ldc + col0;
#pragma unroll
                for (int bj = 0; bj < 2; ++bj) { const f32x4 v0 = acc[ai][bj][m][0], v1 = acc[ai][bj][m][1];
                    u32x4 w; w.x = cvt_pk_bf16(v0[0], v0[1]); w.y = cvt_pk_bf16(v0[2], v0[3]); w.z = cvt_pk_bf16(v1[0], v1[1]); w.w = cvt_pk_bf16(v1[2], v1[3]);
                    *(u32x4*)(rowp + bj * HALF) = w; } }
    }
};
struct EpiProj {
    static constexpr bool PERM = true, AFTER_DRAIN = false; static constexpr int MIDK = 0;
    bf16_t* O; int ldc; const PG8_LAS float* rsT; const float* lbt; float* ssqp; int Mrows; PG8_LAS float* red;
    __device__ __forceinline__ void operator()(const Acc& acc, const Unit& u, int wr, int wc, int fr, int fq, int ui) const {
        const int row0 = u.pm * BM + wr * 64 + fr, col0 = u.pn * BM + wc * 32 + 8 * fq;
        const bool gate = (u.pn >= 2 && u.pn < 6), stat = (u.pn >= 10);
        f32x4 lb[2][2];
#pragma unroll
        for (int bj = 0; bj < 2; ++bj)
#pragma unroll
            for (int n = 0; n < 2; ++n) lb[bj][n] = gate ? *(const f32x4*)(lbt + (col0 - 512) + bj * HALF + 4 * n) : (f32x4){0.f, 0.f, 0.f, 0.f};
#pragma unroll
        for (int ai = 0; ai < 2; ++ai)
#pragma unroll
            for (int m = 0; m < 4; ++m) { const int row = row0 + ai * HALF + m * 16; const float r = rsT[ui * BM + ai * HALF + wr * 64 + m * 16 + fr]; bf16_t* rowp = O + (size_t)row * ldc + col0; float sq[2];
#pragma unroll
                for (int bj = 0; bj < 2; ++bj) { f32x4 v0 = acc[ai][bj][m][0] * r, v1 = acc[ai][bj][m][1] * r; u32x4 w;
                    sq[bj] = ((v0[0] * v0[0] + v0[1] * v0[1]) + (v0[2] * v0[2] + v0[3] * v0[3])) + ((v1[0] * v1[0] + v1[1] * v1[1]) + (v1[2] * v1[2] + v1[3] * v1[3]));
                    if (gate) {
#pragma unroll
                        for (int e = 0; e < 4; ++e) { const float s0 = __builtin_amdgcn_rcpf(1.f + __builtin_amdgcn_exp2f(-1.4426950408889634f * v0[e])), s1 = __builtin_amdgcn_rcpf(1.f + __builtin_amdgcn_exp2f(-1.4426950408889634f * v1[e]));
                            v0[e] = __builtin_amdgcn_logf(lb[bj][0][e] + (1.f - lb[bj][0][e]) * s0); v1[e] = __builtin_amdgcn_logf(lb[bj][1][e] + (1.f - lb[bj][1][e]) * s1); }
                        h16x2 a = {(_Float16)v0[0], (_Float16)v0[1]}, b = {(_Float16)v0[2], (_Float16)v0[3]}, c = {(_Float16)v1[0], (_Float16)v1[1]}, d = {(_Float16)v1[2], (_Float16)v1[3]};
                        w.x = __builtin_bit_cast(unsigned, a); w.y = __builtin_bit_cast(unsigned, b); w.z = __builtin_bit_cast(unsigned, c); w.w = __builtin_bit_cast(unsigned, d);
                    } else { w.x = cvt_pk_bf16(v0[0], v0[1]); w.y = cvt_pk_bf16(v0[2], v0[3]); w.z = cvt_pk_bf16(v1[0], v1[1]); w.w = cvt_pk_bf16(v1[2], v1[3]); }
                    *(u32x4*)(rowp + bj * HALF) = w; }
                if (stat) { sq[0] += __shfl_xor(sq[0], 16); sq[0] += __shfl_xor(sq[0], 32); sq[1] += __shfl_xor(sq[1], 16); sq[1] += __shfl_xor(sq[1], 32);
                    if (fq == 0) { PG8_LAS float* rp = red + (ai * HALF + wr * 64 + m * 16 + fr) * 8 + wc * 2; rp[0] = sq[0]; rp[1] = sq[1]; } } }
        if (stat) {
            asm volatile("s_waitcnt lgkmcnt(0)" ::: "memory"); __builtin_amdgcn_s_barrier(); asm volatile("" ::: "memory");
            const int t = (wr * 4 + wc) * 64 + fq * 16 + fr;
            if (t < 256) { const f32x4 q0 = *(const PG8_LAS f32x4*)(red + t * 8), q1 = *(const PG8_LAS f32x4*)(red + t * 8 + 4);
                float* dst = ssqp + (size_t)((u.pn - 10) * 2) * Mrows + u.pm * BM + t; dst[0] = (q0[0] + q0[2]) + (q1[0] + q1[2]); dst[Mrows] = (q0[1] + q0[3]) + (q1[1] + q1[3]); }
            asm volatile("s_waitcnt lgkmcnt(0)" ::: "memory"); __builtin_amdgcn_s_barrier(); asm volatile("" ::: "memory");
        }
    }
};
struct EpiQ {
    static constexpr bool PERM = true, AFTER_DRAIN = false; static constexpr int MIDK = 0;
    bf16_t* Q; const PG8_LAS float* rsT; const float* gq; const float* cosT; const float* sinT; PG8_LAS float* red;
    __device__ __forceinline__ void operator()(const Acc& acc, const Unit& u, int wr, int wc, int fr, int fq, int ui) const {
        const int h = u.pn, cl = wc * 32 + 8 * fq, ic = 4 * wc + fq;
        f32x4 cs[2][4], sn[2][4];
        if (wc < 2) {
#pragma unroll
            for (int ai = 0; ai < 2; ++ai)
#pragma unroll
                for (int m = 0; m < 4; ++m) { const size_t row = (size_t)(u.pm * BM + ai * HALF + wr * 64 + m * 16 + fr);
                    cs[ai][m] = *(const f32x4*)(cosT + row * 32 + 4 * ic); sn[ai][m] = *(const f32x4*)(sinT + row * 32 + 4 * ic); }
        }
        const f32x4 g00 = *(const f32x4*)(gq + cl), g01 = *(const f32x4*)(gq + cl + 4), g10 = *(const f32x4*)(gq + 128 + cl), g11 = *(const f32x4*)(gq + 128 + cl + 4);
#pragma unroll
        for (int ai = 0; ai < 2; ++ai)
#pragma unroll
            for (int m = 0; m < 4; ++m) { float s = 0.f;
#pragma unroll
                for (int bj = 0; bj < 2; ++bj)
#pragma unroll
                    for (int n = 0; n < 2; ++n) { const f32x4 v = acc[ai][bj][m][n]; s += (v[0] * v[0] + v[1] * v[1]) + (v[2] * v[2] + v[3] * v[3]); }
                s += __shfl_xor(s, 16); s += __shfl_xor(s, 32);
                if (fq == 0) red[(ai * HALF + wr * 64 + m * 16 + fr) * 4 + wc] = s; }
        asm volatile("s_waitcnt lgkmcnt(0)" ::: "memory"); __builtin_amdgcn_s_barrier(); asm volatile("" ::: "memory");
#pragma unroll
        for (int ai = 0; ai < 2; ++ai)
#pragma unroll
            for (int m = 0; m < 4; ++m) { const int rowl = ai * HALF + wr * 64 + m * 16 + fr, row = u.pm * BM + rowl;
                const f32x4 q4 = *(const PG8_LAS f32x4*)(red + rowl * 4); const float ssx = (q4[0] + q4[1]) + (q4[2] + q4[3]);
                const float rs = rsT[ui * BM + rowl];
                const float sc = rs * __builtin_amdgcn_rsqf(rs * rs * ssx * (1.f / 192.f) + 1e-6f);
                bf16_t* dst = Q + ((size_t)((row >> 11) * 4 + h) * 2048 + (row & 2047)) * 192 + cl;
                { const f32x4 v0 = acc[ai][0][m][0] * sc * g00, v1 = acc[ai][0][m][1] * sc * g01; u32x4 w; w.x = cvt_pk_bf16(v0[0], v0[1]); w.y = cvt_pk_bf16(v0[2], v0[3]); w.z = cvt_pk_bf16(v1[0], v1[1]); w.w = cvt_pk_bf16(v1[2], v1[3]); *(u32x4*)dst = w; }
                if (wc < 2) { const f32x4 t1 = acc[ai][1][m][0] * sc * g10, t2 = acc[ai][1][m][1] * sc * g11;
                    const f32x4 o1 = t1 * cs[ai][m] - t2 * sn[ai][m], o2 = t2 * cs[ai][m] + t1 * sn[ai][m];
                    u32x4 w; w.x = cvt_pk_bf16(o1[0], o1[1]); w.y = cvt_pk_bf16(o1[2], o1[3]); w.z = cvt_pk_bf16(o2[0], o2[1]); w.w = cvt_pk_bf16(o2[2], o2[3]); *(u32x4*)(dst + 128) = w; } }
    }
};
struct EpiKV {
    static constexpr bool PERM = true, AFTER_DRAIN = false; static constexpr int MIDK = 0;
    bf16_t* K; bf16_t* V; const bf16_t* proj; int ldp; int ckr; const PG8_LAS float* rsT; const PG8_LAS float* skT; const float* gk; const float* cosT; const float* sinT; PG8_LAS float* red;
    __device__ __forceinline__ void operator()(const Acc& acc, const Unit& u, int wr, int wc, int fr, int fq, int ui) const {
        const int h = u.pn, cl = wc * 32 + 8 * fq, ic = 4 * wc + fq;
#pragma unroll
        for (int ai = 0; ai < 2; ++ai)
#pragma unroll
            for (int m = 0; m < 4; ++m) { float s = 0.f;
#pragma unroll
                for (int n = 0; n < 2; ++n) { const f32x4 v = acc[ai][0][m][n]; s += (v[0] * v[0] + v[1] * v[1]) + (v[2] * v[2] + v[3] * v[3]); }
                s += __shfl_xor(s, 16); s += __shfl_xor(s, 32);
                if (fq == 0) red[(ai * HALF + wr * 64 + m * 16 + fr) * 4 + wc] = s; }
        const f32x4 g0 = *(const f32x4*)(gk + cl), g1 = *(const f32x4*)(gk + cl + 4);
        f32x4 gr0 = {0.f, 0.f, 0.f, 0.f}, gr1 = {0.f, 0.f, 0.f, 0.f};
        if (wc < 2) { gr0 = *(const f32x4*)(gk + 128 + 8 * ic); gr1 = *(const f32x4*)(gk + 128 + 8 * ic + 4); }
        asm volatile("s_waitcnt lgkmcnt(0)" ::: "memory"); __builtin_amdgcn_s_barrier(); asm volatile("" ::: "memory");
#pragma unroll
        for (int ai = 0; ai < 2; ++ai) {
            u32x4 kr[4]; f32x4 cs[4], sn[4];
            if (wc < 2) {
#pragma unroll
                for (int m = 0; m < 4; ++m) { const size_t row = (size_t)(u.pm * BM + ai * HALF + wr * 64 + m * 16 + fr);
                    kr[m] = *(const u32x4*)(proj + row * ldp + ckr + 8 * ic); cs[m] = *(const f32x4*)(cosT + row * 32 + 4 * ic); sn[m] = *(const f32x4*)(sinT + row * 32 + 4 * ic); }
            }
#pragma unroll
            for (int m = 0; m < 4; ++m) { const int rowl = ai * HALF + wr * 64 + m * 16 + fr, row = u.pm * BM + rowl;
                const f32x4 q4 = *(const PG8_LAS f32x4*)(red + rowl * 4); const float ssk = (q4[0] + q4[1]) + (q4[2] + q4[3]);
                const float rsc = rsT[ui * BM + rowl], skr = skT[ui * BM + rowl];
                const float r = __builtin_amdgcn_rsqf((rsc * rsc * ssk + skr) * (1.f / 192.f) + 1e-6f);
                const size_t tok = (size_t)((row >> 11) * 4 + h) * 2048 + (row & 2047);
                bf16_t* kd = K + tok * 192; bf16_t* vd = V + tok * 128;
                { const float sc = rsc * r; const f32x4 v0 = acc[ai][0][m][0] * sc * g0, v1 = acc[ai][0][m][1] * sc * g1; u32x4 w; w.x = cvt_pk_bf16(v0[0], v0[1]); w.y = cvt_pk_bf16(v0[2], v0[3]); w.z = cvt_pk_bf16(v1[0], v1[1]); w.w = cvt_pk_bf16(v1[2], v1[3]); *(u32x4*)(kd + cl) = w; }
                { const f32x4 v0 = acc[ai][1][m][0] * rsc, v1 = acc[ai][1][m][1] * rsc; u32x4 w; w.x = cvt_pk_bf16(v0[0], v0[1]); w.y = cvt_pk_bf16(v0[2], v0[3]); w.z = cvt_pk_bf16(v1[0], v1[1]); w.w = cvt_pk_bf16(v1[2], v1[3]); *(u32x4*)(vd + cl) = w; }
                if (wc < 2) { const f32x4 t1 = (f32x4){bflo(kr[m].x), bfhi(kr[m].x), bflo(kr[m].y), bfhi(kr[m].y)} * gr0 * r, t2 = (f32x4){bflo(kr[m].z), bfhi(kr[m].z), bflo(kr[m].w), bfhi(kr[m].w)} * gr1 * r;
                    const f32x4 o1 = t1 * cs[m] - t2 * sn[m], o2 = t2 * cs[m] + t1 * sn[m];
                    u32x4 w; w.x = cvt_pk_bf16(o1[0], o1[1]); w.y = cvt_pk_bf16(o1[2], o1[3]); w.z = cvt_pk_bf16(o2[0], o2[1]); w.w = cvt_pk_bf16(o2[2], o2[3]); *(u32x4*)(kd + 128 + 8 * ic) = w; } }
        }
    }
};
struct EpiUp {
    static constexpr bool PERM = true, AFTER_DRAIN = false; static constexpr int MIDK = 0;
    bf16_t* O; int ldc; const PG8_LAS float* rsT;
    __device__ __forceinline__ void operator()(const Acc& acc, const Unit& u, int wr, int wc, int fr, int fq, int ui) const {
        const int row0 = u.pm * BM + wr * 64 + fr, col0 = u.pn * BM + wc * 32 + 8 * fq;
#pragma unroll
        for (int ai = 0; ai < 2; ++ai)
#pragma unroll
            for (int m = 0; m < 4; ++m) { const int row = row0 + ai * HALF + m * 16; const float r = rsT[ui * BM + ai * HALF + wr * 64 + m * 16 + fr]; bf16_t* rowp = O + (size_t)row * ldc + col0;
#pragma unroll
                for (int bj = 0; bj < 2; ++bj) { f32x4 v0 = acc[ai][bj][m][0] * r, v1 = acc[ai][bj][m][1] * r;
#pragma unroll
                    for (int e = 0; e < 4; ++e) { const float a = fmaxf(v0[e], 0.f), b = fmaxf(v1[e], 0.f); v0[e] = a * a; v1[e] = b * b; }
                    u32x4 w; w.x = cvt_pk_bf16(v0[0], v0[1]); w.y = cvt_pk_bf16(v0[2], v0[3]); w.z = cvt_pk_bf16(v1[0], v1[1]); w.w = cvt_pk_bf16(v1[2], v1[3]);
                    *(u32x4*)(rowp + bj * HALF) = w; } }
    }
};
struct EpiResid {
    static constexpr bool PERM = false, AFTER_DRAIN = false; static constexpr int MIDK = 0;
    const float* base; float* out; int ldc;
    __device__ __forceinline__ void operator()(const Acc& acc, const Unit& u, int wr, int wc, int fr, int fq, int ui) const {
        const int row0 = u.pm * BM + wr * 64 + fr, col0 = u.pn * BM + wc * 32 + 4 * fq;
#pragma unroll
        for (int ai = 0; ai < 2; ++ai)
#pragma unroll
            for (int m = 0; m < 4; ++m) { const size_t off = (size_t)(row0 + ai * HALF + m * 16) * ldc + col0;
#pragma unroll
                for (int bj = 0; bj < 2; ++bj)
#pragma unroll
                    for (int n = 0; n < 2; ++n) { const f32x4 bs = *(const f32x4*)(base + off + bj * HALF + n * 16); *(f32x4*)(out + off + bj * HALF + n * 16) = bs + acc[ai][bj][m][n]; } }
    }
};

struct EpiResidBf {
    static constexpr bool PERM = false, AFTER_DRAIN = false; static constexpr int MIDK = 0;
    const bf16_t* xb; float* out; int ldc;
    __device__ __forceinline__ void operator()(const Acc& acc, const Unit& u, int wr, int wc, int fr, int fq, int ui) const {
        const int row0 = u.pm * BM + wr * 64 + fr, col0 = u.pn * BM + wc * 32 + 4 * fq;
        u32x2 w[2][4][2][2];
#pragma unroll
        for (int ai = 0; ai < 2; ++ai)
#pragma unroll
            for (int m = 0; m < 4; ++m) { const size_t off = (size_t)(row0 + ai * HALF + m * 16) * ldc + col0;
#pragma unroll
                for (int bj = 0; bj < 2; ++bj)
#pragma unroll
                    for (int n = 0; n < 2; ++n) w[ai][m][bj][n] = *(const u32x2*)(xb + off + bj * HALF + n * 16); }
        __builtin_amdgcn_sched_barrier(0);
#pragma unroll
        for (int ai = 0; ai < 2; ++ai) {
#pragma unroll
            for (int m = 0; m < 4; ++m) { const size_t off = (size_t)(row0 + ai * HALF + m * 16) * ldc + col0;
#pragma unroll
                for (int bj = 0; bj < 2; ++bj)
#pragma unroll
                    for (int n = 0; n < 2; ++n) { const u32x2 ww = w[ai][m][bj][n]; const f32x4 bs = {bflo(ww.x), bfhi(ww.x), bflo(ww.y), bfhi(ww.y)}; *(f32x4*)(out + off + bj * HALF + n * 16) = bs + acc[ai][bj][m][n]; } }
        }
    }
};
struct EpiResidX1 {
    static constexpr bool PERM = false, AFTER_DRAIN = false; static constexpr int MIDK = 8;
    const bf16_t* base; bf16_t* xb; float* ssq; int ldc; int Mrows; PG8_LAS float* red; const PG8_LAS float* rsb;
    __device__ __forceinline__ void mid(Acc& acc, int ui, int wr, int fr) const {
#pragma unroll
        for (int ai = 0; ai < 2; ++ai)
#pragma unroll
            for (int m = 0; m < 4; ++m) { const float r = rsb[ui * BM + ai * HALF + wr * 64 + m * 16 + fr];
#pragma unroll
                for (int bj = 0; bj < 2; ++bj)
#pragma unroll
                    for (int n = 0; n < 2; ++n) acc[ai][bj][m][n] *= r; }
    }
    __device__ __forceinline__ void operator()(const Acc& acc, const Unit& u, int wr, int wc, int fr, int fq, int ui) const {
        const int row0 = u.pm * BM + wr * 64 + fr, col0 = u.pn * BM + wc * 32 + 4 * fq;
        u32x2 xr[2][4][2][2];
#pragma unroll
        for (int ai = 0; ai < 2; ++ai)
#pragma unroll
            for (int m = 0; m < 4; ++m) { const size_t off = (size_t)(row0 + ai * HALF + m * 16) * ldc + col0;
#pragma unroll
                for (int bj = 0; bj < 2; ++bj)
#pragma unroll
                    for (int n = 0; n < 2; ++n) xr[ai][m][bj][n] = *(const u32x2*)(base + off + bj * HALF + n * 16); }
        __builtin_amdgcn_sched_barrier(0);
#pragma unroll
        for (int ai = 0; ai < 2; ++ai) {
#pragma unroll
            for (int m = 0; m < 4; ++m) { const size_t off = (size_t)(row0 + ai * HALF + m * 16) * ldc + col0; float s = 0.f;
#pragma unroll
                for (int bj = 0; bj < 2; ++bj)
#pragma unroll
                    for (int n = 0; n < 2; ++n) { const u32x2 xw = xr[ai][m][bj][n]; const f32x4 v = (f32x4){bflo(xw.x), bfhi(xw.x), bflo(xw.y), bfhi(xw.y)} + acc[ai][bj][m][n];
                        u32x2 w; w.x = cvt_pk_bf16(v[0], v[1]); w.y = cvt_pk_bf16(v[2], v[3]); *(u32x2*)(xb + off + bj * HALF + n * 16) = w;
                        s += (v[0] * v[0] + v[1] * v[1]) + (v[2] * v[2] + v[3] * v[3]); }
                s += __shfl_xor(s, 16); s += __shfl_xor(s, 32);
                if (fq == 0) red[(ai * HALF + wr * 64 + m * 16 + fr) * 4 + wc] = s; }
        }
        asm volatile("s_waitcnt lgkmcnt(0)" ::: "memory"); __builtin_amdgcn_s_barrier(); asm volatile("" ::: "memory");
        const int t = (wr * 4 + wc) * 64 + fq * 16 + fr;
        if (t < 256) { const f32x4 q = *(const PG8_LAS f32x4*)(red + t * 4); ssq[(size_t)u.pn * Mrows + u.pm * BM + t] = (q[0] + q[1]) + (q[2] + q[3]); }
        asm volatile("s_waitcnt lgkmcnt(0)" ::: "memory"); __builtin_amdgcn_s_barrier(); asm volatile("" ::: "memory");
    }
};
template <class Epi, class Sched, bool ALIGN_EPI = false, bool SP2 = false>
__device__ __forceinline__ void gemm_phase(PG8_LAS unsigned char* lds, const Gemm g, const Sched& S, const Epi& E, int wv) {
    int lane = lane_id(); asm volatile("" : "+v"(lane));
    const int wid = wv, tid = wv * 64 + lane, wr = wid >> 2, wc = wid & 3, fr = lane & 15, fq = lane >> 4;
    const int K = g.K, nt = K / BK, lda = g.lda;
    unsigned voffA[2], voffB[2];
#pragma unroll
    for (int i = 0; i < 2; ++i) { int R, C; stage_rc(tid * 16 + i * 8192, R, C); const int Rb = Epi::PERM ? ((R & ~31) + perm32(R & 31)) : R;
        voffA[i] = (unsigned)(R * lda + C) * 2u; voffB[i] = (unsigned)(Rb * K + C) * 2u; }
    const size_t kstep = (size_t)(BK * 2);
    const size_t hstepA = (size_t)HALF * lda * 2, hstepB = (size_t)HALF * K * 2;
    const size_t tstepA = 2 * hstepA, tstepB = 2 * hstepB;
    const unsigned ldsw = (unsigned)wid * 1024u;
    const int aoff = lds_byte(wr * 64 + fr, fq * 8), boff = lds_byte(wc * 32 + fr, fq * 8);
#define PG8_SA(b, h) (((b) * 2 + (h)) * HTB)
#define PG8_SB(b, h) ((4 + (b) * 2 + (h)) * HTB)
#define PG8_STAGE(bufoff, gbase, voff) do { _Pragma("unroll") for (int _i = 0; _i < 2; ++_i) \
        __builtin_amdgcn_global_load_lds((const unsigned*)((const char*)(gbase) + (voff)[_i]), (PG8_LAS unsigned*)(lds + (bufoff) + ldsw + _i * 8192), 16, 0, 0); } while (0)
#define PG8_LDA(dst, b, h) do { _Pragma("unroll") for (int m = 0; m < 4; ++m) _Pragma("unroll") for (int k = 0; k < 2; ++k) dst[m][k] = *(const PG8_LAS bf16x8*)(lds + PG8_SA(b, h) + aoff + m * 2048 + k * 1024); } while (0)
#define PG8_LDB(dst, b, h) do { _Pragma("unroll") for (int n = 0; n < 2; ++n) _Pragma("unroll") for (int k = 0; k < 2; ++k) dst[n][k] = *(const PG8_LAS bf16x8*)(lds + PG8_SB(b, h) + boff + n * 2048 + k * 1024); } while (0)
#define PG8_MMA(ai, bj, At, Bt) do { __builtin_amdgcn_s_setprio(1); _Pragma("unroll") for (int m = 0; m < 4; ++m) _Pragma("unroll") for (int n = 0; n < 2; ++n) _Pragma("unroll") for (int k = 0; k < 2; ++k) \
        acc[ai][bj][m][n] = __builtin_amdgcn_mfma_f32_16x16x32_bf16(Bt[n][k], At[m][k], acc[ai][bj][m][n], 0, 0, 0); __builtin_amdgcn_s_setprio(0); } while (0)
#define PG8_WAIT_V(n) asm volatile("s_waitcnt vmcnt(" #n ")" ::: "memory")
#define PG8_WAIT_L(n) asm volatile("s_waitcnt lgkmcnt(" #n ")" ::: "memory")
#define PG8_BAR __builtin_amdgcn_s_barrier()
#define PG8_SCHED __builtin_amdgcn_sched_barrier(0)
    Unit cur, nxt; int ui = 0;
    if (!S.next(0, cur)) return;
    Acc acc;
#pragma unroll
    for (int a = 0; a < 2; ++a)
#pragma unroll
        for (int b = 0; b < 2; ++b)
#pragma unroll
            for (int m = 0; m < 4; ++m)
#pragma unroll
                for (int n = 0; n < 2; ++n) acc[a][b][m][n] = (f32x4){0.f, 0.f, 0.f, 0.f};
    bf16x8 At[4][2], B0[2][2], B1[2][2];
    const char* cA = (const char*)g.A + (size_t)cur.pm * tstepA; const char* cB = (const char*)g.Bt + (size_t)cur.pn * tstepB;
    S.a_ready(cur);
    if constexpr (SP2) {
        PG8_STAGE(PG8_SB(0, 0), cB, voffB); PG8_STAGE(PG8_SB(0, 1), cB + hstepB, voffB); PG8_STAGE(PG8_SA(0, 0), cA, voffA); PG8_STAGE(PG8_SA(0, 1), cA + hstepA, voffA);
        if (wr == 1) PG8_BAR;
        PG8_WAIT_V(2); PG8_BAR;
        PG8_STAGE(PG8_SB(1, 0), cB + kstep, voffB); PG8_STAGE(PG8_SA(1, 0), cA + kstep, voffA); PG8_STAGE(PG8_SB(1, 1), cB + hstepB + kstep, voffB);
        PG8_WAIT_V(6); PG8_BAR;
    } else {
        PG8_STAGE(PG8_SB(0, 0), cB, voffB); PG8_STAGE(PG8_SA(0, 0), cA, voffA); PG8_STAGE(PG8_SB(0, 1), cB + hstepB, voffB); PG8_STAGE(PG8_SA(0, 1), cA + hstepA, voffA);
        if (wr == 1) PG8_BAR;
        PG8_WAIT_V(4); PG8_BAR;
        PG8_STAGE(PG8_SB(1, 0), cB + kstep, voffB); PG8_STAGE(PG8_SA(1, 0), cA + kstep, voffA); PG8_STAGE(PG8_SB(1, 1), cB + hstepB + kstep, voffB);
        PG8_WAIT_V(6); PG8_BAR;
    }
    for (;;) {
        const bool has_next = S.next(ui + 1, nxt);
        const char* nA = has_next ? (const char*)g.A + (size_t)nxt.pm * tstepA : cA; const char* nB = has_next ? (const char*)g.Bt + (size_t)nxt.pn * tstepB : cB;
#pragma nounroll
        for (int t = 0; t < nt; t += 2) {
            const bool last = (t == nt - 2);
            const char* a1 = cA + (size_t)(t + 1) * kstep;
            const char* a2 = last ? nA : cA + (size_t)(t + 2) * kstep; const char* b2 = last ? nB : cB + (size_t)(t + 2) * kstep;
            const char* a3 = a2 + kstep; const char* b3 = b2 + kstep;
            if (last && has_next) S.a_ready(nxt);
            if constexpr (SP2) {
            PG8_LDB(B0, 0, 0); PG8_LDB(B1, 0, 1); PG8_SCHED; PG8_LDA(At, 0, 0); PG8_STAGE(PG8_SA(1, 1), a1 + hstepA, voffA);
            PG8_WAIT_V(8); PG8_WAIT_L(0); PG8_BAR; PG8_MMA(0, 0, At, B0); PG8_MMA(0, 1, At, B1); PG8_BAR; PG8_SCHED;
            PG8_LDA(At, 0, 1); PG8_STAGE(PG8_SB(0, 0), b2, voffB); PG8_STAGE(PG8_SB(0, 1), b2 + hstepB, voffB); PG8_STAGE(PG8_SA(0, 0), a2, voffA);
            PG8_WAIT_V(8); PG8_WAIT_L(0); PG8_BAR; PG8_MMA(1, 0, At, B0); PG8_MMA(1, 1, At, B1); PG8_BAR; PG8_SCHED;
            PG8_LDB(B0, 1, 0); PG8_LDB(B1, 1, 1); PG8_SCHED; PG8_LDA(At, 1, 0); PG8_STAGE(PG8_SA(0, 1), a2 + hstepA, voffA);
            PG8_WAIT_V(8); PG8_WAIT_L(0); PG8_BAR; PG8_MMA(0, 0, At, B0); PG8_MMA(0, 1, At, B1); PG8_BAR; PG8_SCHED;
            PG8_LDA(At, 1, 1); PG8_STAGE(PG8_SB(1, 0), b3, voffB); PG8_STAGE(PG8_SB(1, 1), b3 + hstepB, voffB); PG8_STAGE(PG8_SA(1, 0), a3, voffA);
            PG8_WAIT_V(8); PG8_WAIT_L(0); PG8_BAR; PG8_MMA(1, 0, At, B0); PG8_MMA(1, 1, At, B1); PG8_BAR; PG8_SCHED;
            if constexpr (Epi::MIDK > 0) { if (t + 2 == Epi::MIDK) { E.mid(acc, ui, wr, fr); PG8_SCHED; } }
            } else {
            PG8_LDB(B0, 0, 0); PG8_SCHED; PG8_LDA(At, 0, 0); PG8_STAGE(PG8_SA(1, 1), a1 + hstepA, voffA);
            PG8_WAIT_L(8); PG8_BAR; PG8_WAIT_L(0); PG8_MMA(0, 0, At, B0); PG8_BAR; PG8_SCHED;
            PG8_LDB(B1, 0, 1); PG8_STAGE(PG8_SB(0, 0), b2, voffB);
            PG8_BAR; PG8_WAIT_L(0); PG8_MMA(0, 1, At, B1); PG8_BAR;
            PG8_LDA(At, 0, 1); PG8_STAGE(PG8_SA(0, 0), a2, voffA);
            PG8_BAR; PG8_WAIT_L(0); PG8_MMA(1, 0, At, B0); PG8_BAR; PG8_SCHED;
            PG8_STAGE(PG8_SB(0, 1), b2 + hstepB, voffB);
            PG8_WAIT_V(6); PG8_BAR; PG8_MMA(1, 1, At, B1); PG8_BAR;
            PG8_LDB(B0, 1, 0); PG8_SCHED; PG8_LDA(At, 1, 0); PG8_STAGE(PG8_SA(0, 1), a2 + hstepA, voffA);
            PG8_WAIT_L(8); PG8_BAR; PG8_WAIT_L(0); PG8_MMA(0, 0, At, B0); PG8_BAR; PG8_SCHED;
            PG8_LDB(B1, 1, 1); PG8_STAGE(PG8_SB(1, 0), b3, voffB);
            PG8_BAR; PG8_WAIT_L(0); PG8_MMA(0, 1, At, B1); PG8_BAR;
            PG8_LDA(At, 1, 1); PG8_STAGE(PG8_SA(1, 0), a3, voffA);
            PG8_BAR; PG8_WAIT_L(0); PG8_MMA(1, 0, At, B0); PG8_BAR; PG8_SCHED;
            PG8_STAGE(PG8_SB(1, 1), b3 + hstepB, voffB);
            PG8_WAIT_V(6); PG8_BAR; PG8_MMA(1, 1, At, B1); PG8_BAR;
            }
        }
        if constexpr (ALIGN_EPI) { if (wr == 0) PG8_BAR; }
        if constexpr (!Epi::AFTER_DRAIN) { E(acc, cur, wr, wc, fr, fq, ui); S.done(cur); }
        if (!has_next) break;
#pragma unroll
        for (int a = 0; a < 2; ++a)
#pragma unroll
            for (int b = 0; b < 2; ++b)
#pragma unroll
                for (int m = 0; m < 4; ++m)
#pragma unroll
                    for (int n = 0; n < 2; ++n) acc[a][b][m][n] = (f32x4){0.f, 0.f, 0.f, 0.f};
        cur = nxt; cA = nA; cB = nB; ++ui;
        if constexpr (ALIGN_EPI) { if (wr == 1) PG8_BAR; }
    }
    PG8_WAIT_V(0);
    if constexpr (!ALIGN_EPI) { if (wr == 0) PG8_BAR; }
    PG8_BAR;
#undef PG8_SA
#undef PG8_SB
#undef PG8_STAGE
#undef PG8_LDA
#undef PG8_LDB
#undef PG8_MMA
#undef PG8_WAIT_V
#undef PG8_WAIT_L
#undef PG8_BAR
#undef PG8_SCHED
}
}

namespace att {
constexpr int DQK = 192, DV = 128, NW = 8, QBLK = 32, KVBLK = 64;
constexpr int SHM_V = KVBLK * DV * 2, SHM_K = KVBLK * DQK * 2, SHM_ATTN = 2 * SHM_V + 2 * SHM_K + NW * 64 * 4;
constexpr float THRL = 11.5f;
#define KSWZ(row, colB) ((row) * 384 + ((colB) ^ ((((row) >> 1) & 7) << 4)))
#define SBAR() __builtin_amdgcn_sched_barrier(0)
__device__ __forceinline__ int crow(int r, int hi) { return (r & 3) + 8 * (r >> 2) + 4 * hi; }
__device__ __forceinline__ void partialSM(f32x16& p0, f32x16& p1, float& m_reg, float& mn, float& alpha) {
    float pmax = p0[0];
#pragma unroll
    for (int r = 1; r < 16; ++r) pmax = fmaxf(pmax, p0[r]);
#pragma unroll
    for (int r = 0; r < 16; ++r) pmax = fmaxf(pmax, p1[r]);
    { auto rr = __builtin_amdgcn_permlane32_swap(__float_as_uint(pmax), __float_as_uint(pmax), false, false);
      pmax = fmaxf(__uint_as_float(rr[0]), __uint_as_float(rr[1])); }
    if (__builtin_expect(__all(pmax - m_reg <= THRL), 1)) { mn = m_reg; alpha = 1.f; }
    else { mn = fmaxf(m_reg, pmax); alpha = __builtin_amdgcn_exp2f(m_reg - mn); m_reg = mn; }
#pragma unroll
    for (int r = 0; r < 16; ++r) p0[r] = p0[r] - mn;
#pragma unroll
    for (int r = 0; r < 16; ++r) p1[r] = p1[r] - mn;
#pragma unroll
    for (int r = 0; r < 16; ++r) p0[r] = __builtin_amdgcn_exp2f(p0[r]);
}
__device__ __forceinline__ void finishSM(f32x16& p0, f32x16& p1, float alpha, float& l_reg, bf16x8& pa0, bf16x8& pa1, bf16x8& pa2, bf16x8& pa3) {
#pragma unroll
    for (int r = 0; r < 16; ++r) p1[r] = __builtin_amdgcn_exp2f(p1[r]);
    float ps = 0;
#pragma unroll
    for (int r = 0; r < 16; ++r) ps += p0[r];
#pragma unroll
    for (int r = 0; r < 16; ++r) ps += p1[r];
    { auto rr = __builtin_amdgcn_permlane32_swap(__float_as_uint(ps), __float_as_uint(ps), false, false);
      ps = __uint_as_float(rr[0]) + __uint_as_float(rr[1]); }
    l_reg = l_reg * alpha + ps;
#define PK4(P, BASE, OUT) do { unsigned a0 = cvt_pk_bf16(P[BASE + 0], P[BASE + 1]), a1 = cvt_pk_bf16(P[BASE + 2], P[BASE + 3]);   \
    unsigned b0 = cvt_pk_bf16(P[BASE + 4], P[BASE + 5]), b1 = cvt_pk_bf16(P[BASE + 6], P[BASE + 7]);                              \
    auto r0 = __builtin_amdgcn_permlane32_swap(a0, b0, false, false); auto r1 = __builtin_amdgcn_permlane32_swap(a1, b1, false, false); \
    u32x4 w = {r0[0], r1[0], r0[1], r1[1]}; OUT = __builtin_bit_cast(bf16x8, w); } while (0)
    PK4(p0, 0, pa0); PK4(p0, 8, pa1); PK4(p1, 0, pa2); PK4(p1, 8, pa3);
#undef PK4
}
__device__ __forceinline__ void qkt(f32x16& p0, f32x16& p1, const char* Ks, const bf16x8* qr, int r32, int hi) {
    p0 = f32x16{}; p1 = f32x16{};
    const char* k0p = Ks + KSWZ(r32, 0); const char* k1p = Ks + KSWZ(32 + r32, 0);
    const int key = ((r32 >> 1) & 7) << 4;
    bf16x8 ka[2], kb[2];
#define KRD(d0, slot) do { const int cb_ = (((d0) * 16 + hi * 8) * 2) ^ key; ka[slot] = *reinterpret_cast<const bf16x8*>(k0p + cb_); kb[slot] = *reinterpret_cast<const bf16x8*>(k1p + cb_); } while (0)
    KRD(0, 0); KRD(1, 1);
#pragma unroll
    for (int d0 = 0; d0 < 12; ++d0) {
        const bf16x8 a = ka[d0 & 1], b = kb[d0 & 1];
        p0 = __builtin_amdgcn_mfma_f32_32x32x16_bf16(a, qr[d0], p0, 0, 0, 0);
        p1 = __builtin_amdgcn_mfma_f32_32x32x16_bf16(b, qr[d0], p1, 0, 0, 0);
        if (d0 + 2 < 12) KRD(d0 + 2, d0 & 1);
    }
#undef KRD
}
__device__ __forceinline__ int v_st(int k, int c) { const int kk = (k & ~0xC) | ((k & 4) << 1) | ((k & 8) >> 1); return ((kk >> 3) * 4 + (c >> 5)) * 512 + ((kk & 7) * 32 + (c & 31)) * 2; }
__device__ __forceinline__ int v_rd_base(int lane) { return ((lane & 3) << 3) | (((lane >> 2) & 3) << 6) | (((lane >> 4) & 1) << 5) | (((lane >> 5) & 1) << 8); }
constexpr int v_rd_off(int d0, int ks, int half) { return d0 * 512 + ks * 4096 + half * 2048; }
template <int OFF> __device__ __forceinline__ s16x4 tr_read(int vb) {
    s16x4 r; asm volatile("ds_read_b64_tr_b16 %0, %1 offset:%2" : "=&v"(r) : "v"(vb), "i"(OFF) : "memory"); return r;
}
#define PKLH(L, H) (bf16x8){L[0], L[1], L[2], L[3], H[0], H[1], H[2], H[3]}
template <int D0> __device__ __forceinline__ void pv_one(f32x16& od, int vb, bf16x8 pa0, bf16x8 pa1, bf16x8 pa2, bf16x8 pa3) {
    const s16x4 l0 = tr_read<v_rd_off(D0, 0, 0)>(vb), h0 = tr_read<v_rd_off(D0, 0, 1)>(vb), l1 = tr_read<v_rd_off(D0, 1, 0)>(vb), h1 = tr_read<v_rd_off(D0, 1, 1)>(vb);
    const s16x4 l2 = tr_read<v_rd_off(D0, 2, 0)>(vb), h2 = tr_read<v_rd_off(D0, 2, 1)>(vb), l3 = tr_read<v_rd_off(D0, 3, 0)>(vb), h3 = tr_read<v_rd_off(D0, 3, 1)>(vb);
    asm volatile("s_waitcnt lgkmcnt(0)" ::: "memory"); SBAR();
    od = __builtin_amdgcn_mfma_f32_32x32x16_bf16(pa0, PKLH(l0, h0), od, 0, 0, 0);
    od = __builtin_amdgcn_mfma_f32_32x32x16_bf16(pa1, PKLH(l1, h1), od, 0, 0, 0);
    od = __builtin_amdgcn_mfma_f32_32x32x16_bf16(pa2, PKLH(l2, h2), od, 0, 0, 0);
    od = __builtin_amdgcn_mfma_f32_32x32x16_bf16(pa3, PKLH(l3, h3), od, 0, 0, 0);
}
__device__ __forceinline__ void pv_d0(f32x16* o, int vb, bf16x8 pa0, bf16x8 pa1, bf16x8 pa2, bf16x8 pa3) {
    pv_one<0>(o[0], vb, pa0, pa1, pa2, pa3); pv_one<1>(o[1], vb, pa0, pa1, pa2, pa3); pv_one<2>(o[2], vb, pa0, pa1, pa2, pa3); pv_one<3>(o[3], vb, pa0, pa1, pa2, pa3);
}
#define PK4S(P, BASE, OUT) do { unsigned a0 = cvt_pk_bf16(P[BASE + 0], P[BASE + 1]), a1 = cvt_pk_bf16(P[BASE + 2], P[BASE + 3]);   \
    unsigned b0 = cvt_pk_bf16(P[BASE + 4], P[BASE + 5]), b1 = cvt_pk_bf16(P[BASE + 6], P[BASE + 7]);                              \
    auto r0 = __builtin_amdgcn_permlane32_swap(a0, b0, false, false); auto r1 = __builtin_amdgcn_permlane32_swap(a1, b1, false, false); \
    u32x4 w = {r0[0], r1[0], r0[1], r1[1]}; OUT = __builtin_bit_cast(bf16x8, w); } while (0)
template <bool FIN>
__device__ __forceinline__ void seg_x(f32x16& n0, f32x16& n1, const LAS char* Ks, const bf16x8* qr, const LAS char* ql, int r32, int hi,
                                      f32x16& f0, f32x16& f1, float alpha, float& l_reg, bf16x8& pa0, bf16x8& pa1, bf16x8& pa2, bf16x8& pa3) {
    n0 = f32x16{}; n1 = f32x16{};
    const LAS char* k0p = Ks + r32 * 384;
    const int key = ((r32 >> 1) & 7) << 4;
    bf16x8 ka[2], kb[2]; float ps = 0.f;
#define KRD(d0, slot) do { const int cb_ = (((d0) * 16 + hi * 8) * 2) ^ key; ka[slot] = *reinterpret_cast<const LAS bf16x8*>(k0p + cb_); kb[slot] = *reinterpret_cast<const LAS bf16x8*>(k0p + 32 * 384 + cb_); } while (0)
    KRD(0, 0); KRD(1, 1); SBAR();
    bf16x8 qlv = qr[0];
#pragma unroll
    for (int d0 = 0; d0 < 12; ++d0) {
        const bf16x8 qv = (d0 < 8) ? qr[d0 < 8 ? d0 : 0] : qlv;
        n0 = __builtin_amdgcn_mfma_f32_32x32x16_bf16(ka[d0 & 1], qv, n0, 0, 0, 0);
        n1 = __builtin_amdgcn_mfma_f32_32x32x16_bf16(kb[d0 & 1], qv, n1, 0, 0, 0);
        SBAR();
        if (d0 + 2 < 12) KRD(d0 + 2, d0 & 1);
        if (d0 + 1 >= 8 && d0 + 1 < 12) qlv = *reinterpret_cast<const LAS bf16x8*>(ql + (d0 + 1 - 8) * 1024);
        if constexpr (FIN) {
            if (d0 < 4) {
#pragma unroll
                for (int r = 0; r < 4; ++r) f1[4 * d0 + r] = __builtin_amdgcn_exp2f(f1[4 * d0 + r]);
            } else if (d0 == 4) {
#pragma unroll
                for (int r = 0; r < 16; ++r) ps += f0[r];
            } else if (d0 == 5) {
#pragma unroll
                for (int r = 0; r < 16; ++r) ps += f1[r];
            } else if (d0 == 6) {
                auto rr = __builtin_amdgcn_permlane32_swap(__float_as_uint(ps), __float_as_uint(ps), false, false);
                ps = __uint_as_float(rr[0]) + __uint_as_float(rr[1]); l_reg = l_reg * alpha + ps;
            } else if (d0 == 7) { PK4S(f0, 0, pa0); } else if (d0 == 8) { PK4S(f0, 8, pa1); } else if (d0 == 9) { PK4S(f1, 0, pa2); } else if (d0 == 10) { PK4S(f1, 8, pa3); }
        }
        SBAR();
    }
#undef KRD
}
__device__ __forceinline__ void seg_y(f32x16* o, int vb, bf16x8 pa0, bf16x8 pa1, bf16x8 pa2, bf16x8 pa3, f32x16& p0, f32x16& p1, float& m_reg, float& mn, float& alpha) {
    pv_one<0>(o[0], vb, pa0, pa1, pa2, pa3); SBAR();
    { float a = fmaxf(p0[0], p0[1]), b = fmaxf(p0[2], p0[3]);
#pragma unroll
      for (int r = 4; r < 16; r += 2) { a = fmaxf(a, p0[r]); b = fmaxf(b, p0[r + 1]); }
#pragma unroll
      for (int r = 0; r < 16; r += 2) { a = fmaxf(a, p1[r]); b = fmaxf(b, p1[r + 1]); }
      float pmax = fmaxf(a, b);
      auto rr = __builtin_amdgcn_permlane32_swap(__float_as_uint(pmax), __float_as_uint(pmax), false, false);
      pmax = fmaxf(__uint_as_float(rr[0]), __uint_as_float(rr[1]));
      if (__builtin_expect(__all(pmax - m_reg <= THRL), 1)) { mn = m_reg; alpha = 1.f; }
      else { mn = fmaxf(m_reg, pmax); alpha = __builtin_amdgcn_exp2f(m_reg - mn); m_reg = mn; } }
    SBAR();
    pv_one<1>(o[1], vb, pa0, pa1, pa2, pa3); SBAR();
#pragma unroll
    for (int r = 0; r < 16; ++r) { p0[r] = p0[r] - mn; p1[r] = p1[r] - mn; }
    SBAR();
    pv_one<2>(o[2], vb, pa0, pa1, pa2, pa3); SBAR();
#pragma unroll
    for (int r = 0; r < 8; ++r) p0[r] = __builtin_amdgcn_exp2f(p0[r]);
    SBAR();
    pv_one<3>(o[3], vb, pa0, pa1, pa2, pa3); SBAR();
#pragma unroll
    for (int r = 8; r < 16; ++r) p0[r] = __builtin_amdgcn_exp2f(p0[r]);
    SBAR();
}
constexpr int L_K = 0, L_VV = 3 * SHM_K, L_WS = L_VV + 3 * SHM_V, L_QL = L_WS + NW * 64 * 4, ATT_LDS = L_QL + NW * 4096;
__device__ __forceinline__ void attn_chain(const bf16_t* __restrict__ QB, const bf16_t* __restrict__ KBp, const bf16_t* __restrict__ VBp, bf16_t* __restrict__ MIXp, int ldo, float* __restrict__ SSQAp,
                                           int bhs, int qb, int k0, int k1, int seq, int Mrows, char* lds, int wv) {
    int lane0 = lane_id(); asm volatile("" : "+v"(lane0));
    const int wid = wv;
    LAS unsigned char* l3 = (LAS unsigned char*)lds;
    const LAS char* K_lds = (const LAS char*)l3 + L_K;
    float* ws = (float*)(lds + L_WS) + wid * 64; float* li_l = ws; float* al_l = ws + 32;
    bf16x8 qr[8];
#define KSRC(i_) ({ const int p_ = (wid + 8 * (i_)) * 64 + lane, row_ = p_ / 24, cpos_ = p_ - row_ * 24; (unsigned)(row_ * 24 + ((cpos_ & ~7) | ((cpos_ ^ (row_ >> 1)) & 7))) * 16u; })
#define VSRC(i_) ({ const int p16_ = (wid + 8 * (i_)) * 64 + lane, sub_ = p16_ >> 5, idx_ = p16_ & 31, kk_ = (sub_ >> 2) * 8 + (idx_ >> 2), c_ = (sub_ & 3) * 32 + (idx_ & 3) * 8; \
    (unsigned)((((kk_ & ~0xC) | ((kk_ & 4) << 1) | ((kk_ & 8) >> 1))) * DV + c_) * 2u; })
#define DMA_KP(KP, t, kboff) do { const char* kt_ = (const char*)(KP) + (size_t)(t) * SHM_K; \
    _Pragma("unroll") for (int i_ = 0; i_ < 3; ++i_) __builtin_amdgcn_global_load_lds((const unsigned*)(kt_ + KSRC(i_)), (LAS unsigned*)(l3 + L_K + (kboff) + (wid + 8 * i_) * 1024), 16, 0, 0); } while (0)
#define DMA_VP(VP, t, vboff) do { const char* vt_ = (const char*)(VP) + (size_t)(t) * SHM_V; \
    _Pragma("unroll") for (int i_ = 0; i_ < 2; ++i_) __builtin_amdgcn_global_load_lds((const unsigned*)(vt_ + VSRC(i_)), (LAS unsigned*)(l3 + L_VV + (vboff) + (wid + 8 * i_) * 1024), 16, 0, 0); } while (0)
#define DMA_K(t, kboff) DMA_KP(Kh, t, kboff)
#define DMA_V(t, vboff) DMA_VP(Vh, t, vboff)
#define QLOAD(QP) do { const bf16_t* Qw_ = (QP) + (long)(wid * QBLK + r32) * DQK + hi * 8; \
    _Pragma("unroll") for (int d0 = 0; d0 < 8; ++d0) qr[d0] = *reinterpret_cast<const bf16x8*>(Qw_ + d0 * 16); \
    _Pragma("unroll") for (int d0 = 8; d0 < 12; ++d0) __builtin_amdgcn_global_load_lds((const unsigned*)(Qw_ + d0 * 16), (LAS unsigned*)(l3 + L_QL + wid * 4096 + (d0 - 8) * 1024), 16, 0, 0); } while (0)
#define TOP(j, KB) do { if ((j) + 2 >= NT) asm volatile("s_waitcnt vmcnt(0) lgkmcnt(0)" ::: "memory"); else asm volatile("s_waitcnt vmcnt(5) lgkmcnt(0)" ::: "memory"); \
    __builtin_amdgcn_s_barrier(); asm volatile("" ::: "memory"); \
    if ((j) + 2 < NT) DMA_K((j) + 2, (((KB) + 2) % 3) * SHM_K); if ((j) + 1 < NT) DMA_V((j) + 1, (((KB) + 1) % 3) * SHM_V); } while (0)
#define RESC(a) do { if (__any((a) < 1.f)) { if (hi == 0) al_l[r32] = (a); asm volatile("s_waitcnt lgkmcnt(0)" ::: "memory"); \
    _Pragma("unroll") for (int d = 0; d < 4; ++d) _Pragma("unroll") for (int r = 0; r < 16; ++r) o[d][r] *= al_l[crow(r, hi)]; } } while (0)
#define TILE(j, KB, PN0, PN1, MNN, ALN, PF0, PF1, AF) do { TOP(j, KB); \
    seg_x<true>(PN0, PN1, K_lds + (KB) * SHM_K, qr, ql, r32, hi, PF0, PF1, AF, l_reg, pa0, pa1, pa2, pa3); \
    seg_y(o, vb0 + (((KB) + 2) % 3) * SHM_V, pa0, pa1, pa2, pa3, PN0, PN1, m_reg, MNN, ALN); RESC(ALN); } while (0)
    const int NT = seq / KVBLK;
    {
        int lane = lane0; asm volatile("" : "+v"(lane)); const int r32 = lane & 31, hi = lane >> 5;
        const size_t bh0 = (size_t)(16 * k0 + bhs);
        QLOAD(QB + (bh0 * seq + qb * 256) * DQK); DMA_KP(KBp + bh0 * seq * DQK, 0, 0); DMA_VP(VBp + bh0 * seq * DV, 0, 0); DMA_KP(KBp + bh0 * seq * DQK, 1, SHM_K);
    }
    for (int k = k0; k < k1; ++k) {
        const size_t bh = (size_t)(16 * k + bhs); const bool has_next = (k + 1 < k1);
        int lane = lane0; asm volatile("" : "+v"(lane)); const int r32 = lane & 31, hi = lane >> 5;
        const LAS char* ql = (const LAS char*)l3 + L_QL + wid * 4096 + lane * 16;
        const int vb0 = (int)(uintptr_t)(lds + L_VV) + v_rd_base(lane);
        const bf16_t* Kh = KBp + bh * seq * DQK; const bf16_t* Vh = VBp + bh * seq * DV;
        float m_reg = -1e30f, l_reg = 0; f32x16 o[4] = {};
        f32x16 pA0, pA1, pB0, pB1; float mnA, mnB, alA, alB; bf16x8 pa0, pa1, pa2, pa3;
        TOP(0, 0);
        seg_x<false>(pA0, pA1, K_lds, qr, ql, r32, hi, pA0, pA1, 1.f, l_reg, pa0, pa1, pa2, pa3); partialSM(pA0, pA1, m_reg, mnA, alA);
        for (int j = 1; j + 6 < NT; j += 6) {
            TILE(j,     1, pB0, pB1, mnB, alB, pA0, pA1, alA);
            TILE(j + 1, 2, pA0, pA1, mnA, alA, pB0, pB1, alB);
            TILE(j + 2, 0, pB0, pB1, mnB, alB, pA0, pA1, alA);
            TILE(j + 3, 1, pA0, pA1, mnA, alA, pB0, pB1, alB);
            TILE(j + 4, 2, pB0, pB1, mnB, alB, pA0, pA1, alA);
            TILE(j + 5, 0, pA0, pA1, mnA, alA, pB0, pB1, alB);
        }
        const size_t bhn = bh + 16;
        TOP(NT - 1, 1);
        if (has_next) DMA_KP(KBp + bhn * seq * DQK, 0, 0);
        seg_x<true>(pB0, pB1, K_lds + 1 * SHM_K, qr, ql, r32, hi, pA0, pA1, alA, l_reg, pa0, pa1, pa2, pa3);
        asm volatile("" ::: "memory");
        if (has_next) QLOAD(QB + (bhn * seq + qb * 256) * DQK);
        seg_y(o, vb0 + 0 * SHM_V, pa0, pa1, pa2, pa3, pB0, pB1, m_reg, mnB, alB); RESC(alB);
        finishSM(pB0, pB1, alB, l_reg, pa0, pa1, pa2, pa3); SBAR();
        pv_d0(o, vb0 + 1 * SHM_V, pa0, pa1, pa2, pa3);
        if (hi == 0) li_l[r32] = l_reg; asm volatile("s_waitcnt lgkmcnt(0)" ::: "memory");
        float rli[16];
#pragma unroll
        for (int r = 0; r < 16; ++r) rli[r] = __builtin_amdgcn_rcpf(li_l[crow(r, hi)]);
        const int b = (int)(bh >> 2), h = (int)(bh & 3);
        bf16_t* Ow = MIXp + ((size_t)b * seq + qb * 256 + wid * QBLK) * ldo + h * 128;
        float* ssq = SSQAp + (size_t)h * Mrows + (size_t)b * seq + qb * 256;
        float myss = 0.f;
#pragma unroll
        for (int r = 0; r < 16; ++r) { const int orow = crow(r, hi); float sq = 0.f;
#pragma unroll
            for (int d0 = 0; d0 < 4; ++d0) { const float v = o[d0][r] * rli[r]; sq += v * v; Ow[(long)orow * ldo + d0 * 32 + r32] = (bf16_t)f2bf(v); }
            sq = dpp_sum8(sq);
            sq += __builtin_bit_cast(float, __builtin_amdgcn_update_dpp(0, __builtin_bit_cast(int, sq), 0x128, 0xF, 0xF, true));
            sq += __shfl_xor(sq, 16);
            if (r32 == r) myss = sq; }
        if (r32 < 16) ssq[wid * QBLK + crow(r32, hi)] = myss;
        if (has_next) { asm volatile("s_waitcnt lgkmcnt(0)" ::: "memory"); __builtin_amdgcn_s_barrier(); asm volatile("" ::: "memory");
            DMA_VP(VBp + bhn * seq * DV, 0, 0); DMA_KP(KBp + bhn * seq * DQK, 1, SHM_K); }
        else { asm volatile("s_waitcnt vmcnt(0) lgkmcnt(0)" ::: "memory"); __builtin_amdgcn_s_barrier(); asm volatile("" ::: "memory"); }
    }
#undef DMA_K
#undef DMA_V
#undef DMA_KP
#undef DMA_VP
#undef QLOAD
#undef TOP
#undef TILE
#undef RESC
}
}

namespace hg {
using att::crow; using att::v_st; using att::v_rd_base; using att::v_rd_off; using att::tr_read;
constexpr int L_QE = 0, L_QT = 16384, L_KT = 32768, L_OT = 122880  , L_KE = 73728, L_V = 90112, L_P = 106496, L_SEG = 114688  , L_DV = 155648, L_GN = 156160  , L_END = 156672;
__device__ __forceinline__ int swzA(int row, int cb) { return row * 256 + (cb ^ ((row & 15) << 4) ^ (((row >> 4) & 1) << 3)); }
__device__ __forceinline__ int swzB(int row, int cb) { return row * 256 + (cb ^ ((row & 15) << 4)); }
__device__ __forceinline__ int swzP(int row, int cb) { return row * 128 + (cb ^ ((row & 7) << 4)); }
template <int D0> __device__ __forceinline__ void tr_frag4(int vb, bf16x8& f0, bf16x8& f1, bf16x8& f2, bf16x8& f3) {
    const s16x4 l0 = tr_read<v_rd_off(D0, 0, 0)>(vb), h0 = tr_read<v_rd_off(D0, 0, 1)>(vb), l1 = tr_read<v_rd_off(D0, 1, 0)>(vb), h1 = tr_read<v_rd_off(D0, 1, 1)>(vb);
    const s16x4 l2 = tr_read<v_rd_off(D0, 2, 0)>(vb), h2 = tr_read<v_rd_off(D0, 2, 1)>(vb), l3 = tr_read<v_rd_off(D0, 3, 0)>(vb), h3 = tr_read<v_rd_off(D0, 3, 1)>(vb);
    asm volatile("s_waitcnt lgkmcnt(0)" ::: "memory"); SBAR();
    f0 = PKLH(l0, h0); f1 = PKLH(l1, h1); f2 = PKLH(l2, h2); f3 = PKLH(l3, h3);
}
struct Pre { u32x2 q4[4], l4[4], v4[4]; };
__device__ __forceinline__ void load_chunk(Pre& P, const bf16_t* pbase, int h, int dir, int cs, int wid, int lane) {
    const int c4 = 4 * (lane & 31), j0 = 8 * wid + 4 * (lane >> 5);
    const int cq = C_Q + h * 128 + c4, cf = C_FF + dir * 512 + h * 128 + c4, ci = C_I + h * 128 + c4;
#pragma unroll
    for (int i = 0; i < 4; ++i) { const int j = j0 + i, pos = dir ? (64 * cs + 63 - j) : (64 * cs + j); const bf16_t* rp = pbase + (size_t)pos * DINP;
        P.q4[i] = *(const u32x2*)(rp + cq); P.l4[i] = *(const u32x2*)(rp + cf); P.v4[i] = *(const u32x2*)(rp + ci); }
}
__device__ __forceinline__ void stage_c(char* lds, f32x16 (&S)[4], f32x16 (&o)[2]  , _Float16* ofp  , int rstride  , bool second, int eb, int lane_, int part  ) {
    int lane = lane_; asm volatile("" : "+v"(lane));
    const int r32 = lane & 31, hi = lane >> 5;
    _Float16* p0 = ofp + r32 + 4 * hi * rstride;
    const int vbV = (int)(uintptr_t)(lds + L_V) + v_rd_base(lane) + eb * 512, vbK = (int)(uintptr_t)(lds + L_KE) + v_rd_base(lane);
    if (part == 0) {
#pragma unroll
    for (int db = 0; db < 4; ++db)
#pragma unroll
        for (int s = 0; s < 2; ++s) {
            u32x4 sw; sw.x = cvtpk(S[db][8 * s + 0], S[db][8 * s + 1]); sw.y = cvtpk(S[db][8 * s + 2], S[db][8 * s + 3]);
            sw.z = cvtpk(S[db][8 * s + 4], S[db][8 * s + 5]); sw.w = cvtpk(S[db][8 * s + 6], S[db][8 * s + 7]);
            const bf16x8 sf = __builtin_bit_cast(bf16x8, sw);
#pragma unroll
            for (int jb = 0; jb < 2; ++jb) { const int row = 32 * jb + r32, d0 = 32 * db + 16 * s + 4 * hi;
                const u32x2 a0 = *(const u32x2*)(lds + L_QE + swzA(row, d0 * 2)), a1 = *(const u32x2*)(lds + L_QE + swzA(row, (d0 + 8) * 2));
                const u32x4 aw = {a0.x, a0.y, a1.x, a1.y};
                o[jb] = __builtin_amdgcn_mfma_f32_32x32x16_bf16(__builtin_bit_cast(bf16x8, aw), sf, o[jb], 0, 0, 0); }
        }
    return; }
    bf16x8 vf0, vf1, vf2, vf3; tr_frag4<0>(vbV, vf0, vf1, vf2, vf3);
#define PFR(jb, ks) (*(const bf16x8*)(lds + L_P + swzP(32 * (jb) + r32, 32 * (ks) + 16 * hi)))
    o[0] = __builtin_amdgcn_mfma_f32_32x32x16_bf16(PFR(0, 0), vf0, o[0], 0, 0, 0);
    o[0] = __builtin_amdgcn_mfma_f32_32x32x16_bf16(PFR(0, 1), vf1, o[0], 0, 0, 0);
    o[1] = __builtin_amdgcn_mfma_f32_32x32x16_bf16(PFR(1, 0), vf0, o[1], 0, 0, 0);
    o[1] = __builtin_amdgcn_mfma_f32_32x32x16_bf16(PFR(1, 1), vf1, o[1], 0, 0, 0);
    o[1] = __builtin_amdgcn_mfma_f32_32x32x16_bf16(PFR(1, 2), vf2, o[1], 0, 0, 0);
    o[1] = __builtin_amdgcn_mfma_f32_32x32x16_bf16(PFR(1, 3), vf3, o[1], 0, 0, 0);
#undef PFR
    if (second) {
        float* ot = (float*)(lds + L_OT) + 32 * eb + r32 + 4 * hi * 128;
#pragma unroll
        for (int jb = 0; jb < 2; ++jb)
#pragma unroll
            for (int r = 0; r < 16; ++r) ot[(32 * jb + 8 * (r >> 2) + (r & 3)) * 128] = o[jb][r];
    } else {
#pragma unroll
        for (int jb = 0; jb < 2; ++jb)
#pragma unroll
            for (int g = 0; g < 4; ++g) { _Float16* pg = p0 + (32 * jb + 8 * g) * rstride;
#pragma unroll
                for (int e = 0; e < 4; ++e) pg[e * rstride] = (_Float16)o[jb][4 * g + e];
                asm volatile("" ::: "memory"); }
    }
    const float* dv = (const float*)(lds + L_DV);
#define SUPD(DB) do { bf16x8 k0_, k1_, k2_, k3_; tr_frag4<DB>(vbK, k0_, k1_, k2_, k3_); \
        { const float* dvp = dv + 32 * DB + 4 * hi; _Pragma("unroll") for (int g = 0; g < 4; ++g) { const f32x4 d4 = *(const f32x4*)(dvp + 8 * g); \
            S[DB][4 * g] *= d4[0]; S[DB][4 * g + 1] *= d4[1]; S[DB][4 * g + 2] *= d4[2]; S[DB][4 * g + 3] *= d4[3]; } } \
        S[DB] = __builtin_amdgcn_mfma_f32_32x32x16_bf16(k0_, vf0, S[DB], 0, 0, 0); S[DB] = __builtin_amdgcn_mfma_f32_32x32x16_bf16(k1_, vf1, S[DB], 0, 0, 0); \
        S[DB] = __builtin_amdgcn_mfma_f32_32x32x16_bf16(k2_, vf2, S[DB], 0, 0, 0); S[DB] = __builtin_amdgcn_mfma_f32_32x32x16_bf16(k3_, vf3, S[DB], 0, 0, 0); } while (0)
    SUPD(0); SUPD(1); SUPD(2); SUPD(3);
#undef SUPD
}
__device__ __forceinline__ void hgrn_bh(int b, int h, const bf16_t* proj, bf16_t* MIXp, const float* __restrict__ gain, char* lds, int wv) {
    int lane = lane_id(); asm volatile("" : "+v"(lane));
    const int wid = wv, tid = wv * 64 + lane, dp_ = lane, seg = wid;
    for (int i = tid; i < 8192 / 4; i += 512) ((unsigned*)(lds + L_P))[i] = 0u;
    f32x16 S[4] = {};
    const bf16_t* pbase = proj + (size_t)b * SEQ * DINP;
    float* segtot = (float*)(lds + L_SEG);
    if (tid < 128) ((float*)(lds + L_GN))[tid] = gain[tid];
    Pre pre; load_chunk(pre, pbase, h, 0, 0, wid, lane);
    __syncthreads();
    const int hw = lane >> 5, cq4 = lane & 31, sg16 = 2 * wid + hw;
    const int cB = (8 * cq4) ^ ((wid & 1) << 7) ^ (hw << 6), cA = cB ^ (((wid >> 1) & 1) << 3), rowb = wid * 2048 + hw * 1024;
    const int gV = (cq4 >> 3) * 512 + (cq4 & 7) * 8 + (wid >> 1) * 4096 + hw * 2048 + (wid & 1) * 256;
    const int drow = tid >> 3, dseg = tid & 7;
#define POST_SEGTOT() do { float a0_ = 0.f, a1_ = 0.f, a2_ = 0.f, a3_ = 0.f; \
        _Pragma("unroll") for (int t_ = 0; t_ < 4; ++t_) { const unsigned lx_ = pre.l4[t_].x, ly_ = pre.l4[t_].y; const h16x2 h0_ = __builtin_bit_cast(h16x2, lx_), h1_ = __builtin_bit_cast(h16x2, ly_); \
            a0_ += (float)h0_[0]; a1_ += (float)h0_[1]; a2_ += (float)h1_[0]; a3_ += (float)h1_[1]; } \
        *(f32x4*)(segtot + sg16 * 128 + 4 * cq4) = (f32x4){a0_, a1_, a2_, a3_}; } while (0)
    POST_SEGTOT();
    asm volatile("s_waitcnt lgkmcnt(0)" ::: "memory"); __builtin_amdgcn_s_barrier(); asm volatile("" ::: "memory");
    for (int k = 0; k < 64; ++k) {
        const int i = k >> 1, dir = k & 1, cs = dir ? 31 - i : i; const bool second = (i >= 16);
        const long row0 = (long)b * SEQ + (dir ? 64 * cs + 63 : 64 * cs);
        const int rstride = dir ? -DINP : DINP; const bool mine = ((wid >> 2) == dir);
        _Float16* rawp = (_Float16*)proj + (size_t)row0 * DINP + C_CQ + h * 128 + 32 * (wid & 3);
        f32x16 o[2]; u32x4 gq0, gq1;
        if (second) {
            if (mine) { const _Float16* p0 = rawp + (lane & 31) + 4 * (lane >> 5) * rstride;
#pragma unroll
                for (int jb = 0; jb < 2; ++jb)
#pragma unroll
                    for (int r = 0; r < 16; ++r) o[jb][r] = (float)p0[(32 * jb + 8 * (r >> 2) + (r & 3)) * rstride]; }
            const long grow = row0 + (dir ? -drow : drow); const bf16_t* gp = proj + (size_t)grow * DINP + C_G + h * 128 + 16 * dseg;
            gq0 = *(const u32x4*)gp; gq1 = *(const u32x4*)(gp + 8);
        } else { o[0] = f32x16{}; o[1] = f32x16{}; }
        const int I = wid >> 1;
        f32x4 rr[5];
        { f32x4 a = {0.f, 0.f, 0.f, 0.f};
#pragma unroll
          for (int sg = 0; sg < 16; ++sg) { if ((sg & 3) == 0) rr[sg >> 2] = a; a += *(const f32x4*)(segtot + sg * 128 + 4 * cq4); }
          rr[4] = a; }
        const f32x4 rI = (I == 0) ? rr[0] : (I == 1) ? rr[1] : (I == 2) ? rr[2] : rr[3];
        f32x4 run = rI;
#pragma unroll
        for (int q = 0; q < 3; ++q) { const f32x4 st = *(const f32x4*)(segtot + (4 * I + q) * 128 + 4 * cq4); if (4 * I + q < sg16) run += st; }
        f32x4 eI, eT, rat[4];
#pragma unroll
        for (int c = 0; c < 4; ++c) { eI[c] = __builtin_amdgcn_exp2f(rI[c]); eT[c] = __builtin_amdgcn_exp2f(rr[4][c] - rI[c]);
#pragma unroll
            for (int sg = 0; sg < 4; ++sg) rat[sg][c] = __builtin_amdgcn_exp2f(fminf(rr[sg][c] - rI[c], 0.f)); }
        if (sg16 == 0) { f32x4 d4;
#pragma unroll
            for (int c = 0; c < 4; ++c) d4[c] = __builtin_amdgcn_exp2f(rr[4][c]);
            *(f32x4*)((float*)(lds + L_DV) + 4 * cq4) = d4; }
#pragma unroll
        for (int t = 0; t < 4; ++t) {
            const unsigned lx = pre.l4[t].x, ly = pre.l4[t].y; const h16x2 h0 = __builtin_bit_cast(h16x2, lx), h1 = __builtin_bit_cast(h16x2, ly);
            const f32x4 lf = {(float)h0[0], (float)h0[1], (float)h1[0], (float)h1[1]};
            const f32x4 q = {bflo(pre.q4[t].x), bfhi(pre.q4[t].x), bflo(pre.q4[t].y), bfhi(pre.q4[t].y)};
            run += lf;
            f32x4 qt, qe, kI, ke;
#pragma unroll
            for (int c = 0; c < 4; ++c) { const float dlt = run[c] - rI[c];
                const float kk = 1.f - __builtin_amdgcn_exp2f(lf[c]);
                qt[c] = q[c] * __builtin_amdgcn_exp2f(dlt); kI[c] = kk * __builtin_amdgcn_exp2f(fminf(-dlt, 115.f)); }
            qe = qt * eI; ke = kI * eT;
            const int aB = (cB ^ (t << 4)) + rowb + t * 256, aA = (cA ^ (t << 4)) + rowb + t * 256, aV = gV + t * 64;
            *(u32x2*)(lds + L_QE + aA) = (u32x2){cvtpk(qe[0], qe[1]), cvtpk(qe[2], qe[3])};
            *(u32x2*)(lds + L_QT + aB) = (u32x2){cvtpk(qt[0], qt[1]), cvtpk(qt[2], qt[3])};
            *(u32x2*)(lds + L_KE + aV) = (u32x2){cvtpk(ke[0], ke[1]), cvtpk(ke[2], ke[3])};
            *(u32x2*)(lds + L_V + aV) = pre.v4[t];
#define KTW(base, SG) do { const f32x4 kv_ = kI * rat[SG]; *(u32x2*)(lds + L_KT + (base) * 256 + aB) = (u32x2){cvtpk(kv_[0], kv_[1]), cvtpk(kv_[2], kv_[3])}; } while (0)
#define KTD(base) do { *(u32x2*)(lds + L_KT + (base) * 256 + aB) = (u32x2){cvtpk(kI[0], kI[1]), cvtpk(kI[2], kI[3])}; } while (0)
            if (I == 0) { KTD(0); KTW(16, 1); KTW(48, 2); KTW(96, 3); }
            else if (I == 1) { KTD(16); KTW(48, 2); KTW(96, 3); }
            else if (I == 2) { KTD(48); KTW(96, 3); }
            else { KTD(96); }
#undef KTW
#undef KTD
        }
        asm volatile("s_waitcnt lgkmcnt(0)" ::: "memory"); __builtin_amdgcn_s_barrier(); asm volatile("" ::: "memory");
        if (k + 1 < 64) { const int k1 = k + 1, i1 = k1 >> 1, d1 = k1 & 1; load_chunk(pre, pbase, h, d1, d1 ? 31 - i1 : i1, wid, lane); }
        const int nblk = mine ? ((wid & 3) < 2 ? 1 : 0) : 2;
        for (int qq = 0; qq < nblk; ++qq) { const int blk = mine ? 8 + (wid & 3) : (wid & 3) + 4 * qq;
            int bi, bjj; if (blk == 0) { bi = 0; bjj = 0; } else if (blk < 3) { bi = 1; bjj = blk - 1; } else if (blk < 6) { bi = 2; bjj = blk - 3; } else { bi = 3; bjj = blk - 6; }
            const int base = (bi == 0) ? 0 : (bi == 1) ? 16 : (bi == 2) ? 48 : 96;
            const int xm = ((lane & 15) << 4), cq4 = 16 * (lane >> 4);
            const char* ap = lds + L_QT + (16 * bi + (lane & 15)) * 256; const char* bp = lds + L_KT + (base + 16 * bjj + (lane & 15)) * 256;
            bf16x8 av[4], bv[4];
#pragma unroll
            for (int ks = 0; ks < 4; ++ks) { const int cb = (64 * ks + cq4) ^ xm; av[ks] = *(const bf16x8*)(ap + cb); bv[ks] = *(const bf16x8*)(bp + cb); }
            f32x4 acc = {0.f, 0.f, 0.f, 0.f};
#pragma unroll
            for (int ks = 0; ks < 4; ++ks) acc = __builtin_amdgcn_mfma_f32_16x16x32_bf16(av[ks], bv[ks], acc, 0, 0, 0);
            const int sl = lane & 15;
#pragma unroll
            for (int r = 0; r < 4; ++r) { const int jl = (lane >> 4) * 4 + r; const float v = (bi != bjj || sl <= jl) ? acc[r] : 0.f;
                *(bf16_t*)(lds + L_P + swzP(16 * bi + jl, (16 * bjj + sl) * 2)) = (bf16_t)(cvtpk(v, v) & 0xffffu); }
        }
        if (mine) stage_c(lds, S, o, rawp, rstride, second, wid & 3, lane, 0);
        asm volatile("s_waitcnt lgkmcnt(0)" ::: "memory"); __builtin_amdgcn_s_barrier(); asm volatile("" ::: "memory");
        if (mine) stage_c(lds, S, o, rawp, rstride, second, wid & 3, lane, 1);
        if (k + 1 < 64) POST_SEGTOT();
        if (k == 31) asm volatile("s_waitcnt vmcnt(0)" ::: "memory");
        asm volatile("s_waitcnt lgkmcnt(0)" ::: "memory"); __builtin_amdgcn_s_barrier(); asm volatile("" ::: "memory");
        if (second) {
            const float* otp = (const float*)(lds + L_OT) + drow * 128 + 16 * dseg;
            f32x4 v[4]; float ss = 0.f;
#pragma unroll
            for (int q = 0; q < 4; ++q) { v[q] = *(const f32x4*)(otp + 4 * q); ss += (v[q][0] * v[q][0] + v[q][1] * v[q][1]) + (v[q][2] * v[q][2] + v[q][3] * v[q][3]); }
            ss = dpp_sum8(ss);
            const float r = __builtin_amdgcn_rsqf(ss * (1.f / 128.f) + EPS);
            f32x4 gn[4];
#pragma unroll
            for (int q = 0; q < 4; ++q) gn[q] = *(const f32x4*)((const float*)(lds + L_GN) + 16 * dseg + 4 * q);
            const unsigned gw[8] = {gq0.x, gq0.y, gq0.z, gq0.w, gq1.x, gq1.y, gq1.z, gq1.w}; unsigned ow[8];
#pragma unroll
            for (int q = 0; q < 8; ++q) { const float g0 = bflo(gw[q]), g1 = bfhi(gw[q]);
                const float s0 = g0 * __builtin_amdgcn_rcpf(1.f + __builtin_amdgcn_exp2f(-1.4426950408889634f * g0)), s1 = g1 * __builtin_amdgcn_rcpf(1.f + __builtin_amdgcn_exp2f(-1.4426950408889634f * g1));
                ow[q] = cvtpk(v[q >> 1][2 * (q & 1)] * r * gn[q >> 1][2 * (q & 1)] * s0, v[q >> 1][2 * (q & 1) + 1] * r * gn[q >> 1][2 * (q & 1) + 1] * s1); }
            const long grow = row0 + (dir ? -drow : drow); bf16_t* mp = MIXp + (size_t)grow * DM + 512 + h * 128 + 16 * dseg;
            *(u32x4*)mp = (u32x4){ow[0], ow[1], ow[2], ow[3]}; *(u32x4*)(mp + 8) = (u32x4){ow[4], ow[5], ow[6], ow[7]};
        }
    }
    __syncthreads();
}
}

#define XB_TMO      128
#define XB_XCNT(j)  (256  + 64 * (j))
#define XB_XSUB(j)  (1280 + 64 * (j))
#define XB_XGEN(j)  (2304 + 64 * (j))
#define XB_TOP      3328
#define XB_TOPGEN   3392
#define XCD_BAR_WORDS 3456
#define XB_SPIN_CAP (1u << 18)

__device__ __forceinline__ unsigned xb_ld(unsigned* p)              { return __hip_atomic_load(p, __ATOMIC_RELAXED, __HIP_MEMORY_SCOPE_AGENT); }
__device__ __forceinline__ unsigned xb_add(unsigned* p, unsigned v) { return __hip_atomic_fetch_add(p, v, __ATOMIC_RELAXED, __HIP_MEMORY_SCOPE_AGENT); }
__device__ __forceinline__ unsigned xb_xcc_id() { return (unsigned)__builtin_amdgcn_s_getreg((3 << 11) | 20) & 0xFu; }
#define XB_SPIN(cond, bar) do { unsigned _sp = 0; while (cond) { __builtin_amdgcn_s_sleep(1); \
    if ((++_sp & 255u) == 0u) { if (xb_ld(&(bar)[XB_TMO])) break; if (_sp > XB_SPIN_CAP) { atomicAdd(&(bar)[XB_TMO], 1u); break; } } } } while (0)

struct XcdBarrier {
    unsigned* bar; unsigned x;
    volatile LAS unsigned* st;
};

__device__ __forceinline__ XcdBarrier xcd_barrier_post(unsigned* bar, volatile LAS unsigned* st, bool leader  ) {
    XcdBarrier b; b.bar = bar; b.x = xb_xcc_id(); b.st = st;
    if (leader) (void)xb_add(&bar[XB_XCNT(b.x)], 1u);
    return b;
}
__device__ __forceinline__ void xcd_barrier_complete(unsigned* bar, unsigned x, unsigned& nloc, unsigned& nx) {
    const unsigned G = gridDim.x * gridDim.y * gridDim.z;
    unsigned sum, cnt, mine, sp = 0u;
    for (;;) {
        sum = 0u; cnt = 0u; mine = 0u;
#pragma unroll
        for (unsigned j = 0; j < 16; ++j) { const unsigned c = xb_ld(&bar[XB_XCNT(j)]); sum += c; cnt += (c > 0u) ? 1u : 0u; mine = (j == x) ? c : mine; }
        if (sum == G) break;
        __builtin_amdgcn_s_sleep(1);
        if ((++sp & 255u) == 0u) { if (xb_ld(&bar[XB_TMO])) break; if (sp > XB_SPIN_CAP) { atomicAdd(&bar[XB_TMO], 1u); break; } }
    }
    nloc = mine > 0u ? mine : 1u; nx = cnt > 0u ? cnt : 1u;
}

__device__ __forceinline__ void xcd_barrier(const XcdBarrier& b, bool leader  ) {
    asm volatile("s_waitcnt vmcnt(0)" ::: "memory");
    __syncthreads();
    if (leader) {
        unsigned* bar = b.bar;
        __builtin_amdgcn_s_waitcnt(0);
        unsigned nloc = b.st[0], nx = b.st[1];
        if (nloc == 0u) { xcd_barrier_complete(bar, b.x, nloc, nx); b.st[0] = nloc; b.st[1] = nx; }
        const unsigned old = xb_add(&bar[XB_XSUB(b.x)], 1u);
        const unsigned gen = old / nloc;
        if (old + 1u == (gen + 1u) * nloc) {
            __builtin_amdgcn_fence(__ATOMIC_RELEASE, "agent");
            asm volatile("s_waitcnt vmcnt(0)" ::: "memory");
            const unsigned og = xb_add(&bar[XB_TOP], 1u);
            const unsigned tg = og / nx;
            if (og + 1u == (tg + 1u) * nx) xb_add(&bar[XB_TOPGEN], 1u);
            else XB_SPIN(xb_ld(&bar[XB_TOPGEN]) == tg, bar);
            __builtin_amdgcn_fence(__ATOMIC_ACQUIRE, "agent");
            xb_add(&bar[XB_XGEN(b.x)], 1u);
            asm volatile("s_waitcnt vmcnt(0)" ::: "memory");
        } else {
            XB_SPIN(xb_ld(&bar[XB_XGEN(b.x)]) == gen, bar);
            __builtin_amdgcn_fence(__ATOMIC_ACQUIRE, "agent");
            asm volatile("s_waitcnt vmcnt(0)" ::: "memory");
        }
    }
    __syncthreads();
}


constexpr int NWAVES = 8;
constexpr int LDS_BYTES = 160 * 1024;
constexpr int RING_BYTES = 131072, EPI_OFF = RING_BYTES  , TAB_OFF = RING_BYTES + 8192  , MISC_OFF = 160 * 1024 - 1024;
constexpr size_t CTL_ZERO_BYTES = 65536;
struct Args { const float* in[17]; float* out; unsigned char* ws; int ph_lo, ph_hi; };

__device__ __forceinline__ int rope_perm(int cp) { const int i = cp >> 3, j = cp & 7; return (j < 4) ? 4 * i + j : 32 + 4 * i + (j - 4); }
__device__ __forceinline__ void tr_item(const float* W, int ldw, int ksrc0, int srccol, const float* gain, int goff, bf16_t* WT, int Kd, int kd0, int nd0, LAS float* scr, int lane) {
    float wv_[32], gv_[32];
#pragma unroll
    for (int i = 0; i < 32; ++i) { const int kk = 2 * i + (lane >> 5); wv_[i] = (srccol >= 0) ? W[(size_t)(ksrc0 + kk) * ldw + srccol] : 0.f; gv_[i] = gain ? gain[ksrc0 + kk - goff] : 1.f; }
#pragma unroll
    for (int i = 0; i < 32; ++i) { const int kk = 2 * i + (lane >> 5); scr[kk * 33 + (lane & 31)] = wv_[i] * gv_[i]; }
    asm volatile("s_waitcnt lgkmcnt(0)" ::: "memory");
    const int c = lane & 7;
#pragma unroll
    for (int j = 0; j < 4; ++j) { const int n = (lane >> 3) + 8 * j; const LAS float* sp = scr + (8 * c) * 33 + n;
        u32x4 o; o.x = pk2(sp[0 * 33], sp[1 * 33]); o.y = pk2(sp[2 * 33], sp[3 * 33]); o.z = pk2(sp[4 * 33], sp[5 * 33]); o.w = pk2(sp[6 * 33], sp[7 * 33]);
        *(u32x4*)(WT + (size_t)(nd0 + n) * Kd + kd0 + 8 * c) = o; }
    asm volatile("s_waitcnt lgkmcnt(0)" ::: "memory");
}
template <int R>
__device__ __forceinline__ void rows_to_bf16_rs(const float* x0, bf16_t* o0, float* rs0, size_t rstep, int lane) {
    f32x4 v[R][4]; float s[R];
#pragma unroll
    for (int r = 0; r < R; ++r) { const f32x4* xr = (const f32x4*)(x0 + (size_t)r * rstep * DM) + lane;
#pragma unroll
        for (int j = 0; j < 4; ++j) v[r][j] = xr[64 * j]; }
#pragma unroll
    for (int r = 0; r < R; ++r) { float a = 0.f;
#pragma unroll
        for (int j = 0; j < 4; ++j) a += (v[r][j].x * v[r][j].x + v[r][j].y * v[r][j].y) + (v[r][j].z * v[r][j].z + v[r][j].w * v[r][j].w);
        s[r] = a; }
#pragma unroll
    for (int o = 1; o < 64; o <<= 1) {
#pragma unroll
        for (int r = 0; r < R; ++r) s[r] += __shfl_xor(s[r], o); }
#pragma unroll
    for (int r = 0; r < R; ++r) { if (lane == 0) rs0[(size_t)r * rstep] = 1.f / sqrtf(s[r] * (1.f / DM) + EPS);
        u32x2* o8 = (u32x2*)(o0 + (size_t)r * rstep * DM) + lane;
#pragma unroll
        for (int j = 0; j < 4; ++j) { u32x2 w; w.x = cvtpk(v[r][j].x, v[r][j].y); w.y = cvtpk(v[r][j].z, v[r][j].w); o8[64 * j] = w; } }
}
__device__ __forceinline__ void sincos_acc(float ang, float& c, float& s) {
    const double x = (double)ang; const double kq = __builtin_rint(x * 0.6366197723675814); const double y = x - kq * 1.5707963267948966 - kq * 6.123233995736766e-17;
    const double y2 = y * y;
    double sp = -7.6471637318198164759e-13; sp = sp * y2 + 1.6059043836821614599e-10; sp = sp * y2 - 2.5052108385441718775e-8; sp = sp * y2 + 2.7557319223985890653e-6; sp = sp * y2 - 1.9841269841269841270e-4; sp = sp * y2 + 8.3333333333333333333e-3; sp = sp * y2 - 1.6666666666666666667e-1; sp = y + y * y2 * sp;
    double cp = 4.7794773323873852974e-14; cp = cp * y2 - 1.1470745597729724714e-11; cp = cp * y2 + 2.0876756987868098979e-9; cp = cp * y2 - 2.7557319223985890653e-7; cp = cp * y2 + 2.4801587301587301587e-5; cp = cp * y2 - 1.3888888888888888889e-3; cp = cp * y2 + 4.1666666666666666667e-2; cp = cp * y2 - 0.5; cp = 1.0 + y2 * cp;
    const int q = ((int)(long long)kq) & 3;
    const double sv = (q == 0) ? sp : (q == 1) ? cp : (q == 2) ? -sp : -cp;
    const double cv = (q == 0) ? cp : (q == 1) ? -sp : (q == 2) ? -cp : sp;
    c = (float)cv; s = (float)sv;
}

__global__ void __launch_bounds__(NWAVES * 64, 2) mk_fwd(Args args) {
    extern __shared__ __attribute__((aligned(16))) unsigned char lds[];
    const int g_wv = __builtin_amdgcn_readfirstlane(threadIdx.x >> 6);
#define TIDV() ({ int t_ = g_wv * 64 + lane_id(); asm volatile("" : "+v"(t_)); t_; })
    const int G = gridDim.x, bx = blockIdx.x;
    unsigned char* ws = args.ws;
    const float* x = args.in[0]; const int* positions = (const int*)args.in[1];
    const float* g_mix = args.in[2]; const float* w_in = args.in[3]; const float* lb_param = args.in[4]; const float* g_hgrn = args.in[5];
    const float* g_cq = args.in[6]; const float* w_q_up = args.in[7]; const float* g_ckv = args.in[8]; const float* w_kv_up = args.in[9];
    const float* g_qn = args.in[10]; const float* g_kn = args.in[11]; const float* g_mla_out = args.in[12]; const float* w_out = args.in[13];
    const float* g_ffn = args.in[14]; const float* w_up = args.in[15]; const float* w_down = args.in[16];
    float* out = args.out;
    float* RS0 = (float*)(ws + WS_RS0); float* SSQ1 = (float*)(ws + WS_SSQ1); float* SSQP = (float*)(ws + WS_SSQP); float* GQT = (float*)(ws + WS_GQT); float* GKT = (float*)(ws + WS_GKT); float* LBT = (float*)(ws + WS_LBT);
    float* COS = (float*)(ws + WS_COS); float* SIN = (float*)(ws + WS_SIN);
    bf16_t* WIN = (bf16_t*)(ws + WS_WIN); bf16_t* WQ = (bf16_t*)(ws + WS_WQ); bf16_t* WKV = (bf16_t*)(ws + WS_WKV); bf16_t* WOUT = (bf16_t*)(ws + WS_WOUT);
    bf16_t* WUP = (bf16_t*)(ws + WS_WUP); bf16_t* WDN = (bf16_t*)(ws + WS_WDN);
    bf16_t* XB = (bf16_t*)(ws + WS_XB); bf16_t* VB = (bf16_t*)(ws + WS_V); bf16_t* X1B = (bf16_t*)(ws + WS_X1B);
    bf16_t* PROJ = (bf16_t*)(ws + WS_PROJ); bf16_t* HB = (bf16_t*)(ws + WS_HB);
    bf16_t* MIX = (bf16_t*)(ws + WS_MIX); float* SSQA = (float*)(ws + WS_SSQA);
    bf16_t* QB = (bf16_t*)(ws + WS_Q); bf16_t* KB = (bf16_t*)(ws + WS_K);
    const int lo = args.ph_lo, hi = args.ph_hi;
    cooperative_groups::grid_group grid = cooperative_groups::this_grid();
    volatile LAS unsigned* MISC = (volatile LAS unsigned*)((LAS unsigned char*)lds + MISC_OFF);
    { const int tid = TIDV(); if (tid < 32) MISC[tid] = 0u; }
    __syncthreads();
    XcdBarrier bar = xcd_barrier_post((unsigned*)(ws + WS_CTL) + 4096, MISC + 8, TIDV() == 0);
    if (args.ph_hi > 1000) grid.sync();
#define SEAM(k) do { if (lo <= (k) && (k) + 1 < hi) xcd_barrier(bar, TIDV() == 0); } while (0)
#ifndef PHMASK
#define PHMASK 0xFFF
#endif
#define IN(k) (((PHMASK >> (k)) & 1) && lo <= (k) && (k) < hi)
#ifndef REPMASK
#define REPMASK 0
#endif
#define REPS(k) for (int rep_ = 0; rep_ < ((((REPMASK) >> (k)) & 1) ? 2 : 1); ++rep_)

    if (IN(0)) REPS(0) {
        const int tid = TIDV(), lane = tid & 63, wave = g_wv;
        const int vcu = (G % 8 == 0) ? (bx % 8) * (G / 8) + bx / 8 : bx;
        const int gw = vcu * NWAVES + wave, NGW = G * NWAVES;
        LAS float* scr = (LAS float*)((LAS unsigned char*)lds + wave * 16384);
        constexpr int I_IN = 16 * 104, I_Q = 6 * 32, I_KV = 4 * 32, I_OUT = 16 * 32, I_UP = 16 * 128, I_DN = 64 * 32;
        constexpr int NITEMS = I_IN + I_Q + I_KV + I_OUT + I_UP + I_DN;
        const int l31 = lane & 31;
        for (int it = gw; it < NITEMS; it += NGW) {
            int r = it;
            if (r < I_IN) { const int kb = r / 104, nb = r % 104, nd = 32 * nb + l31; const int sc = nd < C_KR ? nd : (nd < DIN ? C_KR + rope_perm(nd - C_KR) : -1);
                tr_item(w_in, DIN, 64 * kb, sc, g_mix, 0, WIN, DM, 64 * kb, 32 * nb, scr, lane); continue; } r -= I_IN;
            if (r < I_Q) { const int kb = r / 32, nb = r % 32, nd = 32 * nb + l31, hh = nd >> 8, c = nd & 255; const int sc = c < 128 ? hh * 192 + c : (c < 192 ? hh * 192 + 128 + rope_perm(c - 128) : -1);
                tr_item(w_q_up, NQ, 64 * kb, sc, g_cq, 0, WQ, QLORA, 64 * kb, 32 * nb, scr, lane); continue; } r -= I_Q;
            if (r < I_KV) { const int kb = r / 32, nb = r % 32; tr_item(w_kv_up, NKV, 64 * kb, 32 * nb + l31, g_ckv, 0, WKV, KVLORA, 64 * kb, 32 * nb, scr, lane); continue; } r -= I_KV;
            if (r < I_OUT) { const int kb = r / 32, nb = r % 32; const int kd0 = 64 * kb, ks0 = kd0 < 512 ? kd0 + 512 : kd0 - 512;
                tr_item(w_out, DM, ks0, 32 * nb + l31, kd0 < 512 ? g_mla_out : nullptr, 512, WOUT, DM, kd0, 32 * nb, scr, lane); continue; } r -= I_OUT;
            if (r < I_UP) { const int kb = r / 128, nb = r % 128; tr_item(w_up, DFF, 64 * kb, 32 * nb + l31, g_ffn, 0, WUP, DM, 64 * kb, 32 * nb, scr, lane); continue; } r -= I_UP;
            { const int kb = r / 32, nb = r % 32; tr_item(w_down, DM, 64 * kb, 32 * nb + l31, nullptr, 0, WDN, DFF, 64 * kb, 32 * nb, scr, lane); }
        }
        for (int i = bx * 512 + tid; i < 512; i += G * 512) ((float*)(ws + WS_GHT))[i] = g_hgrn[i];
        for (int i = bx * 512 + tid; i < 512; i += G * 512) {
            if (i < 256) GQT[i] = i < 128 ? g_qn[i] * QSCALE : (i < 192 ? g_qn[128 + rope_perm(i - 128)] * QSCALE : 0.f);
            else { const int c = i - 256; if (c < 192) GKT[c] = c < 128 ? g_kn[c] : g_kn[128 + rope_perm(c - 128)]; } }
        for (int m = gw; m < M; m += 4 * NGW) rows_to_bf16_rs<4>(x + (size_t)m * DM, XB + (size_t)m * DM, RS0 + m, (size_t)NGW, lane);
        for (int i = bx * 512 + tid; i < 1024; i += G * 512) { const int dir = i >> 9, c = i & 511; const float p0 = lb_param[dir * 1024 + c], p1 = lb_param[dir * 1024 + 512 + c];
            LBT[i] = 1.f / (1.f + expf(p1 - p0)); }
        { const int j = tid & 31; const float invf = powf(10000.0f, -(float)(2 * j) / 64.0f);
          for (int i = bx * 512 + tid; i < M * 32; i += G * 512) { const int row = i >> 5; const float ang = (float)positions[row] * invf; float c, sn; sincos_acc(ang, c, sn); COS[i] = c; SIN[i] = sn; } }
    }
    SEAM(0);
    if (IN(1)) REPS(1) {
        pg8::Gemm g{XB, WIN, M, DINP, DM, DM}; pg8::StaticOrder S; S.init(M, DINP, G, bx);
        LAS float* rsT = (LAS float*)((LAS unsigned char*)lds + TAB_OFF);
        for (int ui = 0; ui < 16; ++ui) { pg8::Unit uu; if (!S.next(ui, uu)) break; const int tid = TIDV(); if (tid < 256) rsT[ui * 256 + tid] = RS0[uu.pm * 256 + tid]; }
        __syncthreads();
        pg8::EpiProj E{PROJ, DINP, rsT, LBT, SSQP, M, (LAS float*)((LAS unsigned char*)lds + EPI_OFF)};
        pg8::gemm_phase<pg8::EpiProj, pg8::StaticOrder, true, true>((LAS unsigned char*)lds, g, S, E, g_wv);
    }
    SEAM(1);
    if (IN(2)) REPS(2) {
        pg8::Gemm g{PROJ + C_CQ, WQ, M, 1024, QLORA, DINP}; pg8::StaticOrder S; S.init(M, 1024, G, bx);
        LAS float* rsT = (LAS float*)((LAS unsigned char*)lds + TAB_OFF);
        for (int ui = 0; ui < 4; ++ui) { pg8::Unit uu; if (!S.next(ui, uu)) break;
            const int tid = TIDV(); if (tid < 256) { const int row = uu.pm * 256 + tid; rsT[ui * 256 + tid] = __builtin_amdgcn_rsqf(((SSQP[row] + SSQP[M + row]) + SSQP[2 * (size_t)M + row]) * (1.f / 384.f) + EPS); } }
        __syncthreads();
        pg8::EpiQ E{QB, rsT, GQT, COS, SIN, (LAS float*)((LAS unsigned char*)lds + EPI_OFF)};
        pg8::gemm_phase<pg8::EpiQ, pg8::StaticOrder, true, true>((LAS unsigned char*)lds, g, S, E, g_wv);
    }
    if (IN(3)) REPS(3) {
        pg8::Gemm g{PROJ + C_CKV, WKV, M, NKV, KVLORA, DINP}; pg8::StaticOrder S; S.init(M, NKV, G, bx);
        LAS float* rsT = (LAS float*)((LAS unsigned char*)lds + TAB_OFF + 8192); LAS float* skT = rsT + 1024;
        for (int ui = 0; ui < 4; ++ui) { pg8::Unit uu; if (!S.next(ui, uu)) break;
            const int tid = TIDV(); if (tid < 256) { const int row = uu.pm * 256 + tid; rsT[ui * 256 + tid] = __builtin_amdgcn_rsqf((SSQP[3 * (size_t)M + row] + SSQP[4 * (size_t)M + row]) * (1.f / 256.f) + EPS); skT[ui * 256 + tid] = SSQP[5 * (size_t)M + row]; } }
        __syncthreads();
        pg8::EpiKV E{KB, VB, PROJ, DINP, C_KR, rsT, skT, GKT, COS, SIN, (LAS float*)((LAS unsigned char*)lds + EPI_OFF)};
        pg8::gemm_phase<pg8::EpiKV, pg8::StaticOrder, true, true>((LAS unsigned char*)lds, g, S, E, g_wv);
    }
    SEAM(4);
    if (IN(5)) {
        if (bx < BATCH * 4) hg::hgrn_bh(bx >> 2, bx & 3, PROJ, MIX, (const float*)(ws + WS_GHT) + (bx & 3) * 128, (char*)lds, g_wv);
        { const int a = bx & 127, bhs = (a >> 6) * 8 + (a & 7), qb = (a >> 3) & 7;
          att::attn_chain(QB, KB, VB, MIX, DM, SSQA, bhs, qb, bx < BATCH * 4 ? 7 : 0, bx < BATCH * 4 ? 8 : 7, SEQ, M, (char*)lds, g_wv); }
    }
    SEAM(7);
    if (IN(8)) REPS(8) {
        pg8::Gemm g{MIX, WOUT, M, DM, DM, DM}; pg8::StaticOrder S; S.init(M, DM, G, bx);
        LAS float* rsbT = (LAS float*)((LAS unsigned char*)lds + EPI_OFF + 4096);
        for (int ui = 0; ui < 4; ++ui) { pg8::Unit uu; if (!S.next(ui, uu)) break;
            const int tid = TIDV(); if (tid < 256) { const int row = uu.pm * 256 + tid; rsbT[ui * 256 + tid] = 1.f / sqrtf(((SSQA[row] + SSQA[M + row]) + (SSQA[2 * (size_t)M + row] + SSQA[3 * (size_t)M + row])) * (1.f / 512.f) + EPS); } }
        __syncthreads();
        pg8::EpiResidX1 E{XB, X1B, SSQ1, DM, M, (LAS float*)((LAS unsigned char*)lds + EPI_OFF), rsbT};
        pg8::gemm_phase<pg8::EpiResidX1, pg8::StaticOrder, true, true>((LAS unsigned char*)lds, g, S, E, g_wv);
    }
    SEAM(8);
    if (IN(10)) REPS(10) {
        pg8::Gemm g{X1B, WUP, M, DFF, DM, DM}; pg8::StaticOrder S; S.init(M, DFF, G, bx);
        LAS float* rsT = (LAS float*)((LAS unsigned char*)lds + TAB_OFF);
        for (int ui = 0; ui < 16; ++ui) { pg8::Unit uu; if (!S.next(ui, uu)) break;
            const int tid = TIDV(); if (tid < 256) { const int row = uu.pm * 256 + tid; rsT[ui * 256 + tid] = __builtin_amdgcn_rsqf(((SSQ1[row] + SSQ1[M + row]) + (SSQ1[2 * (size_t)M + row] + SSQ1[3 * (size_t)M + row])) * (1.f / 1024.f) + EPS); } }
        __syncthreads();
        pg8::EpiUp E{HB, DFF, rsT};
        pg8::gemm_phase<pg8::EpiUp, pg8::StaticOrder, true, true>((LAS unsigned char*)lds, g, S, E, g_wv);
    }
    SEAM(10);
    if (IN(11)) {
        pg8::Gemm g{HB, WDN, M, DM, DFF, DFF}; pg8::StaticOrder S; S.init(M, DM, G, bx);
        pg8::EpiResidBf E{X1B, out, DM};
        pg8::gemm_phase<pg8::EpiResidBf, pg8::StaticOrder, true, true>((LAS unsigned char*)lds, g, S, E, g_wv);
    }
#undef IN
}

extern "C" void kernel_launch(void* const* d_in, const int* in_sizes, int n_in, void* d_out, int out_size, void* d_ws, size_t ws_size, hipStream_t stream) {
    static int ok = 0, grid_blocks = 0;
    if (ok == 0) {
        if (n_in != 17 || in_sizes[0] != M * DM || out_size != M * DM || ws_size < WS_END) {
            fprintf(stderr, "kernel_launch: shape mismatch n_in %d in0 %d out %d ws %zu (need %zu)\n", n_in, n_in > 0 ? in_sizes[0] : -1, out_size, ws_size, (size_t)WS_END); ok = -1; return; }
        if (hipFuncSetAttribute((const void*)mk_fwd, hipFuncAttributeMaxDynamicSharedMemorySize, LDS_BYTES) != hipSuccess) { fprintf(stderr, "kernel_launch: hipFuncSetAttribute failed\n"); ok = -1; return; }
        int dev = 0, cus = 0, per_cu = 0;
        (void)hipGetDevice(&dev); (void)hipDeviceGetAttribute(&cus, hipDeviceAttributeMultiprocessorCount, dev);
        (void)hipOccupancyMaxActiveBlocksPerMultiprocessor(&per_cu, (const void*)mk_fwd, NWAVES * 64, LDS_BYTES);
        if (per_cu < 1 || cus < 1) { fprintf(stderr, "kernel_launch: occupancy query gave %d blocks/CU on %d CUs\n", per_cu, cus); ok = -1; return; }
        grid_blocks = cus * (per_cu > 1 ? 1 : per_cu);
        ok = 1;
    }
    if (ok < 0) return;
    (void)hipMemsetAsync((char*)d_ws + WS_CTL, 0, CTL_ZERO_BYTES, stream);
    Args a{};
    for (int i = 0; i < 17; ++i) a.in[i] = (const float*)d_in[i];
    a.out = (float*)d_out; a.ws = (unsigned char*)d_ws;
    a.ph_lo = 0; a.ph_hi = 12;
    void* kargs[] = {&a};
    (void)hipLaunchCooperativeKernel((const void*)mk_fwd, dim3(grid_blocks), dim3(NWAVES * 64), kargs, LDS_BYTES, stream);
    const hipError_t le = hipPeekAtLastError();
    if (le != hipSuccess) fprintf(stderr, "kernel_launch: launch failed: %s\n", hipGetErrorName(le));
}
```

```cpp
#include <hip/hip_runtime.h>
#include <hip/hip_cooperative_groups.h>
#include <cstdio>
#include <cstdint>

#define LAS __attribute__((address_space(3)))
typedef unsigned short bf16_t;
typedef short bf16x8 __attribute__((ext_vector_type(8)));
typedef short s16x4 __attribute__((ext_vector_type(4)));
typedef float f32x4 __attribute__((ext_vector_type(4)));
typedef float f32x16 __attribute__((ext_vector_type(16)));
typedef unsigned u32x4 __attribute__((ext_vector_type(4)));
typedef unsigned u32x2 __attribute__((ext_vector_type(2)));
typedef _Float16 h16x2 __attribute__((ext_vector_type(2)));

constexpr int BATCH = 32, SEQ = 2048, DM = 1024, M = BATCH * SEQ;
constexpr int DIN = 3264, DINP = 3328, DFF = 4096;
constexpr int C_Q = 0, C_FF = 512, C_I = 1536, C_G = 2048, C_CQ = 2560, C_CKV = 2944, C_KR = 3200;
constexpr int QLORA = 384, KVLORA = 256, NQ = 768, NKV = 1024;
constexpr float EPS = 1e-6f;
constexpr float QSCALE = 0.07216878364870322f * 1.4426950408889634f;

constexpr size_t MiB = 1u << 20;
constexpr size_t WS_CTL = 0;
constexpr size_t WS_RS0 = 1 * MiB, WS_RS1 = WS_RS0 + 256 * 1024, WS_LBT = WS_RS1 + 256 * 1024;
constexpr size_t WS_COS = 2 * MiB, WS_SIN = 10 * MiB;
constexpr size_t WS_WIN = 18 * MiB, WS_WQ = 25 * MiB, WS_WKV = 26 * MiB, WS_WOUT = 27 * MiB, WS_WUP = 29 * MiB, WS_WDN = 37 * MiB;
constexpr size_t WS_GQT = WS_LBT + 4096, WS_GKT = WS_GQT + 1024, WS_GHT = WS_GKT + 1024;
constexpr size_t WS_SSQ1 = 45 * MiB;
constexpr size_t WS_XB = 46 * MiB;
constexpr size_t WS_X1B = 718 * MiB;
constexpr size_t WS_PROJ = 174 * MiB;
constexpr size_t WS_HB = 174 * MiB;
constexpr size_t WS_MIX = 590 * MiB;
constexpr size_t WS_Q = 718 * MiB, WS_K = 814 * MiB, WS_V = 910 * MiB;
constexpr size_t WS_SSQP = 974 * MiB;
constexpr size_t WS_SSQA = 976 * MiB;
constexpr size_t WS_END = 977 * MiB;

__device__ __forceinline__ unsigned f2bf(float f) { unsigned u = __builtin_bit_cast(unsigned, f); return (u + 0x7fffu + ((u >> 16) & 1u)) >> 16; }
__device__ __forceinline__ unsigned pk2(float lo, float hi) { return f2bf(lo) | (f2bf(hi) << 16); }
__device__ __forceinline__ float bf2f(unsigned short b) { return __builtin_bit_cast(float, (unsigned)b << 16); }
__device__ __forceinline__ float bflo(unsigned w) { return __builtin_bit_cast(float, w << 16); }
__device__ __forceinline__ float bfhi(unsigned w) { return __builtin_bit_cast(float, w & 0xffff0000u); }
__device__ __forceinline__ float wave_sum(float v) {
#pragma unroll
    for (int o = 1; o < 64; o <<= 1) v += __shfl_xor(v, o);
    return v;
}
__device__ __forceinline__ int lane_id() { int l; asm volatile("v_mbcnt_lo_u32_b32 %0, -1, 0\n\tv_mbcnt_hi_u32_b32 %0, -1, %0" : "=v"(l)); return l; }
__device__ __forceinline__ float dpp_sum8(float v) {
    v += __builtin_bit_cast(float, __builtin_amdgcn_update_dpp(0, __builtin_bit_cast(int, v), 0xB1, 0xF, 0xF, true));
    v += __builtin_bit_cast(float, __builtin_amdgcn_update_dpp(0, __builtin_bit_cast(int, v), 0x4E, 0xF, 0xF, true));
    v += __builtin_bit_cast(float, __builtin_amdgcn_update_dpp(0, __builtin_bit_cast(int, v), 0x141, 0xF, 0xF, true));
    return v;
}
typedef float f32x2_t __attribute__((ext_vector_type(2))); typedef __bf16 bf16x2_t __attribute__((ext_vector_type(2)));
__device__ __forceinline__ unsigned cvtpk(float lo, float hi) { f32x2_t v = {lo, hi}; bf16x2_t b = __builtin_convertvector(v, bf16x2_t); return __builtin_bit_cast(unsigned, b); }
__device__ __forceinline__ unsigned cvt_pk_bf16(float lo, float hi) { unsigned r; asm volatile("v_cvt_pk_bf16_f32 %0, %1, %2" : "=v"(r) : "v"(lo), "v"(hi)); return r; }

namespace pg8 {
#define PG8_LAS __attribute__((address_space(3)))
constexpr int BM = 256, BK = 64, HALF = 128, HTB = HALF * BK * 2, STAGE_BYTES = 8 * HTB, NXCD = 8, WGM = 8;
__host__ __device__ __forceinline__ int lds_byte(int r, int c) { const int st = (r >> 4) * 2 + (c >> 5), rr = r & 15, cc = c & 31, ob = rr * 64 + cc * 2; return st * 1024 + (ob ^ (((ob >> 9) & 1) << 5)); }
__host__ __device__ __forceinline__ void stage_rc(int b, int& R, int& C) { const int st = b / 1024, sb = b % 1024, swz = sb ^ (((sb >> 9) & 1) << 5); R = (st >> 1) * 16 + swz / 64; C = (st & 1) * 32 + (swz % 64) / 2; }
__host__ __device__ __forceinline__ int perm32(int rho) { const int n = rho >> 4, i = rho & 15; return 8 * (i >> 2) + 4 * n + (i & 3); }
struct Unit { int pm, pn; };
struct Gemm { const bf16_t* A; const bf16_t* Bt; int M, N, K, lda; };
struct StaticOrder {
    int nM, nN, nwg, G, c;
    __host__ __device__ __forceinline__ void init(int M_, int N_, int G_, int c_) { nM = M_ / BM; nN = N_ / BM; nwg = nM * nN; G = G_; c = c_; }
    __host__ __device__ __forceinline__ bool next(int i, Unit& u) const {
        const long L = (long)i * G + c; if (L >= nwg) return false;
        int wgid = (int)L; { const int q = nwg / NXCD, r = nwg % NXCD, xcd = wgid % NXCD, off = wgid / NXCD; wgid = (xcd < r ? xcd * (q + 1) : r * (q + 1) + (xcd - r) * q) + off; }
        const int nig = WGM * nN, gid = wgid / nig, fm = gid * WGM, gsz = (nM - fm) < WGM ? (nM - fm) : WGM;
        u.pm = fm + ((wgid % nig) % gsz); u.pn = (wgid % nig) / gsz; return true;
    }
    __device__ __forceinline__ void a_ready(const Unit&) const {}
    __device__ __forceinline__ void done(const Unit&) const {}
};
typedef f32x4 Acc[2][2][4][2];

struct EpiBf16 {
    static constexpr bool PERM = true, AFTER_DRAIN = false; static constexpr int MIDK = 0;
    bf16_t* O; int ldc;
    __device__ __forceinline__ void operator()(const Acc& acc, const Unit& u, int wr, int wc, int fr, int fq, int ui) const {
        const int row0 = u.pm * BM + wr * 64 + fr, col0 = u.pn * BM + wc * 32 + 8 * fq;
#pragma unroll
        for (int ai = 0; ai < 2; ++ai)
#pragma unroll
            for (int m = 0; m < 4; ++m) { bf16_t* rowp = O + (size_t)(row0 + ai * HALF + m * 16) * ldc + col0;
#pragma unroll
                for (int bj = 0; bj < 2; ++bj) { const f32x4 v0 = acc[ai][bj][m][0], v1 = acc[ai][bj][m][1];
                    u32x4 w; w.x = cvt_pk_bf16(v0[0], v0[1]); w.y = cvt_pk_bf16(v0[2], v0[3]); w.z = cvt_pk_bf16(v1[0], v1[1]); w.w = cvt_pk_bf16(v1[2], v1[3]);
                    *(u32x4*)(rowp + bj * HALF) = w; } }
    }
};
struct EpiProj {
    static constexpr bool PERM = true, AFTER_DRAIN = false; static constexpr int MIDK = 0;
    bf16_t* O; int ldc; const PG8_LAS float* rsT; const float* lbt; float* ssqp; int Mrows; PG8_LAS float* red;
    __device__ __forceinline__ void operator()(const Acc& acc, const Unit& u, int wr, int wc, int fr, int fq, int ui) const {
        const int row0 = u.pm * BM + wr * 64 + fr, col0 = u.pn * BM + wc * 32 + 8 * fq;
        const bool gate = (u.pn >= 2 && u.pn < 6), stat = (u.pn >= 10);
        f32x4 lb[2][2];
#pragma unroll
        for (int bj = 0; bj < 2; ++bj)
#pragma unroll
            for (int n = 0; n < 2; ++n) lb[bj][n] = gate ? *(const f32x4*)(lbt + (col0 - 512) + bj * HALF + 4 * n) : (f32x4){0.f, 0.f, 0.f, 0.f};
#pragma unroll
        for (int ai = 0; ai < 2; ++ai)
#pragma unroll
            for (int m = 0; m < 4; ++m) { const int row = row0 + ai * HALF + m * 16; const float r = rsT[ui * BM + ai * HALF + wr * 64 + m * 16 + fr]; bf16_t* rowp = O + (size_t)row * ldc + col0; float sq[2];
#pragma unroll
                for (int bj = 0; bj < 2; ++bj) { f32x4 v0 = acc[ai][bj][m][0] * r, v1 = acc[ai][bj][m][1] * r; u32x4 w;
                    sq[bj] = ((v0[0] * v0[0] + v0[1] * v0[1]) + (v0[2] * v0[2] + v0[3] * v0[3])) + ((v1[0] * v1[0] + v1[1] * v1[1]) + (v1[2] * v1[2] + v1[3] * v1[3]));
                    if (gate) {
#pragma unroll
                        for (int e = 0; e < 4; ++e) { const float s0 = __builtin_amdgcn_rcpf(1.f + __builtin_amdgcn_exp2f(-1.4426950408889634f * v0[e])), s1 = __builtin_amdgcn_rcpf(1.f + __builtin_amdgcn_exp2f(-1.4426950408889634f * v1[e]));
                            v0[e] = __builtin_amdgcn_logf(lb[bj][0][e] + (1.f - lb[bj][0][e]) * s0); v1[e] = __builtin_amdgcn_logf(lb[bj][1][e] + (1.f - lb[bj][1][e]) * s1); }
                        h16x2 a = {(_Float16)v0[0], (_Float16)v0[1]}, b = {(_Float16)v0[2], (_Float16)v0[3]}, c = {(_Float16)v1[0], (_Float16)v1[1]}, d = {(_Float16)v1[2], (_Float16)v1[3]};
                        w.x = __builtin_bit_cast(unsigned, a); w.y = __builtin_bit_cast(unsigned, b); w.z = __builtin_bit_cast(unsigned, c); w.w = __builtin_bit_cast(unsigned, d);
                    } else { w.x = cvt_pk_bf16(v0[0], v0[1]); w.y = cvt_pk_bf16(v0[2], v0[3]); w.z = cvt_pk_bf16(v1[0], v1[1]); w.w = cvt_pk_bf16(v1[2], v1[3]); }
                    *(u32x4*)(rowp + bj * HALF) = w; }
                if (stat) { sq[0] += __shfl_xor(sq[0], 16); sq[0] += __shfl_xor(sq[0], 32); sq[1] += __shfl_xor(sq[1], 16); sq[1] += __shfl_xor(sq[1], 32);
                    if (fq == 0) { PG8_LAS float* rp = red + (ai * HALF + wr * 64 + m * 16 + fr) * 8 + wc * 2; rp[0] = sq[0]; rp[1] = sq[1]; } } }
        if (stat) {
            asm volatile("s_waitcnt lgkmcnt(0)" ::: "memory"); __builtin_amdgcn_s_barrier(); asm volatile("" ::: "memory");
            const int t = (wr * 4 + wc) * 64 + fq * 16 + fr;
            if (t < 256) { const f32x4 q0 = *(const PG8_LAS f32x4*)(red + t * 8), q1 = *(const PG8_LAS f32x4*)(red + t * 8 + 4);
                float* dst = ssqp + (size_t)((u.pn - 10) * 2) * Mrows + u.pm * BM + t; dst[0] = (q0[0] + q0[2]) + (q1[0] + q1[2]); dst[Mrows] = (q0[1] + q0[3]) + (q1[1] + q1[3]); }
            asm volatile("s_waitcnt lgkmcnt(0)" ::: "memory"); __builtin_amdgcn_s_barrier(); asm volatile("" ::: "memory");
        }
    }
};
struct EpiQ {
    static constexpr bool PERM = true, AFTER_DRAIN = false; static constexpr int MIDK = 0;
    bf16_t* Q; const PG8_LAS float* rsT; const float* gq; const float* cosT; const float* sinT; PG8_LAS float* red;
    __device__ __forceinline__ void operator()(const Acc& acc, const Unit& u, int wr, int wc, int fr, int fq, int ui) const {
        const int h = u.pn, cl = wc * 32 + 8 * fq, ic = 4 * wc + fq;
        f32x4 cs[2][4], sn[2][4];
        if (wc < 2) {
#pragma unroll
            for (int ai = 0; ai < 2; ++ai)
#pragma unroll
                for (int m = 0; m < 4; ++m) { const size_t row = (size_t)(u.pm * BM + ai * HALF + wr * 64 + m * 16 + fr);
                    cs[ai][m] = *(const f32x4*)(cosT + row * 32 + 4 * ic); sn[ai][m] = *(const f32x4*)(sinT + row * 32 + 4 * ic); }
        }
        const f32x4 g00 = *(const f32x4*)(gq + cl), g01 = *(const f32x4*)(gq + cl + 4), g10 = *(const f32x4*)(gq + 128 + cl), g11 = *(const f32x4*)(gq + 128 + cl + 4);
#pragma unroll
        for (int ai = 0; ai < 2; ++ai)
#pragma unroll
            for (int m = 0; m < 4; ++m) { float s = 0.f;
#pragma unroll
                for (int bj = 0; bj < 2; ++bj)
#pragma unroll
                    for (int n = 0; n < 2; ++n) { const f32x4 v = acc[ai][bj][m][n]; s += (v[0] * v[0] + v[1] * v[1]) + (v[2] * v[2] + v[3] * v[3]); }
                s += __shfl_xor(s, 16); s += __shfl_xor(s, 32);
                if (fq == 0) red[(ai * HALF + wr * 64 + m * 16 + fr) * 4 + wc] = s; }
        asm volatile("s_waitcnt lgkmcnt(0)" ::: "memory"); __builtin_amdgcn_s_barrier(); asm volatile("" ::: "memory");
#pragma unroll
        for (int ai = 0; ai < 2; ++ai)
#pragma unroll
            for (int m = 0; m < 4; ++m) { const int rowl = ai * HALF + wr * 64 + m * 16 + fr, row = u.pm * BM + rowl;
                const f32x4 q4 = *(const PG8_LAS f32x4*)(red + rowl * 4); const float ssx = (q4[0] + q4[1]) + (q4[2] + q4[3]);
                const float rs = rsT[ui * BM + rowl];
                const float sc = rs * __builtin_amdgcn_rsqf(rs * rs * ssx * (1.f / 192.f) + 1e-6f);
                bf16_t* dst = Q + ((size_t)((row >> 11) * 4 + h) * 2048 + (row & 2047)) * 192 + cl;
                { const f32x4 v0 = acc[ai][0][m][0] * sc * g00, v1 = acc[ai][0][m][1] * sc * g01; u32x4 w; w.x = cvt_pk_bf16(v0[0], v0[1]); w.y = cvt_pk_bf16(v0[2], v0[3]); w.z = cvt_pk_bf16(v1[0], v1[1]); w.w = cvt_pk_bf16(v1[2], v1[3]); *(u32x4*)dst = w; }
                if (wc < 2) { const f32x4 t1 = acc[ai][1][m][0] * sc * g10, t2 = acc[ai][1][m][1] * sc * g11;
                    const f32x4 o1 = t1 * cs[ai][m] - t2 * sn[ai][m], o2 = t2 * cs[ai][m] + t1 * sn[ai][m];
                    u32x4 w; w.x = cvt_pk_bf16(o1[0], o1[1]); w.y = cvt_pk_bf16(o1[2], o1[3]); w.z = cvt_pk_bf16(o2[0], o2[1]); w.w = cvt_pk_bf16(o2[2], o2[3]); *(u32x4*)(dst + 128) = w; } }
    }
};
struct EpiKV {
    static constexpr bool PERM = true, AFTER_DRAIN = false; static constexpr int MIDK = 0;
    bf16_t* K; bf16_t* V; const bf16_t* proj; int ldp; int ckr; const PG8_LAS float* rsT; const PG8_LAS float* skT; const float* gk; const float* cosT; const float* sinT; PG8_LAS float* red;
    __device__ __forceinline__ void operator()(const Acc& acc, const Unit& u, int wr, int wc, int fr, int fq, int ui) const {
        const int h = u.pn, cl = wc * 32 + 8 * fq, ic = 4 * wc + fq;
#pragma unroll
        for (int ai = 0; ai < 2; ++ai)
#pragma unroll
            for (int m = 0; m < 4; ++m) { float s = 0.f;
#pragma unroll
                for (int n = 0; n < 2; ++n) { const f32x4 v = acc[ai][0][m][n]; s += (v[0] * v[0] + v[1] * v[1]) + (v[2] * v[2] + v[3] * v[3]); }
                s += __shfl_xor(s, 16); s += __shfl_xor(s, 32);
                if (fq == 0) red[(ai * HALF + wr * 64 + m * 16 + fr) * 4 + wc] = s; }
        const f32x4 g0 = *(const f32x4*)(gk + cl), g1 = *(const f32x4*)(gk + cl + 4);
        f32x4 gr0 = {0.f, 0.f, 0.f, 0.f}, gr1 = {0.f, 0.f, 0.f, 0.f};
        if (wc < 2) { gr0 = *(const f32x4*)(gk + 128 + 8 * ic); gr1 = *(const f32x4*)(gk + 128 + 8 * ic + 4); }
        asm volatile("s_waitcnt lgkmcnt(0)" ::: "memory"); __builtin_amdgcn_s_barrier(); asm volatile("" ::: "memory");
#pragma unroll
        for (int ai = 0; ai < 2; ++ai) {
            u32x4 kr[4]; f32x4 cs[4], sn[4];
            if (wc < 2) {
#pragma unroll
                for (int m = 0; m < 4; ++m) { const size_t row = (size_t)(u.pm * BM + ai * HALF + wr * 64 + m * 16 + fr);
                    kr[m] = *(const u32x4*)(proj + row * ldp + ckr + 8 * ic); cs[m] = *(const f32x4*)(cosT + row * 32 + 4 * ic); sn[m] = *(const f32x4*)(sinT + row * 32 + 4 * ic); }
            }
#pragma unroll
            for (int m = 0; m < 4; ++m) { const int rowl = ai * HALF + wr * 64 + m * 16 + fr, row = u.pm * BM + rowl;
                const f32x4 q4 = *(const PG8_LAS f32x4*)(red + rowl * 4); const float ssk = (q4[0] + q4[1]) + (q4[2] + q4[3]);
                const float rsc = rsT[ui * BM + rowl], skr = skT[ui * BM + rowl];
                const float r = __builtin_amdgcn_rsqf((rsc * rsc * ssk + skr) * (1.f / 192.f) + 1e-6f);
                const size_t tok = (size_t)((row >> 11) * 4 + h) * 2048 + (row & 2047);
                bf16_t* kd = K + tok * 192; bf16_t* vd = V + tok * 128;
                { const float sc = rsc * r; const f32x4 v0 = acc[ai][0][m][0] * sc * g0, v1 = acc[ai][0][m][1] * sc * g1; u32x4 w; w.x = cvt_pk_bf16(v0[0], v0[1]); w.y = cvt_pk_bf16(v0[2], v0[3]); w.z = cvt_pk_bf16(v1[0], v1[1]); w.w = cvt_pk_bf16(v1[2], v1[3]); *(u32x4*)(kd + cl) = w; }
                { const f32x4 v0 = acc[ai][1][m][0] * rsc, v1 = acc[ai][1][m][1] * rsc; u32x4 w; w.x = cvt_pk_bf16(v0[0], v0[1]); w.y = cvt_pk_bf16(v0[2], v0[3]); w.z = cvt_pk_bf16(v1[0], v1[1]); w.w = cvt_pk_bf16(v1[2], v1[3]); *(u32x4*)(vd + cl) = w; }
                if (wc < 2) { const f32x4 t1 = (f32x4){bflo(kr[m].x), bfhi(kr[m].x), bflo(kr[m].y), bfhi(kr[m].y)} * gr0 * r, t2 = (f32x4){bflo(kr[m].z), bfhi(kr[m].z), bflo(kr[m].w), bfhi(kr[m].w)} * gr1 * r;
                    const f32x4 o1 = t1 * cs[m] - t2 * sn[m], o2 = t2 * cs[m] + t1 * sn[m];
                    u32x4 w; w.x = cvt_pk_bf16(o1[0], o1[1]); w.y = cvt_pk_bf16(o1[2], o1[3]); w.z = cvt_pk_bf16(o2[0], o2[1]); w.w = cvt_pk_bf16(o2[2], o2[3]); *(u32x4*)(kd + 128 + 8 * ic) = w; } }
        }
    }
};
struct EpiUp {
    static constexpr bool PERM = true, AFTER_DRAIN = false; static constexpr int MIDK = 0;
    bf16_t* O; int ldc; const PG8_LAS float* rsT;
    __device__ __forceinline__ void operator()(const Acc& acc, const Unit& u, int wr, int wc, int fr, int fq, int ui) const {
        const int row0 = u.pm * BM + wr * 64 + fr, col0 = u.pn * BM + wc * 32 + 8 * fq;
#pragma unroll
        for (int ai = 0; ai < 2; ++ai)
#pragma unroll
            for (int m = 0; m < 4; ++m) { const int row = row0 + ai * HALF + m * 16; const float r = rsT[ui * BM + ai * HALF + wr * 64 + m * 16 + fr]; bf16_t* rowp = O + (size_t)row * ldc + col0;
#pragma unroll
                for (int bj = 0; bj < 2; ++bj) { f32x4 v0 = acc[ai][bj][m][0] * r, v1 = acc[ai][bj][m][1] * r;
#pragma unroll
                    for (int e = 0; e < 4; ++e) { const float a = fmaxf(v0[e], 0.f), b = fmaxf(v1[e], 0.f); v0[e] = a * a; v1[e] = b * b; }
                    u32x4 w; w.x = cvt_pk_bf16(v0[0], v0[1]); w.y = cvt_pk_bf16(v0[2], v0[3]); w.z = cvt_pk_bf16(v1[0], v1[1]); w.w = cvt_pk_bf16(v1[2], v1[3]);
                    *(u32x4*)(rowp + bj * HALF) = w; } }
    }
};
struct EpiResid {
    static constexpr bool PERM = false, AFTER_DRAIN = false; static constexpr int MIDK = 0;
    const float* base; float* out; int ldc;
    __device__ __forceinline__ void operator()(const Acc& acc, const Unit& u, int wr, int wc, int fr, int fq, int ui) const {
        const int row0 = u.pm * BM + wr * 64 + fr, col0 = u.pn * BM + wc * 32 + 4 * fq;
#pragma unroll
        for (int ai = 0; ai < 2; ++ai)
#pragma unroll
            for (int m = 0; m < 4; ++m) { const size_t off = (size_t)(row0 + ai * HALF + m * 16) * ldc + col0;
#pragma unroll
                for (int bj = 0; bj < 2; ++bj)
#pragma unroll
                    for (int n = 0; n < 2; ++n) { const f32x4 bs = *(const f32x4*)(base + off + bj * HALF + n * 16); *(f32x4*)(out + off + bj * HALF + n * 16) = bs + acc[ai][bj][m][n]; } }
    }
};

struct EpiResidBf {
    static constexpr bool PERM = false, AFTER_DRAIN = false; static constexpr int MIDK = 0;
    const bf16_t* xb; float* out; int ldc;
    __device__ __forceinline__ void operator()(const Acc& acc, const Unit& u, int wr, int wc, int fr, int fq, int ui) const {
        const int row0 = u.pm * BM + wr * 64 + fr, col0 = u.pn * BM + wc * 32 + 4 * fq;
        u32x2 w[2][4][2][2];
#pragma unroll
        for (int ai = 0; ai < 2; ++ai)
#pragma unroll
            for (int m = 0; m < 4; ++m) { const size_t off = (size_t)(row0 + ai * HALF + m * 16) * ldc + col0;
#pragma unroll
                for (int bj = 0; bj < 2; ++bj)
#pragma unroll
                    for (int n = 0; n < 2; ++n) w[ai][m][bj][n] = *(const u32x2*)(xb + off + bj * HALF + n * 16); }
        __builtin_amdgcn_sched_barrier(0);
#pragma unroll
        for (int ai = 0; ai < 2; ++ai) {
#pragma unroll
            for (int m = 0; m < 4; ++m) { const size_t off = (size_t)(row0 + ai * HALF + m * 16) * ldc + col0;
#pragma unroll
                for (int bj = 0; bj < 2; ++bj)
#pragma unroll
                    for (int n = 0; n < 2; ++n) { const u32x2 ww = w[ai][m][bj][n]; const f32x4 bs = {bflo(ww.x), bfhi(ww.x), bflo(ww.y), bfhi(ww.y)}; *(f32x4*)(out + off + bj * HALF + n * 16) = bs + acc[ai][bj][m][n]; } }
        }
    }
};
struct EpiResidX1 {
    static constexpr bool PERM = false, AFTER_DRAIN = false; static constexpr int MIDK = 8;
    const bf16_t* base; bf16_t* xb; float* ssq; int ldc; int Mrows; PG8_LAS float* red; const PG8_LAS float* rsb;
    __device__ __forceinline__ void mid(Acc& acc, int ui, int wr, int fr) const {
#pragma unroll
        for (int ai = 0; ai < 2; ++ai)
#pragma unroll
            for (int m = 0; m < 4; ++m) { const float r = rsb[ui * BM + ai * HALF + wr * 64 + m * 16 + fr];
#pragma unroll
                for (int bj = 0; bj < 2; ++bj)
#pragma unroll
                    for (int n = 0; n < 2; ++n) acc[ai][bj][m][n] *= r; }
    }
    __device__ __forceinline__ void operator()(const Acc& acc, const Unit& u, int wr, int wc, int fr, int fq, int ui) const {
        const int row0 = u.pm * BM + wr * 64 + fr, col0 = u.pn * BM + wc * 32 + 4 * fq;
        u32x2 xr[2][4][2][2];
#pragma unroll
        for (int ai = 0; ai < 2; ++ai)
#pragma unroll
            for (int m = 0; m < 4; ++m) { const size_t off = (size_t)(row0 + ai * HALF + m * 16) * ldc + col0;
#pragma unroll
                for (int bj = 0; bj < 2; ++bj)
#pragma unroll
                    for (int n = 0; n < 2; ++n) xr[ai][m][bj][n] = *(const u32x2*)(base + off + bj * HALF + n * 16); }
        __builtin_amdgcn_sched_barrier(0);
#pragma unroll
        for (int ai = 0; ai < 2; ++ai) {
#pragma unroll
            for (int m = 0; m < 4; ++m) { const size_t off = (size_t)(row0 + ai * HALF + m * 16) * ldc + col0; float s = 0.f;
#pragma unroll
                for (int bj = 0; bj < 2; ++bj)
#pragma unroll
                    for (int n = 0; n < 2; ++n) { const u32x2 xw = xr[ai][m][bj][n]; const f32x4 v = (f32x4){bflo(xw.x), bfhi(xw.x), bflo(xw.y), bfhi(xw.y)} + acc[ai][bj][m][n];
                        u32x2 w; w.x = cvt_pk_bf16(v[0], v[1]); w.y = cvt_pk_bf16(v[2], v[3]); *(u32x2*)(xb + off + bj * HALF + n * 16) = w;
                        s += (v[0] * v[0] + v[1] * v[1]) + (v[2] * v[2] + v[3] * v[3]); }
                s += __shfl_xor(s, 16); s += __shfl_xor(s, 32);
                if (fq == 0) red[(ai * HALF + wr * 64 + m * 16 + fr) * 4 + wc] = s; }
        }
        asm volatile("s_waitcnt lgkmcnt(0)" ::: "memory"); __builtin_amdgcn_s_barrier(); asm volatile("" ::: "memory");
        const int t = (wr * 4 + wc) * 64 + fq * 16 + fr;
        if (t < 256) { const f32x4 q = *(const PG8_LAS f32x4*)(red + t * 4); ssq[(size_t)u.pn * Mrows + u.pm * BM + t] = (q[0] + q[1]) + (q[2] + q[3]); }
        asm volatile("s_waitcnt lgkmcnt(0)" ::: "memory"); __builtin_amdgcn_s_barrier(); asm volatile("" ::: "memory");
    }
};
template <class Epi, class Sched, bool ALIGN_EPI = false, bool SP2 = false>
__device__ __forceinline__ void gemm_phase(PG8_LAS unsigned char* lds, const Gemm g, const Sched& S, const Epi& E, int wv) {
    int lane = lane_id(); asm volatile("" : "+v"(lane));
    const int wid = wv, tid = wv * 64 + lane, wr = wid >> 2, wc = wid & 3, fr = lane & 15, fq = lane >> 4;
    const int K = g.K, nt = K / BK, lda = g.lda;
    unsigned voffA[2], voffB[2];
#pragma unroll
    for (int i = 0; i < 2; ++i) { int R, C; stage_rc(tid * 16 + i * 8192, R, C); const int Rb = Epi::PERM ? ((R & ~31) + perm32(R & 31)) : R;
        voffA[i] = (unsigned)(R * lda + C) * 2u; voffB[i] = (unsigned)(Rb * K + C) * 2u; }
    const size_t kstep = (size_t)(BK * 2);
    const size_t hstepA = (size_t)HALF * lda * 2, hstepB = (size_t)HALF * K * 2;
    const size_t tstepA = 2 * hstepA, tstepB = 2 * hstepB;
    const unsigned ldsw = (unsigned)wid * 1024u;
    const int aoff = lds_byte(wr * 64 + fr, fq * 8), boff = lds_byte(wc * 32 + fr, fq * 8);
#define PG8_SA(b, h) (((b) * 2 + (h)) * HTB)
#define PG8_SB(b, h) ((4 + (b) * 2 + (h)) * HTB)
#define PG8_STAGE(bufoff, gbase, voff) do { _Pragma("unroll") for (int _i = 0; _i < 2; ++_i) \
        __builtin_amdgcn_global_load_lds((const unsigned*)((const char*)(gbase) + (voff)[_i]), (PG8_LAS unsigned*)(lds + (bufoff) + ldsw + _i * 8192), 16, 0, 0); } while (0)
#define PG8_LDA(dst, b, h) do { _Pragma("unroll") for (int m = 0; m < 4; ++m) _Pragma("unroll") for (int k = 0; k < 2; ++k) dst[m][k] = *(const PG8_LAS bf16x8*)(lds + PG8_SA(b, h) + aoff + m * 2048 + k * 1024); } while (0)
#define PG8_LDB(dst, b, h) do { _Pragma("unroll") for (int n = 0; n < 2; ++n) _Pragma("unroll") for (int k = 0; k < 2; ++k) dst[n][k] = *(const PG8_LAS bf16x8*)(lds + PG8_SB(b, h) + boff + n * 2048 + k * 1024); } while (0)
#define PG8_MMA(ai, bj, At, Bt) do { __builtin_amdgcn_s_setprio(1); _Pragma("unroll") for (int m = 0; m < 4; ++m) _Pragma("unroll") for (int n = 0; n < 2; ++n) _Pragma("unroll") for (int k = 0; k < 2; ++k) \
        acc[ai][bj][m][n] = __builtin_amdgcn_mfma_f32_16x16x32_bf16(Bt[n][k], At[m][k], acc[ai][bj][m][n], 0, 0, 0); __builtin_amdgcn_s_setprio(0); } while (0)
#define PG8_WAIT_V(n) asm volatile("s_waitcnt vmcnt(" #n ")" ::: "memory")
#define PG8_WAIT_L(n) asm volatile("s_waitcnt lgkmcnt(" #n ")" ::: "memory")
#define PG8_BAR __builtin_amdgcn_s_barrier()
#define PG8_SCHED __builtin_amdgcn_sched_barrier(0)
    Unit cur, nxt; int ui = 0;
    if (!S.next(0, cur)) return;
    Acc acc;
#pragma unroll
    for (int a = 0; a < 2; ++a)
#pragma unroll
        for (int b = 0; b < 2; ++b)
#pragma unroll
            for (int m = 0; m < 4; ++m)
#pragma unroll
                for (int n = 0; n < 2; ++n) acc[a][b][m][n] = (f32x4){0.f, 0.f, 0.f, 0.f};
    bf16x8 At[4][2], B0[2][2], B1[2][2];
    const char* cA = (const char*)g.A + (size_t)cur.pm * tstepA; const char* cB = (const char*)g.Bt + (size_t)cur.pn * tstepB;
    S.a_ready(cur);
    if constexpr (SP2) {
        PG8_STAGE(PG8_SB(0, 0), cB, voffB); PG8_STAGE(PG8_SB(0, 1), cB + hstepB, voffB); PG8_STAGE(PG8_SA(0, 0), cA, voffA); PG8_STAGE(PG8_SA(0, 1), cA + hstepA, voffA);
        if (wr == 1) PG8_BAR;
        PG8_WAIT_V(2); PG8_BAR;
        PG8_STAGE(PG8_SB(1, 0), cB + kstep, voffB); PG8_STAGE(PG8_SA(1, 0), cA + kstep, voffA); PG8_STAGE(PG8_SB(1, 1), cB + hstepB + kstep, voffB);
        PG8_WAIT_V(6); PG8_BAR;
    } else {
        PG8_STAGE(PG8_SB(0, 0), cB, voffB); PG8_STAGE(PG8_SA(0, 0), cA, voffA); PG8_STAGE(PG8_SB(0, 1), cB + hstepB, voffB); PG8_STAGE(PG8_SA(0, 1), cA + hstepA, voffA);
        if (wr == 1) PG8_BAR;
        PG8_WAIT_V(4); PG8_BAR;
        PG8_STAGE(PG8_SB(1, 0), cB + kstep, voffB); PG8_STAGE(PG8_SA(1, 0), cA + kstep, voffA); PG8_STAGE(PG8_SB(1, 1), cB + hstepB + kstep, voffB);
        PG8_WAIT_V(6); PG8_BAR;
    }
    for (;;) {
        const bool has_next = S.next(ui + 1, nxt);
        const char* nA = has_next ? (const char*)g.A + (size_t)nxt.pm * tstepA : cA; const char* nB = has_next ? (const char*)g.Bt + (size_t)nxt.pn * tstepB : cB;
#pragma nounroll
        for (int t = 0; t < nt; t += 2) {
            const bool last = (t == nt - 2);
            const char* a1 = cA + (size_t)(t + 1) * kstep;
            const char* a2 = last ? nA : cA + (size_t)(t + 2) * kstep; const char* b2 = last ? nB : cB + (size_t)(t + 2) * kstep;
            const char* a3 = a2 + kstep; const char* b3 = b2 + kstep;
            if (last && has_next) S.a_ready(nxt);
            if constexpr (SP2) {
            PG8_LDB(B0, 0, 0); PG8_LDB(B1, 0, 1); PG8_SCHED; PG8_LDA(At, 0, 0); PG8_STAGE(PG8_SA(1, 1), a1 + hstepA, voffA);
            PG8_WAIT_V(8); PG8_WAIT_L(0); PG8_BAR; PG8_MMA(0, 0, At, B0); PG8_MMA(0, 1, At, B1); PG8_BAR; PG8_SCHED;
            PG8_LDA(At, 0, 1); PG8_STAGE(PG8_SB(0, 0), b2, voffB); PG8_STAGE(PG8_SB(0, 1), b2 + hstepB, voffB); PG8_STAGE(PG8_SA(0, 0), a2, voffA);
            PG8_WAIT_V(8); PG8_WAIT_L(0); PG8_BAR; PG8_MMA(1, 0, At, B0); PG8_MMA(1, 1, At, B1); PG8_BAR; PG8_SCHED;
            PG8_LDB(B0, 1, 0); PG8_LDB(B1, 1, 1); PG8_SCHED; PG8_LDA(At, 1, 0); PG8_STAGE(PG8_SA(0, 1), a2 + hstepA, voffA);
            PG8_WAIT_V(8); PG8_WAIT_L(0); PG8_BAR; PG8_MMA(0, 0, At, B0); PG8_MMA(0, 1, At, B1); PG8_BAR; PG8_SCHED;
            PG8_LDA(At, 1, 1); PG8_STAGE(PG8_SB(1, 0), b3, voffB); PG8_STAGE(PG8_SB(1, 1), b3 + hstepB, voffB); PG8_STAGE(PG8_SA(1, 0), a3, voffA);
            PG8_WAIT_V(8); PG8_WAIT_L(0); PG8_BAR; PG8_MMA(1, 0, At, B0); PG8_MMA(1, 1, At, B1); PG8_BAR; PG8_SCHED;
            if constexpr (Epi::MIDK > 0) { if (t + 2 == Epi::MIDK) { E.mid(acc, ui, wr, fr); PG8_SCHED; } }
            } else {
            PG8_LDB(B0, 0, 0); PG8_SCHED; PG8_LDA(At, 0, 0); PG8_STAGE(PG8_SA(1, 1), a1 + hstepA, voffA);
            PG8_WAIT_L(8); PG8_BAR; PG8_WAIT_L(0); PG8_MMA(0, 0, At, B0); PG8_BAR; PG8_SCHED;
            PG8_LDB(B1, 0, 1); PG8_STAGE(PG8_SB(0, 0), b2, voffB);
            PG8_BAR; PG8_WAIT_L(0); PG8_MMA(0, 1, At, B1); PG8_BAR;
            PG8_LDA(At, 0, 1); PG8_STAGE(PG8_SA(0, 0), a2, voffA);
            PG8_BAR; PG8_WAIT_L(0); PG8_MMA(1, 0, At, B0); PG8_BAR; PG8_SCHED;
            PG8_STAGE(PG8_SB(0, 1), b2 + hstepB, voffB);
            PG8_WAIT_V(6); PG8_BAR; PG8_MMA(1, 1, At, B1); PG8_BAR;
            PG8_LDB(B0, 1, 0); PG8_SCHED; PG8_LDA(At, 1, 0); PG8_STAGE(PG8_SA(0, 1), a2 + hstepA, voffA);
            PG8_WAIT_L(8); PG8_BAR; PG8_WAIT_L(0); PG8_MMA(0, 0, At, B0); PG8_BAR; PG8_SCHED;
            PG8_LDB(B1, 1, 1); PG8_STAGE(PG8_SB(1, 0), b3, voffB);
            PG8_BAR; PG8_WAIT_L(0); PG8_MMA(0, 1, At, B1); PG8_BAR;
            PG8_LDA(At, 1, 1); PG8_STAGE(PG8_SA(1, 0), a3, voffA);
            PG8_BAR; PG8_WAIT_L(0); PG8_MMA(1, 0, At, B0); PG8_BAR; PG8_SCHED;
            PG8_STAGE(PG8_SB(1, 1), b3 + hstepB, voffB);
            PG8_WAIT_V(6); PG8_BAR; PG8_MMA(1, 1, At, B1); PG8_BAR;
            }
        }
        if constexpr (ALIGN_EPI) { if (wr == 0) PG8_BAR; }
        if constexpr (!Epi::AFTER_DRAIN) { E(acc, cur, wr, wc, fr, fq, ui); S.done(cur); }
        if (!has_next) break;
#pragma unroll
        for (int a = 0; a < 2; ++a)
#pragma unroll
            for (int b = 0; b < 2; ++b)
#pragma unroll
                for (int m = 0; m < 4; ++m)
#pragma unroll
                    for (int n = 0; n < 2; ++n) acc[a][b][m][n] = (f32x4){0.f, 0.f, 0.f, 0.f};
        cur = nxt; cA = nA; cB = nB; ++ui;
        if constexpr (ALIGN_EPI) { if (wr == 1) PG8_BAR; }
    }
    PG8_WAIT_V(0);
    if constexpr (!ALIGN_EPI) { if (wr == 0) PG8_BAR; }
    PG8_BAR;
#undef PG8_SA
#undef PG8_SB
#undef PG8_STAGE
#undef PG8_LDA
#undef PG8_LDB
#undef PG8_MMA
#undef PG8_WAIT_V
#undef PG8_WAIT_L
#undef PG8_BAR
#undef PG8_SCHED
}
}

namespace att {
constexpr int DQK = 192, DV = 128, NW = 8, QBLK = 32, KVBLK = 64;
constexpr int SHM_V = KVBLK * DV * 2, SHM_K = KVBLK * DQK * 2, SHM_ATTN = 2 * SHM_V + 2 * SHM_K + NW * 64 * 4;
constexpr float THRL = 11.5f;
#define KSWZ(row, colB) ((row) * 384 + ((colB) ^ ((((row) >> 1) & 7) << 4)))
#define SBAR() __builtin_amdgcn_sched_barrier(0)
__device__ __forceinline__ int crow(int r, int hi) { return (r & 3) + 8 * (r >> 2) + 4 * hi; }
__device__ __forceinline__ void partialSM(f32x16& p0, f32x16& p1, float& m_reg, float& mn, float& alpha) {
    float pmax = p0[0];
#pragma unroll
    for (int r = 1; r < 16; ++r) pmax = fmaxf(pmax, p0[r]);
#pragma unroll
    for (int r = 0; r < 16; ++r) pmax = fmaxf(pmax, p1[r]);
    { auto rr = __builtin_amdgcn_permlane32_swap(__float_as_uint(pmax), __float_as_uint(pmax), false, false);
      pmax = fmaxf(__uint_as_float(rr[0]), __uint_as_float(rr[1])); }
    if (__builtin_expect(__all(pmax - m_reg <= THRL), 1)) { mn = m_reg; alpha = 1.f; }
    else { mn = fmaxf(m_reg, pmax); alpha = __builtin_amdgcn_exp2f(m_reg - mn); m_reg = mn; }
#pragma unroll
    for (int r = 0; r < 16; ++r) p0[r] = p0[r] - mn;
#pragma unroll
    for (int r = 0; r < 16; ++r) p1[r] = p1[r] - mn;
#pragma unroll
    for (int r = 0; r < 16; ++r) p0[r] = __builtin_amdgcn_exp2f(p0[r]);
}
__device__ __forceinline__ void finishSM(f32x16& p0, f32x16& p1, float alpha, float& l_reg, bf16x8& pa0, bf16x8& pa1, bf16x8& pa2, bf16x8& pa3) {
#pragma unroll
    for (int r = 0; r < 16; ++r) p1[r] = __builtin_amdgcn_exp2f(p1[r]);
    float ps = 0;
#pragma unroll
    for (int r = 0; r < 16; ++r) ps += p0[r];
#pragma unroll
    for (int r = 0; r < 16; ++r) ps += p1[r];
    { auto rr = __builtin_amdgcn_permlane32_swap(__float_as_uint(ps), __float_as_uint(ps), false, false);
      ps = __uint_as_float(rr[0]) + __uint_as_float(rr[1]); }
    l_reg = l_reg * alpha + ps;
#define PK4(P, BASE, OUT) do { unsigned a0 = cvt_pk_bf16(P[BASE + 0], P[BASE + 1]), a1 = cvt_pk_bf16(P[BASE + 2], P[BASE + 3]);   \
    unsigned b0 = cvt_pk_bf16(P[BASE + 4], P[BASE + 5]), b1 = cvt_pk_bf16(P[BASE + 6], P[BASE + 7]);                              \
    auto r0 = __builtin_amdgcn_permlane32_swap(a0, b0, false, false); auto r1 = __builtin_amdgcn_permlane32_swap(a1, b1, false, false); \
    u32x4 w = {r0[0], r1[0], r0[1], r1[1]}; OUT = __builtin_bit_cast(bf16x8, w); } while (0)
    PK4(p0, 0, pa0); PK4(p0, 8, pa1); PK4(p1, 0, pa2); PK4(p1, 8, pa3);
#undef PK4
}
__device__ __forceinline__ void qkt(f32x16& p0, f32x16& p1, const char* Ks, const bf16x8* qr, int r32, int hi) {
    p0 = f32x16{}; p1 = f32x16{};
    const char* k0p = Ks + KSWZ(r32, 0); const char* k1p = Ks + KSWZ(32 + r32, 0);
    const int key = ((r32 >> 1) & 7) << 4;
    bf16x8 ka[2], kb[2];
#define KRD(d0, slot) do { const int cb_ = (((d0) * 16 + hi * 8) * 2) ^ key; ka[slot] = *reinterpret_cast<const bf16x8*>(k0p + cb_); kb[slot] = *reinterpret_cast<const bf16x8*>(k1p + cb_); } while (0)
    KRD(0, 0); KRD(1, 1);
#pragma unroll
    for (int d0 = 0; d0 < 12; ++d0) {
        const bf16x8 a = ka[d0 & 1], b = kb[d0 & 1];
        p0 = __builtin_amdgcn_mfma_f32_32x32x16_bf16(a, qr[d0], p0, 0, 0, 0);
        p1 = __builtin_amdgcn_mfma_f32_32x32x16_bf16(b, qr[d0], p1, 0, 0, 0);
        if (d0 + 2 < 12) KRD(d0 + 2, d0 & 1);
    }
#undef KRD
}
__device__ __forceinline__ int v_st(int k, int c) { const int kk = (k & ~0xC) | ((k & 4) << 1) | ((k & 8) >> 1); return ((kk >> 3) * 4 + (c >> 5)) * 512 + ((kk & 7) * 32 + (c & 31)) * 2; }
__device__ __forceinline__ int v_rd_base(int lane) { return ((lane & 3) << 3) | (((lane >> 2) & 3) << 6) | (((lane >> 4) & 1) << 5) | (((lane >> 5) & 1) << 8); }
constexpr int v_rd_off(int d0, int ks, int half) { return d0 * 512 + ks * 4096 + half * 2048; }
template <int OFF> __device__ __forceinline__ s16x4 tr_read(int vb) {
    s16x4 r; asm volatile("ds_read_b64_tr_b16 %0, %1 offset:%2" : "=&v"(r) : "v"(vb), "i"(OFF) : "memory"); return r;
}
#define PKLH(L, H) (bf16x8){L[0], L[1], L[2], L[3], H[0], H[1], H[2], H[3]}
template <int D0> __device__ __forceinline__ void pv_one(f32x16& od, int vb, bf16x8 pa0, bf16x8 pa1, bf16x8 pa2, bf16x8 pa3) {
    const s16x4 l0 = tr_read<v_rd_off(D0, 0, 0)>(vb), h0 = tr_read<v_rd_off(D0, 0, 1)>(vb), l1 = tr_read<v_rd_off(D0, 1, 0)>(vb), h1 = tr_read<v_rd_off(D0, 1, 1)>(vb);
    const s16x4 l2 = tr_read<v_rd_off(D0, 2, 0)>(vb), h2 = tr_read<v_rd_off(D0, 2, 1)>(vb), l3 = tr_read<v_rd_off(D0, 3, 0)>(vb), h3 = tr_read<v_rd_off(D0, 3, 1)>(vb);
    asm volatile("s_waitcnt lgkmcnt(0)" ::: "memory"); SBAR();
    od = __builtin_amdgcn_mfma_f32_32x32x16_bf16(pa0, PKLH(l0, h0), od, 0, 0, 0);
    od = __builtin_amdgcn_mfma_f32_32x32x16_bf16(pa1, PKLH(l1, h1), od, 0, 0, 0);
    od = __builtin_amdgcn_mfma_f32_32x32x16_bf16(pa2, PKLH(l2, h2), od, 0, 0, 0);
    od = __builtin_amdgcn_mfma_f32_32x32x16_bf16(pa3, PKLH(l3, h3), od, 0, 0, 0);
}
__device__ __forceinline__ void pv_d0(f32x16* o, int vb, bf16x8 pa0, bf16x8 pa1, bf16x8 pa2, bf16x8 pa3) {
    pv_one<0>(o[0], vb, pa0, pa1, pa2, pa3); pv_one<1>(o[1], vb, pa0, pa1, pa2, pa3); pv_one<2>(o[2], vb, pa0, pa1, pa2, pa3); pv_one<3>(o[3], vb, pa0, pa1, pa2, pa3);
}
#define PK4S(P, BASE, OUT) do { unsigned a0 = cvt_pk_bf16(P[BASE + 0], P[BASE + 1]), a1 = cvt_pk_bf16(P[BASE + 2], P[BASE + 3]);   \
    unsigned b0 = cvt_pk_bf16(P[BASE + 4], P[BASE + 5]), b1 = cvt_pk_bf16(P[BASE + 6], P[BASE + 7]);                              \
    auto r0 = __builtin_amdgcn_permlane32_swap(a0, b0, false, false); auto r1 = __builtin_amdgcn_permlane32_swap(a1, b1, false, false); \
    u32x4 w = {r0[0], r1[0], r0[1], r1[1]}; OUT = __builtin_bit_cast(bf16x8, w); } while (0)
template <bool FIN>
__device__ __forceinline__ void seg_x(f32x16& n0, f32x16& n1, const LAS char* Ks, const bf16x8* qr, const LAS char* ql, int r32, int hi,
                                      f32x16& f0, f32x16& f1, float alpha, float& l_reg, bf16x8& pa0, bf16x8& pa1, bf16x8& pa2, bf16x8& pa3) {
    n0 = f32x16{}; n1 = f32x16{};
    const LAS char* k0p = Ks + r32 * 384;
    const int key = ((r32 >> 1) & 7) << 4;
    bf16x8 ka[2], kb[2]; float ps = 0.f;
#define KRD(d0, slot) do { const int cb_ = (((d0) * 16 + hi * 8) * 2) ^ key; ka[slot] = *reinterpret_cast<const LAS bf16x8*>(k0p + cb_); kb[slot] = *reinterpret_cast<const LAS bf16x8*>(k0p + 32 * 384 + cb_); } while (0)
    KRD(0, 0); KRD(1, 1); SBAR();
    bf16x8 qlv = qr[0];
#pragma unroll
    for (int d0 = 0; d0 < 12; ++d0) {
        const bf16x8 qv = (d0 < 8) ? qr[d0 < 8 ? d0 : 0] : qlv;
        n0 = __builtin_amdgcn_mfma_f32_32x32x16_bf16(ka[d0 & 1], qv, n0, 0, 0, 0);
        n1 = __builtin_amdgcn_mfma_f32_32x32x16_bf16(kb[d0 & 1], qv, n1, 0, 0, 0);
        SBAR();
        if (d0 + 2 < 12) KRD(d0 + 2, d0 & 1);
        if (d0 + 1 >= 8 && d0 + 1 < 12) qlv = *reinterpret_cast<const LAS bf16x8*>(ql + (d0 + 1 - 8) * 1024);
        if constexpr (FIN) {
            if (d0 < 4) {
#pragma unroll
                for (int r = 0; r < 4; ++r) f1[4 * d0 + r] = __builtin_amdgcn_exp2f(f1[4 * d0 + r]);
            } else if (d0 == 4) {
#pragma unroll
                for (int r = 0; r < 16; ++r) ps += f0[r];
            } else if (d0 == 5) {
#pragma unroll
                for (int r = 0; r < 16; ++r) ps += f1[r];
            } else if (d0 == 6) {
                auto rr = __builtin_amdgcn_permlane32_swap(__float_as_uint(ps), __float_as_uint(ps), false, false);
                ps = __uint_as_float(rr[0]) + __uint_as_float(rr[1]); l_reg = l_reg * alpha + ps;
            } else if (d0 == 7) { PK4S(f0, 0, pa0); } else if (d0 == 8) { PK4S(f0, 8, pa1); } else if (d0 == 9) { PK4S(f1, 0, pa2); } else if (d0 == 10) { PK4S(f1, 8, pa3); }
        }
        SBAR();
    }
#undef KRD
}
__device__ __forceinline__ void seg_y(f32x16* o, int vb, bf16x8 pa0, bf16x8 pa1, bf16x8 pa2, bf16x8 pa3, f32x16& p0, f32x16& p1, float& m_reg, float& mn, float& alpha) {
    pv_one<0>(o[0], vb, pa0, pa1, pa2, pa3); SBAR();
    { float a = fmaxf(p0[0], p0[1]), b = fmaxf(p0[2], p0[3]);
#pragma unroll
      for (int r = 4; r < 16; r += 2) { a = fmaxf(a, p0[r]); b = fmaxf(b, p0[r + 1]); }
#pragma unroll
      for (int r = 0; r < 16; r += 2) { a = fmaxf(a, p1[r]); b = fmaxf(b, p1[r + 1]); }
      float pmax = fmaxf(a, b);
      auto rr = __builtin_amdgcn_permlane32_swap(__float_as_uint(pmax), __float_as_uint(pmax), false, false);
      pmax = fmaxf(__uint_as_float(rr[0]), __uint_as_float(rr[1]));
      if (__builtin_expect(__all(pmax - m_reg <= THRL), 1)) { mn = m_reg; alpha = 1.f; }
      else { mn = fmaxf(m_reg, pmax); alpha = __builtin_amdgcn_exp2f(m_reg - mn); m_reg = mn; } }
    SBAR();
    pv_one<1>(o[1], vb, pa0, pa1, pa2, pa3); SBAR();
#pragma unroll
    for (int r = 0; r < 16; ++r) { p0[r] = p0[r] - mn; p1[r] = p1[r] - mn; }
    SBAR();
    pv_one<2>(o[2], vb, pa0, pa1, pa2, pa3); SBAR();
#pragma unroll
    for (int r = 0; r < 8; ++r) p0[r] = __builtin_amdgcn_exp2f(p0[r]);
    SBAR();
    pv_one<3>(o[3], vb, pa0, pa1, pa2, pa3); SBAR();
#pragma unroll
    for (int r = 8; r < 16; ++r) p0[r] = __builtin_amdgcn_exp2f(p0[r]);
    SBAR();
}
constexpr int L_K = 0, L_VV = 3 * SHM_K, L_WS = L_VV + 3 * SHM_V, L_QL = L_WS + NW * 64 * 4, ATT_LDS = L_QL + NW * 4096;
__device__ __forceinline__ void attn_chain(const bf16_t* __restrict__ QB, const bf16_t* __restrict__ KBp, const bf16_t* __restrict__ VBp, bf16_t* __restrict__ MIXp, int ldo, float* __restrict__ SSQAp,
                                           int bhs, int qb, int k0, int k1, int seq, int Mrows, char* lds, int wv) {
    int lane0 = lane_id(); asm volatile("" : "+v"(lane0));
    const int wid = wv;
    LAS unsigned char* l3 = (LAS unsigned char*)lds;
    const LAS char* K_lds = (const LAS char*)l3 + L_K;
    float* ws = (float*)(lds + L_WS) + wid * 64; float* li_l = ws; float* al_l = ws + 32;
    bf16x8 qr[8];
#define KSRC(i_) ({ const int p_ = (wid + 8 * (i_)) * 64 + lane, row_ = p_ / 24, cpos_ = p_ - row_ * 24; (unsigned)(row_ * 24 + ((cpos_ & ~7) | ((cpos_ ^ (row_ >> 1)) & 7))) * 16u; })
#define VSRC(i_) ({ const int p16_ = (wid + 8 * (i_)) * 64 + lane, sub_ = p16_ >> 5, idx_ = p16_ & 31, kk_ = (sub_ >> 2) * 8 + (idx_ >> 2), c_ = (sub_ & 3) * 32 + (idx_ & 3) * 8; \
    (unsigned)((((kk_ & ~0xC) | ((kk_ & 4) << 1) | ((kk_ & 8) >> 1))) * DV + c_) * 2u; })
#define DMA_KP(KP, t, kboff) do { const char* kt_ = (const char*)(KP) + (size_t)(t) * SHM_K; \
    _Pragma("unroll") for (int i_ = 0; i_ < 3; ++i_) __builtin_amdgcn_global_load_lds((const unsigned*)(kt_ + KSRC(i_)), (LAS unsigned*)(l3 + L_K + (kboff) + (wid + 8 * i_) * 1024), 16, 0, 0); } while (0)
#define DMA_VP(VP, t, vboff) do { const char* vt_ = (const char*)(VP) + (size_t)(t) * SHM_V; \
    _Pragma("unroll") for (int i_ = 0; i_ < 2; ++i_) __builtin_amdgcn_global_load_lds((const unsigned*)(vt_ + VSRC(i_)), (LAS unsigned*)(l3 + L_VV + (vboff) + (wid + 8 * i_) * 1024), 16, 0, 0); } while (0)
#define DMA_K(t, kboff) DMA_KP(Kh, t, kboff)
#define DMA_V(t, vboff) DMA_VP(Vh, t, vboff)
#define QLOAD(QP) do { const bf16_t* Qw_ = (QP) + (long)(wid * QBLK + r32) * DQK + hi * 8; \
    _Pragma("unroll") for (int d0 = 0; d0 < 8; ++d0) qr[d0] = *reinterpret_cast<const bf16x8*>(Qw_ + d0 * 16); \
    _Pragma("unroll") for (int d0 = 8; d0 < 12; ++d0) __builtin_amdgcn_global_load_lds((const unsigned*)(Qw_ + d0 * 16), (LAS unsigned*)(l3 + L_QL + wid * 4096 + (d0 - 8) * 1024), 16, 0, 0); } while (0)
#define TOP(j, KB) do { if ((j) + 2 >= NT) asm volatile("s_waitcnt vmcnt(0) lgkmcnt(0)" ::: "memory"); else asm volatile("s_waitcnt vmcnt(5) lgkmcnt(0)" ::: "memory"); \
    __builtin_amdgcn_s_barrier(); asm volatile("" ::: "memory"); \
    if ((j) + 2 < NT) DMA_K((j) + 2, (((KB) + 2) % 3) * SHM_K); if ((j) + 1 < NT) DMA_V((j) + 1, (((KB) + 1) % 3) * SHM_V); } while (0)
#define RESC(a) do { if (__any((a) < 1.f)) { if (hi == 0) al_l[r32] = (a); asm volatile("s_waitcnt lgkmcnt(0)" ::: "memory"); \
    _Pragma("unroll") for (int d = 0; d < 4; ++d) _Pragma("unroll") for (int r = 0; r < 16; ++r) o[d][r] *= al_l[crow(r, hi)]; } } while (0)
#define TILE(j, KB, PN0, PN1, MNN, ALN, PF0, PF1, AF) do { TOP(j, KB); \
    seg_x<true>(PN0, PN1, K_lds + (KB) * SHM_K, qr, ql, r32, hi, PF0, PF1, AF, l_reg, pa0, pa1, pa2, pa3); \
    seg_y(o, vb0 + (((KB) + 2) % 3) * SHM_V, pa0, pa1, pa2, pa3, PN0, PN1, m_reg, MNN, ALN); RESC(ALN); } while (0)
    const int NT = seq / KVBLK;
    {
        int lane = lane0; asm volatile("" : "+v"(lane)); const int r32 = lane & 31, hi = lane >> 5;
        const size_t bh0 = (size_t)(16 * k0 + bhs);
        QLOAD(QB + (bh0 * seq + qb * 256) * DQK); DMA_KP(KBp + bh0 * seq * DQK, 0, 0); DMA_VP(VBp + bh0 * seq * DV, 0, 0); DMA_KP(KBp + bh0 * seq * DQK, 1, SHM_K);
    }
    for (int k = k0; k < k1; ++k) {
        const size_t bh = (size_t)(16 * k + bhs); const bool has_next = (k + 1 < k1);
        int lane = lane0; asm volatile("" : "+v"(lane)); const int r32 = lane & 31, hi = lane >> 5;
        const LAS char* ql = (const LAS char*)l3 + L_QL + wid * 4096 + lane * 16;
        const int vb0 = (int)(uintptr_t)(lds + L_VV) + v_rd_base(lane);
        const bf16_t* Kh = KBp + bh * seq * DQK; const bf16_t* Vh = VBp + bh * seq * DV;
        float m_reg = -1e30f, l_reg = 0; f32x16 o[4] = {};
        f32x16 pA0, pA1, pB0, pB1; float mnA, mnB, alA, alB; bf16x8 pa0, pa1, pa2, pa3;
        TOP(0, 0);
        seg_x<false>(pA0, pA1, K_lds, qr, ql, r32, hi, pA0, pA1, 1.f, l_reg, pa0, pa1, pa2, pa3); partialSM(pA0, pA1, m_reg, mnA, alA);
        for (int j = 1; j + 6 < NT; j += 6) {
            TILE(j,     1, pB0, pB1, mnB, alB, pA0, pA1, alA);
            TILE(j + 1, 2, pA0, pA1, mnA, alA, pB0, pB1, alB);
            TILE(j + 2, 0, pB0, pB1, mnB, alB, pA0, pA1, alA);
            TILE(j + 3, 1, pA0, pA1, mnA, alA, pB0, pB1, alB);
            TILE(j + 4, 2, pB0, pB1, mnB, alB, pA0, pA1, alA);
            TILE(j + 5, 0, pA0, pA1, mnA, alA, pB0, pB1, alB);
        }
        const size_t bhn = bh + 16;
        TOP(NT - 1, 1);
        if (has_next) DMA_KP(KBp + bhn * seq * DQK, 0, 0);
        seg_x<true>(pB0, pB1, K_lds + 1 * SHM_K, qr, ql, r32, hi, pA0, pA1, alA, l_reg, pa0, pa1, pa2, pa3);
        asm volatile("" ::: "memory");
        if (has_next) QLOAD(QB + (bhn * seq + qb * 256) * DQK);
        seg_y(o, vb0 + 0 * SHM_V, pa0, pa1, pa2, pa3, pB0, pB1, m_reg, mnB, alB); RESC(alB);
        finishSM(pB0, pB1, alB, l_reg, pa0, pa1, pa2, pa3); SBAR();
        pv_d0(o, vb0 + 1 * SHM_V, pa0, pa1, pa2, pa3);
        if (hi == 0) li_l[r32] = l_reg; asm volatile("s_waitcnt lgkmcnt(0)" ::: "memory");
        float rli[16];
#pragma unroll
        for (int r = 0; r < 16; ++r) rli[r] = __builtin_amdgcn_rcpf(li_l[crow(r, hi)]);
        const int b = (int)(bh >> 2), h = (int)(bh & 3);
        bf16_t* Ow = MIXp + ((size_t)b * seq + qb * 256 + wid * QBLK) * ldo + h * 128;
        float* ssq = SSQAp + (size_t)h * Mrows + (size_t)b * seq + qb * 256;
        float myss = 0.f;
#pragma unroll
        for (int r = 0; r < 16; ++r) { const int orow = crow(r, hi); float sq = 0.f;
#pragma unroll
            for (int d0 = 0; d0 < 4; ++d0) { const float v = o[d0][r] * rli[r]; sq += v * v; Ow[(long)orow * ldo + d0 * 32 + r32] = (bf16_t)f2bf(v); }
            sq = dpp_sum8(sq);
            sq += __builtin_bit_cast(float, __builtin_amdgcn_update_dpp(0, __builtin_bit_cast(int, sq), 0x128, 0xF, 0xF, true));
            sq += __shfl_xor(sq, 16);
            if (r32 == r) myss = sq; }
        if (r32 < 16) ssq[wid * QBLK + crow(r32, hi)] = myss;
        if (has_next) { asm volatile("s_waitcnt lgkmcnt(0)" ::: "memory"); __builtin_amdgcn_s_barrier(); asm volatile("" ::: "memory");
            DMA_VP(VBp + bhn * seq * DV, 0, 0); DMA_KP(KBp + bhn * seq * DQK, 1, SHM_K); }
        else { asm volatile("s_waitcnt vmcnt(0) lgkmcnt(0)" ::: "memory"); __builtin_amdgcn_s_barrier(); asm volatile("" ::: "memory"); }
    }
#undef DMA_K
#undef DMA_V
#undef DMA_KP
#undef DMA_VP
#undef QLOAD
#undef TOP
#undef TILE
#undef RESC
}
}

namespace hg {
using att::crow; using att::v_st; using att::v_rd_base; using att::v_rd_off; using att::tr_read;
constexpr int L_QE = 0, L_QT = 16384, L_KT = 32768, L_OT = 122880  , L_KE = 73728, L_V = 90112, L_P = 106496, L_SEG = 114688  , L_DV = 155648, L_GN = 156160  , L_END = 156672;
__device__ __forceinline__ int swzA(int row, int cb) { return row * 256 + (cb ^ ((row & 15) << 4) ^ (((row >> 4) & 1) << 3)); }
__device__ __forceinline__ int swzB(int row, int cb) { return row * 256 + (cb ^ ((row & 15) << 4)); }
__device__ __forceinline__ int swzP(int row, int cb) { return row * 128 + (cb ^ ((row & 7) << 4)); }
template <int D0> __device__ __forceinline__ void tr_frag4(int vb, bf16x8& f0, bf16x8& f1, bf16x8& f2, bf16x8& f3) {
    const s16x4 l0 = tr_read<v_rd_off(D0, 0, 0)>(vb), h0 = tr_read<v_rd_off(D0, 0, 1)>(vb), l1 = tr_read<v_rd_off(D0, 1, 0)>(vb), h1 = tr_read<v_rd_off(D0, 1, 1)>(vb);
    const s16x4 l2 = tr_read<v_rd_off(D0, 2, 0)>(vb), h2 = tr_read<v_rd_off(D0, 2, 1)>(vb), l3 = tr_read<v_rd_off(D0, 3, 0)>(vb), h3 = tr_read<v_rd_off(D0, 3, 1)>(vb);
    asm volatile("s_waitcnt lgkmcnt(0)" ::: "memory"); SBAR();
    f0 = PKLH(l0, h0); f1 = PKLH(l1, h1); f2 = PKLH(l2, h2); f3 = PKLH(l3, h3);
}
struct Pre { u32x2 q4[4], l4[4], v4[4]; };
__device__ __forceinline__ void load_chunk(Pre& P, const bf16_t* pbase, int h, int dir, int cs, int wid, int lane) {
    const int c4 = 4 * (lane & 31), j0 = 8 * wid + 4 * (lane >> 5);
    const int cq = C_Q + h * 128 + c4, cf = C_FF + dir * 512 + h * 128 + c4, ci = C_I + h * 128 + c4;
#pragma unroll
    for (int i = 0; i < 4; ++i) { const int j = j0 + i, pos = dir ? (64 * cs + 63 - j) : (64 * cs + j); const bf16_t* rp = pbase + (size_t)pos * DINP;
        P.q4[i] = *(const u32x2*)(rp + cq); P.l4[i] = *(const u32x2*)(rp + cf); P.v4[i] = *(const u32x2*)(rp + ci); }
}
__device__ __forceinline__ void stage_c(char* lds, f32x16 (&S)[4], f32x16 (&o)[2]  , _Float16* ofp  , int rstride  , bool second, int eb, int lane_, int part  ) {
    int lane = lane_; asm volatile("" : "+v"(lane));
    const int r32 = lane & 31, hi = lane >> 5;
    _Float16* p0 = ofp + r32 + 4 * hi * rstride;
    const int vbV = (int)(uintptr_t)(lds + L_V) + v_rd_base(lane) + eb * 512, vbK = (int)(uintptr_t)(lds + L_KE) + v_rd_base(lane);
    if (part == 0) {
#pragma unroll
    for (int db = 0; db < 4; ++db)
#pragma unroll
        for (int s = 0; s < 2; ++s) {
            u32x4 sw; sw.x = cvtpk(S[db][8 * s + 0], S[db][8 * s + 1]); sw.y = cvtpk(S[db][8 * s + 2], S[db][8 * s + 3]);
            sw.z = cvtpk(S[db][8 * s + 4], S[db][8 * s + 5]); sw.w = cvtpk(S[db][8 * s + 6], S[db][8 * s + 7]);
            const bf16x8 sf = __builtin_bit_cast(bf16x8, sw);
#pragma unroll
            for (int jb = 0; jb < 2; ++jb) { const int row = 32 * jb + r32, d0 = 32 * db + 16 * s + 4 * hi;
                const u32x2 a0 = *(const u32x2*)(lds + L_QE + swzA(row, d0 * 2)), a1 = *(const u32x2*)(lds + L_QE + swzA(row, (d0 + 8) * 2));
                const u32x4 aw = {a0.x, a0.y, a1.x, a1.y};
                o[jb] = __builtin_amdgcn_mfma_f32_32x32x16_bf16(__builtin_bit_cast(bf16x8, aw), sf, o[jb], 0, 0, 0); }
        }
    return; }
    bf16x8 vf0, vf1, vf2, vf3; tr_frag4<0>(vbV, vf0, vf1, vf2, vf3);
#define PFR(jb, ks) (*(const bf16x8*)(lds + L_P + swzP(32 * (jb) + r32, 32 * (ks) + 16 * hi)))
    o[0] = __builtin_amdgcn_mfma_f32_32x32x16_bf16(PFR(0, 0), vf0, o[0], 0, 0, 0);
    o[0] = __builtin_amdgcn_mfma_f32_32x32x16_bf16(PFR(0, 1), vf1, o[0], 0, 0, 0);
    o[1] = __builtin_amdgcn_mfma_f32_32x32x16_bf16(PFR(1, 0), vf0, o[1], 0, 0, 0);
    o[1] = __builtin_amdgcn_mfma_f32_32x32x16_bf16(PFR(1, 1), vf1, o[1], 0, 0, 0);
    o[1] = __builtin_amdgcn_mfma_f32_32x32x16_bf16(PFR(1, 2), vf2, o[1], 0, 0, 0);
    o[1] = __builtin_amdgcn_mfma_f32_32x32x16_bf16(PFR(1, 3), vf3, o[1], 0, 0, 0);
#undef PFR
    if (second) {
        float* ot = (float*)(lds + L_OT) + 32 * eb + r32 + 4 * hi * 128;
#pragma unroll
        for (int jb = 0; jb < 2; ++jb)
#pragma unroll
            for (int r = 0; r < 16; ++r) ot[(32 * jb + 8 * (r >> 2) + (r & 3)) * 128] = o[jb][r];
    } else {
#pragma unroll
        for (int jb = 0; jb < 2; ++jb)
#pragma unroll
            for (int g = 0; g < 4; ++g) { _Float16* pg = p0 + (32 * jb + 8 * g) * rstride;
#pragma unroll
                for (int e = 0; e < 4; ++e) pg[e * rstride] = (_Float16)o[jb][4 * g + e];
                asm volatile("" ::: "memory"); }
    }
    const float* dv = (const float*)(lds + L_DV);
#define SUPD(DB) do { bf16x8 k0_, k1_, k2_, k3_; tr_frag4<DB>(vbK, k0_, k1_, k2_, k3_); \
        { const float* dvp = dv + 32 * DB + 4 * hi; _Pragma("unroll") for (int g = 0; g < 4; ++g) { const f32x4 d4 = *(const f32x4*)(dvp + 8 * g); \
            S[DB][4 * g] *= d4[0]; S[DB][4 * g + 1] *= d4[1]; S[DB][4 * g + 2] *= d4[2]; S[DB][4 * g + 3] *= d4[3]; } } \
        S[DB] = __builtin_amdgcn_mfma_f32_32x32x16_bf16(k0_, vf0, S[DB], 0, 0, 0); S[DB] = __builtin_amdgcn_mfma_f32_32x32x16_bf16(k1_, vf1, S[DB], 0, 0, 0); \
        S[DB] = __builtin_amdgcn_mfma_f32_32x32x16_bf16(k2_, vf2, S[DB], 0, 0, 0); S[DB] = __builtin_amdgcn_mfma_f32_32x32x16_bf16(k3_, vf3, S[DB], 0, 0, 0); } while (0)
    SUPD(0); SUPD(1); SUPD(2); SUPD(3);
#undef SUPD
}
__device__ __forceinline__ void hgrn_bh(int b, int h, const bf16_t* proj, bf16_t* MIXp, const float* __restrict__ gain, char* lds, int wv) {
    int lane = lane_id(); asm volatile("" : "+v"(lane));
    const int wid = wv, tid = wv * 64 + lane, dp_ = lane, seg = wid;
    for (int i = tid; i < 8192 / 4; i += 512) ((unsigned*)(lds + L_P))[i] = 0u;
    f32x16 S[4] = {};
    const bf16_t* pbase = proj + (size_t)b * SEQ * DINP;
    float* segtot = (float*)(lds + L_SEG);
    if (tid < 128) ((float*)(lds + L_GN))[tid] = gain[tid];
    Pre pre; load_chunk(pre, pbase, h, 0, 0, wid, lane);
    __syncthreads();
    const int hw = lane >> 5, cq4 = lane & 31, sg16 = 2 * wid + hw;
    const int cB = (8 * cq4) ^ ((wid & 1) << 7) ^ (hw << 6), cA = cB ^ (((wid >> 1) & 1) << 3), rowb = wid * 2048 + hw * 1024;
    const int gV = (cq4 >> 3) * 512 + (cq4 & 7) * 8 + (wid >> 1) * 4096 + hw * 2048 + (wid & 1) * 256;
    const int drow = tid >> 3, dseg = tid & 7;
#define POST_SEGTOT() do { float a0_ = 0.f, a1_ = 0.f, a2_ = 0.f, a3_ = 0.f; \
        _Pragma("unroll") for (int t_ = 0; t_ < 4; ++t_) { const unsigned lx_ = pre.l4[t_].x, ly_ = pre.l4[t_].y; const h16x2 h0_ = __builtin_bit_cast(h16x2, lx_), h1_ = __builtin_bit_cast(h16x2, ly_); \
            a0_ += (float)h0_[0]; a1_ += (float)h0_[1]; a2_ += (float)h1_[0]; a3_ += (float)h1_[1]; } \
        *(f32x4*)(segtot + sg16 * 128 + 4 * cq4) = (f32x4){a0_, a1_, a2_, a3_}; } while (0)
    POST_SEGTOT();
    asm volatile("s_waitcnt lgkmcnt(0)" ::: "memory"); __builtin_amdgcn_s_barrier(); asm volatile("" ::: "memory");
    for (int k = 0; k < 64; ++k) {
        const int i = k >> 1, dir = k & 1, cs = dir ? 31 - i : i; const bool second = (i >= 16);
        const long row0 = (long)b * SEQ + (dir ? 64 * cs + 63 : 64 * cs);
        const int rstride = dir ? -DINP : DINP; const bool mine = ((wid >> 2) == dir);
        _Float16* rawp = (_Float16*)proj + (size_t)row0 * DINP + C_CQ + h * 128 + 32 * (wid & 3);
        f32x16 o[2]; u32x4 gq0, gq1;
        if (second) {
            if (mine) { const _Float16* p0 = rawp + (lane & 31) + 4 * (lane >> 5) * rstride;
#pragma unroll
                for (int jb = 0; jb < 2; ++jb)
#pragma unroll
                    for (int r = 0; r < 16; ++r) o[jb][r] = (float)p0[(32 * jb + 8 * (r >> 2) + (r & 3)) * rstride]; }
            const long grow = row0 + (dir ? -drow : drow); const bf16_t* gp = proj + (size_t)grow * DINP + C_G + h * 128 + 16 * dseg;
            gq0 = *(const u32x4*)gp; gq1 = *(const u32x4*)(gp + 8);
        } else { o[0] = f32x16{}; o[1] = f32x16{}; }
        const int I = wid >> 1;
        f32x4 rr[5];
        { f32x4 a = {0.f, 0.f, 0.f, 0.f};
#pragma unroll
          for (int sg = 0; sg < 16; ++sg) { if ((sg & 3) == 0) rr[sg >> 2] = a; a += *(const f32x4*)(segtot + sg * 128 + 4 * cq4); }
          rr[4] = a; }
        const f32x4 rI = (I == 0) ? rr[0] : (I == 1) ? rr[1] : (I == 2) ? rr[2] : rr[3];
        f32x4 run = rI;
#pragma unroll
        for (int q = 0; q < 3; ++q) { const f32x4 st = *(const f32x4*)(segtot + (4 * I + q) * 128 + 4 * cq4); if (4 * I + q < sg16) run += st; }
        f32x4 eI, eT, rat[4];
#pragma unroll
        for (int c = 0; c < 4; ++c) { eI[c] = __builtin_amdgcn_exp2f(rI[c]); eT[c] = __builtin_amdgcn_exp2f(rr[4][c] - rI[c]);
#pragma unroll
            for (int sg = 0; sg < 4; ++sg) rat[sg][c] = __builtin_amdgcn_exp2f(fminf(rr[sg][c] - rI[c], 0.f)); }
        if (sg16 == 0) { f32x4 d4;
#pragma unroll
            for (int c = 0; c < 4; ++c) d4[c] = __builtin_amdgcn_exp2f(rr[4][c]);
            *(f32x4*)((float*)(lds + L_DV) + 4 * cq4) = d4; }
        f32x4 gE[4], Ef[4], Rf[4];
        { f32x4 E;
#pragma unroll
          for (int c = 0; c < 4; ++c) E[c] = __builtin_amdgcn_exp2f(run[c] - rI[c]);
#pragma unroll
          for (int t = 0; t < 4; ++t) { const unsigned lx = pre.l4[t].x, ly = pre.l4[t].y; const h16x2 h0 = __builtin_bit_cast(h16x2, lx), h1 = __builtin_bit_cast(h16x2, ly);
              gE[t] = (f32x4){__builtin_amdgcn_exp2f((float)h0[0]), __builtin_amdgcn_exp2f((float)h0[1]), __builtin_amdgcn_exp2f((float)h1[0]), __builtin_amdgcn_exp2f((float)h1[1])};
              E = E * gE[t]; Ef[t] = E; }
          f32x4 R;
#pragma unroll
          for (int c = 0; c < 4; ++c) R[c] = fminf(__builtin_amdgcn_rcpf(E[c]), 4.1538374868278621e34f);
          Rf[3] = R; Rf[2] = Rf[3] * gE[3]; Rf[1] = Rf[2] * gE[2]; Rf[0] = Rf[1] * gE[1]; }
#pragma unroll
        for (int t = 0; t < 4; ++t) {
            const f32x4 q = {bflo(pre.q4[t].x), bfhi(pre.q4[t].x), bflo(pre.q4[t].y), bfhi(pre.q4[t].y)};
            const f32x4 qt = q * Ef[t], kI = ((f32x4){1.f, 1.f, 1.f, 1.f} - gE[t]) * Rf[t];
            const f32x4 qe = qt * eI, ke = kI * eT;
            const int aB = (cB ^ (t << 4)) + rowb + t * 256, aA = (cA ^ (t << 4)) + rowb + t * 256, aV = gV + t * 64;
            *(u32x2*)(lds + L_QE + aA) = (u32x2){cvtpk(qe[0], qe[1]), cvtpk(qe[2], qe[3])};
            *(u32x2*)(lds + L_QT + aB) = (u32x2){cvtpk(qt[0], qt[1]), cvtpk(qt[2], qt[3])};
            *(u32x2*)(lds + L_KE + aV) = (u32x2){cvtpk(ke[0], ke[1]), cvtpk(ke[2], ke[3])};
            *(u32x2*)(lds + L_V + aV) = pre.v4[t];
#define KTW(base, SG) do { const f32x4 kv_ = kI * rat[SG]; *(u32x2*)(lds + L_KT + (base) * 256 + aB) = (u32x2){cvtpk(kv_[0], kv_[1]), cvtpk(kv_[2], kv_[3])}; } while (0)
#define KTD(base) do { *(u32x2*)(lds + L_KT + (base) * 256 + aB) = (u32x2){cvtpk(kI[0], kI[1]), cvtpk(kI[2], kI[3])}; } while (0)
            if (I == 0) { KTD(0); KTW(16, 1); KTW(48, 2); KTW(96, 3); }
            else if (I == 1) { KTD(16); KTW(48, 2); KTW(96, 3); }
            else if (I == 2) { KTD(48); KTW(96, 3); }
            else { KTD(96); }
#undef KTW
#undef KTD
        }
        asm volatile("s_waitcnt lgkmcnt(0)" ::: "memory"); __builtin_amdgcn_s_barrier(); asm volatile("" ::: "memory");
        if (k + 1 < 64) { const int k1 = k + 1, i1 = k1 >> 1, d1 = k1 & 1; load_chunk(pre, pbase, h, d1, d1 ? 31 - i1 : i1, wid, lane); }
        if (mine) stage_c(lds, S, o, rawp, rstride, second, wid & 3, lane, 0);
        else for (int blk = (wid & 3); blk < 10; blk += 4) {
            int bi, bjj; if (blk == 0) { bi = 0; bjj = 0; } else if (blk < 3) { bi = 1; bjj = blk - 1; } else if (blk < 6) { bi = 2; bjj = blk - 3; } else { bi = 3; bjj = blk - 6; }
            const int base = (bi == 0) ? 0 : (bi == 1) ? 16 : (bi == 2) ? 48 : 96;
            const int xm = ((lane & 15) << 4), cq4 = 16 * (lane >> 4);
            const char* ap = lds + L_QT + (16 * bi + (lane & 15)) * 256; const char* bp = lds + L_KT + (base + 16 * bjj + (lane & 15)) * 256;
            bf16x8 av[4], bv[4];
#pragma unroll
            for (int ks = 0; ks < 4; ++ks) { const int cb = (64 * ks + cq4) ^ xm; av[ks] = *(const bf16x8*)(ap + cb); bv[ks] = *(const bf16x8*)(bp + cb); }
            f32x4 acc = {0.f, 0.f, 0.f, 0.f};
#pragma unroll
            for (int ks = 0; ks < 4; ++ks) acc = __builtin_amdgcn_mfma_f32_16x16x32_bf16(av[ks], bv[ks], acc, 0, 0, 0);
            const int sl = lane & 15;
#pragma unroll
            for (int r = 0; r < 4; ++r) { const int jl = (lane >> 4) * 4 + r; const float v = (bi != bjj || sl <= jl) ? acc[r] : 0.f;
                *(bf16_t*)(lds + L_P + swzP(16 * bi + jl, (16 * bjj + sl) * 2)) = (bf16_t)(cvtpk(v, v) & 0xffffu); }
        }
        asm volatile("s_waitcnt lgkmcnt(0)" ::: "memory"); __builtin_amdgcn_s_barrier(); asm volatile("" ::: "memory");
        if (mine) stage_c(lds, S, o, rawp, rstride, second, wid & 3, lane, 1);
        if (k + 1 < 64) POST_SEGTOT();
        if (k == 31) asm volatile("s_waitcnt vmcnt(0)" ::: "memory");
        asm volatile("s_waitcnt lgkmcnt(0)" ::: "memory"); __builtin_amdgcn_s_barrier(); asm volatile("" ::: "memory");
        if (second) {
            const float* otp = (const float*)(lds + L_OT) + drow * 128 + 16 * dseg;
            f32x4 v[4]; float ss = 0.f;
#pragma unroll
            for (int q = 0; q < 4; ++q) { v[q] = *(const f32x4*)(otp + 4 * q); ss += (v[q][0] * v[q][0] + v[q][1] * v[q][1]) + (v[q][2] * v[q][2] + v[q][3] * v[q][3]); }
            ss = dpp_sum8(ss);
            const float r = __builtin_amdgcn_rsqf(ss * (1.f / 128.f) + EPS);
            f32x4 gn[4];
#pragma unroll
            for (int q = 0; q < 4; ++q) gn[q] = *(const f32x4*)((const float*)(lds + L_GN) + 16 * dseg + 4 * q);
            const unsigned gw[8] = {gq0.x, gq0.y, gq0.z, gq0.w, gq1.x, gq1.y, gq1.z, gq1.w}; unsigned ow[8];
#pragma unroll
            for (int q = 0; q < 8; ++q) { const float g0 = bflo(gw[q]), g1 = bfhi(gw[q]);
                const float s0 = g0 * __builtin_amdgcn_rcpf(1.f + __builtin_amdgcn_exp2f(-1.4426950408889634f * g0)), s1 = g1 * __builtin_amdgcn_rcpf(1.f + __builtin_amdgcn_exp2f(-1.4426950408889634f * g1));
                ow[q] = cvtpk(v[q >> 1][2 * (q & 1)] * r * gn[q >> 1][2 * (q & 1)] * s0, v[q >> 1][2 * (q & 1) + 1] * r * gn[q >> 1][2 * (q & 1) + 1] * s1); }
            const long grow = row0 + (dir ? -drow : drow); bf16_t* mp = MIXp + (size_t)grow * DM + 512 + h * 128 + 16 * dseg;
            *(u32x4*)mp = (u32x4){ow[0], ow[1], ow[2], ow[3]}; *(u32x4*)(mp + 8) = (u32x4){ow[4], ow[5], ow[6], ow[7]};
        }
    }
    __syncthreads();
}
}

#define XB_TMO      128
#define XB_XCNT(j)  (256  + 64 * (j))
#define XB_XSUB(j)  (1280 + 64 * (j))
#define XB_XGEN(j)  (2304 + 64 * (j))
#define XB_TOP      3328
#define XB_TOPGEN   3392
#define XCD_BAR_WORDS 3456
#define XB_SPIN_CAP (1u << 18)

__device__ __forceinline__ unsigned xb_ld(unsigned* p)              { return __hip_atomic_load(p, __ATOMIC_RELAXED, __HIP_MEMORY_SCOPE_AGENT); }
__device__ __forceinline__ unsigned xb_add(unsigned* p, unsigned v) { return __hip_atomic_fetch_add(p, v, __ATOMIC_RELAXED, __HIP_MEMORY_SCOPE_AGENT); }
__device__ __forceinline__ unsigned xb_xcc_id() { return (unsigned)__builtin_amdgcn_s_getreg((3 << 11) | 20) & 0xFu; }
#define XB_SPIN(cond, bar) do { unsigned _sp = 0; while (cond) { __builtin_amdgcn_s_sleep(1); \
    if ((++_sp & 255u) == 0u) { if (xb_ld(&(bar)[XB_TMO])) break; if (_sp > XB_SPIN_CAP) { atomicAdd(&(bar)[XB_TMO], 1u); break; } } } } while (0)

struct XcdBarrier {
    unsigned* bar; unsigned x;
    volatile LAS unsigned* st;
};

__device__ __forceinline__ XcdBarrier xcd_barrier_post(unsigned* bar, volatile LAS unsigned* st, bool leader  ) {
    XcdBarrier b; b.bar = bar; b.x = xb_xcc_id(); b.st = st;
    if (leader) (void)xb_add(&bar[XB_XCNT(b.x)], 1u);
    return b;
}
__device__ __forceinline__ void xcd_barrier_complete(unsigned* bar, unsigned x, unsigned& nloc, unsigned& nx) {
    const unsigned G = gridDim.x * gridDim.y * gridDim.z;
    unsigned sum, cnt, mine, sp = 0u;
    for (;;) {
        sum = 0u; cnt = 0u; mine = 0u;
#pragma unroll
        for (unsigned j = 0; j < 16; ++j) { const unsigned c = xb_ld(&bar[XB_XCNT(j)]); sum += c; cnt += (c > 0u) ? 1u : 0u; mine = (j == x) ? c : mine; }
        if (sum == G) break;
        __builtin_amdgcn_s_sleep(1);
        if ((++sp & 255u) == 0u) { if (xb_ld(&bar[XB_TMO])) break; if (sp > XB_SPIN_CAP) { atomicAdd(&bar[XB_TMO], 1u); break; } }
    }
    nloc = mine > 0u ? mine : 1u; nx = cnt > 0u ? cnt : 1u;
}

__device__ __forceinline__ void xcd_barrier(const XcdBarrier& b, bool leader  ) {
    asm volatile("s_waitcnt vmcnt(0)" ::: "memory");
    __syncthreads();
    if (leader) {
        unsigned* bar = b.bar;
        __builtin_amdgcn_s_waitcnt(0);
        unsigned nloc = b.st[0], nx = b.st[1];
        if (nloc == 0u) { xcd_barrier_complete(bar, b.x, nloc, nx); b.st[0] = nloc; b.st[1] = nx; }
        const unsigned old = xb_add(&bar[XB_XSUB(b.x)], 1u);
        const unsigned gen = old / nloc;
        if (old + 1u == (gen + 1u) * nloc) {
            __builtin_amdgcn_fence(__ATOMIC_RELEASE, "agent");
            asm volatile("s_waitcnt vmcnt(0)" ::: "memory");
            const unsigned og = xb_add(&bar[XB_TOP], 1u);
            const unsigned tg = og / nx;
            if (og + 1u == (tg + 1u) * nx) xb_add(&bar[XB_TOPGEN], 1u);
            else XB_SPIN(xb_ld(&bar[XB_TOPGEN]) == tg, bar);
            __builtin_amdgcn_fence(__ATOMIC_ACQUIRE, "agent");
            xb_add(&bar[XB_XGEN(b.x)], 1u);
            asm volatile("s_waitcnt vmcnt(0)" ::: "memory");
        } else {
            XB_SPIN(xb_ld(&bar[XB_XGEN(b.x)]) == gen, bar);
            __builtin_amdgcn_fence(__ATOMIC_ACQUIRE, "agent");
            asm volatile("s_waitcnt vmcnt(0)" ::: "memory");
        }
    }
    __syncthreads();
}


constexpr int NWAVES = 8;
constexpr int LDS_BYTES = 160 * 1024;
constexpr int RING_BYTES = 131072, EPI_OFF = RING_BYTES  , TAB_OFF = RING_BYTES + 8192  , MISC_OFF = 160 * 1024 - 1024;
constexpr size_t CTL_ZERO_BYTES = 65536;
struct Args { const float* in[17]; float* out; unsigned char* ws; int ph_lo, ph_hi; };

__device__ __forceinline__ int rope_perm(int cp) { const int i = cp >> 3, j = cp & 7; return (j < 4) ? 4 * i + j : 32 + 4 * i + (j - 4); }
__device__ __forceinline__ void tr_item(const float* W, int ldw, int ksrc0, int srccol, const float* gain, int goff, bf16_t* WT, int Kd, int kd0, int nd0, LAS float* scr, int lane) {
    float wv_[32], gv_[32];
#pragma unroll
    for (int i = 0; i < 32; ++i) { const int kk = 2 * i + (lane >> 5); wv_[i] = (srccol >= 0) ? W[(size_t)(ksrc0 + kk) * ldw + srccol] : 0.f; gv_[i] = gain ? gain[ksrc0 + kk - goff] : 1.f; }
#pragma unroll
    for (int i = 0; i < 32; ++i) { const int kk = 2 * i + (lane >> 5); scr[kk * 33 + (lane & 31)] = wv_[i] * gv_[i]; }
    asm volatile("s_waitcnt lgkmcnt(0)" ::: "memory");
    const int c = lane & 7;
#pragma unroll
    for (int j = 0; j < 4; ++j) { const int n = (lane >> 3) + 8 * j; const LAS float* sp = scr + (8 * c) * 33 + n;
        u32x4 o; o.x = pk2(sp[0 * 33], sp[1 * 33]); o.y = pk2(sp[2 * 33], sp[3 * 33]); o.z = pk2(sp[4 * 33], sp[5 * 33]); o.w = pk2(sp[6 * 33], sp[7 * 33]);
        *(u32x4*)(WT + (size_t)(nd0 + n) * Kd + kd0 + 8 * c) = o; }
    asm volatile("s_waitcnt lgkmcnt(0)" ::: "memory");
}
template <int R>
__device__ __forceinline__ void rows_to_bf16_rs(const float* x0, bf16_t* o0, float* rs0, size_t rstep, int lane) {
    f32x4 v[R][4]; float s[R];
#pragma unroll
    for (int r = 0; r < R; ++r) { const f32x4* xr = (const f32x4*)(x0 + (size_t)r * rstep * DM) + lane;
#pragma unroll
        for (int j = 0; j < 4; ++j) v[r][j] = xr[64 * j]; }
#pragma unroll
    for (int r = 0; r < R; ++r) { float a = 0.f;
#pragma unroll
        for (int j = 0; j < 4; ++j) a += (v[r][j].x * v[r][j].x + v[r][j].y * v[r][j].y) + (v[r][j].z * v[r][j].z + v[r][j].w * v[r][j].w);
        s[r] = a; }
#pragma unroll
    for (int o = 1; o < 64; o <<= 1) {
#pragma unroll
        for (int r = 0; r < R; ++r) s[r] += __shfl_xor(s[r], o); }
#pragma unroll
    for (int r = 0; r < R; ++r) { if (lane == 0) rs0[(size_t)r * rstep] = 1.f / sqrtf(s[r] * (1.f / DM) + EPS);
        u32x2* o8 = (u32x2*)(o0 + (size_t)r * rstep * DM) + lane;
#pragma unroll
        for (int j = 0; j < 4; ++j) { u32x2 w; w.x = cvtpk(v[r][j].x, v[r][j].y); w.y = cvtpk(v[r][j].z, v[r][j].w); o8[64 * j] = w; } }
}
__device__ __forceinline__ void sincos_acc(float ang, float& c, float& s) {
    const double x = (double)ang; const double kq = __builtin_rint(x * 0.6366197723675814); const double y = x - kq * 1.5707963267948966 - kq * 6.123233995736766e-17;
    const double y2 = y * y;
    double sp = -7.6471637318198164759e-13; sp = sp * y2 + 1.6059043836821614599e-10; sp = sp * y2 - 2.5052108385441718775e-8; sp = sp * y2 + 2.7557319223985890653e-6; sp = sp * y2 - 1.9841269841269841270e-4; sp = sp * y2 + 8.3333333333333333333e-3; sp = sp * y2 - 1.6666666666666666667e-1; sp = y + y * y2 * sp;
    double cp = 4.7794773323873852974e-14; cp = cp * y2 - 1.1470745597729724714e-11; cp = cp * y2 + 2.0876756987868098979e-9; cp = cp * y2 - 2.7557319223985890653e-7; cp = cp * y2 + 2.4801587301587301587e-5; cp = cp * y2 - 1.3888888888888888889e-3; cp = cp * y2 + 4.1666666666666666667e-2; cp = cp * y2 - 0.5; cp = 1.0 + y2 * cp;
    const int q = ((int)(long long)kq) & 3;
    const double sv = (q == 0) ? sp : (q == 1) ? cp : (q == 2) ? -sp : -cp;
    const double cv = (q == 0) ? cp : (q == 1) ? -sp : (q == 2) ? -cp : sp;
    c = (float)cv; s = (float)sv;
}

__global__ void __launch_bounds__(NWAVES * 64, 2) mk_fwd(Args args) {
    extern __shared__ __attribute__((aligned(16))) unsigned char lds[];
    const int g_wv = __builtin_amdgcn_readfirstlane(threadIdx.x >> 6);
#define TIDV() ({ int t_ = g_wv * 64 + lane_id(); asm volatile("" : "+v"(t_)); t_; })
    const int G = gridDim.x, bx = blockIdx.x;
    unsigned char* ws = args.ws;
    const float* x = args.in[0]; const int* positions = (const int*)args.in[1];
    const float* g_mix = args.in[2]; const float* w_in = args.in[3]; const float* lb_param = args.in[4]; const float* g_hgrn = args.in[5];
    const float* g_cq = args.in[6]; const float* w_q_up = args.in[7]; const float* g_ckv = args.in[8]; const float* w_kv_up = args.in[9];
    const float* g_qn = args.in[10]; const float* g_kn = args.in[11]; const float* g_mla_out = args.in[12]; const float* w_out = args.in[13];
    const float* g_ffn = args.in[14]; const float* w_up = args.in[15]; const float* w_down = args.in[16];
    float* out = args.out;
    float* RS0 = (float*)(ws + WS_RS0); float* SSQ1 = (float*)(ws + WS_SSQ1); float* SSQP = (float*)(ws + WS_SSQP); float* GQT = (float*)(ws + WS_GQT); float* GKT = (float*)(ws + WS_GKT); float* LBT = (float*)(ws + WS_LBT);
    float* COS = (float*)(ws + WS_COS); float* SIN = (float*)(ws + WS_SIN);
    bf16_t* WIN = (bf16_t*)(ws + WS_WIN); bf16_t* WQ = (bf16_t*)(ws + WS_WQ); bf16_t* WKV = (bf16_t*)(ws + WS_WKV); bf16_t* WOUT = (bf16_t*)(ws + WS_WOUT);
    bf16_t* WUP = (bf16_t*)(ws + WS_WUP); bf16_t* WDN = (bf16_t*)(ws + WS_WDN);
    bf16_t* XB = (bf16_t*)(ws + WS_XB); bf16_t* VB = (bf16_t*)(ws + WS_V); bf16_t* X1B = (bf16_t*)(ws + WS_X1B);
    bf16_t* PROJ = (bf16_t*)(ws + WS_PROJ); bf16_t* HB = (bf16_t*)(ws + WS_HB);
    bf16_t* MIX = (bf16_t*)(ws + WS_MIX); float* SSQA = (float*)(ws + WS_SSQA);
    bf16_t* QB = (bf16_t*)(ws + WS_Q); bf16_t* KB = (bf16_t*)(ws + WS_K);
    const int lo = args.ph_lo, hi = args.ph_hi;
    cooperative_groups::grid_group grid = cooperative_groups::this_grid();
    volatile LAS unsigned* MISC = (volatile LAS unsigned*)((LAS unsigned char*)lds + MISC_OFF);
    { const int tid = TIDV(); if (tid < 32) MISC[tid] = 0u; }
    __syncthreads();
    XcdBarrier bar = xcd_barrier_post((unsigned*)(ws + WS_CTL) + 4096, MISC + 8, TIDV() == 0);
    if (args.ph_hi > 1000) grid.sync();
#define SEAM(k) do { if (lo <= (k) && (k) + 1 < hi) xcd_barrier(bar, TIDV() == 0); } while (0)
#ifndef PHMASK
#define PHMASK 0xFFF
#endif
#define IN(k) (((PHMASK >> (k)) & 1) && lo <= (k) && (k) < hi)
#ifndef REPMASK
#define REPMASK 0
#endif
#define REPS(k) for (int rep_ = 0; rep_ < ((((REPMASK) >> (k)) & 1) ? 2 : 1); ++rep_)

    if (IN(0)) REPS(0) {
        const int tid = TIDV(), lane = tid & 63, wave = g_wv;
        const int vcu = (G % 8 == 0) ? (bx % 8) * (G / 8) + bx / 8 : bx;
        const int gw = vcu * NWAVES + wave, NGW = G * NWAVES;
        LAS float* scr = (LAS float*)((LAS unsigned char*)lds + wave * 16384);
        constexpr int I_IN = 16 * 104, I_Q = 6 * 32, I_KV = 4 * 32, I_OUT = 16 * 32, I_UP = 16 * 128, I_DN = 64 * 32;
        constexpr int NITEMS = I_IN + I_Q + I_KV + I_OUT + I_UP + I_DN;
        const int l31 = lane & 31;
        for (int it = gw; it < NITEMS; it += NGW) {
            int r = it;
            if (r < I_IN) { const int kb = r / 104, nb = r % 104, nd = 32 * nb + l31; const int sc = nd < C_KR ? nd : (nd < DIN ? C_KR + rope_perm(nd - C_KR) : -1);
                tr_item(w_in, DIN, 64 * kb, sc, g_mix, 0, WIN, DM, 64 * kb, 32 * nb, scr, lane); continue; } r -= I_IN;
            if (r < I_Q) { const int kb = r / 32, nb = r % 32, nd = 32 * nb + l31, hh = nd >> 8, c = nd & 255; const int sc = c < 128 ? hh * 192 + c : (c < 192 ? hh * 192 + 128 + rope_perm(c - 128) : -1);
                tr_item(w_q_up, NQ, 64 * kb, sc, g_cq, 0, WQ, QLORA, 64 * kb, 32 * nb, scr, lane); continue; } r -= I_Q;
            if (r < I_KV) { const int kb = r / 32, nb = r % 32; tr_item(w_kv_up, NKV, 64 * kb, 32 * nb + l31, g_ckv, 0, WKV, KVLORA, 64 * kb, 32 * nb, scr, lane); continue; } r -= I_KV;
            if (r < I_OUT) { const int kb = r / 32, nb = r % 32; const int kd0 = 64 * kb, ks0 = kd0 < 512 ? kd0 + 512 : kd0 - 512;
                tr_item(w_out, DM, ks0, 32 * nb + l31, kd0 < 512 ? g_mla_out : nullptr, 512, WOUT, DM, kd0, 32 * nb, scr, lane); continue; } r -= I_OUT;
            if (r < I_UP) { const int kb = r / 128, nb = r % 128; tr_item(w_up, DFF, 64 * kb, 32 * nb + l31, g_ffn, 0, WUP, DM, 64 * kb, 32 * nb, scr, lane); continue; } r -= I_UP;
            { const int kb = r / 32, nb = r % 32; tr_item(w_down, DM, 64 * kb, 32 * nb + l31, nullptr, 0, WDN, DFF, 64 * kb, 32 * nb, scr, lane); }
        }
        for (int i = bx * 512 + tid; i < 512; i += G * 512) ((float*)(ws + WS_GHT))[i] = g_hgrn[i];
        for (int i = bx * 512 + tid; i < 512; i += G * 512) {
            if (i < 256) GQT[i] = i < 128 ? g_qn[i] * QSCALE : (i < 192 ? g_qn[128 + rope_perm(i - 128)] * QSCALE : 0.f);
            else { const int c = i - 256; if (c < 192) GKT[c] = c < 128 ? g_kn[c] : g_kn[128 + rope_perm(c - 128)]; } }
        for (int m = gw; m < M; m += 4 * NGW) rows_to_bf16_rs<4>(x + (size_t)m * DM, XB + (size_t)m * DM, RS0 + m, (size_t)NGW, lane);
        for (int i = bx * 512 + tid; i < 1024; i += G * 512) { const int dir = i >> 9, c = i & 511; const float p0 = lb_param[dir * 1024 + c], p1 = lb_param[dir * 1024 + 512 + c];
            LBT[i] = 1.f / (1.f + expf(p1 - p0)); }
        { const int j = tid & 31; const float invf = powf(10000.0f, -(float)(2 * j) / 64.0f);
          for (int i = bx * 512 + tid; i < M * 32; i += G * 512) { const int row = i >> 5; const float ang = (float)positions[row] * invf; float c, sn; sincos_acc(ang, c, sn); COS[i] = c; SIN[i] = sn; } }
    }
    SEAM(0);
    if (IN(1)) REPS(1) {
        pg8::Gemm g{XB, WIN, M, DINP, DM, DM}; pg8::StaticOrder S; S.init(M, DINP, G, bx);
        LAS float* rsT = (LAS float*)((LAS unsigned char*)lds + TAB_OFF);
        for (int ui = 0; ui < 16; ++ui) { pg8::Unit uu; if (!S.next(ui, uu)) break; const int tid = TIDV(); if (tid < 256) rsT[ui * 256 + tid] = RS0[uu.pm * 256 + tid]; }
        __syncthreads();
        pg8::EpiProj E{PROJ, DINP, rsT, LBT, SSQP, M, (LAS float*)((LAS unsigned char*)lds + EPI_OFF)};
        pg8::gemm_phase<pg8::EpiProj, pg8::StaticOrder, true, true>((LAS unsigned char*)lds, g, S, E, g_wv);
    }
    SEAM(1);
    if (IN(2)) REPS(2) {
        pg8::Gemm g{PROJ + C_CQ, WQ, M, 1024, QLORA, DINP}; pg8::StaticOrder S; S.init(M, 1024, G, bx);
        LAS float* rsT = (LAS float*)((LAS unsigned char*)lds + TAB_OFF);
        for (int ui = 0; ui < 4; ++ui) { pg8::Unit uu; if (!S.next(ui, uu)) break;
            const int tid = TIDV(); if (tid < 256) { const int row = uu.pm * 256 + tid; rsT[ui * 256 + tid] = __builtin_amdgcn_rsqf(((SSQP[row] + SSQP[M + row]) + SSQP[2 * (size_t)M + row]) * (1.f / 384.f) + EPS); } }
        __syncthreads();
        pg8::EpiQ E{QB, rsT, GQT, COS, SIN, (LAS float*)((LAS unsigned char*)lds + EPI_OFF)};
        pg8::gemm_phase<pg8::EpiQ, pg8::StaticOrder, true, true>((LAS unsigned char*)lds, g, S, E, g_wv);
    }
    if (IN(3)) REPS(3) {
        pg8::Gemm g{PROJ + C_CKV, WKV, M, NKV, KVLORA, DINP}; pg8::StaticOrder S; S.init(M, NKV, G, bx);
        LAS float* rsT = (LAS float*)((LAS unsigned char*)lds + TAB_OFF + 8192); LAS float* skT = rsT + 1024;
        for (int ui = 0; ui < 4; ++ui) { pg8::Unit uu; if (!S.next(ui, uu)) break;
            const int tid = TIDV(); if (tid < 256) { const int row = uu.pm * 256 + tid; rsT[ui * 256 + tid] = __builtin_amdgcn_rsqf((SSQP[3 * (size_t)M + row] + SSQP[4 * (size_t)M + row]) * (1.f / 256.f) + EPS); skT[ui * 256 + tid] = SSQP[5 * (size_t)M + row]; } }
        __syncthreads();
        pg8::EpiKV E{KB, VB, PROJ, DINP, C_KR, rsT, skT, GKT, COS, SIN, (LAS float*)((LAS unsigned char*)lds + EPI_OFF)};
        pg8::gemm_phase<pg8::EpiKV, pg8::StaticOrder, true, true>((LAS unsigned char*)lds, g, S, E, g_wv);
    }
    SEAM(4);
    if (IN(5)) {
        if (bx < BATCH * 4) hg::hgrn_bh(bx >> 2, bx & 3, PROJ, MIX, (const float*)(ws + WS_GHT) + (bx & 3) * 128, (char*)lds, g_wv);
        { const int a = bx & 127, bhs = (a >> 6) * 8 + (a & 7), qb = (a >> 3) & 7;
          att::attn_chain(QB, KB, VB, MIX, DM, SSQA, bhs, qb, bx < BATCH * 4 ? 7 : 0, bx < BATCH * 4 ? 8 : 7, SEQ, M, (char*)lds, g_wv); }
    }
    SEAM(7);
    if (IN(8)) REPS(8) {
        pg8::Gemm g{MIX, WOUT, M, DM, DM, DM}; pg8::StaticOrder S; S.init(M, DM, G, bx);
        LAS float* rsbT = (LAS float*)((LAS unsigned char*)lds + EPI_OFF + 4096);
        for (int ui = 0; ui < 4; ++ui) { pg8::Unit uu; if (!S.next(ui, uu)) break;
            const int tid = TIDV(); if (tid < 256) { const int row = uu.pm * 256 + tid; rsbT[ui * 256 + tid] = 1.f / sqrtf(((SSQA[row] + SSQA[M + row]) + (SSQA[2 * (size_t)M + row] + SSQA[3 * (size_t)M + row])) * (1.f / 512.f) + EPS); } }
        __syncthreads();
        pg8::EpiResidX1 E{XB, X1B, SSQ1, DM, M, (LAS float*)((LAS unsigned char*)lds + EPI_OFF), rsbT};
        pg8::gemm_phase<pg8::EpiResidX1, pg8::StaticOrder, true, true>((LAS unsigned char*)lds, g, S, E, g_wv);
    }
    SEAM(8);
    if (IN(10)) REPS(10) {
        pg8::Gemm g{X1B, WUP, M, DFF, DM, DM}; pg8::StaticOrder S; S.init(M, DFF, G, bx);
        LAS float* rsT = (LAS float*)((LAS unsigned char*)lds + TAB_OFF);
        for (int ui = 0; ui < 16; ++ui) { pg8::Unit uu; if (!S.next(ui, uu)) break;
            const int tid = TIDV(); if (tid < 256) { const int row = uu.pm * 256 + tid; rsT[ui * 256 + tid] = __builtin_amdgcn_rsqf(((SSQ1[row] + SSQ1[M + row]) + (SSQ1[2 * (size_t)M + row] + SSQ1[3 * (size_t)M + row])) * (1.f / 1024.f) + EPS); } }
        __syncthreads();
        pg8::EpiUp E{HB, DFF, rsT};
        pg8::gemm_phase<pg8::EpiUp, pg8::StaticOrder, true, true>((LAS unsigned char*)lds, g, S, E, g_wv);
    }
    SEAM(10);
    if (IN(11)) {
        pg8::Gemm g{HB, WDN, M, DM, DFF, DFF}; pg8::StaticOrder S; S.init(M, DM, G, bx);
        pg8::EpiResidBf E{X1B, out, DM};
        pg8::gemm_phase<pg8::EpiResidBf, pg8::StaticOrder, true, true>((LAS unsigned char*)lds, g, S, E, g_wv);
    }
#undef IN
}

extern "C" void kernel_launch(void* const* d_in, const int* in_sizes, int n_in, void* d_out, int out_size, void* d_ws, size_t ws_size, hipStream_t stream) {
    static int ok = 0, grid_blocks = 0;
    if (ok == 0) {
        if (n_in != 17 || in_sizes[0] != M * DM || out_size != M * DM || ws_size < WS_END) {
            fprintf(stderr, "kernel_launch: shape mismatch n_in %d in0 %d out %d ws %zu (need %zu)\n", n_in, n_in > 0 ? in_sizes[0] : -1, out_size, ws_size, (size_t)WS_END); ok = -1; return; }
        if (hipFuncSetAttribute((const void*)mk_fwd, hipFuncAttributeMaxDynamicSharedMemorySize, LDS_BYTES) != hipSuccess) { fprintf(stderr, "kernel_launch: hipFuncSetAttribute failed\n"); ok = -1; return; }
        int dev = 0, cus = 0, per_cu = 0;
        (void)hipGetDevice(&dev); (void)hipDeviceGetAttribute(&cus, hipDeviceAttributeMultiprocessorCount, dev);
        (void)hipOccupancyMaxActiveBlocksPerMultiprocessor(&per_cu, (const void*)mk_fwd, NWAVES * 64, LDS_BYTES);
        if (per_cu < 1 || cus < 1) { fprintf(stderr, "kernel_launch: occupancy query gave %d blocks/CU on %d CUs\n", per_cu, cus); ok = -1; return; }
        grid_blocks = cus * (per_cu > 1 ? 1 : per_cu);
        ok = 1;
    }
    if (ok < 0) return;
    (void)hipMemsetAsync((char*)d_ws + WS_CTL, 0, CTL_ZERO_BYTES, stream);
    Args a{};
    for (int i = 0; i < 17; ++i) a.in[i] = (const float*)d_in[i];
    a.out = (float*)d_out; a.ws = (unsigned char*)d_ws;
    a.ph_lo = 0; a.ph_hi = 12;
    void* kargs[] = {&a};
    (void)hipLaunchCooperativeKernel((const void*)mk_fwd, dim3(grid_blocks), dim3(NWAVES * 64), kargs, LDS_BYTES, stream);
    const hipError_t le = hipPeekAtLastError();
    if (le != hipSuccess) fprintf(stderr, "kernel_launch: launch failed: %s\n", hipGetErrorName(le));
}
```

```cpp
#include <hip/hip_runtime.h>
#include <hip/hip_cooperative_groups.h>
#include <cstdio>
#include <cstdint>

#define LAS __attribute__((address_space(3)))
typedef unsigned short bf16_t;
typedef short bf16x8 __attribute__((ext_vector_type(8)));
typedef short s16x4 __attribute__((ext_vector_type(4)));
typedef float f32x4 __attribute__((ext_vector_type(4)));
typedef float f32x16 __attribute__((ext_vector_type(16)));
typedef unsigned u32x4 __attribute__((ext_vector_type(4)));
typedef unsigned u32x2 __attribute__((ext_vector_type(2)));
typedef _Float16 h16x2 __attribute__((ext_vector_type(2)));

constexpr int BATCH = 32, SEQ = 2048, DM = 1024, M = BATCH * SEQ;
constexpr int DIN = 3264, DINP = 3328, DFF = 4096;
constexpr int C_Q = 0, C_FF = 512, C_I = 1536, C_G = 2048, C_CQ = 2560, C_CKV = 2944, C_KR = 3200;
constexpr int QLORA = 384, KVLORA = 256, NQ = 768, NKV = 1024;
constexpr float EPS = 1e-6f;
constexpr float QSCALE = 0.07216878364870322f * 1.4426950408889634f;

constexpr size_t MiB = 1u << 20;
constexpr size_t WS_CTL = 0;
constexpr size_t WS_RS0 = 1 * MiB, WS_RS1 = WS_RS0 + 256 * 1024, WS_LBT = WS_RS1 + 256 * 1024;
constexpr size_t WS_COS = 2 * MiB, WS_SIN = 10 * MiB;
constexpr size_t WS_WIN = 18 * MiB, WS_WQ = 25 * MiB, WS_WKV = 26 * MiB, WS_WOUT = 27 * MiB, WS_WUP = 29 * MiB, WS_WDN = 37 * MiB;
constexpr size_t WS_GQT = WS_LBT + 4096, WS_GKT = WS_GQT + 1024, WS_GHT = WS_GKT + 1024;
constexpr size_t WS_SSQ1 = 45 * MiB;
constexpr size_t WS_XB = 46 * MiB;
constexpr size_t WS_X1B = 718 * MiB;
constexpr size_t WS_PROJ = 174 * MiB;
constexpr size_t WS_HB = 174 * MiB;
constexpr size_t WS_MIX = 590 * MiB;
constexpr size_t WS_Q = 718 * MiB, WS_K = 814 * MiB, WS_V = 910 * MiB;
constexpr size_t WS_SSQP = 974 * MiB;
constexpr size_t WS_SSQA = 976 * MiB;
constexpr size_t WS_END = 977 * MiB;

__device__ __forceinline__ unsigned f2bf(float f) { unsigned u = __builtin_bit_cast(unsigned, f); return (u + 0x7fffu + ((u >> 16) & 1u)) >> 16; }
__device__ __forceinline__ unsigned pk2(float lo, float hi) { return f2bf(lo) | (f2bf(hi) << 16); }
__device__ __forceinline__ float bf2f(unsigned short b) { return __builtin_bit_cast(float, (unsigned)b << 16); }
__device__ __forceinline__ float bflo(unsigned w) { return __builtin_bit_cast(float, w << 16); }
__device__ __forceinline__ float bfhi(unsigned w) { return __builtin_bit_cast(float, w & 0xffff0000u); }
__device__ __forceinline__ float wave_sum(float v) {
#pragma unroll
    for (int o = 1; o < 64; o <<= 1) v += __shfl_xor(v, o);
    return v;
}
__device__ __forceinline__ int lane_id() { int l; asm volatile("v_mbcnt_lo_u32_b32 %0, -1, 0\n\tv_mbcnt_hi_u32_b32 %0, -1, %0" : "=v"(l)); return l; }
__device__ __forceinline__ float dpp_sum8(float v) {
    v += __builtin_bit_cast(float, __builtin_amdgcn_update_dpp(0, __builtin_bit_cast(int, v), 0xB1, 0xF, 0xF, true));
    v += __builtin_bit_cast(float, __builtin_amdgcn_update_dpp(0, __builtin_bit_cast(int, v), 0x4E, 0xF, 0xF, true));
    v += __builtin_bit_cast(float, __builtin_amdgcn_update_dpp(0, __builtin_bit_cast(int, v), 0x141, 0xF, 0xF, true));
    return v;
}
typedef float f32x2_t __attribute__((ext_vector_type(2))); typedef __bf16 bf16x2_t __attribute__((ext_vector_type(2)));
__device__ __forceinline__ unsigned cvtpk(float lo, float hi) { f32x2_t v = {lo, hi}; bf16x2_t b = __builtin_convertvector(v, bf16x2_t); return __builtin_bit_cast(unsigned, b); }
__device__ __forceinline__ unsigned cvt_pk_bf16(float lo, float hi) { unsigned r; asm volatile("v_cvt_pk_bf16_f32 %0, %1, %2" : "=v"(r) : "v"(lo), "v"(hi)); return r; }

namespace pg8 {
#define PG8_LAS __attribute__((address_space(3)))
constexpr int BM = 256, BK = 64, HALF = 128, HTB = HALF * BK * 2, STAGE_BYTES = 8 * HTB, NXCD = 8, WGM = 8;
__host__ __device__ __forceinline__ int lds_byte(int r, int c) { const int st = (r >> 4) * 2 + (c >> 5), rr = r & 15, cc = c & 31, ob = rr * 64 + cc * 2; return st * 1024 + (ob ^ (((ob >> 9) & 1) << 5)); }
__host__ __device__ __forceinline__ void stage_rc(int b, int& R, int& C) { const int st = b / 1024, sb = b % 1024, swz = sb ^ (((sb >> 9) & 1) << 5); R = (st >> 1) * 16 + swz / 64; C = (st & 1) * 32 + (swz % 64) / 2; }
__host__ __device__ __forceinline__ int perm32(int rho) { const int n = rho >> 4, i = rho & 15; return 8 * (i >> 2) + 4 * n + (i & 3); }
struct Unit { int pm, pn; };
struct Gemm { const bf16_t* A; const bf16_t* Bt; int M, N, K, lda; };
struct StaticOrder {
    int nM, nN, nwg, G, c;
    __host__ __device__ __forceinline__ void init(int M_, int N_, int G_, int c_) { nM = M_ / BM; nN = N_ / BM; nwg = nM * nN; G = G_; c = c_; }
    __host__ __device__ __forceinline__ bool next(int i, Unit& u) const {
        const long L = (long)i * G + c; if (L >= nwg) return false;
        int wgid = (int)L; { const int q = nwg / NXCD, r = nwg % NXCD, xcd = wgid % NXCD, off = wgid / NXCD; wgid = (xcd < r ? xcd * (q + 1) : r * (q + 1) + (xcd - r) * q) + off; }
        const int nig = WGM * nN, gid = wgid / nig, fm = gid * WGM, gsz = (nM - fm) < WGM ? (nM - fm) : WGM;
        u.pm = fm + ((wgid % nig) % gsz); u.pn = (wgid % nig) / gsz; return true;
    }
    __device__ __forceinline__ void a_ready(const Unit&) const {}
    __device__ __forceinline__ void done(const Unit&) const {}
};
typedef f32x4 Acc[2][2][4][2];

struct EpiBf16 {
    static constexpr bool PERM = true, AFTER_DRAIN = false; static constexpr int MIDK = 0;
    bf16_t* O; int ldc;
    __device__ __forceinline__ void operator()(const Acc& acc, const Unit& u, int wr, int wc, int fr, int fq, int ui) const {
        const int row0 = u.pm * BM + wr * 64 + fr, col0 = u.pn * BM + wc * 32 + 8 * fq;
#pragma unroll
        for (int ai = 0; ai < 2; ++ai)
#pragma unroll
            for (int m = 0; m < 4; ++m) { bf16_t* rowp = O + (size_t)(row0 + ai * HALF + m * 16) * ldc + col0;
#pragma unroll
                for (int bj = 0; bj < 2; ++bj) { const f32x4 v0 = acc[ai][bj][m][0], v1 = acc[ai][bj][m][1];
                    u32x4 w; w.x = cvt_pk_bf16(v0[0], v0[1]); w.y = cvt_pk_bf16(v0[2], v0[3]); w.z = cvt_pk_bf16(v1[0], v1[1]); w.w = cvt_pk_bf16(v1[2], v1[3]);
                    *(u32x4*)(rowp + bj * HALF) = w; } }
    }
};
struct EpiProj {
    static constexpr bool PERM = true, AFTER_DRAIN = false; static constexpr int MIDK = 0;
    bf16_t* O; int ldc; const PG8_LAS float* rsT; const float* lbt; float* ssqp; int Mrows; PG8_LAS float* red;
    __device__ __forceinline__ void operator()(const Acc& acc, const Unit& u, int wr, int wc, int fr, int fq, int ui) const {
        const int row0 = u.pm * BM + wr * 64 + fr, col0 = u.pn * BM + wc * 32 + 8 * fq;
        const bool gate = (u.pn >= 2 && u.pn < 6), stat = (u.pn >= 10);
        f32x4 lb[2][2];
#pragma unroll
        for (int bj = 0; bj < 2; ++bj)
#pragma unroll
            for (int n = 0; n < 2; ++n) lb[bj][n] = gate ? *(const f32x4*)(lbt + (col0 - 512) + bj * HALF + 4 * n) : (f32x4){0.f, 0.f, 0.f, 0.f};
#pragma unroll
        for (int ai = 0; ai < 2; ++ai)
#pragma unroll
            for (int m = 0; m < 4; ++m) { const int row = row0 + ai * HALF + m * 16; const float r = rsT[ui * BM + ai * HALF + wr * 64 + m * 16 + fr]; bf16_t* rowp = O + (size_t)row * ldc + col0; float sq[2];
#pragma unroll
                for (int bj = 0; bj < 2; ++bj) { f32x4 v0 = acc[ai][bj][m][0] * r, v1 = acc[ai][bj][m][1] * r; u32x4 w;
                    sq[bj] = ((v0[0] * v0[0] + v0[1] * v0[1]) + (v0[2] * v0[2] + v0[3] * v0[3])) + ((v1[0] * v1[0] + v1[1] * v1[1]) + (v1[2] * v1[2] + v1[3] * v1[3]));
                    if (gate) {
#pragma unroll
                        for (int e = 0; e < 4; ++e) { const float s0 = __builtin_amdgcn_rcpf(1.f + __builtin_amdgcn_exp2f(-1.4426950408889634f * v0[e])), s1 = __builtin_amdgcn_rcpf(1.f + __builtin_amdgcn_exp2f(-1.4426950408889634f * v1[e]));
                            v0[e] = __builtin_amdgcn_logf(lb[bj][0][e] + (1.f - lb[bj][0][e]) * s0); v1[e] = __builtin_amdgcn_logf(lb[bj][1][e] + (1.f - lb[bj][1][e]) * s1); }
                        h16x2 a = {(_Float16)v0[0], (_Float16)v0[1]}, b = {(_Float16)v0[2], (_Float16)v0[3]}, c = {(_Float16)v1[0], (_Float16)v1[1]}, d = {(_Float16)v1[2], (_Float16)v1[3]};
                        w.x = __builtin_bit_cast(unsigned, a); w.y = __builtin_bit_cast(unsigned, b); w.z = __builtin_bit_cast(unsigned, c); w.w = __builtin_bit_cast(unsigned, d);
                    } else { w.x = cvt_pk_bf16(v0[0], v0[1]); w.y = cvt_pk_bf16(v0[2], v0[3]); w.z = cvt_pk_bf16(v1[0], v1[1]); w.w = cvt_pk_bf16(v1[2], v1[3]); }
                    *(u32x4*)(rowp + bj * HALF) = w; }
                if (stat) { sq[0] += __shfl_xor(sq[0], 16); sq[0] += __shfl_xor(sq[0], 32); sq[1] += __shfl_xor(sq[1], 16); sq[1] += __shfl_xor(sq[1], 32);
                    if (fq == 0) { PG8_LAS float* rp = red + (ai * HALF + wr * 64 + m * 16 + fr) * 8 + wc * 2; rp[0] = sq[0]; rp[1] = sq[1]; } } }
        if (stat) {
            asm volatile("s_waitcnt lgkmcnt(0)" ::: "memory"); __builtin_amdgcn_s_barrier(); asm volatile("" ::: "memory");
            const int t = (wr * 4 + wc) * 64 + fq * 16 + fr;
            if (t < 256) { const f32x4 q0 = *(const PG8_LAS f32x4*)(red + t * 8), q1 = *(const PG8_LAS f32x4*)(red + t * 8 + 4);
                float* dst = ssqp + (size_t)((u.pn - 10) * 2) * Mrows + u.pm * BM + t; dst[0] = (q0[0] + q0[2]) + (q1[0] + q1[2]); dst[Mrows] = (q0[1] + q0[3]) + (q1[1] + q1[3]); }
            asm volatile("s_waitcnt lgkmcnt(0)" ::: "memory"); __builtin_amdgcn_s_barrier(); asm volatile("" ::: "memory");
        }
    }
};
struct EpiQ {
    static constexpr bool PERM = true, AFTER_DRAIN = false; static constexpr int MIDK = 0;
    bf16_t* Q; const PG8_LAS float* rsT; const float* gq; const float* cosT; const float* sinT; PG8_LAS float* red;
    __device__ __forceinline__ void operator()(const Acc& acc, const Unit& u, int wr, int wc, int fr, int fq, int ui) const {
        const int h = u.pn, cl = wc * 32 + 8 * fq, ic = 4 * wc + fq;
        f32x4 cs[2][4], sn[2][4];
        if (wc < 2) {
#pragma unroll
            for (int ai = 0; ai < 2; ++ai)
#pragma unroll
                for (int m = 0; m < 4; ++m) { const size_t row = (size_t)(u.pm * BM + ai * HALF + wr * 64 + m * 16 + fr);
                    cs[ai][m] = *(const f32x4*)(cosT + row * 32 + 4 * ic); sn[ai][m] = *(const f32x4*)(sinT + row * 32 + 4 * ic); }
        }
        const f32x4 g00 = *(const f32x4*)(gq + cl), g01 = *(const f32x4*)(gq + cl + 4), g10 = *(const f32x4*)(gq + 128 + cl), g11 = *(const f32x4*)(gq + 128 + cl + 4);
#pragma unroll
        for (int ai = 0; ai < 2; ++ai)
#pragma unroll
            for (int m = 0; m < 4; ++m) { float s = 0.f;
#pragma unroll
                for (int bj = 0; bj < 2; ++bj)
#pragma unroll
                    for (int n = 0; n < 2; ++n) { const f32x4 v = acc[ai][bj][m][n]; s += (v[0] * v[0] + v[1] * v[1]) + (v[2] * v[2] + v[3] * v[3]); }
                s += __shfl_xor(s, 16); s += __shfl_xor(s, 32);
                if (fq == 0) red[(ai * HALF + wr * 64 + m * 16 + fr) * 4 + wc] = s; }
        asm volatile("s_waitcnt lgkmcnt(0)" ::: "memory"); __builtin_amdgcn_s_barrier(); asm volatile("" ::: "memory");
#pragma unroll
        for (int ai = 0; ai < 2; ++ai)
#pragma unroll
            for (int m = 0; m < 4; ++m) { const int rowl = ai * HALF + wr * 64 + m * 16 + fr, row = u.pm * BM + rowl;
                const f32x4 q4 = *(const PG8_LAS f32x4*)(red + rowl * 4); const float ssx = (q4[0] + q4[1]) + (q4[2] + q4[3]);
                const float rs = rsT[ui * BM + rowl];
                const float sc = rs * __builtin_amdgcn_rsqf(rs * rs * ssx * (1.f / 192.f) + 1e-6f);
                bf16_t* dst = Q + ((size_t)((row >> 11) * 4 + h) * 2048 + (row & 2047)) * 192 + cl;
                { const f32x4 v0 = acc[ai][0][m][0] * sc * g00, v1 = acc[ai][0][m][1] * sc * g01; u32x4 w; w.x = cvt_pk_bf16(v0[0], v0[1]); w.y = cvt_pk_bf16(v0[2], v0[3]); w.z = cvt_pk_bf16(v1[0], v1[1]); w.w = cvt_pk_bf16(v1[2], v1[3]); *(u32x4*)dst = w; }
                if (wc < 2) { const f32x4 t1 = acc[ai][1][m][0] * sc * g10, t2 = acc[ai][1][m][1] * sc * g11;
                    const f32x4 o1 = t1 * cs[ai][m] - t2 * sn[ai][m], o2 = t2 * cs[ai][m] + t1 * sn[ai][m];
                    u32x4 w; w.x = cvt_pk_bf16(o1[0], o1[1]); w.y = cvt_pk_bf16(o1[2], o1[3]); w.z = cvt_pk_bf16(o2[0], o2[1]); w.w = cvt_pk_bf16(o2[2], o2[3]); *(u32x4*)(dst + 128) = w; } }
    }
};
struct EpiKV {
    static constexpr bool PERM = true, AFTER_DRAIN = false; static constexpr int MIDK = 0;
    bf16_t* K; bf16_t* V; const bf16_t* proj; int ldp; int ckr; const PG8_LAS float* rsT; const PG8_LAS float* skT; const float* gk; const float* cosT; const float* sinT; PG8_LAS float* red;
    __device__ __forceinline__ void operator()(const Acc& acc, const Unit& u, int wr, int wc, int fr, int fq, int ui) const {
        const int h = u.pn, cl = wc * 32 + 8 * fq, ic = 4 * wc + fq;
#pragma unroll
        for (int ai = 0; ai < 2; ++ai)
#pragma unroll
            for (int m = 0; m < 4; ++m) { float s = 0.f;
#pragma unroll
                for (int n = 0; n < 2; ++n) { const f32x4 v = acc[ai][0][m][n]; s += (v[0] * v[0] + v[1] * v[1]) + (v[2] * v[2] + v[3] * v[3]); }
                s += __shfl_xor(s, 16); s += __shfl_xor(s, 32);
                if (fq == 0) red[(ai * HALF + wr * 64 + m * 16 + fr) * 4 + wc] = s; }
        const f32x4 g0 = *(const f32x4*)(gk + cl), g1 = *(const f32x4*)(gk + cl + 4);
        f32x4 gr0 = {0.f, 0.f, 0.f, 0.f}, gr1 = {0.f, 0.f, 0.f, 0.f};
        if (wc < 2) { gr0 = *(const f32x4*)(gk + 128 + 8 * ic); gr1 = *(const f32x4*)(gk + 128 + 8 * ic + 4); }
        asm volatile("s_waitcnt lgkmcnt(0)" ::: "memory"); __builtin_amdgcn_s_barrier(); asm volatile("" ::: "memory");
#pragma unroll
        for (int ai = 0; ai < 2; ++ai) {
            u32x4 kr[4]; f32x4 cs[4], sn[4];
            if (wc < 2) {
#pragma unroll
                for (int m = 0; m < 4; ++m) { const size_t row = (size_t)(u.pm * BM + ai * HALF + wr * 64 + m * 16 + fr);
                    kr[m] = *(const u32x4*)(proj + row * ldp + ckr + 8 * ic); cs[m] = *(const f32x4*)(cosT + row * 32 + 4 * ic); sn[m] = *(const f32x4*)(sinT + row * 32 + 4 * ic); }
            }
#pragma unroll
            for (int m = 0; m < 4; ++m) { const int rowl = ai * HALF + wr * 64 + m * 16 + fr, row = u.pm * BM + rowl;
                const f32x4 q4 = *(const PG8_LAS f32x4*)(red + rowl * 4); const float ssk = (q4[0] + q4[1]) + (q4[2] + q4[3]);
                const float rsc = rsT[ui * BM + rowl], skr = skT[ui * BM + rowl];
                const float r = __builtin_amdgcn_rsqf((rsc * rsc * ssk + skr) * (1.f / 192.f) + 1e-6f);
                const size_t tok = (size_t)((row >> 11) * 4 + h) * 2048 + (row & 2047);
                bf16_t* kd = K + tok * 192; bf16_t* vd = V + tok * 128;
                { const float sc = rsc * r; const f32x4 v0 = acc[ai][0][m][0] * sc * g0, v1 = acc[ai][0][m][1] * sc * g1; u32x4 w; w.x = cvt_pk_bf16(v0[0], v0[1]); w.y = cvt_pk_bf16(v0[2], v0[3]); w.z = cvt_pk_bf16(v1[0], v1[1]); w.w = cvt_pk_bf16(v1[2], v1[3]); *(u32x4*)(kd + cl) = w; }
                { const f32x4 v0 = acc[ai][1][m][0] * rsc, v1 = acc[ai][1][m][1] * rsc; u32x4 w; w.x = cvt_pk_bf16(v0[0], v0[1]); w.y = cvt_pk_bf16(v0[2], v0[3]); w.z = cvt_pk_bf16(v1[0], v1[1]); w.w = cvt_pk_bf16(v1[2], v1[3]); *(u32x4*)(vd + cl) = w; }
                if (wc < 2) { const f32x4 t1 = (f32x4){bflo(kr[m].x), bfhi(kr[m].x), bflo(kr[m].y), bfhi(kr[m].y)} * gr0 * r, t2 = (f32x4){bflo(kr[m].z), bfhi(kr[m].z), bflo(kr[m].w), bfhi(kr[m].w)} * gr1 * r;
                    const f32x4 o1 = t1 * cs[m] - t2 * sn[m], o2 = t2 * cs[m] + t1 * sn[m];
                    u32x4 w; w.x = cvt_pk_bf16(o1[0], o1[1]); w.y = cvt_pk_bf16(o1[2], o1[3]); w.z = cvt_pk_bf16(o2[0], o2[1]); w.w = cvt_pk_bf16(o2[2], o2[3]); *(u32x4*)(kd + 128 + 8 * ic) = w; } }
        }
    }
};
struct EpiUp {
    static constexpr bool PERM = true, AFTER_DRAIN = false; static constexpr int MIDK = 0;
    bf16_t* O; int ldc; const PG8_LAS float* rsT;
    __device__ __forceinline__ void operator()(const Acc& acc, const Unit& u, int wr, int wc, int fr, int fq, int ui) const {
        const int row0 = u.pm * BM + wr * 64 + fr, col0 = u.pn * BM + wc * 32 + 8 * fq;
#pragma unroll
        for (int ai = 0; ai < 2; ++ai)
#pragma unroll
            for (int m = 0; m < 4; ++m) { const int row = row0 + ai * HALF + m * 16; const float r = rsT[ui * BM + ai * HALF + wr * 64 + m * 16 + fr]; bf16_t* rowp = O + (size_t)row * ldc + col0;
#pragma unroll
                for (int bj = 0; bj < 2; ++bj) { f32x4 v0 = acc[ai][bj][m][0] * r, v1 = acc[ai][bj][m][1] * r;
#pragma unroll
                    for (int e = 0; e < 4; ++e) { const float a = fmaxf(v0[e], 0.f), b = fmaxf(v1[e], 0.f); v0[e] = a * a; v1[e] = b * b; }
                    u32x4 w; w.x = cvt_pk_bf16(v0[0], v0[1]); w.y = cvt_pk_bf16(v0[2], v0[3]); w.z = cvt_pk_bf16(v1[0], v1[1]); w.w = cvt_pk_bf16(v1[2], v1[3]);
                    *(u32x4*)(rowp + bj * HALF) = w; } }
    }
};
struct EpiResid {
    static constexpr bool PERM = false, AFTER_DRAIN = false; static constexpr int MIDK = 0;
    const float* base; float* out; int ldc;
    __device__ __forceinline__ void operator()(const Acc& acc, const Unit& u, int wr, int wc, int fr, int fq, int ui) const {
        const int row0 = u.pm * BM + wr * 64 + fr, col0 = u.pn * BM + wc * 32 + 4 * fq;
#pragma unroll
        for (int ai = 0; ai < 2; ++ai)
#pragma unroll
            for (int m = 0; m < 4; ++m) { const size_t off = (size_t)(row0 + ai * HALF + m * 16) * ldc + col0;
#pragma unroll
                for (int bj = 0; bj < 2; ++bj)
#pragma unroll
                    for (int n = 0; n < 2; ++n) { const f32x4 bs = *(const f32x4*)(base + off + bj * HALF + n * 16); *(f32x4*)(out + off + bj * HALF + n * 16) = bs + acc[ai][bj][m][n]; } }
    }
};

struct EpiResidBf {
    static constexpr bool PERM = false, AFTER_DRAIN = false; static constexpr int MIDK = 0;
    const bf16_t* xb; float* out; int ldc;
    __device__ __forceinline__ void operator()(const Acc& acc, const Unit& u, int wr, int wc, int fr, int fq, int ui) const {
        const int row0 = u.pm * BM + wr * 64 + fr, col0 = u.pn * BM + wc * 32 + 4 * fq;
        u32x2 w[2][4][2][2];
#pragma unroll
        for (int ai = 0; ai < 2; ++ai)
#pragma unroll
            for (int m = 0; m < 4; ++m) { const size_t off = (size_t)(row0 + ai * HALF + m * 16) * ldc + col0;
#pragma unroll
                for (int bj = 0; bj < 2; ++bj)
#pragma unroll
                    for (int n = 0; n < 2; ++n) w[ai][m][bj][n] = *(const u32x2*)(xb + off + bj * HALF + n * 16); }
        __builtin_amdgcn_sched_barrier(0);
#pragma unroll
        for (int ai = 0; ai < 2; ++ai) {
#pragma unroll
            for (int m = 0; m < 4; ++m) { const size_t off = (size_t)(row0 + ai * HALF + m * 16) * ldc + col0;
#pragma unroll
                for (int bj = 0; bj < 2; ++bj)
#pragma unroll
                    for (int n = 0; n < 2; ++n) { const u32x2 ww = w[ai][m][bj][n]; const f32x4 bs = {bflo(ww.x), bfhi(ww.x), bflo(ww.y), bfhi(ww.y)}; *(f32x4*)(out + off + bj * HALF + n * 16) = bs + acc[ai][bj][m][n]; } }
        }
    }
};
struct EpiResidX1 {
    static constexpr bool PERM = false, AFTER_DRAIN = false; static constexpr int MIDK = 8;
    const bf16_t* base; bf16_t* xb; float* ssq; int ldc; int Mrows; PG8_LAS float* red; const PG8_LAS float* rsb;
    __device__ __forceinline__ void mid(Acc& acc, int ui, int wr, int fr) const {
#pragma unroll
        for (int ai = 0; ai < 2; ++ai)
#pragma unroll
            for (int m = 0; m < 4; ++m) { const float r = rsb[ui * BM + ai * HALF + wr * 64 + m * 16 + fr];
#pragma unroll
                for (int bj = 0; bj < 2; ++bj)
#pragma unroll
                    for (int n = 0; n < 2; ++n) acc[ai][bj][m][n] *= r; }
    }
    __device__ __forceinline__ void operator()(const Acc& acc, const Unit& u, int wr, int wc, int fr, int fq, int ui) const {
        const int row0 = u.pm * BM + wr * 64 + fr, col0 = u.pn * BM + wc * 32 + 4 * fq;
        u32x2 xr[2][4][2][2];
#pragma unroll
        for (int ai = 0; ai < 2; ++ai)
#pragma unroll
            for (int m = 0; m < 4; ++m) { const size_t off = (size_t)(row0 + ai * HALF + m * 16) * ldc + col0;
#pragma unroll
                for (int bj = 0; bj < 2; ++bj)
#pragma unroll
                    for (int n = 0; n < 2; ++n) xr[ai][m][bj][n] = *(const u32x2*)(base + off + bj * HALF + n * 16); }
        __builtin_amdgcn_sched_barrier(0);
#pragma unroll
        for (int ai = 0; ai < 2; ++ai) {
#pragma unroll
            for (int m = 0; m < 4; ++m) { const size_t off = (size_t)(row0 + ai * HALF + m * 16) * ldc + col0; float s = 0.f;
#pragma unroll
                for (int bj = 0; bj < 2; ++bj)
#pragma unroll
                    for (int n = 0; n < 2; ++n) { const u32x2 xw = xr[ai][m][bj][n]; const f32x4 v = (f32x4){bflo(xw.x), bfhi(xw.x), bflo(xw.y), bfhi(xw.y)} + acc[ai][bj][m][n];
                        u32x2 w; w.x = cvt_pk_bf16(v[0], v[1]); w.y = cvt_pk_bf16(v[2], v[3]); *(u32x2*)(xb + off + bj * HALF + n * 16) = w;
                        s += (v[0] * v[0] + v[1] * v[1]) + (v[2] * v[2] + v[3] * v[3]); }
                s += __shfl_xor(s, 16); s += __shfl_xor(s, 32);
                if (fq == 0) red[(ai * HALF + wr * 64 + m * 16 + fr) * 4 + wc] = s; }
        }
        asm volatile("s_waitcnt lgkmcnt(0)" ::: "memory"); __builtin_amdgcn_s_barrier(); asm volatile("" ::: "memory");
        const int t = (wr * 4 + wc) * 64 + fq * 16 + fr;
        if (t < 256) { const f32x4 q = *(const PG8_LAS f32x4*)(red + t * 4); ssq[(size_t)u.pn * Mrows + u.pm * BM + t] = (q[0] + q[1]) + (q[2] + q[3]); }
        asm volatile("s_waitcnt lgkmcnt(0)" ::: "memory"); __builtin_amdgcn_s_barrier(); asm volatile("" ::: "memory");
    }
};
template <class Epi, class Sched, bool ALIGN_EPI = false, bool SP2 = false>
__device__ __forceinline__ void gemm_phase(PG8_LAS unsigned char* lds, const Gemm g, const Sched& S, const Epi& E, int wv) {
    int lane = lane_id(); asm volatile("" : "+v"(lane));
    const int wid = wv, tid = wv * 64 + lane, wr = wid >> 2, wc = wid & 3, fr = lane & 15, fq = lane >> 4;
    const int K = g.K, nt = K / BK, lda = g.lda;
    unsigned voffA[2], voffB[2];
#pragma unroll
    for (int i = 0; i < 2; ++i) { int R, C; stage_rc(tid * 16 + i * 8192, R, C); const int Rb = Epi::PERM ? ((R & ~31) + perm32(R & 31)) : R;
        voffA[i] = (unsigned)(R * lda + C) * 2u; voffB[i] = (unsigned)(Rb * K + C) * 2u; }
    const size_t kstep = (size_t)(BK * 2);
    const size_t hstepA = (size_t)HALF * lda * 2, hstepB = (size_t)HALF * K * 2;
    const size_t tstepA = 2 * hstepA, tstepB = 2 * hstepB;
    const unsigned ldsw = (unsigned)wid * 1024u;
    const int aoff = lds_byte(wr * 64 + fr, fq * 8), boff = lds_byte(wc * 32 + fr, fq * 8);
#define PG8_SA(b, h) (((b) * 2 + (h)) * HTB)
#define PG8_SB(b, h) ((4 + (b) * 2 + (h)) * HTB)
#define PG8_STAGE(bufoff, gbase, voff) do { _Pragma("unroll") for (int _i = 0; _i < 2; ++_i) \
        __builtin_amdgcn_global_load_lds((const unsigned*)((const char*)(gbase) + (voff)[_i]), (PG8_LAS unsigned*)(lds + (bufoff) + ldsw + _i * 8192), 16, 0, 0); } while (0)
#define PG8_LDA(dst, b, h) do { _Pragma("unroll") for (int m = 0; m < 4; ++m) _Pragma("unroll") for (int k = 0; k < 2; ++k) dst[m][k] = *(const PG8_LAS bf16x8*)(lds + PG8_SA(b, h) + aoff + m * 2048 + k * 1024); } while (0)
#define PG8_LDB(dst, b, h) do { _Pragma("unroll") for (int n = 0; n < 2; ++n) _Pragma("unroll") for (int k = 0; k < 2; ++k) dst[n][k] = *(const PG8_LAS bf16x8*)(lds + PG8_SB(b, h) + boff + n * 2048 + k * 1024); } while (0)
#define PG8_MMA(ai, bj, At, Bt) do { __builtin_amdgcn_s_setprio(1); _Pragma("unroll") for (int m = 0; m < 4; ++m) _Pragma("unroll") for (int n = 0; n < 2; ++n) _Pragma("unroll") for (int k = 0; k < 2; ++k) \
        acc[ai][bj][m][n] = __builtin_amdgcn_mfma_f32_16x16x32_bf16(Bt[n][k], At[m][k], acc[ai][bj][m][n], 0, 0, 0); __builtin_amdgcn_s_setprio(0); } while (0)
#define PG8_WAIT_V(n) asm volatile("s_waitcnt vmcnt(" #n ")" ::: "memory")
#define PG8_WAIT_L(n) asm volatile("s_waitcnt lgkmcnt(" #n ")" ::: "memory")
#define PG8_BAR __builtin_amdgcn_s_barrier()
#define PG8_SCHED __builtin_amdgcn_sched_barrier(0)
    Unit cur, nxt; int ui = 0;
    if (!S.next(0, cur)) return;
    Acc acc;
#pragma unroll
    for (int a = 0; a < 2; ++a)
#pragma unroll
        for (int b = 0; b < 2; ++b)
#pragma unroll
            for (int m = 0; m < 4; ++m)
#pragma unroll
                for (int n = 0; n < 2; ++n) acc[a][b][m][n] = (f32x4){0.f, 0.f, 0.f, 0.f};
    bf16x8 At[4][2], B0[2][2], B1[2][2];
    const char* cA = (const char*)g.A + (size_t)cur.pm * tstepA; const char* cB = (const char*)g.Bt + (size_t)cur.pn * tstepB;
    S.a_ready(cur);
    if constexpr (SP2) {
        PG8_STAGE(PG8_SB(0, 0), cB, voffB); PG8_STAGE(PG8_SB(0, 1), cB + hstepB, voffB); PG8_STAGE(PG8_SA(0, 0), cA, voffA); PG8_STAGE(PG8_SA(0, 1), cA + hstepA, voffA);
        if (wr == 1) PG8_BAR;
        PG8_WAIT_V(2); PG8_BAR;
        PG8_STAGE(PG8_SB(1, 0), cB + kstep, voffB); PG8_STAGE(PG8_SA(1, 0), cA + kstep, voffA); PG8_STAGE(PG8_SB(1, 1), cB + hstepB + kstep, voffB);
        PG8_WAIT_V(6); PG8_BAR;
    } else {
        PG8_STAGE(PG8_SB(0, 0), cB, voffB); PG8_STAGE(PG8_SA(0, 0), cA, voffA); PG8_STAGE(PG8_SB(0, 1), cB + hstepB, voffB); PG8_STAGE(PG8_SA(0, 1), cA + hstepA, voffA);
        if (wr == 1) PG8_BAR;
        PG8_WAIT_V(4); PG8_BAR;
        PG8_STAGE(PG8_SB(1, 0), cB + kstep, voffB); PG8_STAGE(PG8_SA(1, 0), cA + kstep, voffA); PG8_STAGE(PG8_SB(1, 1), cB + hstepB + kstep, voffB);
        PG8_WAIT_V(6); PG8_BAR;
    }
    for (;;) {
        const bool has_next = S.next(ui + 1, nxt);
        const char* nA = has_next ? (const char*)g.A + (size_t)nxt.pm * tstepA : cA; const char* nB = has_next ? (const char*)g.Bt + (size_t)nxt.pn * tstepB : cB;
#pragma nounroll
        for (int t = 0; t < nt; t += 2) {
            const bool last = (t == nt - 2);
            const char* a1 = cA + (size_t)(t + 1) * kstep;
            const char* a2 = last ? nA : cA + (size_t)(t + 2) * kstep; const char* b2 = last ? nB : cB + (size_t)(t + 2) * kstep;
            const char* a3 = a2 + kstep; const char* b3 = b2 + kstep;
            if (last && has_next) S.a_ready(nxt);
            if constexpr (SP2) {
            PG8_LDB(B0, 0, 0); PG8_LDB(B1, 0, 1); PG8_SCHED; PG8_LDA(At, 0, 0); PG8_STAGE(PG8_SA(1, 1), a1 + hstepA, voffA);
            PG8_WAIT_V(8); PG8_WAIT_L(0); PG8_BAR; PG8_MMA(0, 0, At, B0); PG8_MMA(0, 1, At, B1); PG8_BAR; PG8_SCHED;
            PG8_LDA(At, 0, 1); PG8_STAGE(PG8_SB(0, 0), b2, voffB); PG8_STAGE(PG8_SB(0, 1), b2 + hstepB, voffB); PG8_STAGE(PG8_SA(0, 0), a2, voffA);
            PG8_WAIT_V(8); PG8_WAIT_L(0); PG8_BAR; PG8_MMA(1, 0, At, B0); PG8_MMA(1, 1, At, B1); PG8_BAR; PG8_SCHED;
            PG8_LDB(B0, 1, 0); PG8_LDB(B1, 1, 1); PG8_SCHED; PG8_LDA(At, 1, 0); PG8_STAGE(PG8_SA(0, 1), a2 + hstepA, voffA);
            PG8_WAIT_V(8); PG8_WAIT_L(0); PG8_BAR; PG8_MMA(0, 0, At, B0); PG8_MMA(0, 1, At, B1); PG8_BAR; PG8_SCHED;
            PG8_LDA(At, 1, 1); PG8_STAGE(PG8_SB(1, 0), b3, voffB); PG8_STAGE(PG8_SB(1, 1), b3 + hstepB, voffB); PG8_STAGE(PG8_SA(1, 0), a3, voffA);
            PG8_WAIT_V(8); PG8_WAIT_L(0); PG8_BAR; PG8_MMA(1, 0, At, B0); PG8_MMA(1, 1, At, B1); PG8_BAR; PG8_SCHED;
            if constexpr (Epi::MIDK > 0) { if (t + 2 == Epi::MIDK) { E.mid(acc, ui, wr, fr); PG8_SCHED; } }
            } else {
            PG8_LDB(B0, 0, 0); PG8_SCHED; PG8_LDA(At, 0, 0); PG8_STAGE(PG8_SA(1, 1), a1 + hstepA, voffA);
            PG8_WAIT_L(8); PG8_BAR; PG8_WAIT_L(0); PG8_MMA(0, 0, At, B0); PG8_BAR; PG8_SCHED;
            PG8_LDB(B1, 0, 1); PG8_STAGE(PG8_SB(0, 0), b2, voffB);
            PG8_BAR; PG8_WAIT_L(0); PG8_MMA(0, 1, At, B1); PG8_BAR;
            PG8_LDA(At, 0, 1); PG8_STAGE(PG8_SA(0, 0), a2, voffA);
            PG8_BAR; PG8_WAIT_L(0); PG8_MMA(1, 0, At, B0); PG8_BAR; PG8_SCHED;
            PG8_STAGE(PG8_SB(0, 1), b2 + hstepB, voffB);
            PG8_WAIT_V(6); PG8_BAR; PG8_MMA(1, 1, At, B1); PG8_BAR;
            PG8_LDB(B0, 1, 0); PG8_SCHED; PG8_LDA(At, 1, 0); PG8_STAGE(PG8_SA(0, 1), a2 + hstepA, voffA);
            PG8_WAIT_L(8); PG8_BAR; PG8_WAIT_L(0); PG8_MMA(0, 0, At, B0); PG8_BAR; PG8_SCHED;
            PG8_LDB(B1, 1, 1); PG8_STAGE(PG8_SB(1, 0), b3, voffB);
            PG8_BAR; PG8_WAIT_L(0); PG8_MMA(0, 1, At, B1); PG8_BAR;
            PG8_LDA(At, 1, 1); PG8_STAGE(PG8_SA(1, 0), a3, voffA);
            PG8_BAR; PG8_WAIT_L(0); PG8_MMA(1, 0, At, B0); PG8_BAR; PG8_SCHED;
            PG8_STAGE(PG8_SB(1, 1), b3 + hstepB, voffB);
            PG8_WAIT_V(6); PG8_BAR; PG8_MMA(1, 1, At, B1); PG8_BAR;
            }
        }
        if constexpr (ALIGN_EPI) { if (wr == 0) PG8_BAR; }
        if constexpr (!Epi::AFTER_DRAIN) { E(acc, cur, wr, wc, fr, fq, ui); S.done(cur); }
        if (!has_next) break;
#pragma unroll
        for (int a = 0; a < 2; ++a)
#pragma unroll
            for (int b = 0; b < 2; ++b)
#pragma unroll
                for (int m = 0; m < 4; ++m)
#pragma unroll
                    for (int n = 0; n < 2; ++n) acc[a][b][m][n] = (f32x4){0.f, 0.f, 0.f, 0.f};
        cur = nxt; cA = nA; cB = nB; ++ui;
        if constexpr (ALIGN_EPI) { if (wr == 1) PG8_BAR; }
    }
    PG8_WAIT_V(0);
    if constexpr (!ALIGN_EPI) { if (wr == 0) PG8_BAR; }
    PG8_BAR;
#undef PG8_SA
#undef PG8_SB
#undef PG8_STAGE
#undef PG8_LDA
#undef PG8_LDB
#undef PG8_MMA
#undef PG8_WAIT_V
#undef PG8_WAIT_L
#undef PG8_BAR
#undef PG8_SCHED
}
}

namespace att {
constexpr int DQK = 192, DV = 128, NW = 8, QBLK = 32, KVBLK = 64;
constexpr int SHM_V = KVBLK * DV * 2, SHM_K = KVBLK * DQK * 2, SHM_ATTN = 2 * SHM_V + 2 * SHM_K + NW * 64 * 4;
constexpr float THRL = 11.5f;
#define KSWZ(row, colB) ((row) * 384 + ((colB) ^ ((((row) >> 1) & 7) << 4)))
#define SBAR() __builtin_amdgcn_sched_barrier(0)
__device__ __forceinline__ int crow(int r, int hi) { return (r & 3) + 8 * (r >> 2) + 4 * hi; }
__device__ __forceinline__ void partialSM(f32x16& p0, f32x16& p1, float& m_reg, float& mn, float& alpha) {
    float pmax = p0[0];
#pragma unroll
    for (int r = 1; r < 16; ++r) pmax = fmaxf(pmax, p0[r]);
#pragma unroll
    for (int r = 0; r < 16; ++r) pmax = fmaxf(pmax, p1[r]);
    { auto rr = __builtin_amdgcn_permlane32_swap(__float_as_uint(pmax), __float_as_uint(pmax), false, false);
      pmax = fmaxf(__uint_as_float(rr[0]), __uint_as_float(rr[1])); }
    if (__builtin_expect(__all(pmax - m_reg <= THRL), 1)) { mn = m_reg; alpha = 1.f; }
    else { mn = fmaxf(m_reg, pmax); alpha = __builtin_amdgcn_exp2f(m_reg - mn); m_reg = mn; }
#pragma unroll
    for (int r = 0; r < 16; ++r) p0[r] = p0[r] - mn;
#pragma unroll
    for (int r = 0; r < 16; ++r) p1[r] = p1[r] - mn;
#pragma unroll
    for (int r = 0; r < 16; ++r) p0[r] = __builtin_amdgcn_exp2f(p0[r]);
}
__device__ __forceinline__ void finishSM(f32x16& p0, f32x16& p1, float alpha, float& l_reg, bf16x8& pa0, bf16x8& pa1, bf16x8& pa2, bf16x8& pa3) {
#pragma unroll
    for (int r = 0; r < 16; ++r) p1[r] = __builtin_amdgcn_exp2f(p1[r]);
    float ps = 0;
#pragma unroll
    for (int r = 0; r < 16; ++r) ps += p0[r];
#pragma unroll
    for (int r = 0; r < 16; ++r) ps += p1[r];
    { auto rr = __builtin_amdgcn_permlane32_swap(__float_as_uint(ps), __float_as_uint(ps), false, false);
      ps = __uint_as_float(rr[0]) + __uint_as_float(rr[1]); }
    l_reg = l_reg * alpha + ps;
#define PK4(P, BASE, OUT) do { unsigned a0 = cvt_pk_bf16(P[BASE + 0], P[BASE + 1]), a1 = cvt_pk_bf16(P[BASE + 2], P[BASE + 3]);   \
    unsigned b0 = cvt_pk_bf16(P[BASE + 4], P[BASE + 5]), b1 = cvt_pk_bf16(P[BASE + 6], P[BASE + 7]);                              \
    auto r0 = __builtin_amdgcn_permlane32_swap(a0, b0, false, false); auto r1 = __builtin_amdgcn_permlane32_swap(a1, b1, false, false); \
    u32x4 w = {r0[0], r1[0], r0[1], r1[1]}; OUT = __builtin_bit_cast(bf16x8, w); } while (0)
    PK4(p0, 0, pa0); PK4(p0, 8, pa1); PK4(p1, 0, pa2); PK4(p1, 8, pa3);
#undef PK4
}
__device__ __forceinline__ void qkt(f32x16& p0, f32x16& p1, const char* Ks, const bf16x8* qr, int r32, int hi) {
    p0 = f32x16{}; p1 = f32x16{};
    const char* k0p = Ks + KSWZ(r32, 0); const char* k1p = Ks + KSWZ(32 + r32, 0);
    const int key = ((r32 >> 1) & 7) << 4;
    bf16x8 ka[2], kb[2];
#define KRD(d0, slot) do { const int cb_ = (((d0) * 16 + hi * 8) * 2) ^ key; ka[slot] = *reinterpret_cast<const bf16x8*>(k0p + cb_); kb[slot] = *reinterpret_cast<const bf16x8*>(k1p + cb_); } while (0)
    KRD(0, 0); KRD(1, 1);
#pragma unroll
    for (int d0 = 0; d0 < 12; ++d0) {
        const bf16x8 a = ka[d0 & 1], b = kb[d0 & 1];
        p0 = __builtin_amdgcn_mfma_f32_32x32x16_bf16(a, qr[d0], p0, 0, 0, 0);
        p1 = __builtin_amdgcn_mfma_f32_32x32x16_bf16(b, qr[d0], p1, 0, 0, 0);
        if (d0 + 2 < 12) KRD(d0 + 2, d0 & 1);
    }
#undef KRD
}
__device__ __forceinline__ int v_st(int k, int c) { const int kk = (k & ~0xC) | ((k & 4) << 1) | ((k & 8) >> 1); return ((kk >> 3) * 4 + (c >> 5)) * 512 + ((kk & 7) * 32 + (c & 31)) * 2; }
__device__ __forceinline__ int v_rd_base(int lane) { return ((lane & 3) << 3) | (((lane >> 2) & 3) << 6) | (((lane >> 4) & 1) << 5) | (((lane >> 5) & 1) << 8); }
constexpr int v_rd_off(int d0, int ks, int half) { return d0 * 512 + ks * 4096 + half * 2048; }
template <int OFF> __device__ __forceinline__ s16x4 tr_read(int vb) {
    s16x4 r; asm volatile("ds_read_b64_tr_b16 %0, %1 offset:%2" : "=&v"(r) : "v"(vb), "i"(OFF) : "memory"); return r;
}
#define PKLH(L, H) (bf16x8){L[0], L[1], L[2], L[3], H[0], H[1], H[2], H[3]}
template <int D0> __device__ __forceinline__ void pv_one(f32x16& od, int vb, bf16x8 pa0, bf16x8 pa1, bf16x8 pa2, bf16x8 pa3) {
    const s16x4 l0 = tr_read<v_rd_off(D0, 0, 0)>(vb), h0 = tr_read<v_rd_off(D0, 0, 1)>(vb), l1 = tr_read<v_rd_off(D0, 1, 0)>(vb), h1 = tr_read<v_rd_off(D0, 1, 1)>(vb);
    const s16x4 l2 = tr_read<v_rd_off(D0, 2, 0)>(vb), h2 = tr_read<v_rd_off(D0, 2, 1)>(vb), l3 = tr_read<v_rd_off(D0, 3, 0)>(vb), h3 = tr_read<v_rd_off(D0, 3, 1)>(vb);
    asm volatile("s_waitcnt lgkmcnt(0)" ::: "memory"); SBAR();
    od = __builtin_amdgcn_mfma_f32_32x32x16_bf16(pa0, PKLH(l0, h0), od, 0, 0, 0);
    od = __builtin_amdgcn_mfma_f32_32x32x16_bf16(pa1, PKLH(l1, h1), od, 0, 0, 0);
    od = __builtin_amdgcn_mfma_f32_32x32x16_bf16(pa2, PKLH(l2, h2), od, 0, 0, 0);
    od = __builtin_amdgcn_mfma_f32_32x32x16_bf16(pa3, PKLH(l3, h3), od, 0, 0, 0);
}
__device__ __forceinline__ void pv_d0(f32x16* o, int vb, bf16x8 pa0, bf16x8 pa1, bf16x8 pa2, bf16x8 pa3) {
    pv_one<0>(o[0], vb, pa0, pa1, pa2, pa3); pv_one<1>(o[1], vb, pa0, pa1, pa2, pa3); pv_one<2>(o[2], vb, pa0, pa1, pa2, pa3); pv_one<3>(o[3], vb, pa0, pa1, pa2, pa3);
}
#define PK4S(P, BASE, OUT) do { unsigned a0 = cvt_pk_bf16(P[BASE + 0], P[BASE + 1]), a1 = cvt_pk_bf16(P[BASE + 2], P[BASE + 3]);   \
    unsigned b0 = cvt_pk_bf16(P[BASE + 4], P[BASE + 5]), b1 = cvt_pk_bf16(P[BASE + 6], P[BASE + 7]);                              \
    auto r0 = __builtin_amdgcn_permlane32_swap(a0, b0, false, false); auto r1 = __builtin_amdgcn_permlane32_swap(a1, b1, false, false); \
    u32x4 w = {r0[0], r1[0], r0[1], r1[1]}; OUT = __builtin_bit_cast(bf16x8, w); } while (0)
template <bool FIN>
__device__ __forceinline__ void seg_x(f32x16& n0, f32x16& n1, const LAS char* Ks, const bf16x8* qr, const LAS char* ql, int r32, int hi,
                                      f32x16& f0, f32x16& f1, float alpha, float& l_reg, bf16x8& pa0, bf16x8& pa1, bf16x8& pa2, bf16x8& pa3) {
    n0 = f32x16{}; n1 = f32x16{};
    const LAS char* k0p = Ks + r32 * 384;
    const int key = ((r32 >> 1) & 7) << 4;
    bf16x8 ka[2], kb[2]; float ps = 0.f;
#define KRD(d0, slot) do { const int cb_ = (((d0) * 16 + hi * 8) * 2) ^ key; ka[slot] = *reinterpret_cast<const LAS bf16x8*>(k0p + cb_); kb[slot] = *reinterpret_cast<const LAS bf16x8*>(k0p + 32 * 384 + cb_); } while (0)
    KRD(0, 0); KRD(1, 1); SBAR();
    bf16x8 qlv = qr[0];
#pragma unroll
    for (int d0 = 0; d0 < 12; ++d0) {
        const bf16x8 qv = (d0 < 8) ? qr[d0 < 8 ? d0 : 0] : qlv;
        n0 = __builtin_amdgcn_mfma_f32_32x32x16_bf16(ka[d0 & 1], qv, n0, 0, 0, 0);
        n1 = __builtin_amdgcn_mfma_f32_32x32x16_bf16(kb[d0 & 1], qv, n1, 0, 0, 0);
        SBAR();
        if (d0 + 2 < 12) KRD(d0 + 2, d0 & 1);
        if (d0 + 1 >= 8 && d0 + 1 < 12) qlv = *reinterpret_cast<const LAS bf16x8*>(ql + (d0 + 1 - 8) * 1024);
        if constexpr (FIN) {
            if (d0 < 4) {
#pragma unroll
                for (int r = 0; r < 4; ++r) f1[4 * d0 + r] = __builtin_amdgcn_exp2f(f1[4 * d0 + r]);
            } else if (d0 == 4) {
#pragma unroll
                for (int r = 0; r < 16; ++r) ps += f0[r];
            } else if (d0 == 5) {
#pragma unroll
                for (int r = 0; r < 16; ++r) ps += f1[r];
            } else if (d0 == 6) {
                auto rr = __builtin_amdgcn_permlane32_swap(__float_as_uint(ps), __float_as_uint(ps), false, false);
                ps = __uint_as_float(rr[0]) + __uint_as_float(rr[1]); l_reg = l_reg * alpha + ps;
            } else if (d0 == 7) { PK4S(f0, 0, pa0); } else if (d0 == 8) { PK4S(f0, 8, pa1); } else if (d0 == 9) { PK4S(f1, 0, pa2); } else if (d0 == 10) { PK4S(f1, 8, pa3); }
        }
        SBAR();
    }
#undef KRD
}
__device__ __forceinline__ void seg_y(f32x16* o, int vb, bf16x8 pa0, bf16x8 pa1, bf16x8 pa2, bf16x8 pa3, f32x16& p0, f32x16& p1, float& m_reg, float& mn, float& alpha) {
    pv_one<0>(o[0], vb, pa0, pa1, pa2, pa3); SBAR();
    { float a = fmaxf(p0[0], p0[1]), b = fmaxf(p0[2], p0[3]);
#pragma unroll
      for (int r = 4; r < 16; r += 2) { a = fmaxf(a, p0[r]); b = fmaxf(b, p0[r + 1]); }
#pragma unroll
      for (int r = 0; r < 16; r += 2) { a = fmaxf(a, p1[r]); b = fmaxf(b, p1[r + 1]); }
      float pmax = fmaxf(a, b);
      auto rr = __builtin_amdgcn_permlane32_swap(__float_as_uint(pmax), __float_as_uint(pmax), false, false);
      pmax = fmaxf(__uint_as_float(rr[0]), __uint_as_float(rr[1]));
      if (__builtin_expect(__all(pmax - m_reg <= THRL), 1)) { mn = m_reg; alpha = 1.f; }
      else { mn = fmaxf(m_reg, pmax); alpha = __builtin_amdgcn_exp2f(m_reg - mn); m_reg = mn; } }
    SBAR();
    pv_one<1>(o[1], vb, pa0, pa1, pa2, pa3); SBAR();
#pragma unroll
    for (int r = 0; r < 16; ++r) { p0[r] = p0[r] - mn; p1[r] = p1[r] - mn; }
    SBAR();
    pv_one<2>(o[2], vb, pa0, pa1, pa2, pa3); SBAR();
#pragma unroll
    for (int r = 0; r < 8; ++r) p0[r] = __builtin_amdgcn_exp2f(p0[r]);
    SBAR();
    pv_one<3>(o[3], vb, pa0, pa1, pa2, pa3); SBAR();
#pragma unroll
    for (int r = 8; r < 16; ++r) p0[r] = __builtin_amdgcn_exp2f(p0[r]);
    SBAR();
}
constexpr int L_K = 0, L_VV = 3 * SHM_K, L_WS = L_VV + 3 * SHM_V, L_QL = L_WS + NW * 64 * 4, ATT_LDS = L_QL + NW * 4096;
__device__ __forceinline__ void attn_chain(const bf16_t* __restrict__ QB, const bf16_t* __restrict__ KBp, const bf16_t* __restrict__ VBp, bf16_t* __restrict__ MIXp, int ldo, float* __restrict__ SSQAp,
                                           int bhs, int qb, int k0, int k1, int seq, int Mrows, char* lds, int wv) {
    int lane0 = lane_id(); asm volatile("" : "+v"(lane0));
    const int wid = wv;
    LAS unsigned char* l3 = (LAS unsigned char*)lds;
    const LAS char* K_lds = (const LAS char*)l3 + L_K;
    float* ws = (float*)(lds + L_WS) + wid * 64; float* li_l = ws; float* al_l = ws + 32;
    bf16x8 qr[8];
#define KSRC(i_) ({ const int p_ = (wid + 8 * (i_)) * 64 + lane, row_ = p_ / 24, cpos_ = p_ - row_ * 24; (unsigned)(row_ * 24 + ((cpos_ & ~7) | ((cpos_ ^ (row_ >> 1)) & 7))) * 16u; })
#define VSRC(i_) ({ const int p16_ = (wid + 8 * (i_)) * 64 + lane, sub_ = p16_ >> 5, idx_ = p16_ & 31, kk_ = (sub_ >> 2) * 8 + (idx_ >> 2), c_ = (sub_ & 3) * 32 + (idx_ & 3) * 8; \
    (unsigned)((((kk_ & ~0xC) | ((kk_ & 4) << 1) | ((kk_ & 8) >> 1))) * DV + c_) * 2u; })
#define DMA_KP(KP, t, kboff) do { const char* kt_ = (const char*)(KP) + (size_t)(t) * SHM_K; \
    _Pragma("unroll") for (int i_ = 0; i_ < 3; ++i_) __builtin_amdgcn_global_load_lds((const unsigned*)(kt_ + KSRC(i_)), (LAS unsigned*)(l3 + L_K + (kboff) + (wid + 8 * i_) * 1024), 16, 0, 0); } while (0)
#define DMA_VP(VP, t, vboff) do { const char* vt_ = (const char*)(VP) + (size_t)(t) * SHM_V; \
    _Pragma("unroll") for (int i_ = 0; i_ < 2; ++i_) __builtin_amdgcn_global_load_lds((const unsigned*)(vt_ + VSRC(i_)), (LAS unsigned*)(l3 + L_VV + (vboff) + (wid + 8 * i_) * 1024), 16, 0, 0); } while (0)
#define DMA_K(t, kboff) DMA_KP(Kh, t, kboff)
#define DMA_V(t, vboff) DMA_VP(Vh, t, vboff)
#define QLOAD(QP) do { const bf16_t* Qw_ = (QP) + (long)(wid * QBLK + r32) * DQK + hi * 8; \
    _Pragma("unroll") for (int d0 = 0; d0 < 8; ++d0) qr[d0] = *reinterpret_cast<const bf16x8*>(Qw_ + d0 * 16); \
    _Pragma("unroll") for (int d0 = 8; d0 < 12; ++d0) __builtin_amdgcn_global_load_lds((const unsigned*)(Qw_ + d0 * 16), (LAS unsigned*)(l3 + L_QL + wid * 4096 + (d0 - 8) * 1024), 16, 0, 0); } while (0)
#define TOP(j, KB) do { if ((j) + 2 >= NT) asm volatile("s_waitcnt vmcnt(0) lgkmcnt(0)" ::: "memory"); else asm volatile("s_waitcnt vmcnt(5) lgkmcnt(0)" ::: "memory"); \
    __builtin_amdgcn_s_barrier(); asm volatile("" ::: "memory"); \
    if ((j) + 2 < NT) DMA_K((j) + 2, (((KB) + 2) % 3) * SHM_K); if ((j) + 1 < NT) DMA_V((j) + 1, (((KB) + 1) % 3) * SHM_V); } while (0)
#define RESC(a) do { if (__any((a) < 1.f)) { if (hi == 0) al_l[r32] = (a); asm volatile("s_waitcnt lgkmcnt(0)" ::: "memory"); \
    _Pragma("unroll") for (int d = 0; d < 4; ++d) _Pragma("unroll") for (int r = 0; r < 16; ++r) o[d][r] *= al_l[crow(r, hi)]; } } while (0)
#define TILE(j, KB, PN0, PN1, MNN, ALN, PF0, PF1, AF) do { TOP(j, KB); \
    seg_x<true>(PN0, PN1, K_lds + (KB) * SHM_K, qr, ql, r32, hi, PF0, PF1, AF, l_reg, pa0, pa1, pa2, pa3); \
    seg_y(o, vb0 + (((KB) + 2) % 3) * SHM_V, pa0, pa1, pa2, pa3, PN0, PN1, m_reg, MNN, ALN); RESC(ALN); } while (0)
    const int NT = seq / KVBLK;
    {
        int lane = lane0; asm volatile("" : "+v"(lane)); const int r32 = lane & 31, hi = lane >> 5;
        const size_t bh0 = (size_t)(16 * k0 + bhs);
        QLOAD(QB + (bh0 * seq + qb * 256) * DQK); DMA_KP(KBp + bh0 * seq * DQK, 0, 0); DMA_VP(VBp + bh0 * seq * DV, 0, 0); DMA_KP(KBp + bh0 * seq * DQK, 1, SHM_K);
    }
    for (int k = k0; k < k1; ++k) {
        const size_t bh = (size_t)(16 * k + bhs); const bool has_next = (k + 1 < k1);
        int lane = lane0; asm volatile("" : "+v"(lane)); const int r32 = lane & 31, hi = lane >> 5;
        const LAS char* ql = (const LAS char*)l3 + L_QL + wid * 4096 + lane * 16;
        const int vb0 = (int)(uintptr_t)(lds + L_VV) + v_rd_base(lane);
        const bf16_t* Kh = KBp + bh * seq * DQK; const bf16_t* Vh = VBp + bh * seq * DV;
        float m_reg = -1e30f, l_reg = 0; f32x16 o[4] = {};
        f32x16 pA0, pA1, pB0, pB1; float mnA, mnB, alA, alB; bf16x8 pa0, pa1, pa2, pa3;
        TOP(0, 0);
        seg_x<false>(pA0, pA1, K_lds, qr, ql, r32, hi, pA0, pA1, 1.f, l_reg, pa0, pa1, pa2, pa3); partialSM(pA0, pA1, m_reg, mnA, alA);
        for (int j = 1; j + 6 < NT; j += 6) {
            TILE(j,     1, pB0, pB1, mnB, alB, pA0, pA1, alA);
            TILE(j + 1, 2, pA0, pA1, mnA, alA, pB0, pB1, alB);
            TILE(j + 2, 0, pB0, pB1, mnB, alB, pA0, pA1, alA);
            TILE(j + 3, 1, pA0, pA1, mnA, alA, pB0, pB1, alB);
            TILE(j + 4, 2, pB0, pB1, mnB, alB, pA0, pA1, alA);
            TILE(j + 5, 0, pA0, pA1, mnA, alA, pB0, pB1, alB);
        }
        const size_t bhn = bh + 16;
        TOP(NT - 1, 1);
        if (has_next) DMA_KP(KBp + bhn * seq * DQK, 0, 0);
        seg_x<true>(pB0, pB1, K_lds + 1 * SHM_K, qr, ql, r32, hi, pA0, pA1, alA, l_reg, pa0, pa1, pa2, pa3);
        asm volatile("" ::: "memory");
        if (has_next) QLOAD(QB + (bhn * seq + qb * 256) * DQK);
        seg_y(o, vb0 + 0 * SHM_V, pa0, pa1, pa2, pa3, pB0, pB1, m_reg, mnB, alB); RESC(alB);
        finishSM(pB0, pB1, alB, l_reg, pa0, pa1, pa2, pa3); SBAR();
        pv_d0(o, vb0 + 1 * SHM_V, pa0, pa1, pa2, pa3);
        if (hi == 0) li_l[r32] = l_reg; asm volatile("s_waitcnt lgkmcnt(0)" ::: "memory");
        float rli[16];
#pragma unroll
        for (int r = 0; r < 16; ++r) rli[r] = __builtin_amdgcn_rcpf(li_l[crow(r, hi)]);
        const int b = (int)(bh >> 2), h = (int)(bh & 3);
        bf16_t* Ow = MIXp + ((size_t)b * seq + qb * 256 + wid * QBLK) * ldo + h * 128;
        float* ssq = SSQAp + (size_t)h * Mrows + (size_t)b * seq + qb * 256;
        float myss = 0.f;
#pragma unroll
        for (int r = 0; r < 16; ++r) { const int orow = crow(r, hi); float sq = 0.f;
#pragma unroll
            for (int d0 = 0; d0 < 4; ++d0) { const float v = o[d0][r] * rli[r]; sq += v * v; Ow[(long)orow * ldo + d0 * 32 + r32] = (bf16_t)f2bf(v); }
            sq = dpp_sum8(sq);
            sq += __builtin_bit_cast(float, __builtin_amdgcn_update_dpp(0, __builtin_bit_cast(int, sq), 0x128, 0xF, 0xF, true));
            sq += __shfl_xor(sq, 16);
            if (r32 == r) myss = sq; }
        if (r32 < 16) ssq[wid * QBLK + crow(r32, hi)] = myss;
        if (has_next) { asm volatile("s_waitcnt lgkmcnt(0)" ::: "memory"); __builtin_amdgcn_s_barrier(); asm volatile("" ::: "memory");
            DMA_VP(VBp + bhn * seq * DV, 0, 0); DMA_KP(KBp + bhn * seq * DQK, 1, SHM_K); }
        else { asm volatile("s_waitcnt vmcnt(0) lgkmcnt(0)" ::: "memory"); __builtin_amdgcn_s_barrier(); asm volatile("" ::: "memory"); }
    }
#undef DMA_K
#undef DMA_V
#undef DMA_KP
#undef DMA_VP
#undef QLOAD
#undef TOP
#undef TILE
#undef RESC
}
}

namespace hg {
using att::crow; using att::v_st; using att::v_rd_base; using att::v_rd_off; using att::tr_read;
constexpr int L_QE = 0, L_QT = 16384, L_KT = 32768, L_OT = 122880  , L_KE = 73728, L_V = 90112, L_P = 106496, L_SEG = 114688  , L_DV = 155648, L_GN = 156160  , L_END = 156672;
__device__ __forceinline__ int swzA(int row, int cb) { return row * 256 + (cb ^ ((row & 15) << 4) ^ (((row >> 4) & 1) << 3)); }
__device__ __forceinline__ int swzB(int row, int cb) { return row * 256 + (cb ^ ((row & 15) << 4)); }
__device__ __forceinline__ int swzP(int row, int cb) { return row * 128 + (cb ^ ((row & 7) << 4)); }
template <int D0> __device__ __forceinline__ void tr_frag4(int vb, bf16x8& f0, bf16x8& f1, bf16x8& f2, bf16x8& f3) {
    const s16x4 l0 = tr_read<v_rd_off(D0, 0, 0)>(vb), h0 = tr_read<v_rd_off(D0, 0, 1)>(vb), l1 = tr_read<v_rd_off(D0, 1, 0)>(vb), h1 = tr_read<v_rd_off(D0, 1, 1)>(vb);
    const s16x4 l2 = tr_read<v_rd_off(D0, 2, 0)>(vb), h2 = tr_read<v_rd_off(D0, 2, 1)>(vb), l3 = tr_read<v_rd_off(D0, 3, 0)>(vb), h3 = tr_read<v_rd_off(D0, 3, 1)>(vb);
    asm volatile("s_waitcnt lgkmcnt(0)" ::: "memory"); SBAR();
    f0 = PKLH(l0, h0); f1 = PKLH(l1, h1); f2 = PKLH(l2, h2); f3 = PKLH(l3, h3);
}
struct Pre { u32x2 q4[4], l4[4], v4[4]; };
__device__ __forceinline__ void load_chunk(Pre& P, const bf16_t* pbase, int h, int dir, int cs, int wid, int lane) {
    const int c4 = 4 * (lane & 31), j0 = 8 * wid + 4 * (lane >> 5);
    const int cq = C_Q + h * 128 + c4, cf = C_FF + dir * 512 + h * 128 + c4, ci = C_I + h * 128 + c4;
#pragma unroll
    for (int i = 0; i < 4; ++i) { const int j = j0 + i, pos = dir ? (64 * cs + 63 - j) : (64 * cs + j); const bf16_t* rp = pbase + (size_t)pos * DINP;
        P.q4[i] = *(const u32x2*)(rp + cq); P.l4[i] = *(const u32x2*)(rp + cf); P.v4[i] = *(const u32x2*)(rp + ci); }
}
__device__ __forceinline__ void stage_c(char* lds, f32x16 (&S)[4], f32x16 (&o)[2]  , _Float16* ofp  , int rstride  , bool second, int eb, int lane_, int part  ) {
    int lane = lane_; asm volatile("" : "+v"(lane));
    const int r32 = lane & 31, hi = lane >> 5;
    _Float16* p0 = ofp + r32 + 4 * hi * rstride;
    const int vbV = (int)(uintptr_t)(lds + L_V) + v_rd_base(lane) + eb * 512, vbK = (int)(uintptr_t)(lds + L_KE) + v_rd_base(lane);
    if (part == 0) {
#pragma unroll
    for (int db = 0; db < 4; ++db)
#pragma unroll
        for (int s = 0; s < 2; ++s) {
            u32x4 sw; sw.x = cvtpk(S[db][8 * s + 0], S[db][8 * s + 1]); sw.y = cvtpk(S[db][8 * s + 2], S[db][8 * s + 3]);
            sw.z = cvtpk(S[db][8 * s + 4], S[db][8 * s + 5]); sw.w = cvtpk(S[db][8 * s + 6], S[db][8 * s + 7]);
            const bf16x8 sf = __builtin_bit_cast(bf16x8, sw);
#pragma unroll
            for (int jb = 0; jb < 2; ++jb) { const int row = 32 * jb + r32, d0 = 32 * db + 16 * s + 4 * hi;
                const u32x2 a0 = *(const u32x2*)(lds + L_QE + swzA(row, d0 * 2)), a1 = *(const u32x2*)(lds + L_QE + swzA(row, (d0 + 8) * 2));
                const u32x4 aw = {a0.x, a0.y, a1.x, a1.y};
                o[jb] = __builtin_amdgcn_mfma_f32_32x32x16_bf16(__builtin_bit_cast(bf16x8, aw), sf, o[jb], 0, 0, 0); }
        }
    return; }
    const float* dv = (const float*)(lds + L_DV) + 4 * hi;
#define KRAW(DB, P) const s16x4 P##l0 = tr_read<v_rd_off(DB, 0, 0)>(vbK), P##h0 = tr_read<v_rd_off(DB, 0, 1)>(vbK), P##l1 = tr_read<v_rd_off(DB, 1, 0)>(vbK), P##h1 = tr_read<v_rd_off(DB, 1, 1)>(vbK), \
                                P##l2 = tr_read<v_rd_off(DB, 2, 0)>(vbK), P##h2 = tr_read<v_rd_off(DB, 2, 1)>(vbK), P##l3 = tr_read<v_rd_off(DB, 3, 0)>(vbK), P##h3 = tr_read<v_rd_off(DB, 3, 1)>(vbK)
#define DVLD(DB, D) f32x4 D[4]; _Pragma("unroll") for (int g = 0; g < 4; ++g) D[g] = *(const f32x4*)(dv + 32 * DB + 8 * g)
#define SSCALE(DB, D) do { _Pragma("unroll") for (int g = 0; g < 4; ++g) { S[DB][4 * g] *= D[g][0]; S[DB][4 * g + 1] *= D[g][1]; S[DB][4 * g + 2] *= D[g][2]; S[DB][4 * g + 3] *= D[g][3]; } } while (0)
#define PFR(jb, ks) (*(const bf16x8*)(lds + L_P + swzP(32 * (jb) + r32, 32 * (ks) + 16 * hi)))
#define MM(A, B, C) C = __builtin_amdgcn_mfma_f32_32x32x16_bf16(A, B, C, 0, 0, 0)
    bf16x8 vf0, vf1, vf2, vf3;
    {
        const s16x4 vl0 = tr_read<v_rd_off(0, 0, 0)>(vbV), vh0 = tr_read<v_rd_off(0, 0, 1)>(vbV), vl1 = tr_read<v_rd_off(0, 1, 0)>(vbV), vh1 = tr_read<v_rd_off(0, 1, 1)>(vbV);
        const s16x4 vl2 = tr_read<v_rd_off(0, 2, 0)>(vbV), vh2 = tr_read<v_rd_off(0, 2, 1)>(vbV), vl3 = tr_read<v_rd_off(0, 3, 0)>(vbV), vh3 = tr_read<v_rd_off(0, 3, 1)>(vbV);
        asm volatile("s_waitcnt lgkmcnt(0)" ::: "memory"); SBAR();
        vf0 = PKLH(vl0, vh0); vf1 = PKLH(vl1, vh1); vf2 = PKLH(vl2, vh2); vf3 = PKLH(vl3, vh3);
        MM(PFR(1, 0), vf0, o[1]); MM(PFR(0, 0), vf0, o[0]); MM(PFR(1, 1), vf1, o[1]); MM(PFR(0, 1), vf1, o[0]); MM(PFR(1, 2), vf2, o[1]); MM(PFR(1, 3), vf3, o[1]);
    }
    SBAR();
    {
        if (second) {
            float* ot = (float*)(lds + L_OT) + 32 * eb + r32 + 4 * hi * 128;
#pragma unroll
            for (int jb = 0; jb < 2; ++jb)
#pragma unroll
                for (int r = 0; r < 16; ++r) ot[(32 * jb + 8 * (r >> 2) + (r & 3)) * 128] = o[jb][r];
        } else {
#pragma unroll
            for (int jb = 0; jb < 2; ++jb)
#pragma unroll
                for (int g = 0; g < 4; ++g) { _Float16* pg = p0 + (32 * jb + 8 * g) * rstride;
#pragma unroll
                    for (int e = 0; e < 4; ++e) pg[e * rstride] = (_Float16)o[jb][4 * g + e];
                    asm volatile("" ::: "memory"); }
        }
        SBAR();
        DVLD(0, d1v);
        KRAW(0, a); KRAW(1, b);
        asm volatile("s_waitcnt lgkmcnt(0)" ::: "memory"); SBAR();
        SSCALE(0, d1v); DVLD(1, d2v);
        MM(PKLH(al0, ah0), vf0, S[0]); SSCALE(1, d2v); MM(PKLH(bl0, bh0), vf0, S[1]); MM(PKLH(al1, ah1), vf1, S[0]); MM(PKLH(bl1, bh1), vf1, S[1]);
        MM(PKLH(al2, ah2), vf2, S[0]); MM(PKLH(bl2, bh2), vf2, S[1]); MM(PKLH(al3, ah3), vf3, S[0]); MM(PKLH(bl3, bh3), vf3, S[1]);
    }
    SBAR();
    {
        DVLD(2, d1v);
        KRAW(2, a); KRAW(3, b);
        asm volatile("s_waitcnt lgkmcnt(0)" ::: "memory"); SBAR();
        SSCALE(2, d1v); DVLD(3, d2v);
        MM(PKLH(al0, ah0), vf0, S[2]); SSCALE(3, d2v); MM(PKLH(bl0, bh0), vf0, S[3]); MM(PKLH(al1, ah1), vf1, S[2]); MM(PKLH(bl1, bh1), vf1, S[3]);
        MM(PKLH(al2, ah2), vf2, S[2]); MM(PKLH(bl2, bh2), vf2, S[3]); MM(PKLH(al3, ah3), vf3, S[2]); MM(PKLH(bl3, bh3), vf3, S[3]);
    }
#undef MM
#undef PFR
#undef KRAW
#undef DVLD
#undef SSCALE
}
__device__ __forceinline__ void hgrn_bh(int b, int h, const bf16_t* proj, bf16_t* MIXp, const float* __restrict__ gain, char* lds, int wv) {
    int lane = lane_id(); asm volatile("" : "+v"(lane));
    const int wid = wv, tid = wv * 64 + lane, dp_ = lane, seg = wid;
    for (int i = tid; i < 8192 / 4; i += 512) ((unsigned*)(lds + L_P))[i] = 0u;
    f32x16 S[4] = {};
    const bf16_t* pbase = proj + (size_t)b * SEQ * DINP;
    float* segtot = (float*)(lds + L_SEG);
    if (tid < 128) ((float*)(lds + L_GN))[tid] = gain[tid];
    Pre pre; load_chunk(pre, pbase, h, 0, 0, wid, lane);
    __syncthreads();
    const int hw = lane >> 5, cq4 = lane & 31, sg16 = 2 * wid + hw;
    const int cB = (8 * cq4) ^ ((wid & 1) << 7) ^ (hw << 6), cA = cB ^ (((wid >> 1) & 1) << 3), rowb = wid * 2048 + hw * 1024;
    const int gV = (cq4 >> 3) * 512 + (cq4 & 7) * 8 + (wid >> 1) * 4096 + hw * 2048 + (wid & 1) * 256;
    const int drow = tid >> 3, dseg = tid & 7;
#define POST_SEGTOT() do { float a0_ = 0.f, a1_ = 0.f, a2_ = 0.f, a3_ = 0.f; \
        _Pragma("unroll") for (int t_ = 0; t_ < 4; ++t_) { const unsigned lx_ = pre.l4[t_].x, ly_ = pre.l4[t_].y; const h16x2 h0_ = __builtin_bit_cast(h16x2, lx_), h1_ = __builtin_bit_cast(h16x2, ly_); \
            a0_ += (float)h0_[0]; a1_ += (float)h0_[1]; a2_ += (float)h1_[0]; a3_ += (float)h1_[1]; } \
        *(f32x4*)(segtot + sg16 * 128 + 4 * cq4) = (f32x4){a0_, a1_, a2_, a3_}; } while (0)
    POST_SEGTOT();
    asm volatile("s_waitcnt lgkmcnt(0)" ::: "memory"); __builtin_amdgcn_s_barrier(); asm volatile("" ::: "memory");
    for (int k = 0; k < 64; ++k) {
        const int i = k >> 1, dir = k & 1, cs = dir ? 31 - i : i; const bool second = (i >= 16);
        const long row0 = (long)b * SEQ + (dir ? 64 * cs + 63 : 64 * cs);
        const int rstride = dir ? -DINP : DINP; const bool mine = ((wid >> 2) == dir);
        _Float16* rawp = (_Float16*)proj + (size_t)row0 * DINP + C_CQ + h * 128 + 32 * (wid & 3);
        f32x16 o[2]; u32x4 gq0, gq1;
        if (second) {
            if (mine) { const _Float16* p0 = rawp + (lane & 31) + 4 * (lane >> 5) * rstride;
#pragma unroll
                for (int jb = 0; jb < 2; ++jb)
#pragma unroll
                    for (int r = 0; r < 16; ++r) o[jb][r] = (float)p0[(32 * jb + 8 * (r >> 2) + (r & 3)) * rstride]; }
            const long grow = row0 + (dir ? -drow : drow); const bf16_t* gp = proj + (size_t)grow * DINP + C_G + h * 128 + 16 * dseg;
            gq0 = *(const u32x4*)gp; gq1 = *(const u32x4*)(gp + 8);
        } else { o[0] = f32x16{}; o[1] = f32x16{}; }
        const int I = wid >> 1;
        f32x4 rr[5];
        { f32x4 a = {0.f, 0.f, 0.f, 0.f};
#pragma unroll
          for (int sg = 0; sg < 16; ++sg) { if ((sg & 3) == 0) rr[sg >> 2] = a; a += *(const f32x4*)(segtot + sg * 128 + 4 * cq4); }
          rr[4] = a; }
        const f32x4 rI = (I == 0) ? rr[0] : (I == 1) ? rr[1] : (I == 2) ? rr[2] : rr[3];
        f32x4 run = rI;
#pragma unroll
        for (int q = 0; q < 3; ++q) { const f32x4 st = *(const f32x4*)(segtot + (4 * I + q) * 128 + 4 * cq4); if (4 * I + q < sg16) run += st; }
        f32x4 eI, eT, rat[4];
#pragma unroll
        for (int c = 0; c < 4; ++c) { eI[c] = __builtin_amdgcn_exp2f(rI[c]); eT[c] = __builtin_amdgcn_exp2f(rr[4][c] - rI[c]);
#pragma unroll
            for (int sg = 0; sg < 4; ++sg) rat[sg][c] = __builtin_amdgcn_exp2f(fminf(rr[sg][c] - rI[c], 0.f)); }
        if (sg16 == 0) { f32x4 d4;
#pragma unroll
            for (int c = 0; c < 4; ++c) d4[c] = __builtin_amdgcn_exp2f(rr[4][c]);
            *(f32x4*)((float*)(lds + L_DV) + 4 * cq4) = d4; }
        f32x4 gE[4], Ef[4], Rf[4];
        { f32x4 E;
#pragma unroll
          for (int c = 0; c < 4; ++c) E[c] = __builtin_amdgcn_exp2f(run[c] - rI[c]);
#pragma unroll
          for (int t = 0; t < 4; ++t) { const unsigned lx = pre.l4[t].x, ly = pre.l4[t].y; const h16x2 h0 = __builtin_bit_cast(h16x2, lx), h1 = __builtin_bit_cast(h16x2, ly);
              gE[t] = (f32x4){__builtin_amdgcn_exp2f((float)h0[0]), __builtin_amdgcn_exp2f((float)h0[1]), __builtin_amdgcn_exp2f((float)h1[0]), __builtin_amdgcn_exp2f((float)h1[1])};
              E = E * gE[t]; Ef[t] = E; }
          f32x4 R;
#pragma unroll
          for (int c = 0; c < 4; ++c) R[c] = fminf(__builtin_amdgcn_rcpf(E[c]), 4.1538374868278621e34f);
          Rf[3] = R; Rf[2] = Rf[3] * gE[3]; Rf[1] = Rf[2] * gE[2]; Rf[0] = Rf[1] * gE[1]; }
#pragma unroll
        for (int t = 0; t < 4; ++t) {
            const f32x4 q = {bflo(pre.q4[t].x), bfhi(pre.q4[t].x), bflo(pre.q4[t].y), bfhi(pre.q4[t].y)};
            const f32x4 qt = q * Ef[t], kI = ((f32x4){1.f, 1.f, 1.f, 1.f} - gE[t]) * Rf[t];
            const f32x4 qe = qt * eI, ke = kI * eT;
            const int aB = (cB ^ (t << 4)) + rowb + t * 256, aA = (cA ^ (t << 4)) + rowb + t * 256, aV = gV + t * 64;
            *(u32x2*)(lds + L_QE + aA) = (u32x2){cvtpk(qe[0], qe[1]), cvtpk(qe[2], qe[3])};
            *(u32x2*)(lds + L_QT + aB) = (u32x2){cvtpk(qt[0], qt[1]), cvtpk(qt[2], qt[3])};
            *(u32x2*)(lds + L_KE + aV) = (u32x2){cvtpk(ke[0], ke[1]), cvtpk(ke[2], ke[3])};
            *(u32x2*)(lds + L_V + aV) = pre.v4[t];
#define KTW(base, SG) do { const f32x4 kv_ = kI * rat[SG]; *(u32x2*)(lds + L_KT + (base) * 256 + aB) = (u32x2){cvtpk(kv_[0], kv_[1]), cvtpk(kv_[2], kv_[3])}; } while (0)
#define KTD(base) do { *(u32x2*)(lds + L_KT + (base) * 256 + aB) = (u32x2){cvtpk(kI[0], kI[1]), cvtpk(kI[2], kI[3])}; } while (0)
            if (I == 0) { KTD(0); KTW(16, 1); KTW(48, 2); KTW(96, 3); }
            else if (I == 1) { KTD(16); KTW(48, 2); KTW(96, 3); }
            else if (I == 2) { KTD(48); KTW(96, 3); }
            else { KTD(96); }
#undef KTW
#undef KTD
        }
        asm volatile("s_waitcnt lgkmcnt(0)" ::: "memory"); __builtin_amdgcn_s_barrier(); asm volatile("" ::: "memory");
        if (k + 1 < 64) { const int k1 = k + 1, i1 = k1 >> 1, d1 = k1 & 1; load_chunk(pre, pbase, h, d1, d1 ? 31 - i1 : i1, wid, lane); }
        if (mine) stage_c(lds, S, o, rawp, rstride, second, wid & 3, lane, 0);
        else for (int blk = (wid & 3); blk < 10; blk += 4) {
            int bi, bjj; if (blk == 0) { bi = 0; bjj = 0; } else if (blk < 3) { bi = 1; bjj = blk - 1; } else if (blk < 6) { bi = 2; bjj = blk - 3; } else { bi = 3; bjj = blk - 6; }
            const int base = (bi == 0) ? 0 : (bi == 1) ? 16 : (bi == 2) ? 48 : 96;
            const int xm = ((lane & 15) << 4), cq4 = 16 * (lane >> 4);
            const char* ap = lds + L_QT + (16 * bi + (lane & 15)) * 256; const char* bp = lds + L_KT + (base + 16 * bjj + (lane & 15)) * 256;
            bf16x8 av[4], bv[4];
#pragma unroll
            for (int ks = 0; ks < 4; ++ks) { const int cb = (64 * ks + cq4) ^ xm; av[ks] = *(const bf16x8*)(ap + cb); bv[ks] = *(const bf16x8*)(bp + cb); }
            f32x4 acc = {0.f, 0.f, 0.f, 0.f};
#pragma unroll
            for (int ks = 0; ks < 4; ++ks) acc = __builtin_amdgcn_mfma_f32_16x16x32_bf16(av[ks], bv[ks], acc, 0, 0, 0);
            const int sl = lane & 15;
#pragma unroll
            for (int r = 0; r < 4; ++r) { const int jl = (lane >> 4) * 4 + r; const float v = (bi != bjj || sl <= jl) ? acc[r] : 0.f;
                *(bf16_t*)(lds + L_P + swzP(16 * bi + jl, (16 * bjj + sl) * 2)) = (bf16_t)(cvtpk(v, v) & 0xffffu); }
        }
        asm volatile("s_waitcnt lgkmcnt(0)" ::: "memory"); __builtin_amdgcn_s_barrier(); asm volatile("" ::: "memory");
        if (mine) stage_c(lds, S, o, rawp, rstride, second, wid & 3, lane, 1);
        if (k + 1 < 64) POST_SEGTOT();
        if (k == 31) asm volatile("s_waitcnt vmcnt(0)" ::: "memory");
        asm volatile("s_waitcnt lgkmcnt(0)" ::: "memory"); __builtin_amdgcn_s_barrier(); asm volatile("" ::: "memory");
        if (second) {
            const float* otp = (const float*)(lds + L_OT) + drow * 128 + 16 * dseg;
            f32x4 v[4]; float ss = 0.f;
#pragma unroll
            for (int q = 0; q < 4; ++q) { v[q] = *(const f32x4*)(otp + 4 * q); ss += (v[q][0] * v[q][0] + v[q][1] * v[q][1]) + (v[q][2] * v[q][2] + v[q][3] * v[q][3]); }
            ss = dpp_sum8(ss);
            const float r = __builtin_amdgcn_rsqf(ss * (1.f / 128.f) + EPS);
            f32x4 gn[4];
#pragma unroll
            for (int q = 0; q < 4; ++q) gn[q] = *(const f32x4*)((const float*)(lds + L_GN) + 16 * dseg + 4 * q);
            const unsigned gw[8] = {gq0.x, gq0.y, gq0.z, gq0.w, gq1.x, gq1.y, gq1.z, gq1.w}; unsigned ow[8];
#pragma unroll
            for (int q = 0; q < 8; ++q) { const float g0 = bflo(gw[q]), g1 = bfhi(gw[q]);
                const float s0 = g0 * __builtin_amdgcn_rcpf(1.f + __builtin_amdgcn_exp2f(-1.4426950408889634f * g0)), s1 = g1 * __builtin_amdgcn_rcpf(1.f + __builtin_amdgcn_exp2f(-1.4426950408889634f * g1));
                ow[q] = cvtpk(v[q >> 1][2 * (q & 1)] * r * gn[q >> 1][2 * (q & 1)] * s0, v[q >> 1][2 * (q & 1) + 1] * r * gn[q >> 1][2 * (q & 1) + 1] * s1); }
            const long grow = row0 + (dir ? -drow : drow); bf16_t* mp = MIXp + (size_t)grow * DM + 512 + h * 128 + 16 * dseg;
            *(u32x4*)mp = (u32x4){ow[0], ow[1], ow[2], ow[3]}; *(u32x4*)(mp + 8) = (u32x4){ow[4], ow[5], ow[6], ow[7]};
        }
    }
    __syncthreads();
}
}

#define XB_TMO      128
#define XB_XCNT(j)  (256  + 64 * (j))
#define XB_XSUB(j)  (1280 + 64 * (j))
#define XB_XGEN(j)  (2304 + 64 * (j))
#define XB_TOP      3328
#define XB_TOPGEN   3392
#define XCD_BAR_WORDS 3456
#define XB_SPIN_CAP (1u << 18)

__device__ __forceinline__ unsigned xb_ld(unsigned* p)              { return __hip_atomic_load(p, __ATOMIC_RELAXED, __HIP_MEMORY_SCOPE_AGENT); }
__device__ __forceinline__ unsigned xb_add(unsigned* p, unsigned v) { return __hip_atomic_fetch_add(p, v, __ATOMIC_RELAXED, __HIP_MEMORY_SCOPE_AGENT); }
__device__ __forceinline__ unsigned xb_xcc_id() { return (unsigned)__builtin_amdgcn_s_getreg((3 << 11) | 20) & 0xFu; }
#define XB_SPIN(cond, bar) do { unsigned _sp = 0; while (cond) { __builtin_amdgcn_s_sleep(1); \
    if ((++_sp & 255u) == 0u) { if (xb_ld(&(bar)[XB_TMO])) break; if (_sp > XB_SPIN_CAP) { atomicAdd(&(bar)[XB_TMO], 1u); break; } } } } while (0)

struct XcdBarrier {
    unsigned* bar; unsigned x;
    volatile LAS unsigned* st;
};

__device__ __forceinline__ XcdBarrier xcd_barrier_post(unsigned* bar, volatile LAS unsigned* st, bool leader  ) {
    XcdBarrier b; b.bar = bar; b.x = xb_xcc_id(); b.st = st;
    if (leader) (void)xb_add(&bar[XB_XCNT(b.x)], 1u);
    return b;
}
__device__ __forceinline__ void xcd_barrier_complete(unsigned* bar, unsigned x, unsigned& nloc, unsigned& nx) {
    const unsigned G = gridDim.x * gridDim.y * gridDim.z;
    unsigned sum, cnt, mine, sp = 0u;
    for (;;) {
        sum = 0u; cnt = 0u; mine = 0u;
#pragma unroll
        for (unsigned j = 0; j < 16; ++j) { const unsigned c = xb_ld(&bar[XB_XCNT(j)]); sum += c; cnt += (c > 0u) ? 1u : 0u; mine = (j == x) ? c : mine; }
        if (sum == G) break;
        __builtin_amdgcn_s_sleep(1);
        if ((++sp & 255u) == 0u) { if (xb_ld(&bar[XB_TMO])) break; if (sp > XB_SPIN_CAP) { atomicAdd(&bar[XB_TMO], 1u); break; } }
    }
    nloc = mine > 0u ? mine : 1u; nx = cnt > 0u ? cnt : 1u;
}

__device__ __forceinline__ void xcd_barrier(const XcdBarrier& b, bool leader  ) {
    asm volatile("s_waitcnt vmcnt(0)" ::: "memory");
    __syncthreads();
    if (leader) {
        unsigned* bar = b.bar;
        __builtin_amdgcn_s_waitcnt(0);
        unsigned nloc = b.st[0], nx = b.st[1];
        if (nloc == 0u) { xcd_barrier_complete(bar, b.x, nloc, nx); b.st[0] = nloc; b.st[1] = nx; }
        const unsigned old = xb_add(&bar[XB_XSUB(b.x)], 1u);
        const unsigned gen = old / nloc;
        if (old + 1u == (gen + 1u) * nloc) {
            __builtin_amdgcn_fence(__ATOMIC_RELEASE, "agent");
            asm volatile("s_waitcnt vmcnt(0)" ::: "memory");
            const unsigned og = xb_add(&bar[XB_TOP], 1u);
            const unsigned tg = og / nx;
            if (og + 1u == (tg + 1u) * nx) xb_add(&bar[XB_TOPGEN], 1u);
            else XB_SPIN(xb_ld(&bar[XB_TOPGEN]) == tg, bar);
            __builtin_amdgcn_fence(__ATOMIC_ACQUIRE, "agent");
            xb_add(&bar[XB_XGEN(b.x)], 1u);
            asm volatile("s_waitcnt vmcnt(0)" ::: "memory");
        } else {
            XB_SPIN(xb_ld(&bar[XB_XGEN(b.x)]) == gen, bar);
            __builtin_amdgcn_fence(__ATOMIC_ACQUIRE, "agent");
            asm volatile("s_waitcnt vmcnt(0)" ::: "memory");
        }
    }
    __syncthreads();
}


constexpr int NWAVES = 8;
constexpr int LDS_BYTES = 160 * 1024;
constexpr int RING_BYTES = 131072, EPI_OFF = RING_BYTES  , TAB_OFF = RING_BYTES + 8192  , MISC_OFF = 160 * 1024 - 1024;
constexpr size_t CTL_ZERO_BYTES = 65536;
struct Args { const float* in[17]; float* out; unsigned char* ws; int ph_lo, ph_hi; };

__device__ __forceinline__ int rope_perm(int cp) { const int i = cp >> 3, j = cp & 7; return (j < 4) ? 4 * i + j : 32 + 4 * i + (j - 4); }
__device__ __forceinline__ void tr_item(const float* W, int ldw, int ksrc0, int srccol, const float* gain, int goff, bf16_t* WT, int Kd, int kd0, int nd0, LAS float* scr, int lane) {
    float wv_[32], gv_[32];
#pragma unroll
    for (int i = 0; i < 32; ++i) { const int kk = 2 * i + (lane >> 5); wv_[i] = (srccol >= 0) ? W[(size_t)(ksrc0 + kk) * ldw + srccol] : 0.f; gv_[i] = gain ? gain[ksrc0 + kk - goff] : 1.f; }
#pragma unroll
    for (int i = 0; i < 32; ++i) { const int kk = 2 * i + (lane >> 5); scr[kk * 33 + (lane & 31)] = wv_[i] * gv_[i]; }
    asm volatile("s_waitcnt lgkmcnt(0)" ::: "memory");
    const int c = lane & 7;
#pragma unroll
    for (int j = 0; j < 4; ++j) { const int n = (lane >> 3) + 8 * j; const LAS float* sp = scr + (8 * c) * 33 + n;
        u32x4 o; o.x = pk2(sp[0 * 33], sp[1 * 33]); o.y = pk2(sp[2 * 33], sp[3 * 33]); o.z = pk2(sp[4 * 33], sp[5 * 33]); o.w = pk2(sp[6 * 33], sp[7 * 33]);
        *(u32x4*)(WT + (size_t)(nd0 + n) * Kd + kd0 + 8 * c) = o; }
    asm volatile("s_waitcnt lgkmcnt(0)" ::: "memory");
}
template <int R>
__device__ __forceinline__ void rows_to_bf16_rs(const float* x0, bf16_t* o0, float* rs0, size_t rstep, int lane) {
    f32x4 v[R][4]; float s[R];
#pragma unroll
    for (int r = 0; r < R; ++r) { const f32x4* xr = (const f32x4*)(x0 + (size_t)r * rstep * DM) + lane;
#pragma unroll
        for (int j = 0; j < 4; ++j) v[r][j] = xr[64 * j]; }
#pragma unroll
    for (int r = 0; r < R; ++r) { float a = 0.f;
#pragma unroll
        for (int j = 0; j < 4; ++j) a += (v[r][j].x * v[r][j].x + v[r][j].y * v[r][j].y) + (v[r][j].z * v[r][j].z + v[r][j].w * v[r][j].w);
        s[r] = a; }
#pragma unroll
    for (int o = 1; o < 64; o <<= 1) {
#pragma unroll
        for (int r = 0; r < R; ++r) s[r] += __shfl_xor(s[r], o); }
#pragma unroll
    for (int r = 0; r < R; ++r) { if (lane == 0) rs0[(size_t)r * rstep] = 1.f / sqrtf(s[r] * (1.f / DM) + EPS);
        u32x2* o8 = (u32x2*)(o0 + (size_t)r * rstep * DM) + lane;
#pragma unroll
        for (int j = 0; j < 4; ++j) { u32x2 w; w.x = cvtpk(v[r][j].x, v[r][j].y); w.y = cvtpk(v[r][j].z, v[r][j].w); o8[64 * j] = w; } }
}
__device__ __forceinline__ void sincos_acc(float ang, float& c, float& s) {
    const double x = (double)ang; const double kq = __builtin_rint(x * 0.6366197723675814); const double y = x - kq * 1.5707963267948966 - kq * 6.123233995736766e-17;
    const double y2 = y * y;
    double sp = -7.6471637318198164759e-13; sp = sp * y2 + 1.6059043836821614599e-10; sp = sp * y2 - 2.5052108385441718775e-8; sp = sp * y2 + 2.7557319223985890653e-6; sp = sp * y2 - 1.9841269841269841270e-4; sp = sp * y2 + 8.3333333333333333333e-3; sp = sp * y2 - 1.6666666666666666667e-1; sp = y + y * y2 * sp;
    double cp = 4.7794773323873852974e-14; cp = cp * y2 - 1.1470745597729724714e-11; cp = cp * y2 + 2.0876756987868098979e-9; cp = cp * y2 - 2.7557319223985890653e-7; cp = cp * y2 + 2.4801587301587301587e-5; cp = cp * y2 - 1.3888888888888888889e-3; cp = cp * y2 + 4.1666666666666666667e-2; cp = cp * y2 - 0.5; cp = 1.0 + y2 * cp;
    const int q = ((int)(long long)kq) & 3;
    const double sv = (q == 0) ? sp : (q == 1) ? cp : (q == 2) ? -sp : -cp;
    const double cv = (q == 0) ? cp : (q == 1) ? -sp : (q == 2) ? -cp : sp;
    c = (float)cv; s = (float)sv;
}

__global__ void __launch_bounds__(NWAVES * 64, 2) mk_fwd(Args args) {
    extern __shared__ __attribute__((aligned(16))) unsigned char lds[];
    const int g_wv = __builtin_amdgcn_readfirstlane(threadIdx.x >> 6);
#define TIDV() ({ int t_ = g_wv * 64 + lane_id(); asm volatile("" : "+v"(t_)); t_; })
    const int G = gridDim.x, bx = blockIdx.x;
    unsigned char* ws = args.ws;
    const float* x = args.in[0]; const int* positions = (const int*)args.in[1];
    const float* g_mix = args.in[2]; const float* w_in = args.in[3]; const float* lb_param = args.in[4]; const float* g_hgrn = args.in[5];
    const float* g_cq = args.in[6]; const float* w_q_up = args.in[7]; const float* g_ckv = args.in[8]; const float* w_kv_up = args.in[9];
    const float* g_qn = args.in[10]; const float* g_kn = args.in[11]; const float* g_mla_out = args.in[12]; const float* w_out = args.in[13];
    const float* g_ffn = args.in[14]; const float* w_up = args.in[15]; const float* w_down = args.in[16];
    float* out = args.out;
    float* RS0 = (float*)(ws + WS_RS0); float* SSQ1 = (float*)(ws + WS_SSQ1); float* SSQP = (float*)(ws + WS_SSQP); float* GQT = (float*)(ws + WS_GQT); float* GKT = (float*)(ws + WS_GKT); float* LBT = (float*)(ws + WS_LBT);
    float* COS = (float*)(ws + WS_COS); float* SIN = (float*)(ws + WS_SIN);
    bf16_t* WIN = (bf16_t*)(ws + WS_WIN); bf16_t* WQ = (bf16_t*)(ws + WS_WQ); bf16_t* WKV = (bf16_t*)(ws + WS_WKV); bf16_t* WOUT = (bf16_t*)(ws + WS_WOUT);
    bf16_t* WUP = (bf16_t*)(ws + WS_WUP); bf16_t* WDN = (bf16_t*)(ws + WS_WDN);
    bf16_t* XB = (bf16_t*)(ws + WS_XB); bf16_t* VB = (bf16_t*)(ws + WS_V); bf16_t* X1B = (bf16_t*)(ws + WS_X1B);
    bf16_t* PROJ = (bf16_t*)(ws + WS_PROJ); bf16_t* HB = (bf16_t*)(ws + WS_HB);
    bf16_t* MIX = (bf16_t*)(ws + WS_MIX); float* SSQA = (float*)(ws + WS_SSQA);
    bf16_t* QB = (bf16_t*)(ws + WS_Q); bf16_t* KB = (bf16_t*)(ws + WS_K);
    const int lo = args.ph_lo, hi = args.ph_hi;
    cooperative_groups::grid_group grid = cooperative_groups::this_grid();
    volatile LAS unsigned* MISC = (volatile LAS unsigned*)((LAS unsigned char*)lds + MISC_OFF);
    { const int tid = TIDV(); if (tid < 32) MISC[tid] = 0u; }
    __syncthreads();
    XcdBarrier bar = xcd_barrier_post((unsigned*)(ws + WS_CTL) + 4096, MISC + 8, TIDV() == 0);
    if (args.ph_hi > 1000) grid.sync();
#define SEAM(k) do { if (lo <= (k) && (k) + 1 < hi) xcd_barrier(bar, TIDV() == 0); } while (0)
#ifndef PHMASK
#define PHMASK 0xFFF
#endif
#define IN(k) (((PHMASK >> (k)) & 1) && lo <= (k) && (k) < hi)
#ifndef REPMASK
#define REPMASK 0
#endif
#define REPS(k) for (int rep_ = 0; rep_ < ((((REPMASK) >> (k)) & 1) ? 2 : 1); ++rep_)

    if (IN(0)) REPS(0) {
        const int tid = TIDV(), lane = tid & 63, wave = g_wv;
        const int vcu = (G % 8 == 0) ? (bx % 8) * (G / 8) + bx / 8 : bx;
        const int gw = vcu * NWAVES + wave, NGW = G * NWAVES;
        LAS float* scr = (LAS float*)((LAS unsigned char*)lds + wave * 16384);
        constexpr int I_IN = 16 * 104, I_Q = 6 * 32, I_KV = 4 * 32, I_OUT = 16 * 32, I_UP = 16 * 128, I_DN = 64 * 32;
        constexpr int NITEMS = I_IN + I_Q + I_KV + I_OUT + I_UP + I_DN;
        const int l31 = lane & 31;
        for (int it = gw; it < NITEMS; it += NGW) {
            int r = it;
            if (r < I_IN) { const int kb = r / 104, nb = r % 104, nd = 32 * nb + l31; const int sc = nd < C_KR ? nd : (nd < DIN ? C_KR + rope_perm(nd - C_KR) : -1);
                tr_item(w_in, DIN, 64 * kb, sc, g_mix, 0, WIN, DM, 64 * kb, 32 * nb, scr, lane); continue; } r -= I_IN;
            if (r < I_Q) { const int kb = r / 32, nb = r % 32, nd = 32 * nb + l31, hh = nd >> 8, c = nd & 255; const int sc = c < 128 ? hh * 192 + c : (c < 192 ? hh * 192 + 128 + rope_perm(c - 128) : -1);
                tr_item(w_q_up, NQ, 64 * kb, sc, g_cq, 0, WQ, QLORA, 64 * kb, 32 * nb, scr, lane); continue; } r -= I_Q;
            if (r < I_KV) { const int kb = r / 32, nb = r % 32; tr_item(w_kv_up, NKV, 64 * kb, 32 * nb + l31, g_ckv, 0, WKV, KVLORA, 64 * kb, 32 * nb, scr, lane); continue; } r -= I_KV;
            if (r < I_OUT) { const int kb = r / 32, nb = r % 32; const int kd0 = 64 * kb, ks0 = kd0 < 512 ? kd0 + 512 : kd0 - 512;
                tr_item(w_out, DM, ks0, 32 * nb + l31, kd0 < 512 ? g_mla_out : nullptr, 512, WOUT, DM, kd0, 32 * nb, scr, lane); continue; } r -= I_OUT;
            if (r < I_UP) { const int kb = r / 128, nb = r % 128; tr_item(w_up, DFF, 64 * kb, 32 * nb + l31, g_ffn, 0, WUP, DM, 64 * kb, 32 * nb, scr, lane); continue; } r -= I_UP;
            { const int kb = r / 32, nb = r % 32; tr_item(w_down, DM, 64 * kb, 32 * nb + l31, nullptr, 0, WDN, DFF, 64 * kb, 32 * nb, scr, lane); }
        }
        for (int i = bx * 512 + tid; i < 512; i += G * 512) ((float*)(ws + WS_GHT))[i] = g_hgrn[i];
        for (int i = bx * 512 + tid; i < 512; i += G * 512) {
            if (i < 256) GQT[i] = i < 128 ? g_qn[i] * QSCALE : (i < 192 ? g_qn[128 + rope_perm(i - 128)] * QSCALE : 0.f);
            else { const int c = i - 256; if (c < 192) GKT[c] = c < 128 ? g_kn[c] : g_kn[128 + rope_perm(c - 128)]; } }
        for (int m = gw; m < M; m += 4 * NGW) rows_to_bf16_rs<4>(x + (size_t)m * DM, XB + (size_t)m * DM, RS0 + m, (size_t)NGW, lane);
        for (int i = bx * 512 + tid; i < 1024; i += G * 512) { const int dir = i >> 9, c = i & 511; const float p0 = lb_param[dir * 1024 + c], p1 = lb_param[dir * 1024 + 512 + c];
            LBT[i] = 1.f / (1.f + expf(p1 - p0)); }
        { const int j = tid & 31; const float invf = powf(10000.0f, -(float)(2 * j) / 64.0f);
          for (int i = bx * 512 + tid; i < M * 32; i += G * 512) { const int row = i >> 5; const float ang = (float)positions[row] * invf; float c, sn; sincos_acc(ang, c, sn); COS[i] = c; SIN[i] = sn; } }
    }
    SEAM(0);
    if (IN(1)) REPS(1) {
        pg8::Gemm g{XB, WIN, M, DINP, DM, DM}; pg8::StaticOrder S; S.init(M, DINP, G, bx);
        LAS float* rsT = (LAS float*)((LAS unsigned char*)lds + TAB_OFF);
        for (int ui = 0; ui < 16; ++ui) { pg8::Unit uu; if (!S.next(ui, uu)) break; const int tid = TIDV(); if (tid < 256) rsT[ui * 256 + tid] = RS0[uu.pm * 256 + tid]; }
        __syncthreads();
        pg8::EpiProj E{PROJ, DINP, rsT, LBT, SSQP, M, (LAS float*)((LAS unsigned char*)lds + EPI_OFF)};
        pg8::gemm_phase<pg8::EpiProj, pg8::StaticOrder, true, true>((LAS unsigned char*)lds, g, S, E, g_wv);
    }
    SEAM(1);
    if (IN(2)) REPS(2) {
        pg8::Gemm g{PROJ + C_CQ, WQ, M, 1024, QLORA, DINP}; pg8::StaticOrder S; S.init(M, 1024, G, bx);
        LAS float* rsT = (LAS float*)((LAS unsigned char*)lds + TAB_OFF);
        for (int ui = 0; ui < 4; ++ui) { pg8::Unit uu; if (!S.next(ui, uu)) break;
            const int tid = TIDV(); if (tid < 256) { const int row = uu.pm * 256 + tid; rsT[ui * 256 + tid] = __builtin_amdgcn_rsqf(((SSQP[row] + SSQP[M + row]) + SSQP[2 * (size_t)M + row]) * (1.f / 384.f) + EPS); } }
        __syncthreads();
        pg8::EpiQ E{QB, rsT, GQT, COS, SIN, (LAS float*)((LAS unsigned char*)lds + EPI_OFF)};
        pg8::gemm_phase<pg8::EpiQ, pg8::StaticOrder, true, true>((LAS unsigned char*)lds, g, S, E, g_wv);
    }
    if (IN(3)) REPS(3) {
        pg8::Gemm g{PROJ + C_CKV, WKV, M, NKV, KVLORA, DINP}; pg8::StaticOrder S; S.init(M, NKV, G, bx);
        LAS float* rsT = (LAS float*)((LAS unsigned char*)lds + TAB_OFF + 8192); LAS float* skT = rsT + 1024;
        for (int ui = 0; ui < 4; ++ui) { pg8::Unit uu; if (!S.next(ui, uu)) break;
            const int tid = TIDV(); if (tid < 256) { const int row = uu.pm * 256 + tid; rsT[ui * 256 + tid] = __builtin_amdgcn_rsqf((SSQP[3 * (size_t)M + row] + SSQP[4 * (size_t)M + row]) * (1.f / 256.f) + EPS); skT[ui * 256 + tid] = SSQP[5 * (size_t)M + row]; } }
        __syncthreads();
        pg8::EpiKV E{KB, VB, PROJ, DINP, C_KR, rsT, skT, GKT, COS, SIN, (LAS float*)((LAS unsigned char*)lds + EPI_OFF)};
        pg8::gemm_phase<pg8::EpiKV, pg8::StaticOrder, true, true>((LAS unsigned char*)lds, g, S, E, g_wv);
    }
    SEAM(4);
    if (IN(5)) {
        if (bx < BATCH * 4) hg::hgrn_bh(bx >> 2, bx & 3, PROJ, MIX, (const float*)(ws + WS_GHT) + (bx & 3) * 128, (char*)lds, g_wv);
        { const int a = bx & 127, bhs = (a >> 6) * 8 + (a & 7), qb = (a >> 3) & 7;
          att::attn_chain(QB, KB, VB, MIX, DM, SSQA, bhs, qb, bx < BATCH * 4 ? 7 : 0, bx < BATCH * 4 ? 8 : 7, SEQ, M, (char*)lds, g_wv); }
    }
    SEAM(7);
    if (IN(8)) REPS(8) {
        pg8::Gemm g{MIX, WOUT, M, DM, DM, DM}; pg8::StaticOrder S; S.init(M, DM, G, bx);
        LAS float* rsbT = (LAS float*)((LAS unsigned char*)lds + EPI_OFF + 4096);
        for (int ui = 0; ui < 4; ++ui) { pg8::Unit uu; if (!S.next(ui, uu)) break;
            const int tid = TIDV(); if (tid < 256) { const int row = uu.pm * 256 + tid; rsbT[ui * 256 + tid] = 1.f / sqrtf(((SSQA[row] + SSQA[M + row]) + (SSQA[2 * (size_t)M + row] + SSQA[3 * (size_t)M + row])) * (1.f / 512.f) + EPS); } }
        __syncthreads();
        pg8::EpiResidX1 E{XB, X1B, SSQ1, DM, M, (LAS float*)((LAS unsigned char*)lds + EPI_OFF), rsbT};
        pg8::gemm_phase<pg8::EpiResidX1, pg8::StaticOrder, true, true>((LAS unsigned char*)lds, g, S, E, g_wv);
    }
    SEAM(8);
    if (IN(10)) REPS(10) {
        pg8::Gemm g{X1B, WUP, M, DFF, DM, DM}; pg8::StaticOrder S; S.init(M, DFF, G, bx);
        LAS float* rsT = (LAS float*)((LAS unsigned char*)lds + TAB_OFF);
        for (int ui = 0; ui < 16; ++ui) { pg8::Unit uu; if (!S.next(ui, uu)) break;
            const int tid = TIDV(); if (tid < 256) { const int row = uu.pm * 256 + tid; rsT[ui * 256 + tid] = __builtin_amdgcn_rsqf(((SSQ1[row] + SSQ1[M + row]) + (SSQ1[2 * (size_t)M + row] + SSQ1[3 * (size_t)M + row])) * (1.f / 1024.f) + EPS); } }
        __syncthreads();
        pg8::EpiUp E{HB, DFF, rsT};
        pg8::gemm_phase<pg8::EpiUp, pg8::StaticOrder, true, true>((LAS unsigned char*)lds, g, S, E, g_wv);
    }
    SEAM(10);
    if (IN(11)) {
        pg8::Gemm g{HB, WDN, M, DM, DFF, DFF}; pg8::StaticOrder S; S.init(M, DM, G, bx);
        pg8::EpiResidBf E{X1B, out, DM};
        pg8::gemm_phase<pg8::EpiResidBf, pg8::StaticOrder, true, true>((LAS unsigned char*)lds, g, S, E, g_wv);
    }
#undef IN
}

extern "C" void kernel_launch(void* const* d_in, const int* in_sizes, int n_in, void* d_out, int out_size, void* d_ws, size_t ws_size, hipStream_t stream) {
    static int ok = 0, grid_blocks = 0;
    if (ok == 0) {
        if (n_in != 17 || in_sizes[0] != M * DM || out_size != M * DM || ws_size < WS_END) {
            fprintf(stderr, "kernel_launch: shape mismatch n_in %d in0 %d out %d ws %zu (need %zu)\n", n_in, n_in > 0 ? in_sizes[0] : -1, out_size, ws_size, (size_t)WS_END); ok = -1; return; }
        if (hipFuncSetAttribute((const void*)mk_fwd, hipFuncAttributeMaxDynamicSharedMemorySize, LDS_BYTES) != hipSuccess) { fprintf(stderr, "kernel_launch: hipFuncSetAttribute failed\n"); ok = -1; return; }
        int dev = 0, cus = 0, per_cu = 0;
        (void)hipGetDevice(&dev); (void)hipDeviceGetAttribute(&cus, hipDeviceAttributeMultiprocessorCount, dev);
        (void)hipOccupancyMaxActiveBlocksPerMultiprocessor(&per_cu, (const void*)mk_fwd, NWAVES * 64, LDS_BYTES);
        if (per_cu < 1 || cus < 1) { fprintf(stderr, "kernel_launch: occupancy query gave %d blocks/CU on %d CUs\n", per_cu, cus); ok = -1; return; }
        grid_blocks = cus * (per_cu > 1 ? 1 : per_cu);
        ok = 1;
    }
    if (ok < 0) return;
    (void)hipMemsetAsync((char*)d_ws + WS_CTL, 0, CTL_ZERO_BYTES, stream);
    Args a{};
    for (int i = 0; i < 17; ++i) a.in[i] = (const float*)d_in[i];
    a.out = (float*)d_out; a.ws = (unsigned char*)d_ws;
    a.ph_lo = 0; a.ph_hi = 12;
    void* kargs[] = {&a};
    (void)hipLaunchCooperativeKernel((const void*)mk_fwd, dim3(grid_blocks), dim3(NWAVES * 64), kargs, LDS_BYTES, stream);
    const hipError_t le = hipPeekAtLastError();
    if (le != hipSuccess) fprintf(stderr, "kernel_launch: launch failed: %s\n", hipGetErrorName(le));
}
```

```cpp
#include <hip/hip_runtime.h>
#include <hip/hip_cooperative_groups.h>
#include <cstdio>
#include <cstdint>

#define LAS __attribute__((address_space(3)))
typedef unsigned short bf16_t;
typedef short bf16x8 __attribute__((ext_vector_type(8)));
typedef short s16x4 __attribute__((ext_vector_type(4)));
typedef float f32x4 __attribute__((ext_vector_type(4)));
typedef float f32x16 __attribute__((ext_vector_type(16)));
typedef unsigned u32x4 __attribute__((ext_vector_type(4)));
typedef unsigned u32x2 __attribute__((ext_vector_type(2)));
typedef _Float16 h16x2 __attribute__((ext_vector_type(2)));

constexpr int BATCH = 32, SEQ = 2048, DM = 1024, M = BATCH * SEQ;
constexpr int DIN = 3264, DINP = 3328, DFF = 4096;
constexpr int C_Q = 0, C_FF = 512, C_I = 1536, C_G = 2048, C_CQ = 2560, C_CKV = 2944, C_KR = 3200;
constexpr int QLORA = 384, KVLORA = 256, NQ = 768, NKV = 1024;
constexpr float EPS = 1e-6f;
constexpr float QSCALE = 0.07216878364870322f * 1.4426950408889634f;

constexpr size_t MiB = 1u << 20;
constexpr size_t WS_CTL = 0;
constexpr size_t WS_RS0 = 1 * MiB, WS_RS1 = WS_RS0 + 256 * 1024, WS_LBT = WS_RS1 + 256 * 1024;
constexpr size_t WS_COS = 2 * MiB, WS_SIN = 10 * MiB;
constexpr size_t WS_WIN = 18 * MiB, WS_WQ = 25 * MiB, WS_WKV = 26 * MiB, WS_WOUT = 27 * MiB, WS_WUP = 29 * MiB, WS_WDN = 37 * MiB;
constexpr size_t WS_GQT = WS_LBT + 4096, WS_GKT = WS_GQT + 1024, WS_GHT = WS_GKT + 1024;
constexpr size_t WS_SSQ1 = 45 * MiB;
constexpr size_t WS_XB = 46 * MiB;
constexpr size_t WS_X1B = 718 * MiB;
constexpr size_t WS_PROJ = 174 * MiB;
constexpr size_t WS_HB = 174 * MiB;
constexpr size_t WS_MIX = 590 * MiB;
constexpr size_t WS_Q = 718 * MiB, WS_K = 814 * MiB, WS_V = 910 * MiB;
constexpr size_t WS_SSQP = 974 * MiB;
constexpr size_t WS_SSQA = 976 * MiB;
constexpr size_t WS_END = 977 * MiB;

__device__ __forceinline__ unsigned f2bf(float f) { unsigned u = __builtin_bit_cast(unsigned, f); return (u + 0x7fffu + ((u >> 16) & 1u)) >> 16; }
__device__ __forceinline__ unsigned pk2(float lo, float hi) { return f2bf(lo) | (f2bf(hi) << 16); }
__device__ __forceinline__ float bf2f(unsigned short b) { return __builtin_bit_cast(float, (unsigned)b << 16); }
__device__ __forceinline__ float bflo(unsigned w) { return __builtin_bit_cast(float, w << 16); }
__device__ __forceinline__ float bfhi(unsigned w) { return __builtin_bit_cast(float, w & 0xffff0000u); }
__device__ __forceinline__ float wave_sum(float v) {
#pragma unroll
    for (int o = 1; o < 64; o <<= 1) v += __shfl_xor(v, o);
    return v;
}
__device__ __forceinline__ int lane_id() { int l; asm volatile("v_mbcnt_lo_u32_b32 %0, -1, 0\n\tv_mbcnt_hi_u32_b32 %0, -1, %0" : "=v"(l)); return l; }
__device__ __forceinline__ float dpp_sum8(float v) {
    v += __builtin_bit_cast(float, __builtin_amdgcn_update_dpp(0, __builtin_bit_cast(int, v), 0xB1, 0xF, 0xF, true));
    v += __builtin_bit_cast(float, __builtin_amdgcn_update_dpp(0, __builtin_bit_cast(int, v), 0x4E, 0xF, 0xF, true));
    v += __builtin_bit_cast(float, __builtin_amdgcn_update_dpp(0, __builtin_bit_cast(int, v), 0x141, 0xF, 0xF, true));
    return v;
}
typedef float f32x2_t __attribute__((ext_vector_type(2))); typedef __bf16 bf16x2_t __attribute__((ext_vector_type(2)));
__device__ __forceinline__ unsigned cvtpk(float lo, float hi) { f32x2_t v = {lo, hi}; bf16x2_t b = __builtin_convertvector(v, bf16x2_t); return __builtin_bit_cast(unsigned, b); }
__device__ __forceinline__ unsigned cvt_pk_bf16(float lo, float hi) { unsigned r; asm volatile("v_cvt_pk_bf16_f32 %0, %1, %2" : "=v"(r) : "v"(lo), "v"(hi)); return r; }

namespace pg8 {
#define PG8_LAS __attribute__((address_space(3)))
constexpr int BM = 256, BK = 64, HALF = 128, HTB = HALF * BK * 2, STAGE_BYTES = 8 * HTB, NXCD = 8, WGM = 8;
__host__ __device__ __forceinline__ int lds_byte(int r, int c) { const int st = (r >> 4) * 2 + (c >> 5), rr = r & 15, cc = c & 31, ob = rr * 64 + cc * 2; return st * 1024 + (ob ^ (((ob >> 9) & 1) << 5)); }
__host__ __device__ __forceinline__ void stage_rc(int b, int& R, int& C) { const int st = b / 1024, sb = b % 1024, swz = sb ^ (((sb >> 9) & 1) << 5); R = (st >> 1) * 16 + swz / 64; C = (st & 1) * 32 + (swz % 64) / 2; }
__host__ __device__ __forceinline__ int perm32(int rho) { const int n = rho >> 4, i = rho & 15; return 8 * (i >> 2) + 4 * n + (i & 3); }
struct Unit { int pm, pn; };
struct Gemm { const bf16_t* A; const bf16_t* Bt; int M, N, K, lda; };
struct StaticOrder {
    int nM, nN, nwg, G, c;
    __host__ __device__ __forceinline__ void init(int M_, int N_, int G_, int c_) { nM = M_ / BM; nN = N_ / BM; nwg = nM * nN; G = G_; c = c_; }
    __host__ __device__ __forceinline__ bool next(int i, Unit& u) const {
        const long L = (long)i * G + c; if (L >= nwg) return false;
        int wgid = (int)L; { const int q = nwg / NXCD, r = nwg % NXCD, xcd = wgid % NXCD, off = wgid / NXCD; wgid = (xcd < r ? xcd * (q + 1) : r * (q + 1) + (xcd - r) * q) + off; }
        const int nig = WGM * nN, gid = wgid / nig, fm = gid * WGM, gsz = (nM - fm) < WGM ? (nM - fm) : WGM;
        u.pm = fm + ((wgid % nig) % gsz); u.pn = (wgid % nig) / gsz; return true;
    }
    __device__ __forceinline__ void a_ready(const Unit&) const {}
    __device__ __forceinline__ void done(const Unit&) const {}
};
typedef f32x4 Acc[2][2][4][2];

struct EpiBf16 {
    static constexpr bool PERM = true, AFTER_DRAIN = false; static constexpr int MIDK = 0;
    bf16_t* O; int ldc;
    __device__ __forceinline__ void operator()(const Acc& acc, const Unit& u, int wr, int wc, int fr, int fq, int ui) const {
        const int row0 = u.pm * BM + wr * 64 + fr, col0 = u.pn * BM + wc * 32 + 8 * fq;
#pragma unroll
        for (int ai = 0; ai < 2; ++ai)
#pragma unroll
            for (int m = 0; m < 4; ++m) { bf16_t* rowp = O + (size_t)(row0 + ai * HALF + m * 16) * ldc + col0;
#pragma unroll
                for (int bj = 0; bj < 2; ++bj) { const f32x4 v0 = acc[ai][bj][m][0], v1 = acc[ai][bj][m][1];
                    u32x4 w; w.x = cvt_pk_bf16(v0[0], v0[1]); w.y = cvt_pk_bf16(v0[2], v0[3]); w.z = cvt_pk_bf16(v1[0], v1[1]); w.w = cvt_pk_bf16(v1[2], v1[3]);
                    *(u32x4*)(rowp + bj * HALF) = w; } }
    }
};
struct EpiProj {
    static constexpr bool PERM = true, AFTER_DRAIN = false; static constexpr int MIDK = 0;
    bf16_t* O; int ldc; const PG8_LAS float* rsT; const float* lbt; float* ssqp; int Mrows; PG8_LAS float* red; bf16_t* lat; int ldl;
    __device__ __forceinline__ void operator()(const Acc& acc, const Unit& u, int wr, int wc, int fr, int fq, int ui) const {
        const int row0 = u.pm * BM + wr * 64 + fr, col0 = u.pn * BM + wc * 32 + 8 * fq;
        const bool gate = (u.pn >= 2 && u.pn < 6), stat = (u.pn >= 10);
        f32x4 lb[2][2];
#pragma unroll
        for (int bj = 0; bj < 2; ++bj)
#pragma unroll
            for (int n = 0; n < 2; ++n) lb[bj][n] = gate ? *(const f32x4*)(lbt + (col0 - 512) + bj * HALF + 4 * n) : (f32x4){0.f, 0.f, 0.f, 0.f};
#pragma unroll
        for (int ai = 0; ai < 2; ++ai)
#pragma unroll
            for (int m = 0; m < 4; ++m) { const int row = row0 + ai * HALF + m * 16; const float r = rsT[ui * BM + ai * HALF + wr * 64 + m * 16 + fr]; bf16_t* rowp = stat ? lat + (size_t)row * ldl + (col0 - 10 * BM) : O + (size_t)row * ldc + col0; float sq[2];
#pragma unroll
                for (int bj = 0; bj < 2; ++bj) { f32x4 v0 = acc[ai][bj][m][0] * r, v1 = acc[ai][bj][m][1] * r; u32x4 w;
                    sq[bj] = ((v0[0] * v0[0] + v0[1] * v0[1]) + (v0[2] * v0[2] + v0[3] * v0[3])) + ((v1[0] * v1[0] + v1[1] * v1[1]) + (v1[2] * v1[2] + v1[3] * v1[3]));
                    if (gate) {
#pragma unroll
                        for (int e = 0; e < 4; ++e) { const float s0 = __builtin_amdgcn_rcpf(1.f + __builtin_amdgcn_exp2f(-1.4426950408889634f * v0[e])), s1 = __builtin_amdgcn_rcpf(1.f + __builtin_amdgcn_exp2f(-1.4426950408889634f * v1[e]));
                            v0[e] = __builtin_amdgcn_logf(lb[bj][0][e] + (1.f - lb[bj][0][e]) * s0); v1[e] = __builtin_amdgcn_logf(lb[bj][1][e] + (1.f - lb[bj][1][e]) * s1); }
                        h16x2 a = {(_Float16)v0[0], (_Float16)v0[1]}, b = {(_Float16)v0[2], (_Float16)v0[3]}, c = {(_Float16)v1[0], (_Float16)v1[1]}, d = {(_Float16)v1[2], (_Float16)v1[3]};
                        w.x = __builtin_bit_cast(unsigned, a); w.y = __builtin_bit_cast(unsigned, b); w.z = __builtin_bit_cast(unsigned, c); w.w = __builtin_bit_cast(unsigned, d);
                    } else { w.x = cvt_pk_bf16(v0[0], v0[1]); w.y = cvt_pk_bf16(v0[2], v0[3]); w.z = cvt_pk_bf16(v1[0], v1[1]); w.w = cvt_pk_bf16(v1[2], v1[3]); }
                    if (stat) { asm volatile("" ::: "memory"); *(u32x4*)(rowp + bj * HALF) = w; asm volatile("" ::: "memory"); } else __builtin_nontemporal_store(w, (u32x4*)(rowp + bj * HALF)); }
                if (stat) { sq[0] += __shfl_xor(sq[0], 16); sq[0] += __shfl_xor(sq[0], 32); sq[1] += __shfl_xor(sq[1], 16); sq[1] += __shfl_xor(sq[1], 32);
                    if (fq == 0) { PG8_LAS float* rp = red + (ai * HALF + wr * 64 + m * 16 + fr) * 8 + wc * 2; rp[0] = sq[0]; rp[1] = sq[1]; } } }
        if (stat) {
            asm volatile("s_waitcnt lgkmcnt(0)" ::: "memory"); __builtin_amdgcn_s_barrier(); asm volatile("" ::: "memory");
            const int t = (wr * 4 + wc) * 64 + fq * 16 + fr;
            if (t < 256) { const f32x4 q0 = *(const PG8_LAS f32x4*)(red + t * 8), q1 = *(const PG8_LAS f32x4*)(red + t * 8 + 4);
                float* dst = ssqp + (size_t)((u.pn - 10) * 2) * Mrows + u.pm * BM + t; dst[0] = (q0[0] + q0[2]) + (q1[0] + q1[2]); dst[Mrows] = (q0[1] + q0[3]) + (q1[1] + q1[3]); }
            asm volatile("s_waitcnt lgkmcnt(0)" ::: "memory"); __builtin_amdgcn_s_barrier(); asm volatile("" ::: "memory");
        }
    }
};
struct EpiQ {
    static constexpr bool PERM = true, AFTER_DRAIN = false; static constexpr int MIDK = 0;
    bf16_t* Q; const PG8_LAS float* rsT; const float* gq; const float* cosT; const float* sinT; PG8_LAS float* red;
    __device__ __forceinline__ void operator()(const Acc& acc, const Unit& u, int wr, int wc, int fr, int fq, int ui) const {
        const int h = u.pn, cl = wc * 32 + 8 * fq, ic = 4 * wc + fq;
        f32x4 cs[2][4], sn[2][4];
        if (wc < 2) {
#pragma unroll
            for (int ai = 0; ai < 2; ++ai)
#pragma unroll
                for (int m = 0; m < 4; ++m) { const size_t row = (size_t)(u.pm * BM + ai * HALF + wr * 64 + m * 16 + fr);
                    cs[ai][m] = *(const f32x4*)(cosT + row * 32 + 4 * ic); sn[ai][m] = *(const f32x4*)(sinT + row * 32 + 4 * ic); }
        }
        const f32x4 g00 = *(const f32x4*)(gq + cl), g01 = *(const f32x4*)(gq + cl + 4), g10 = *(const f32x4*)(gq + 128 + cl), g11 = *(const f32x4*)(gq + 128 + cl + 4);
#pragma unroll
        for (int ai = 0; ai < 2; ++ai)
#pragma unroll
            for (int m = 0; m < 4; ++m) { float s = 0.f;
#pragma unroll
                for (int bj = 0; bj < 2; ++bj)
#pragma unroll
                    for (int n = 0; n < 2; ++n) { const f32x4 v = acc[ai][bj][m][n]; s += (v[0] * v[0] + v[1] * v[1]) + (v[2] * v[2] + v[3] * v[3]); }
                s += __shfl_xor(s, 16); s += __shfl_xor(s, 32);
                if (fq == 0) red[(ai * HALF + wr * 64 + m * 16 + fr) * 4 + wc] = s; }
        asm volatile("s_waitcnt lgkmcnt(0)" ::: "memory"); __builtin_amdgcn_s_barrier(); asm volatile("" ::: "memory");
#pragma unroll
        for (int ai = 0; ai < 2; ++ai)
#pragma unroll
            for (int m = 0; m < 4; ++m) { const int rowl = ai * HALF + wr * 64 + m * 16 + fr, row = u.pm * BM + rowl;
                const f32x4 q4 = *(const PG8_LAS f32x4*)(red + rowl * 4); const float ssx = (q4[0] + q4[1]) + (q4[2] + q4[3]);
                const float rs = rsT[ui * BM + rowl];
                const float sc = rs * __builtin_amdgcn_rsqf(rs * rs * ssx * (1.f / 192.f) + 1e-6f);
                bf16_t* dst = Q + ((size_t)((row >> 11) * 4 + h) * 2048 + (row & 2047)) * 192 + cl;
                { const f32x4 v0 = acc[ai][0][m][0] * sc * g00, v1 = acc[ai][0][m][1] * sc * g01; u32x4 w; w.x = cvt_pk_bf16(v0[0], v0[1]); w.y = cvt_pk_bf16(v0[2], v0[3]); w.z = cvt_pk_bf16(v1[0], v1[1]); w.w = cvt_pk_bf16(v1[2], v1[3]); *(u32x4*)dst = w; }
                if (wc < 2) { const f32x4 t1 = acc[ai][1][m][0] * sc * g10, t2 = acc[ai][1][m][1] * sc * g11;
                    const f32x4 o1 = t1 * cs[ai][m] - t2 * sn[ai][m], o2 = t2 * cs[ai][m] + t1 * sn[ai][m];
                    u32x4 w; w.x = cvt_pk_bf16(o1[0], o1[1]); w.y = cvt_pk_bf16(o1[2], o1[3]); w.z = cvt_pk_bf16(o2[0], o2[1]); w.w = cvt_pk_bf16(o2[2], o2[3]); *(u32x4*)(dst + 128) = w; } }
    }
};
struct EpiKV {
    static constexpr bool PERM = true, AFTER_DRAIN = false; static constexpr int MIDK = 0;
    bf16_t* K; bf16_t* V; const bf16_t* proj; int ldp; int ckr; const PG8_LAS float* rsT; const PG8_LAS float* skT; const float* gk; const float* cosT; const float* sinT; PG8_LAS float* red;
    __device__ __forceinline__ void operator()(const Acc& acc, const Unit& u, int wr, int wc, int fr, int fq, int ui) const {
        const int h = u.pn, cl = wc * 32 + 8 * fq, ic = 4 * wc + fq;
#pragma unroll
        for (int ai = 0; ai < 2; ++ai)
#pragma unroll
            for (int m = 0; m < 4; ++m) { float s = 0.f;
#pragma unroll
                for (int n = 0; n < 2; ++n) { const f32x4 v = acc[ai][0][m][n]; s += (v[0] * v[0] + v[1] * v[1]) + (v[2] * v[2] + v[3] * v[3]); }
                s += __shfl_xor(s, 16); s += __shfl_xor(s, 32);
                if (fq == 0) red[(ai * HALF + wr * 64 + m * 16 + fr) * 4 + wc] = s; }
        const f32x4 g0 = *(const f32x4*)(gk + cl), g1 = *(const f32x4*)(gk + cl + 4);
        f32x4 gr0 = {0.f, 0.f, 0.f, 0.f}, gr1 = {0.f, 0.f, 0.f, 0.f};
        if (wc < 2) { gr0 = *(const f32x4*)(gk + 128 + 8 * ic); gr1 = *(const f32x4*)(gk + 128 + 8 * ic + 4); }
        asm volatile("s_waitcnt lgkmcnt(0)" ::: "memory"); __builtin_amdgcn_s_barrier(); asm volatile("" ::: "memory");
#pragma unroll
        for (int ai = 0; ai < 2; ++ai) {
            u32x4 kr[4]; f32x4 cs[4], sn[4];
            if (wc < 2) {
#pragma unroll
                for (int m = 0; m < 4; ++m) { const size_t row = (size_t)(u.pm * BM + ai * HALF + wr * 64 + m * 16 + fr);
                    kr[m] = *(const u32x4*)(proj + row * ldp + ckr + 8 * ic); cs[m] = *(const f32x4*)(cosT + row * 32 + 4 * ic); sn[m] = *(const f32x4*)(sinT + row * 32 + 4 * ic); }
            }
#pragma unroll
            for (int m = 0; m < 4; ++m) { const int rowl = ai * HALF + wr * 64 + m * 16 + fr, row = u.pm * BM + rowl;
                const f32x4 q4 = *(const PG8_LAS f32x4*)(red + rowl * 4); const float ssk = (q4[0] + q4[1]) + (q4[2] + q4[3]);
                const float rsc = rsT[ui * BM + rowl], skr = skT[ui * BM + rowl];
                const float r = __builtin_amdgcn_rsqf((rsc * rsc * ssk + skr) * (1.f / 192.f) + 1e-6f);
                const size_t tok = (size_t)((row >> 11) * 4 + h) * 2048 + (row & 2047);
                bf16_t* kd = K + tok * 192; bf16_t* vd = V + tok * 128;
                { const float sc = rsc * r; const f32x4 v0 = acc[ai][0][m][0] * sc * g0, v1 = acc[ai][0][m][1] * sc * g1; u32x4 w; w.x = cvt_pk_bf16(v0[0], v0[1]); w.y = cvt_pk_bf16(v0[2], v0[3]); w.z = cvt_pk_bf16(v1[0], v1[1]); w.w = cvt_pk_bf16(v1[2], v1[3]); *(u32x4*)(kd + cl) = w; }
                { const f32x4 v0 = acc[ai][1][m][0] * rsc, v1 = acc[ai][1][m][1] * rsc; u32x4 w; w.x = cvt_pk_bf16(v0[0], v0[1]); w.y = cvt_pk_bf16(v0[2], v0[3]); w.z = cvt_pk_bf16(v1[0], v1[1]); w.w = cvt_pk_bf16(v1[2], v1[3]); *(u32x4*)(vd + cl) = w; }
                if (wc < 2) { const f32x4 t1 = (f32x4){bflo(kr[m].x), bfhi(kr[m].x), bflo(kr[m].y), bfhi(kr[m].y)} * gr0 * r, t2 = (f32x4){bflo(kr[m].z), bfhi(kr[m].z), bflo(kr[m].w), bfhi(kr[m].w)} * gr1 * r;
                    const f32x4 o1 = t1 * cs[m] - t2 * sn[m], o2 = t2 * cs[m] + t1 * sn[m];
                    u32x4 w; w.x = cvt_pk_bf16(o1[0], o1[1]); w.y = cvt_pk_bf16(o1[2], o1[3]); w.z = cvt_pk_bf16(o2[0], o2[1]); w.w = cvt_pk_bf16(o2[2], o2[3]); *(u32x4*)(kd + 128 + 8 * ic) = w; } }
        }
    }
};
struct EpiUp {
    static constexpr bool PERM = true, AFTER_DRAIN = false; static constexpr int MIDK = 0;
    bf16_t* O; int ldc; const PG8_LAS float* rsT;
    __device__ __forceinline__ void operator()(const Acc& acc, const Unit& u, int wr, int wc, int fr, int fq, int ui) const {
        const int row0 = u.pm * BM + wr * 64 + fr, col0 = u.pn * BM + wc * 32 + 8 * fq;
#pragma unroll
        for (int ai = 0; ai < 2; ++ai)
#pragma unroll
            for (int m = 0; m < 4; ++m) { const int row = row0 + ai * HALF + m * 16; const float r = rsT[ui * BM + ai * HALF + wr * 64 + m * 16 + fr]; bf16_t* rowp = O + (size_t)row * ldc + col0;
#pragma unroll
                for (int bj = 0; bj < 2; ++bj) { f32x4 v0 = acc[ai][bj][m][0] * r, v1 = acc[ai][bj][m][1] * r;
#pragma unroll
                    for (int e = 0; e < 4; ++e) { const float a = fmaxf(v0[e], 0.f), b = fmaxf(v1[e], 0.f); v0[e] = a * a; v1[e] = b * b; }
                    u32x4 w; w.x = cvt_pk_bf16(v0[0], v0[1]); w.y = cvt_pk_bf16(v0[2], v0[3]); w.z = cvt_pk_bf16(v1[0], v1[1]); w.w = cvt_pk_bf16(v1[2], v1[3]);
                    __builtin_nontemporal_store(w, (u32x4*)(rowp + bj * HALF)); } }
    }
};
struct EpiResid {
    static constexpr bool PERM = false, AFTER_DRAIN = false; static constexpr int MIDK = 0;
    const float* base; float* out; int ldc;
    __device__ __forceinline__ void operator()(const Acc& acc, const Unit& u, int wr, int wc, int fr, int fq, int ui) const {
        const int row0 = u.pm * BM + wr * 64 + fr, col0 = u.pn * BM + wc * 32 + 4 * fq;
#pragma unroll
        for (int ai = 0; ai < 2; ++ai)
#pragma unroll
            for (int m = 0; m < 4; ++m) { const size_t off = (size_t)(row0 + ai * HALF + m * 16) * ldc + col0;
#pragma unroll
                for (int bj = 0; bj < 2; ++bj)
#pragma unroll
                    for (int n = 0; n < 2; ++n) { const f32x4 bs = *(const f32x4*)(base + off + bj * HALF + n * 16); *(f32x4*)(out + off + bj * HALF + n * 16) = bs + acc[ai][bj][m][n]; } }
    }
};

struct EpiResidBf {
    static constexpr bool PERM = false, AFTER_DRAIN = false; static constexpr int MIDK = 0;
    const bf16_t* xb; float* out; int ldc;
    __device__ __forceinline__ void operator()(const Acc& acc, const Unit& u, int wr, int wc, int fr, int fq, int ui) const {
        const int row0 = u.pm * BM + wr * 64 + fr, col0 = u.pn * BM + wc * 32 + 4 * fq;
        u32x2 w[2][4][2][2];
#pragma unroll
        for (int ai = 0; ai < 2; ++ai)
#pragma unroll
            for (int m = 0; m < 4; ++m) { const size_t off = (size_t)(row0 + ai * HALF + m * 16) * ldc + col0;
#pragma unroll
                for (int bj = 0; bj < 2; ++bj)
#pragma unroll
                    for (int n = 0; n < 2; ++n) w[ai][m][bj][n] = *(const u32x2*)(xb + off + bj * HALF + n * 16); }
        __builtin_amdgcn_sched_barrier(0);
#pragma unroll
        for (int ai = 0; ai < 2; ++ai) {
#pragma unroll
            for (int m = 0; m < 4; ++m) { const size_t off = (size_t)(row0 + ai * HALF + m * 16) * ldc + col0;
#pragma unroll
                for (int bj = 0; bj < 2; ++bj)
#pragma unroll
                    for (int n = 0; n < 2; ++n) { const u32x2 ww = w[ai][m][bj][n]; const f32x4 bs = {bflo(ww.x), bfhi(ww.x), bflo(ww.y), bfhi(ww.y)}; *(f32x4*)(out + off + bj * HALF + n * 16) = bs + acc[ai][bj][m][n]; } }
        }
    }
};
struct EpiResidX1 {
    static constexpr bool PERM = false, AFTER_DRAIN = false; static constexpr int MIDK = 8;
    const bf16_t* base; bf16_t* xb; float* ssq; int ldc; int Mrows; PG8_LAS float* red; const PG8_LAS float* rsb;
    __device__ __forceinline__ void mid(Acc& acc, int ui, int wr, int fr) const {
#pragma unroll
        for (int ai = 0; ai < 2; ++ai)
#pragma unroll
            for (int m = 0; m < 4; ++m) { const float r = rsb[ui * BM + ai * HALF + wr * 64 + m * 16 + fr];
#pragma unroll
                for (int bj = 0; bj < 2; ++bj)
#pragma unroll
                    for (int n = 0; n < 2; ++n) acc[ai][bj][m][n] *= r; }
    }
    __device__ __forceinline__ void operator()(const Acc& acc, const Unit& u, int wr, int wc, int fr, int fq, int ui) const {
        const int row0 = u.pm * BM + wr * 64 + fr, col0 = u.pn * BM + wc * 32 + 4 * fq;
        u32x2 xr[2][4][2][2];
#pragma unroll
        for (int ai = 0; ai < 2; ++ai)
#pragma unroll
            for (int m = 0; m < 4; ++m) { const size_t off = (size_t)(row0 + ai * HALF + m * 16) * ldc + col0;
#pragma unroll
                for (int bj = 0; bj < 2; ++bj)
#pragma unroll
                    for (int n = 0; n < 2; ++n) xr[ai][m][bj][n] = *(const u32x2*)(base + off + bj * HALF + n * 16); }
        __builtin_amdgcn_sched_barrier(0);
#pragma unroll
        for (int ai = 0; ai < 2; ++ai) {
#pragma unroll
            for (int m = 0; m < 4; ++m) { const size_t off = (size_t)(row0 + ai * HALF + m * 16) * ldc + col0; float s = 0.f;
#pragma unroll
                for (int bj = 0; bj < 2; ++bj)
#pragma unroll
                    for (int n = 0; n < 2; ++n) { const u32x2 xw = xr[ai][m][bj][n]; const f32x4 v = (f32x4){bflo(xw.x), bfhi(xw.x), bflo(xw.y), bfhi(xw.y)} + acc[ai][bj][m][n];
                        u32x2 w; w.x = cvt_pk_bf16(v[0], v[1]); w.y = cvt_pk_bf16(v[2], v[3]); *(u32x2*)(xb + off + bj * HALF + n * 16) = w;
                        s += (v[0] * v[0] + v[1] * v[1]) + (v[2] * v[2] + v[3] * v[3]); }
                s += __shfl_xor(s, 16); s += __shfl_xor(s, 32);
                if (fq == 0) red[(ai * HALF + wr * 64 + m * 16 + fr) * 4 + wc] = s; }
        }
        asm volatile("s_waitcnt lgkmcnt(0)" ::: "memory"); __builtin_amdgcn_s_barrier(); asm volatile("" ::: "memory");
        const int t = (wr * 4 + wc) * 64 + fq * 16 + fr;
        if (t < 256) { const f32x4 q = *(const PG8_LAS f32x4*)(red + t * 4); ssq[(size_t)u.pn * Mrows + u.pm * BM + t] = (q[0] + q[1]) + (q[2] + q[3]); }
        asm volatile("s_waitcnt lgkmcnt(0)" ::: "memory"); __builtin_amdgcn_s_barrier(); asm volatile("" ::: "memory");
    }
};
struct NoPre { __device__ __forceinline__ void operator()() const {} };
template <class Epi, class Sched, bool ALIGN_EPI = false, bool SP2 = false, class Pre = NoPre>
__device__ __forceinline__ void gemm_phase(PG8_LAS unsigned char* lds, const Gemm g, const Sched& S, const Epi& E, int wv, const Pre& pre = Pre()) {
    int lane = lane_id(); asm volatile("" : "+v"(lane));
    const int wid = wv, tid = wv * 64 + lane, wr = wid >> 2, wc = wid & 3, fr = lane & 15, fq = lane >> 4;
    const int K = g.K, nt = K / BK, lda = g.lda;
    unsigned voffA[2], voffB[2];
#pragma unroll
    for (int i = 0; i < 2; ++i) { int R, C; stage_rc(tid * 16 + i * 8192, R, C); const int Rb = Epi::PERM ? ((R & ~31) + perm32(R & 31)) : R;
        voffA[i] = (unsigned)(R * lda + C) * 2u; voffB[i] = (unsigned)(Rb * K + C) * 2u; }
    const size_t kstep = (size_t)(BK * 2);
    const size_t hstepA = (size_t)HALF * lda * 2, hstepB = (size_t)HALF * K * 2;
    const size_t tstepA = 2 * hstepA, tstepB = 2 * hstepB;
    const unsigned ldsw = (unsigned)wid * 1024u;
    const int aoff = lds_byte(wr * 64 + fr, fq * 8), boff = lds_byte(wc * 32 + fr, fq * 8);
#define PG8_SA(b, h) (((b) * 2 + (h)) * HTB)
#define PG8_SB(b, h) ((4 + (b) * 2 + (h)) * HTB)
#define PG8_STAGE(bufoff, gbase, voff) do { _Pragma("unroll") for (int _i = 0; _i < 2; ++_i) \
        __builtin_amdgcn_global_load_lds((const unsigned*)((const char*)(gbase) + (voff)[_i]), (PG8_LAS unsigned*)(lds + (bufoff) + ldsw + _i * 8192), 16, 0, 0); } while (0)
#define PG8_LDA(dst, b, h) do { _Pragma("unroll") for (int m = 0; m < 4; ++m) _Pragma("unroll") for (int k = 0; k < 2; ++k) dst[m][k] = *(const PG8_LAS bf16x8*)(lds + PG8_SA(b, h) + aoff + m * 2048 + k * 1024); } while (0)
#define PG8_LDB(dst, b, h) do { _Pragma("unroll") for (int n = 0; n < 2; ++n) _Pragma("unroll") for (int k = 0; k < 2; ++k) dst[n][k] = *(const PG8_LAS bf16x8*)(lds + PG8_SB(b, h) + boff + n * 2048 + k * 1024); } while (0)
#define PG8_MMA(ai, bj, At, Bt) do { __builtin_amdgcn_s_setprio(1); _Pragma("unroll") for (int m = 0; m < 4; ++m) _Pragma("unroll") for (int n = 0; n < 2; ++n) _Pragma("unroll") for (int k = 0; k < 2; ++k) \
        acc[ai][bj][m][n] = __builtin_amdgcn_mfma_f32_16x16x32_bf16(Bt[n][k], At[m][k], acc[ai][bj][m][n], 0, 0, 0); __builtin_amdgcn_s_setprio(0); } while (0)
#define PG8_WAIT_V(n) asm volatile("s_waitcnt vmcnt(" #n ")" ::: "memory")
#define PG8_WAIT_L(n) asm volatile("s_waitcnt lgkmcnt(" #n ")" ::: "memory")
#define PG8_BAR __builtin_amdgcn_s_barrier()
#define PG8_SCHED __builtin_amdgcn_sched_barrier(0)
    Unit cur, nxt; int ui = 0;
    if (!S.next(0, cur)) return;
    Acc acc;
#pragma unroll
    for (int a = 0; a < 2; ++a)
#pragma unroll
        for (int b = 0; b < 2; ++b)
#pragma unroll
            for (int m = 0; m < 4; ++m)
#pragma unroll
                for (int n = 0; n < 2; ++n) acc[a][b][m][n] = (f32x4){0.f, 0.f, 0.f, 0.f};
    bf16x8 At[4][2], B0[2][2], B1[2][2];
    const char* cA = (const char*)g.A + (size_t)cur.pm * tstepA; const char* cB = (const char*)g.Bt + (size_t)cur.pn * tstepB;
    S.a_ready(cur);
    if constexpr (SP2) {
        PG8_STAGE(PG8_SB(0, 0), cB, voffB); PG8_STAGE(PG8_SB(0, 1), cB + hstepB, voffB); PG8_STAGE(PG8_SA(0, 0), cA, voffA); PG8_STAGE(PG8_SA(0, 1), cA + hstepA, voffA);
        pre(); asm volatile("" ::: "memory");
        if (wr == 1) PG8_BAR;
        PG8_WAIT_V(2); PG8_BAR;
        PG8_STAGE(PG8_SB(1, 0), cB + kstep, voffB); PG8_STAGE(PG8_SA(1, 0), cA + kstep, voffA); PG8_STAGE(PG8_SB(1, 1), cB + hstepB + kstep, voffB);
        PG8_WAIT_V(6); PG8_BAR;
    } else {
        PG8_STAGE(PG8_SB(0, 0), cB, voffB); PG8_STAGE(PG8_SA(0, 0), cA, voffA); PG8_STAGE(PG8_SB(0, 1), cB + hstepB, voffB); PG8_STAGE(PG8_SA(0, 1), cA + hstepA, voffA);
        pre(); asm volatile("" ::: "memory");
        if (wr == 1) PG8_BAR;
        PG8_WAIT_V(4); PG8_BAR;
        PG8_STAGE(PG8_SB(1, 0), cB + kstep, voffB); PG8_STAGE(PG8_SA(1, 0), cA + kstep, voffA); PG8_STAGE(PG8_SB(1, 1), cB + hstepB + kstep, voffB);
        PG8_WAIT_V(6); PG8_BAR;
    }
    for (;;) {
        const bool has_next = S.next(ui + 1, nxt);
        const char* nA = has_next ? (const char*)g.A + (size_t)nxt.pm * tstepA : cA; const char* nB = has_next ? (const char*)g.Bt + (size_t)nxt.pn * tstepB : cB;
#pragma nounroll
        for (int t = 0; t < nt; t += 2) {
            const bool last = (t == nt - 2);
            const char* a1 = cA + (size_t)(t + 1) * kstep;
            const char* a2 = last ? nA : cA + (size_t)(t + 2) * kstep; const char* b2 = last ? nB : cB + (size_t)(t + 2) * kstep;
            const char* a3 = a2 + kstep; const char* b3 = b2 + kstep;
            if (last && has_next) S.a_ready(nxt);
            if constexpr (SP2) {
            PG8_LDB(B0, 0, 0); PG8_LDB(B1, 0, 1); PG8_SCHED; PG8_LDA(At, 0, 0); PG8_STAGE(PG8_SA(1, 1), a1 + hstepA, voffA);
            PG8_WAIT_V(8); PG8_WAIT_L(0); PG8_BAR; PG8_MMA(0, 0, At, B0); PG8_MMA(0, 1, At, B1); PG8_BAR; PG8_SCHED;
            PG8_LDA(At, 0, 1); PG8_STAGE(PG8_SB(0, 0), b2, voffB); PG8_STAGE(PG8_SB(0, 1), b2 + hstepB, voffB); PG8_STAGE(PG8_SA(0, 0), a2, voffA);
            PG8_WAIT_V(8); PG8_WAIT_L(0); PG8_BAR; PG8_MMA(1, 0, At, B0); PG8_MMA(1, 1, At, B1); PG8_BAR; PG8_SCHED;
            PG8_LDB(B0, 1, 0); PG8_LDB(B1, 1, 1); PG8_SCHED; PG8_LDA(At, 1, 0); PG8_STAGE(PG8_SA(0, 1), a2 + hstepA, voffA);
            PG8_WAIT_V(8); PG8_WAIT_L(0); PG8_BAR; PG8_MMA(0, 0, At, B0); PG8_MMA(0, 1, At, B1); PG8_BAR; PG8_SCHED;
            PG8_LDA(At, 1, 1); PG8_STAGE(PG8_SB(1, 0), b3, voffB); PG8_STAGE(PG8_SB(1, 1), b3 + hstepB, voffB); PG8_STAGE(PG8_SA(1, 0), a3, voffA);
            PG8_WAIT_V(8); PG8_WAIT_L(0); PG8_BAR; PG8_MMA(1, 0, At, B0); PG8_MMA(1, 1, At, B1); PG8_BAR; PG8_SCHED;
            if constexpr (Epi::MIDK > 0) { if (t + 2 == Epi::MIDK) { E.mid(acc, ui, wr, fr); PG8_SCHED; } }
            } else {
            PG8_LDB(B0, 0, 0); PG8_SCHED; PG8_LDA(At, 0, 0); PG8_STAGE(PG8_SA(1, 1), a1 + hstepA, voffA);
            PG8_WAIT_L(8); PG8_BAR; PG8_WAIT_L(0); PG8_MMA(0, 0, At, B0); PG8_BAR; PG8_SCHED;
            PG8_LDB(B1, 0, 1); PG8_STAGE(PG8_SB(0, 0), b2, voffB);
            PG8_BAR; PG8_WAIT_L(0); PG8_MMA(0, 1, At, B1); PG8_BAR;
            PG8_LDA(At, 0, 1); PG8_STAGE(PG8_SA(0, 0), a2, voffA);
            PG8_BAR; PG8_WAIT_L(0); PG8_MMA(1, 0, At, B0); PG8_BAR; PG8_SCHED;
            PG8_STAGE(PG8_SB(0, 1), b2 + hstepB, voffB);
            PG8_WAIT_V(6); PG8_BAR; PG8_MMA(1, 1, At, B1); PG8_BAR;
            PG8_LDB(B0, 1, 0); PG8_SCHED; PG8_LDA(At, 1, 0); PG8_STAGE(PG8_SA(0, 1), a2 + hstepA, voffA);
            PG8_WAIT_L(8); PG8_BAR; PG8_WAIT_L(0); PG8_MMA(0, 0, At, B0); PG8_BAR; PG8_SCHED;
            PG8_LDB(B1, 1, 1); PG8_STAGE(PG8_SB(1, 0), b3, voffB);
            PG8_BAR; PG8_WAIT_L(0); PG8_MMA(0, 1, At, B1); PG8_BAR;
            PG8_LDA(At, 1, 1); PG8_STAGE(PG8_SA(1, 0), a3, voffA);
            PG8_BAR; PG8_WAIT_L(0); PG8_MMA(1, 0, At, B0); PG8_BAR; PG8_SCHED;
            PG8_STAGE(PG8_SB(1, 1), b3 + hstepB, voffB);
            PG8_WAIT_V(6); PG8_BAR; PG8_MMA(1, 1, At, B1); PG8_BAR;
            }
        }
        if constexpr (ALIGN_EPI) { if (wr == 0) PG8_BAR; }
        if constexpr (!Epi::AFTER_DRAIN) { E(acc, cur, wr, wc, fr, fq, ui); S.done(cur); }
        if (!has_next) break;
#pragma unroll
        for (int a = 0; a < 2; ++a)
#pragma unroll
            for (int b = 0; b < 2; ++b)
#pragma unroll
                for (int m = 0; m < 4; ++m)
#pragma unroll
                    for (int n = 0; n < 2; ++n) acc[a][b][m][n] = (f32x4){0.f, 0.f, 0.f, 0.f};
        cur = nxt; cA = nA; cB = nB; ++ui;
        if constexpr (ALIGN_EPI) { if (wr == 1) PG8_BAR; }
    }
    PG8_WAIT_V(0);
    if constexpr (!ALIGN_EPI) { if (wr == 0) PG8_BAR; }
    PG8_BAR;
#undef PG8_SA
#undef PG8_SB
#undef PG8_STAGE
#undef PG8_LDA
#undef PG8_LDB
#undef PG8_MMA
#undef PG8_WAIT_V
#undef PG8_WAIT_L
#undef PG8_BAR
#undef PG8_SCHED
}
}

namespace att {
constexpr int DQK = 192, DV = 128, NW = 8, QBLK = 32, KVBLK = 64;
constexpr int SHM_V = KVBLK * DV * 2, SHM_K = KVBLK * DQK * 2, SHM_ATTN = 2 * SHM_V + 2 * SHM_K + NW * 64 * 4;
constexpr float THRL = 11.5f;
#define KSWZ(row, colB) ((row) * 384 + ((colB) ^ ((((row) >> 1) & 7) << 4)))
#define SBAR() __builtin_amdgcn_sched_barrier(0)
__device__ __forceinline__ int crow(int r, int hi) { return (r & 3) + 8 * (r >> 2) + 4 * hi; }
__device__ __forceinline__ void partialSM(f32x16& p0, f32x16& p1, float& m_reg, float& mn, float& alpha) {
    float pmax = p0[0];
#pragma unroll
    for (int r = 1; r < 16; ++r) pmax = fmaxf(pmax, p0[r]);
#pragma unroll
    for (int r = 0; r < 16; ++r) pmax = fmaxf(pmax, p1[r]);
    { auto rr = __builtin_amdgcn_permlane32_swap(__float_as_uint(pmax), __float_as_uint(pmax), false, false);
      pmax = fmaxf(__uint_as_float(rr[0]), __uint_as_float(rr[1])); }
    if (__builtin_expect(__all(pmax - m_reg <= THRL), 1)) { mn = m_reg; alpha = 1.f; }
    else { mn = fmaxf(m_reg, pmax); alpha = __builtin_amdgcn_exp2f(m_reg - mn); m_reg = mn; }
#pragma unroll
    for (int r = 0; r < 16; ++r) p0[r] = p0[r] - mn;
#pragma unroll
    for (int r = 0; r < 16; ++r) p1[r] = p1[r] - mn;
#pragma unroll
    for (int r = 0; r < 16; ++r) p0[r] = __builtin_amdgcn_exp2f(p0[r]);
}
__device__ __forceinline__ void finishSM(f32x16& p0, f32x16& p1, float alpha, float& l_reg, bf16x8& pa0, bf16x8& pa1, bf16x8& pa2, bf16x8& pa3) {
#pragma unroll
    for (int r = 0; r < 16; ++r) p1[r] = __builtin_amdgcn_exp2f(p1[r]);
    float ps = 0;
#pragma unroll
    for (int r = 0; r < 16; ++r) ps += p0[r];
#pragma unroll
    for (int r = 0; r < 16; ++r) ps += p1[r];
    { auto rr = __builtin_amdgcn_permlane32_swap(__float_as_uint(ps), __float_as_uint(ps), false, false);
      ps = __uint_as_float(rr[0]) + __uint_as_float(rr[1]); }
    l_reg = l_reg * alpha + ps;
#define PK4(P, BASE, OUT) do { unsigned a0 = cvt_pk_bf16(P[BASE + 0], P[BASE + 1]), a1 = cvt_pk_bf16(P[BASE + 2], P[BASE + 3]);   \
    unsigned b0 = cvt_pk_bf16(P[BASE + 4], P[BASE + 5]), b1 = cvt_pk_bf16(P[BASE + 6], P[BASE + 7]);                              \
    auto r0 = __builtin_amdgcn_permlane32_swap(a0, b0, false, false); auto r1 = __builtin_amdgcn_permlane32_swap(a1, b1, false, false); \
    u32x4 w = {r0[0], r1[0], r0[1], r1[1]}; OUT = __builtin_bit_cast(bf16x8, w); } while (0)
    PK4(p0, 0, pa0); PK4(p0, 8, pa1); PK4(p1, 0, pa2); PK4(p1, 8, pa3);
#undef PK4
}
__device__ __forceinline__ void qkt(f32x16& p0, f32x16& p1, const char* Ks, const bf16x8* qr, int r32, int hi) {
    p0 = f32x16{}; p1 = f32x16{};
    const char* k0p = Ks + KSWZ(r32, 0); const char* k1p = Ks + KSWZ(32 + r32, 0);
    const int key = ((r32 >> 1) & 7) << 4;
    bf16x8 ka[2], kb[2];
#define KRD(d0, slot) do { const int cb_ = (((d0) * 16 + hi * 8) * 2) ^ key; ka[slot] = *reinterpret_cast<const bf16x8*>(k0p + cb_); kb[slot] = *reinterpret_cast<const bf16x8*>(k1p + cb_); } while (0)
    KRD(0, 0); KRD(1, 1);
#pragma unroll
    for (int d0 = 0; d0 < 12; ++d0) {
        const bf16x8 a = ka[d0 & 1], b = kb[d0 & 1];
        p0 = __builtin_amdgcn_mfma_f32_32x32x16_bf16(a, qr[d0], p0, 0, 0, 0);
        p1 = __builtin_amdgcn_mfma_f32_32x32x16_bf16(b, qr[d0], p1, 0, 0, 0);
        if (d0 + 2 < 12) KRD(d0 + 2, d0 & 1);
    }
#undef KRD
}
__device__ __forceinline__ int v_st(int k, int c) { const int kk = (k & ~0xC) | ((k & 4) << 1) | ((k & 8) >> 1); return ((kk >> 3) * 4 + (c >> 5)) * 512 + ((kk & 7) * 32 + (c & 31)) * 2; }
__device__ __forceinline__ int v_rd_base(int lane) { return ((lane & 3) << 3) | (((lane >> 2) & 3) << 6) | (((lane >> 4) & 1) << 5) | (((lane >> 5) & 1) << 8); }
constexpr int v_rd_off(int d0, int ks, int half) { return d0 * 512 + ks * 4096 + half * 2048; }
template <int OFF> __device__ __forceinline__ s16x4 tr_read(int vb) {
    s16x4 r; asm volatile("ds_read_b64_tr_b16 %0, %1 offset:%2" : "=&v"(r) : "v"(vb), "i"(OFF) : "memory"); return r;
}
#define PKLH(L, H) (bf16x8){L[0], L[1], L[2], L[3], H[0], H[1], H[2], H[3]}
template <int D0> __device__ __forceinline__ void pv_one(f32x16& od, int vb, bf16x8 pa0, bf16x8 pa1, bf16x8 pa2, bf16x8 pa3) {
    const s16x4 l0 = tr_read<v_rd_off(D0, 0, 0)>(vb), h0 = tr_read<v_rd_off(D0, 0, 1)>(vb), l1 = tr_read<v_rd_off(D0, 1, 0)>(vb), h1 = tr_read<v_rd_off(D0, 1, 1)>(vb);
    const s16x4 l2 = tr_read<v_rd_off(D0, 2, 0)>(vb), h2 = tr_read<v_rd_off(D0, 2, 1)>(vb), l3 = tr_read<v_rd_off(D0, 3, 0)>(vb), h3 = tr_read<v_rd_off(D0, 3, 1)>(vb);
    asm volatile("s_waitcnt lgkmcnt(0)" ::: "memory"); SBAR();
    od = __builtin_amdgcn_mfma_f32_32x32x16_bf16(pa0, PKLH(l0, h0), od, 0, 0, 0);
    od = __builtin_amdgcn_mfma_f32_32x32x16_bf16(pa1, PKLH(l1, h1), od, 0, 0, 0);
    od = __builtin_amdgcn_mfma_f32_32x32x16_bf16(pa2, PKLH(l2, h2), od, 0, 0, 0);
    od = __builtin_amdgcn_mfma_f32_32x32x16_bf16(pa3, PKLH(l3, h3), od, 0, 0, 0);
}
__device__ __forceinline__ void pv_d0(f32x16* o, int vb, bf16x8 pa0, bf16x8 pa1, bf16x8 pa2, bf16x8 pa3) {
    pv_one<0>(o[0], vb, pa0, pa1, pa2, pa3); pv_one<1>(o[1], vb, pa0, pa1, pa2, pa3); pv_one<2>(o[2], vb, pa0, pa1, pa2, pa3); pv_one<3>(o[3], vb, pa0, pa1, pa2, pa3);
}
#define PK4S(P, BASE, OUT) do { unsigned a0 = cvt_pk_bf16(P[BASE + 0], P[BASE + 1]), a1 = cvt_pk_bf16(P[BASE + 2], P[BASE + 3]);   \
    unsigned b0 = cvt_pk_bf16(P[BASE + 4], P[BASE + 5]), b1 = cvt_pk_bf16(P[BASE + 6], P[BASE + 7]);                              \
    auto r0 = __builtin_amdgcn_permlane32_swap(a0, b0, false, false); auto r1 = __builtin_amdgcn_permlane32_swap(a1, b1, false, false); \
    u32x4 w = {r0[0], r1[0], r0[1], r1[1]}; OUT = __builtin_bit_cast(bf16x8, w); } while (0)
template <bool FIN, bool QW = false>
__device__ __forceinline__ void seg_x(f32x16& n0, f32x16& n1, const LAS char* Ks, const bf16x8* qr, const LAS char* ql, int r32, int hi,
                                      f32x16& f0, f32x16& f1, float alpha, float& l_reg, bf16x8& pa0, bf16x8& pa1, bf16x8& pa2, bf16x8& pa3) {
    n0 = f32x16{}; n1 = f32x16{};
    const LAS char* k0p = Ks + r32 * 384;
    const int key = ((r32 >> 1) & 7) << 4;
    bf16x8 ka[2], kb[2]; float ps = 0.f;
#define KRD(d0, slot) do { const int cb_ = (((d0) * 16 + hi * 8) * 2) ^ key; ka[slot] = *reinterpret_cast<const LAS bf16x8*>(k0p + cb_); kb[slot] = *reinterpret_cast<const LAS bf16x8*>(k0p + 32 * 384 + cb_); } while (0)
    KRD(0, 0); KRD(1, 1); SBAR();
    bf16x8 qlv = qr[0];
#pragma unroll
    for (int d0 = 0; d0 < 12; ++d0) {
        const bf16x8 qv = (d0 < 8) ? qr[d0 < 8 ? d0 : 0] : qlv;
        n0 = __builtin_amdgcn_mfma_f32_32x32x16_bf16(ka[d0 & 1], qv, n0, 0, 0, 0);
        n1 = __builtin_amdgcn_mfma_f32_32x32x16_bf16(kb[d0 & 1], qv, n1, 0, 0, 0);
        SBAR();
        if (d0 + 2 < 12) KRD(d0 + 2, d0 & 1);
        if constexpr (QW) { if (d0 == 7) asm volatile("s_waitcnt vmcnt(8)" ::: "memory"); }
        if (d0 + 1 >= 8 && d0 + 1 < 12) qlv = *reinterpret_cast<const LAS bf16x8*>(ql + (d0 + 1 - 8) * 1024);
        if constexpr (FIN) {
            if (d0 < 4) {
#pragma unroll
                for (int r = 0; r < 4; ++r) f1[4 * d0 + r] = __builtin_amdgcn_exp2f(f1[4 * d0 + r]);
            } else if (d0 == 4) {
#pragma unroll
                for (int r = 0; r < 16; ++r) ps += f0[r];
            } else if (d0 == 5) {
#pragma unroll
                for (int r = 0; r < 16; ++r) ps += f1[r];
            } else if (d0 == 6) {
                auto rr = __builtin_amdgcn_permlane32_swap(__float_as_uint(ps), __float_as_uint(ps), false, false);
                ps = __uint_as_float(rr[0]) + __uint_as_float(rr[1]); l_reg = l_reg * alpha + ps;
            } else if (d0 == 7) { PK4S(f0, 0, pa0); } else if (d0 == 8) { PK4S(f0, 8, pa1); } else if (d0 == 9) { PK4S(f1, 0, pa2); } else if (d0 == 10) { PK4S(f1, 8, pa3); }
        }
        SBAR();
    }
#undef KRD
}
__device__ __forceinline__ void seg_y(f32x16* o, int vb, bf16x8 pa0, bf16x8 pa1, bf16x8 pa2, bf16x8 pa3, f32x16& p0, f32x16& p1, float& m_reg, float& mn, float& alpha) {
    pv_one<0>(o[0], vb, pa0, pa1, pa2, pa3); SBAR();
    { float a = fmaxf(p0[0], p0[1]), b = fmaxf(p0[2], p0[3]);
#pragma unroll
      for (int r = 4; r < 16; r += 2) { a = fmaxf(a, p0[r]); b = fmaxf(b, p0[r + 1]); }
#pragma unroll
      for (int r = 0; r < 16; r += 2) { a = fmaxf(a, p1[r]); b = fmaxf(b, p1[r + 1]); }
      float pmax = fmaxf(a, b);
      auto rr = __builtin_amdgcn_permlane32_swap(__float_as_uint(pmax), __float_as_uint(pmax), false, false);
      pmax = fmaxf(__uint_as_float(rr[0]), __uint_as_float(rr[1]));
      if (__builtin_expect(__all(pmax - m_reg <= THRL), 1)) { mn = m_reg; alpha = 1.f; }
      else { mn = fmaxf(m_reg, pmax); alpha = __builtin_amdgcn_exp2f(m_reg - mn); m_reg = mn; } }
    SBAR();
    pv_one<1>(o[1], vb, pa0, pa1, pa2, pa3); SBAR();
#pragma unroll
    for (int r = 0; r < 16; ++r) { p0[r] = p0[r] - mn; p1[r] = p1[r] - mn; }
    SBAR();
    pv_one<2>(o[2], vb, pa0, pa1, pa2, pa3); SBAR();
#pragma unroll
    for (int r = 0; r < 8; ++r) p0[r] = __builtin_amdgcn_exp2f(p0[r]);
    SBAR();
    pv_one<3>(o[3], vb, pa0, pa1, pa2, pa3); SBAR();
#pragma unroll
    for (int r = 8; r < 16; ++r) p0[r] = __builtin_amdgcn_exp2f(p0[r]);
    SBAR();
}
constexpr int L_K = 0, L_VV = 3 * SHM_K, L_WS = L_VV + 3 * SHM_V, L_QL = L_WS + NW * 64 * 4, ATT_LDS = L_QL + NW * 4096;
__device__ __forceinline__ void attn_chain(const bf16_t* __restrict__ QB, const bf16_t* __restrict__ KBp, const bf16_t* __restrict__ VBp, bf16_t* __restrict__ MIXp, int ldo, float* __restrict__ SSQAp,
                                           int bhs, int qb, int k0, int k1, int seq, int Mrows, char* lds, int wv) {
    const int wid = wv;
    LAS unsigned char* l3 = (LAS unsigned char*)lds;
    const LAS char* K_lds = (const LAS char*)l3 + L_K;
    float* ws = (float*)(lds + L_WS) + wid * 64; float* li_l = ws; float* al_l = ws + 32;
    bf16x8 qr[8];
#define KSRC(i_) ({ const int p_ = (wid + 8 * (i_)) * 64 + lane, row_ = p_ / 24, cpos_ = p_ - row_ * 24; (unsigned)(row_ * 24 + ((cpos_ & ~7) | ((cpos_ ^ (row_ >> 1)) & 7))) * 16u; })
#define VSRC(i_) ({ const int p16_ = (wid + 8 * (i_)) * 64 + lane, sub_ = p16_ >> 5, idx_ = p16_ & 31, kk_ = (sub_ >> 2) * 8 + (idx_ >> 2), c_ = (sub_ & 3) * 32 + (idx_ & 3) * 8; \
    (unsigned)((((kk_ & ~0xC) | ((kk_ & 4) << 1) | ((kk_ & 8) >> 1))) * DV + c_) * 2u; })
#define DMA_KP(KP, t, kboff) do { const char* kt_ = (const char*)(KP) + (size_t)(t) * SHM_K; \
    _Pragma("unroll") for (int i_ = 0; i_ < 3; ++i_) __builtin_amdgcn_global_load_lds((const unsigned*)(kt_ + KSRC(i_)), (LAS unsigned*)(l3 + L_K + (kboff) + (wid + 8 * i_) * 1024), 16, 0, 0); } while (0)
#define DMA_VP(VP, t, vboff) do { const char* vt_ = (const char*)(VP) + (size_t)(t) * SHM_V; \
    _Pragma("unroll") for (int i_ = 0; i_ < 2; ++i_) __builtin_amdgcn_global_load_lds((const unsigned*)(vt_ + VSRC(i_)), (LAS unsigned*)(l3 + L_VV + (vboff) + (wid + 8 * i_) * 1024), 16, 0, 0); } while (0)
#define DMA_K(t, kboff) DMA_KP(Kh, t, kboff)
#define DMA_V(t, vboff) DMA_VP(Vh, t, vboff)
#define QLOAD(QP) do { const bf16_t* Qw_ = (QP) + (long)(wid * QBLK + r32) * DQK + hi * 8; \
    _Pragma("unroll") for (int d0 = 0; d0 < 8; ++d0) qr[d0] = *reinterpret_cast<const bf16x8*>(Qw_ + d0 * 16); \
    _Pragma("unroll") for (int d0 = 8; d0 < 12; ++d0) __builtin_amdgcn_global_load_lds((const unsigned*)(Qw_ + d0 * 16), (LAS unsigned*)(l3 + L_QL + wid * 4096 + (d0 - 8) * 1024), 16, 0, 0); } while (0)
#define TOP(j, KB) do { if ((j) + 2 >= NT) asm volatile("s_waitcnt vmcnt(0) lgkmcnt(0)" ::: "memory"); else asm volatile("s_waitcnt vmcnt(5) lgkmcnt(0)" ::: "memory"); \
    __builtin_amdgcn_s_barrier(); asm volatile("" ::: "memory"); \
    if ((j) + 2 < NT) DMA_K((j) + 2, (((KB) + 2) % 3) * SHM_K); if ((j) + 1 < NT) DMA_V((j) + 1, (((KB) + 1) % 3) * SHM_V); } while (0)
#define RESC(a) do { if (__any((a) < 1.f)) { if (hi == 0) al_l[r32] = (a); asm volatile("s_waitcnt lgkmcnt(0)" ::: "memory"); \
    _Pragma("unroll") for (int d = 0; d < 4; ++d) _Pragma("unroll") for (int r = 0; r < 16; ++r) o[d][r] *= al_l[crow(r, hi)]; } } while (0)
#define TILE_BODY(KB, PN0, PN1, MNN, ALN, PF0, PF1, AF) do { \
    seg_x<true>(PN0, PN1, K_lds + (KB) * SHM_K, qr, ql, r32, hi, PF0, PF1, AF, l_reg, pa0, pa1, pa2, pa3); \
    seg_y(o, vb0 + (((KB) + 2) % 3) * SHM_V, pa0, pa1, pa2, pa3, PN0, PN1, m_reg, MNN, ALN); RESC(ALN); } while (0)
#define TILE(j, KB, PN0, PN1, MNN, ALN, PF0, PF1, AF) do { TOP(j, KB); TILE_BODY(KB, PN0, PN1, MNN, ALN, PF0, PF1, AF); } while (0)
    const int NT = seq / KVBLK;
#define ATT_EPILOGUE(BH_) do { \
        if (hi == 0) li_l[r32] = l_reg; asm volatile("s_waitcnt lgkmcnt(0)" ::: "memory"); \
        float rli[16]; \
        _Pragma("unroll") \
        for (int r = 0; r < 16; ++r) rli[r] = __builtin_amdgcn_rcpf(li_l[crow(r, hi)]); \
        const int b = (int)(BH_ >> 2), h = (int)(BH_ & 3); \
        bf16_t* Ow = MIXp + ((size_t)b * seq + qb * 256 + wid * QBLK) * ldo + h * 128; \
        float* ssq = SSQAp + (size_t)h * Mrows + (size_t)b * seq + qb * 256; \
        float myss = 0.f; \
        const unsigned sel1 = (lane & 1) ? 0x03020706u : 0x05040100u; const bool p1 = (lane & 2) != 0; \
        bf16_t* Oq = Ow + (long)(4 * hi + (lane & 3)) * ldo + 4 * (r32 >> 2); \
        _Pragma("unroll") \
        for (int g = 0; g < 4; ++g) { float sq[4] = {0.f, 0.f, 0.f, 0.f}; \
        _Pragma("unroll") \
            for (int d0 = 0; d0 < 4; ++d0) { float a[4]; \
        _Pragma("unroll") \
                for (int e = 0; e < 4; ++e) { a[e] = o[d0][4 * g + e] * rli[4 * g + e]; sq[e] += a[e] * a[e]; } \
                const unsigned wA = cvtpk(a[0], a[1]), wB = cvtpk(a[2], a[3]); \
                const unsigned tA = (unsigned)__builtin_amdgcn_update_dpp(0, (int)wA, 0xB1, 0xF, 0xF, true), tB = (unsigned)__builtin_amdgcn_update_dpp(0, (int)wB, 0xB1, 0xF, 0xF, true); \
                const unsigned xA = __builtin_amdgcn_perm(tA, wA, sel1), xB = __builtin_amdgcn_perm(tB, wB, sel1); \
                const unsigned tt = (unsigned)__builtin_amdgcn_update_dpp(0, (int)(p1 ? xA : xB), 0x4E, 0xF, 0xF, true); \
                u32x2 w; w.x = p1 ? tt : xA; w.y = p1 ? xB : tt; \
                *(u32x2*)(Oq + (long)(8 * g) * ldo + d0 * 32) = w; } \
        _Pragma("unroll") \
            for (int e = 0; e < 4; ++e) { const int r = 4 * g + e; float q = dpp_sum8(sq[e]); \
                q += __builtin_bit_cast(float, __builtin_amdgcn_update_dpp(0, __builtin_bit_cast(int, q), 0x128, 0xF, 0xF, true)); \
                q += __builtin_bit_cast(float, __builtin_amdgcn_ds_swizzle(__builtin_bit_cast(int, q), 0x401F)); \
                if (r32 == r) myss = q; } } \
        if (r32 < 16) ssq[wid * QBLK + crow(r32, hi)] = myss; } while (0)
    { int lane = lane_id(); asm volatile("" : "+v"(lane)); const int r32 = lane & 31, hi = lane >> 5;
      const size_t bh0 = (size_t)(16 * k0 + bhs); DMA_KP(KBp + bh0 * seq * DQK, 0, 0); QLOAD(QB + (bh0 * seq + qb * 256) * DQK); }
    float m_reg = -1e30f, l_reg = 0.f, mnA, mnB, alA, alB = 1.f; f32x16 o[4] = {}; f32x16 pA0, pA1, pB0 = {}, pB1; bf16x8 pa0, pa1, pa2, pa3;
#pragma unroll
    for (int r = 0; r < 16; ++r) pB1[r] = -1e30f;
    for (int k = k0; k < k1; ++k) {
        const size_t bh = (size_t)(16 * k + bhs), bhn = bh + 16; const bool has_next = (k + 1 < k1);
        const bf16_t* Kh = KBp + bh * seq * DQK; const bf16_t* Vh = VBp + bh * seq * DV;
        int lane = lane_id(); asm volatile("" : "+v"(lane)); const int r32 = lane & 31, hi = lane >> 5;
        const LAS char* ql = (const LAS char*)l3 + L_QL + wid * 4096 + lane * 16;
        const int vb0 = (int)(uintptr_t)(lds + L_VV) + v_rd_base(lane);
        asm volatile("s_waitcnt vmcnt(12) lgkmcnt(0)" ::: "memory"); __builtin_amdgcn_s_barrier(); asm volatile("" ::: "memory");
        DMA_V(0, 0); DMA_K(1, SHM_K); DMA_K(2, 2 * SHM_K);
        seg_x<true, true>(pA0, pA1, K_lds, qr, ql, r32, hi, pB0, pB1, alB, l_reg, pa0, pa1, pa2, pa3);
        float m_new = -1e30f;
        seg_y(o, vb0 + 1 * SHM_V, pa0, pa1, pa2, pa3, pA0, pA1, m_new, mnA, alA);
        if (k > k0) ATT_EPILOGUE(bh - 16);
        m_reg = m_new; l_reg = 0.f;
#pragma unroll
        for (int d = 0; d < 4; ++d) o[d] = f32x16{};
        for (int j = 1; j + 6 < NT; j += 6) {
            if (j == 1) { if (k > k0) asm volatile("s_waitcnt vmcnt(16) lgkmcnt(0)" ::: "memory"); else asm volatile("s_waitcnt vmcnt(3) lgkmcnt(0)" ::: "memory");
                __builtin_amdgcn_s_barrier(); asm volatile("" ::: "memory");
                DMA_V(1, 1 * SHM_V); DMA_K(3, 0 * SHM_K); DMA_V(2, 2 * SHM_V); }
            else TOP(j, 1);
            TILE_BODY(1, pB0, pB1, mnB, alB, pA0, pA1, alA);
            TILE(j + 1, 2, pA0, pA1, mnA, alA, pB0, pB1, alB);
            TILE(j + 2, 0, pB0, pB1, mnB, alB, pA0, pA1, alA);
            TILE(j + 3, 1, pA0, pA1, mnA, alA, pB0, pB1, alB);
            TILE(j + 4, 2, pB0, pB1, mnB, alB, pA0, pA1, alA);
            TILE(j + 5, 0, pA0, pA1, mnA, alA, pB0, pB1, alB);
        }
        TOP(NT - 1, 1);
        if (has_next) { int lane = lane_id(); asm volatile("" : "+v"(lane)); DMA_KP(KBp + bhn * seq * DQK, 0, 0); }
        seg_x<true>(pB0, pB1, K_lds + 1 * SHM_K, qr, ql, r32, hi, pA0, pA1, alA, l_reg, pa0, pa1, pa2, pa3);
        asm volatile("" ::: "memory");
        if (has_next) { int ln_ = lane_id(); asm volatile("" : "+v"(ln_)); const int r32 = ln_ & 31, hi = ln_ >> 5; QLOAD(QB + (bhn * seq + qb * 256) * DQK); }
        seg_y(o, vb0 + 0 * SHM_V, pa0, pa1, pa2, pa3, pB0, pB1, m_reg, mnB, alB); RESC(alB);
    }
    int lane = lane_id(); asm volatile("" : "+v"(lane)); const int r32 = lane & 31, hi = lane >> 5;
    const int vb0 = (int)(uintptr_t)(lds + L_VV) + v_rd_base(lane);
    finishSM(pB0, pB1, alB, l_reg, pa0, pa1, pa2, pa3); SBAR();
    pv_d0(o, vb0 + 1 * SHM_V, pa0, pa1, pa2, pa3);
    ATT_EPILOGUE((size_t)(16 * (k1 - 1) + bhs));
    asm volatile("s_waitcnt vmcnt(0) lgkmcnt(0)" ::: "memory"); __builtin_amdgcn_s_barrier(); asm volatile("" ::: "memory");
#undef ATT_EPILOGUE
#undef DMA_K
#undef DMA_V
#undef DMA_KP
#undef DMA_VP
#undef QLOAD
#undef TOP
#undef TILE
#undef TILE_BODY
#undef RESC
}
}

namespace hg {
using att::crow; using att::v_st; using att::v_rd_base; using att::v_rd_off; using att::tr_read;
constexpr int L_QE = 0, L_QT = 16384, L_KT = 32768, L_OT = 122880  , L_KE = 73728, L_V = 90112, L_P = 106496, L_SEG = 114688  , L_DV = 155648, L_GN = 156160  , L_END = 156672;
__device__ __forceinline__ int swzA(int row, int cb) { return row * 256 + (cb ^ ((row & 15) << 4) ^ (((row >> 4) & 1) << 3)); }
__device__ __forceinline__ int swzB(int row, int cb) { return row * 256 + (cb ^ ((row & 15) << 4)); }
__device__ __forceinline__ int swzP(int row, int cb) { return row * 128 + (cb ^ ((row & 7) << 4)); }
template <int D0> __device__ __forceinline__ void tr_frag4(int vb, bf16x8& f0, bf16x8& f1, bf16x8& f2, bf16x8& f3) {
    const s16x4 l0 = tr_read<v_rd_off(D0, 0, 0)>(vb), h0 = tr_read<v_rd_off(D0, 0, 1)>(vb), l1 = tr_read<v_rd_off(D0, 1, 0)>(vb), h1 = tr_read<v_rd_off(D0, 1, 1)>(vb);
    const s16x4 l2 = tr_read<v_rd_off(D0, 2, 0)>(vb), h2 = tr_read<v_rd_off(D0, 2, 1)>(vb), l3 = tr_read<v_rd_off(D0, 3, 0)>(vb), h3 = tr_read<v_rd_off(D0, 3, 1)>(vb);
    asm volatile("s_waitcnt lgkmcnt(0)" ::: "memory"); SBAR();
    f0 = PKLH(l0, h0); f1 = PKLH(l1, h1); f2 = PKLH(l2, h2); f3 = PKLH(l3, h3);
}
struct Pre { u32x2 q4[4], l4[4], v4[4]; };
__device__ __forceinline__ void load_chunk(Pre& P, const bf16_t* pbase, int h, int dir, int cs, int wid, int lane) {
    const int c4 = 4 * (lane & 31), j0 = 8 * wid + 4 * (lane >> 5);
    const int cq = C_Q + h * 128 + c4, cf = C_FF + dir * 512 + h * 128 + c4, ci = C_I + h * 128 + c4;
#pragma unroll
    for (int i = 0; i < 4; ++i) { const int j = j0 + i, pos = dir ? (64 * cs + 63 - j) : (64 * cs + j); const bf16_t* rp = pbase + (size_t)pos * DINP;
        P.q4[i] = __builtin_nontemporal_load((const u32x2*)(rp + cq)); P.l4[i] = __builtin_nontemporal_load((const u32x2*)(rp + cf)); P.v4[i] = __builtin_nontemporal_load((const u32x2*)(rp + ci)); }
}
__device__ __forceinline__ void stage_c(char* lds, f32x16 (&S)[4], f32x16 (&o)[2]  , _Float16* ofp  , int rstride  , bool second, int eb, int lane_, int part  ) {
    int lane = lane_; asm volatile("" : "+v"(lane));
    const int r32 = lane & 31, hi = lane >> 5;
    _Float16* p0 = ofp + r32 + 4 * hi * rstride;
    const int vbV = (int)(uintptr_t)(lds + L_V) + v_rd_base(lane) + eb * 512, vbK = (int)(uintptr_t)(lds + L_KE) + v_rd_base(lane);
    if (part == 0) {
#pragma unroll
    for (int dp2 = 0; dp2 < 2; ++dp2) {
        u32x2 qa[2][2][2][2];
#pragma unroll
        for (int dd = 0; dd < 2; ++dd)
#pragma unroll
            for (int s = 0; s < 2; ++s)
#pragma unroll
                for (int jb = 0; jb < 2; ++jb) { const int row = 32 * jb + r32, d0 = 32 * (2 * dp2 + dd) + 16 * s + 4 * hi;
                    qa[dd][s][jb][0] = *(const u32x2*)(lds + L_QE + swzA(row, d0 * 2)); qa[dd][s][jb][1] = *(const u32x2*)(lds + L_QE + swzA(row, (d0 + 8) * 2)); }
#pragma unroll
        for (int dd = 0; dd < 2; ++dd)
#pragma unroll
            for (int s = 0; s < 2; ++s) { const int db = 2 * dp2 + dd;
                u32x4 sw; sw.x = cvtpk(S[db][8 * s + 0], S[db][8 * s + 1]); sw.y = cvtpk(S[db][8 * s + 2], S[db][8 * s + 3]);
                sw.z = cvtpk(S[db][8 * s + 4], S[db][8 * s + 5]); sw.w = cvtpk(S[db][8 * s + 6], S[db][8 * s + 7]);
                const bf16x8 sf = __builtin_bit_cast(bf16x8, sw);
#pragma unroll
                for (int jb = 0; jb < 2; ++jb) { const u32x4 aw = {qa[dd][s][jb][0].x, qa[dd][s][jb][0].y, qa[dd][s][jb][1].x, qa[dd][s][jb][1].y};
                    o[jb] = __builtin_amdgcn_mfma_f32_32x32x16_bf16(__builtin_bit_cast(bf16x8, aw), sf, o[jb], 0, 0, 0); }
            }
    }
    return; }
    const float* dv = (const float*)(lds + L_DV) + 4 * hi;
#define KRAW(DB, P) const s16x4 P##l0 = tr_read<v_rd_off(DB, 0, 0)>(vbK), P##h0 = tr_read<v_rd_off(DB, 0, 1)>(vbK), P##l1 = tr_read<v_rd_off(DB, 1, 0)>(vbK), P##h1 = tr_read<v_rd_off(DB, 1, 1)>(vbK), \
                                P##l2 = tr_read<v_rd_off(DB, 2, 0)>(vbK), P##h2 = tr_read<v_rd_off(DB, 2, 1)>(vbK), P##l3 = tr_read<v_rd_off(DB, 3, 0)>(vbK), P##h3 = tr_read<v_rd_off(DB, 3, 1)>(vbK)
#define DVLD(DB, D) f32x4 D[4]; _Pragma("unroll") for (int g = 0; g < 4; ++g) D[g] = *(const f32x4*)(dv + 32 * DB + 8 * g)
#define SSCALE(DB, D) do { _Pragma("unroll") for (int g = 0; g < 4; ++g) { S[DB][4 * g] *= D[g][0]; S[DB][4 * g + 1] *= D[g][1]; S[DB][4 * g + 2] *= D[g][2]; S[DB][4 * g + 3] *= D[g][3]; } } while (0)
#define PFR(jb, ks) (*(const bf16x8*)(lds + L_P + swzP(32 * (jb) + r32, 32 * (ks) + 16 * hi)))
#define MM(A, B, C) C = __builtin_amdgcn_mfma_f32_32x32x16_bf16(A, B, C, 0, 0, 0)
    bf16x8 vf0, vf1, vf2, vf3;
    {
        const s16x4 vl0 = tr_read<v_rd_off(0, 0, 0)>(vbV), vh0 = tr_read<v_rd_off(0, 0, 1)>(vbV), vl1 = tr_read<v_rd_off(0, 1, 0)>(vbV), vh1 = tr_read<v_rd_off(0, 1, 1)>(vbV);
        const s16x4 vl2 = tr_read<v_rd_off(0, 2, 0)>(vbV), vh2 = tr_read<v_rd_off(0, 2, 1)>(vbV), vl3 = tr_read<v_rd_off(0, 3, 0)>(vbV), vh3 = tr_read<v_rd_off(0, 3, 1)>(vbV);
        asm volatile("s_waitcnt lgkmcnt(0)" ::: "memory"); SBAR();
        vf0 = PKLH(vl0, vh0); vf1 = PKLH(vl1, vh1); vf2 = PKLH(vl2, vh2); vf3 = PKLH(vl3, vh3);
        MM(PFR(1, 0), vf0, o[1]); MM(PFR(0, 0), vf0, o[0]); MM(PFR(1, 1), vf1, o[1]); MM(PFR(0, 1), vf1, o[0]); MM(PFR(1, 2), vf2, o[1]); MM(PFR(1, 3), vf3, o[1]);
    }
    SBAR();
    {
        if (second) {
            float* ot = (float*)(lds + L_OT) + 32 * eb + r32 + 4 * hi * 128;
#pragma unroll
            for (int jb = 0; jb < 2; ++jb)
#pragma unroll
                for (int r = 0; r < 16; ++r) ot[(32 * jb + 8 * (r >> 2) + (r & 3)) * 128] = o[jb][r];
        } else {
#pragma unroll
            for (int jb = 0; jb < 2; ++jb)
#pragma unroll
                for (int g = 0; g < 4; ++g) { _Float16* pg = p0 + (32 * jb + 8 * g) * rstride;
#pragma unroll
                    for (int e = 0; e < 4; ++e) pg[e * rstride] = (_Float16)o[jb][4 * g + e];
                    asm volatile("" ::: "memory"); }
        }
        SBAR();
        DVLD(0, d1v);
        KRAW(0, a); KRAW(1, b);
        asm volatile("s_waitcnt lgkmcnt(0)" ::: "memory"); SBAR();
        SSCALE(0, d1v); DVLD(1, d2v);
        MM(PKLH(al0, ah0), vf0, S[0]); SSCALE(1, d2v); MM(PKLH(bl0, bh0), vf0, S[1]); MM(PKLH(al1, ah1), vf1, S[0]); MM(PKLH(bl1, bh1), vf1, S[1]);
        MM(PKLH(al2, ah2), vf2, S[0]); MM(PKLH(bl2, bh2), vf2, S[1]); MM(PKLH(al3, ah3), vf3, S[0]); MM(PKLH(bl3, bh3), vf3, S[1]);
    }
    SBAR();
    {
        DVLD(2, d1v);
        KRAW(2, a); KRAW(3, b);
        asm volatile("s_waitcnt lgkmcnt(0)" ::: "memory"); SBAR();
        SSCALE(2, d1v); DVLD(3, d2v);
        MM(PKLH(al0, ah0), vf0, S[2]); SSCALE(3, d2v); MM(PKLH(bl0, bh0), vf0, S[3]); MM(PKLH(al1, ah1), vf1, S[2]); MM(PKLH(bl1, bh1), vf1, S[3]);
        MM(PKLH(al2, ah2), vf2, S[2]); MM(PKLH(bl2, bh2), vf2, S[3]); MM(PKLH(al3, ah3), vf3, S[2]); MM(PKLH(bl3, bh3), vf3, S[3]);
    }
#undef MM
#undef PFR
#undef KRAW
#undef DVLD
#undef SSCALE
}
__device__ __forceinline__ void hgrn_bh(int b, int h, const bf16_t* proj, bf16_t* MIXp, const float* __restrict__ gain, char* lds, int wv) {
    int lane = lane_id(); asm volatile("" : "+v"(lane));
    const int wid = wv, tid = wv * 64 + lane, dp_ = lane, seg = wid;
    for (int i = tid; i < 8192 / 4; i += 512) ((unsigned*)(lds + L_P))[i] = 0u;
    f32x16 S[4] = {};
    const bf16_t* pbase = proj + (size_t)b * SEQ * DINP;
    float* segtot = (float*)(lds + L_SEG);
    if (tid < 128) ((float*)(lds + L_GN))[tid] = gain[tid];
    Pre pre; load_chunk(pre, pbase, h, 0, 0, wid, lane);
    __syncthreads();
    const int hw = lane >> 5, cq4 = lane & 31, sg16 = 2 * wid + hw;
    const int cB = (8 * cq4) ^ ((wid & 1) << 7) ^ (hw << 6), cA = cB ^ (((wid >> 1) & 1) << 3), rowb = wid * 2048 + hw * 1024;
    const int gV = (cq4 >> 3) * 512 + (cq4 & 7) * 8 + (wid >> 1) * 4096 + hw * 2048 + (wid & 1) * 256;
    const int drow = tid >> 3, dseg = tid & 7;
#define POST_SEGTOT() do { float a0_ = 0.f, a1_ = 0.f, a2_ = 0.f, a3_ = 0.f; \
        _Pragma("unroll") for (int t_ = 0; t_ < 4; ++t_) { const unsigned lx_ = pre.l4[t_].x, ly_ = pre.l4[t_].y; const h16x2 h0_ = __builtin_bit_cast(h16x2, lx_), h1_ = __builtin_bit_cast(h16x2, ly_); \
            a0_ += (float)h0_[0]; a1_ += (float)h0_[1]; a2_ += (float)h1_[0]; a3_ += (float)h1_[1]; } \
        *(f32x4*)(segtot + sg16 * 128 + 4 * cq4) = (f32x4){a0_, a1_, a2_, a3_}; } while (0)
    POST_SEGTOT();
    asm volatile("s_waitcnt lgkmcnt(0)" ::: "memory"); __builtin_amdgcn_s_barrier(); asm volatile("" ::: "memory");
    for (int k = 0; k < 64; ++k) {
        const int i = k >> 1, dir = k & 1, cs = dir ? 31 - i : i; const bool second = (i >= 16);
        const long row0 = (long)b * SEQ + (dir ? 64 * cs + 63 : 64 * cs);
        const int rstride = dir ? -DINP : DINP; const bool mine = ((wid >> 2) == dir);
        _Float16* rawp = (_Float16*)proj + (size_t)row0 * DINP + C_CQ + h * 128 + 32 * (wid & 3);
        f32x16 o[2]; u32x4 gq0, gq1;
        if (second) {
            if (mine) { const _Float16* p0 = rawp + (lane & 31) + 4 * (lane >> 5) * rstride;
#pragma unroll
                for (int jb = 0; jb < 2; ++jb)
#pragma unroll
                    for (int r = 0; r < 16; ++r) o[jb][r] = (float)p0[(32 * jb + 8 * (r >> 2) + (r & 3)) * rstride]; }
            const long grow = row0 + (dir ? -drow : drow); const bf16_t* gp = proj + (size_t)grow * DINP + C_G + h * 128 + 16 * dseg;
            gq0 = __builtin_nontemporal_load((const u32x4*)gp); gq1 = __builtin_nontemporal_load((const u32x4*)(gp + 8));
        } else { o[0] = f32x16{}; o[1] = f32x16{}; }
        const int I = wid >> 1;
        f32x4 rr[5];
        { f32x4 a = {0.f, 0.f, 0.f, 0.f};
#pragma unroll
          for (int sg = 0; sg < 16; ++sg) { if ((sg & 3) == 0) rr[sg >> 2] = a; a += *(const f32x4*)(segtot + sg * 128 + 4 * cq4); }
          rr[4] = a; }
        const f32x4 rI = (I == 0) ? rr[0] : (I == 1) ? rr[1] : (I == 2) ? rr[2] : rr[3];
        f32x4 run = rI;
#pragma unroll
        for (int q = 0; q < 3; ++q) { const f32x4 st = *(const f32x4*)(segtot + (4 * I + q) * 128 + 4 * cq4); if (4 * I + q < sg16) run += st; }
        f32x4 eI, eT, rat[4];
#pragma unroll
        for (int c = 0; c < 4; ++c) { eI[c] = __builtin_amdgcn_exp2f(rI[c]); eT[c] = __builtin_amdgcn_exp2f(rr[4][c] - rI[c]);
#pragma unroll
            for (int sg = 0; sg < 4; ++sg) rat[sg][c] = __builtin_amdgcn_exp2f(fminf(rr[sg][c] - rI[c], 0.f)); }
        if (sg16 == 0) { f32x4 d4;
#pragma unroll
            for (int c = 0; c < 4; ++c) d4[c] = __builtin_amdgcn_exp2f(rr[4][c]);
            *(f32x4*)((float*)(lds + L_DV) + 4 * cq4) = d4; }
        f32x4 gE[4], Ef[4], Rf[4];
        { f32x4 E;
#pragma unroll
          for (int c = 0; c < 4; ++c) E[c] = __builtin_amdgcn_exp2f(run[c] - rI[c]);
#pragma unroll
          for (int t = 0; t < 4; ++t) { const unsigned lx = pre.l4[t].x, ly = pre.l4[t].y; const h16x2 h0 = __builtin_bit_cast(h16x2, lx), h1 = __builtin_bit_cast(h16x2, ly);
              gE[t] = (f32x4){__builtin_amdgcn_exp2f((float)h0[0]), __builtin_amdgcn_exp2f((float)h0[1]), __builtin_amdgcn_exp2f((float)h1[0]), __builtin_amdgcn_exp2f((float)h1[1])};
              E = E * gE[t]; Ef[t] = E; }
          f32x4 R;
#pragma unroll
          for (int c = 0; c < 4; ++c) R[c] = fminf(__builtin_amdgcn_rcpf(E[c]), 4.1538374868278621e34f);
          Rf[3] = R; Rf[2] = Rf[3] * gE[3]; Rf[1] = Rf[2] * gE[2]; Rf[0] = Rf[1] * gE[1]; }
#pragma unroll
        for (int t = 0; t < 4; ++t) {
            const f32x4 q = {bflo(pre.q4[t].x), bfhi(pre.q4[t].x), bflo(pre.q4[t].y), bfhi(pre.q4[t].y)};
            const f32x4 qt = q * Ef[t], kI = ((f32x4){1.f, 1.f, 1.f, 1.f} - gE[t]) * Rf[t];
            const f32x4 qe = qt * eI, ke = kI * eT;
            const int aB = (cB ^ (t << 4)) + rowb + t * 256, aA = (cA ^ (t << 4)) + rowb + t * 256, aV = gV + t * 64;
            *(u32x2*)(lds + L_QE + aA) = (u32x2){cvtpk(qe[0], qe[1]), cvtpk(qe[2], qe[3])};
            *(u32x2*)(lds + L_QT + aB) = (u32x2){cvtpk(qt[0], qt[1]), cvtpk(qt[2], qt[3])};
            *(u32x2*)(lds + L_KE + aV) = (u32x2){cvtpk(ke[0], ke[1]), cvtpk(ke[2], ke[3])};
            *(u32x2*)(lds + L_V + aV) = pre.v4[t];
#define KTW(base, SG) do { const f32x4 kv_ = kI * rat[SG]; *(u32x2*)(lds + L_KT + (base) * 256 + aB) = (u32x2){cvtpk(kv_[0], kv_[1]), cvtpk(kv_[2], kv_[3])}; } while (0)
#define KTD(base) do { *(u32x2*)(lds + L_KT + (base) * 256 + aB) = (u32x2){cvtpk(kI[0], kI[1]), cvtpk(kI[2], kI[3])}; } while (0)
            if (I == 0) { KTD(0); KTW(16, 1); KTW(48, 2); KTW(96, 3); }
            else if (I == 1) { KTD(16); KTW(48, 2); KTW(96, 3); }
            else if (I == 2) { KTD(48); KTW(96, 3); }
            else { KTD(96); }
#undef KTW
#undef KTD
        }
        asm volatile("s_waitcnt lgkmcnt(0)" ::: "memory"); __builtin_amdgcn_s_barrier(); asm volatile("" ::: "memory");
        if (k + 1 < 64) { const int k1 = k + 1, i1 = k1 >> 1, d1 = k1 & 1; load_chunk(pre, pbase, h, d1, d1 ? 31 - i1 : i1, wid, lane); }
        if (mine) stage_c(lds, S, o, rawp, rstride, second, wid & 3, lane, 0);
        else {
            int lane_b = lane; asm volatile("" : "+v"(lane_b));
            const int q = wid & 3, xm = ((lane_b & 15) << 4), cq4 = 16 * (lane_b >> 4), sl = lane_b & 15;
#define BLK_IDX(blk, bi, bjj, base) int bi, bjj; if ((blk) == 0) { bi = 0; bjj = 0; } else if ((blk) < 3) { bi = 1; bjj = (blk) - 1; } else if ((blk) < 6) { bi = 2; bjj = (blk) - 3; } else { bi = 3; bjj = (blk) - 6; } \
            const int base = (bi == 0) ? 0 : (bi == 1) ? 16 : (bi == 2) ? 48 : 96
#define BLK_LOAD(bi, bjj, base, av, bv) bf16x8 av[4], bv[4]; { const char* ap = lds + L_QT + (16 * bi + sl) * 256; const char* bp = lds + L_KT + (base + 16 * bjj + sl) * 256; \
            _Pragma("unroll") for (int ks = 0; ks < 4; ++ks) { const int cb = (64 * ks + cq4) ^ xm; av[ks] = *(const bf16x8*)(ap + cb); bv[ks] = *(const bf16x8*)(bp + cb); } }
#define BLK_MMA(acc, av, bv) f32x4 acc = {0.f, 0.f, 0.f, 0.f}; _Pragma("unroll") for (int ks = 0; ks < 4; ++ks) acc = __builtin_amdgcn_mfma_f32_16x16x32_bf16(av[ks], bv[ks], acc, 0, 0, 0); __builtin_amdgcn_sched_barrier(0)
#define BLK_WR(bi, bjj, acc) do { _Pragma("unroll") for (int r = 0; r < 4; ++r) { const int jl = (lane_b >> 4) * 4 + r; const float v = (bi != bjj || sl <= jl) ? acc[r] : 0.f; \
                *(bf16_t*)(lds + L_P + swzP(16 * bi + jl, (16 * bjj + sl) * 2)) = (bf16_t)(cvtpk(v, v) & 0xffffu); } } while (0)
            BLK_IDX(q, bi0, bj0, base0); BLK_IDX(q + 4, bi1, bj1, base1);
            BLK_LOAD(bi0, bj0, base0, av0, bv0); BLK_MMA(acc0, av0, bv0);
            BLK_LOAD(bi1, bj1, base1, av1, bv1); __builtin_amdgcn_sched_barrier(0);
            BLK_WR(bi0, bj0, acc0); BLK_MMA(acc1, av1, bv1);
            if (q < 2) { BLK_IDX(q + 8, bi2, bj2, base2); BLK_LOAD(bi2, bj2, base2, av2, bv2); __builtin_amdgcn_sched_barrier(0); BLK_WR(bi1, bj1, acc1); BLK_MMA(acc2, av2, bv2); BLK_WR(bi2, bj2, acc2); }
            else BLK_WR(bi1, bj1, acc1);
#undef BLK_WR
#undef BLK_IDX
#undef BLK_LOAD
#undef BLK_MMA
        }
        asm volatile("s_waitcnt lgkmcnt(0)" ::: "memory"); __builtin_amdgcn_s_barrier(); asm volatile("" ::: "memory");
        if (mine) stage_c(lds, S, o, rawp, rstride, second, wid & 3, lane, 1);
        if (k + 1 < 64) POST_SEGTOT();
        if (k == 31) asm volatile("s_waitcnt vmcnt(0)" ::: "memory");
        asm volatile("s_waitcnt lgkmcnt(0)" ::: "memory"); __builtin_amdgcn_s_barrier(); asm volatile("" ::: "memory");
        if (second) {
            const float* otp = (const float*)(lds + L_OT) + drow * 128 + 16 * dseg;
            f32x4 v[4]; float ss = 0.f;
#pragma unroll
            for (int q = 0; q < 4; ++q) { v[q] = *(const f32x4*)(otp + 4 * q); ss += (v[q][0] * v[q][0] + v[q][1] * v[q][1]) + (v[q][2] * v[q][2] + v[q][3] * v[q][3]); }
            ss = dpp_sum8(ss);
            const float r = __builtin_amdgcn_rsqf(ss * (1.f / 128.f) + EPS);
            f32x4 gn[4];
#pragma unroll
            for (int q = 0; q < 4; ++q) gn[q] = *(const f32x4*)((const float*)(lds + L_GN) + 16 * dseg + 4 * q);
            const unsigned gw[8] = {gq0.x, gq0.y, gq0.z, gq0.w, gq1.x, gq1.y, gq1.z, gq1.w}; unsigned ow[8];
#pragma unroll
            for (int q = 0; q < 8; ++q) { const float g0 = bflo(gw[q]), g1 = bfhi(gw[q]);
                const float s0 = g0 * __builtin_amdgcn_rcpf(1.f + __builtin_amdgcn_exp2f(-1.4426950408889634f * g0)), s1 = g1 * __builtin_amdgcn_rcpf(1.f + __builtin_amdgcn_exp2f(-1.4426950408889634f * g1));
                ow[q] = cvtpk(v[q >> 1][2 * (q & 1)] * r * gn[q >> 1][2 * (q & 1)] * s0, v[q >> 1][2 * (q & 1) + 1] * r * gn[q >> 1][2 * (q & 1) + 1] * s1); }
            const long grow = row0 + (dir ? -drow : drow); bf16_t* mp = MIXp + (size_t)grow * DM + 512 + h * 128 + 16 * dseg;
            *(u32x4*)mp = (u32x4){ow[0], ow[1], ow[2], ow[3]}; *(u32x4*)(mp + 8) = (u32x4){ow[4], ow[5], ow[6], ow[7]};
        }
    }
    __syncthreads();
}
}

#define XB_TMO      128
#define XB_XCNT(j)  (256  + 64 * (j))
#define XB_XSUB(j)  (1280 + 64 * (j))
#define XB_XGEN(j)  (2304 + 64 * (j))
#define XB_TOP      3328
#define XB_TOPGEN   3392
#define XCD_BAR_WORDS 3456
#define XB_SPIN_CAP (1u << 18)

__device__ __forceinline__ unsigned xb_ld(unsigned* p)              { return __hip_atomic_load(p, __ATOMIC_RELAXED, __HIP_MEMORY_SCOPE_AGENT); }
__device__ __forceinline__ unsigned xb_add(unsigned* p, unsigned v) { return __hip_atomic_fetch_add(p, v, __ATOMIC_RELAXED, __HIP_MEMORY_SCOPE_AGENT); }
__device__ __forceinline__ unsigned xb_xcc_id() { return (unsigned)__builtin_amdgcn_s_getreg((3 << 11) | 20) & 0xFu; }
#define XB_SPIN(cond, bar) do { unsigned _sp = 0; while (cond) { __builtin_amdgcn_s_sleep(1); \
    if ((++_sp & 255u) == 0u) { if (xb_ld(&(bar)[XB_TMO])) break; if (_sp > XB_SPIN_CAP) { atomicAdd(&(bar)[XB_TMO], 1u); break; } } } } while (0)

struct XcdBarrier {
    unsigned* bar; unsigned x;
    volatile LAS unsigned* st;
};

__device__ __forceinline__ XcdBarrier xcd_barrier_post(unsigned* bar, volatile LAS unsigned* st, bool leader  ) {
    XcdBarrier b; b.bar = bar; b.x = xb_xcc_id(); b.st = st;
    if (leader) (void)xb_add(&bar[XB_XCNT(b.x)], 1u);
    return b;
}
__device__ __forceinline__ void xcd_barrier_complete(unsigned* bar, unsigned x, unsigned& nloc, unsigned& nx) {
    const unsigned G = gridDim.x * gridDim.y * gridDim.z;
    unsigned sum, cnt, mine, sp = 0u;
    for (;;) {
        sum = 0u; cnt = 0u; mine = 0u;
#pragma unroll
        for (unsigned j = 0; j < 16; ++j) { const unsigned c = xb_ld(&bar[XB_XCNT(j)]); sum += c; cnt += (c > 0u) ? 1u : 0u; mine = (j == x) ? c : mine; }
        if (sum == G) break;
        __builtin_amdgcn_s_sleep(1);
        if ((++sp & 255u) == 0u) { if (xb_ld(&bar[XB_TMO])) break; if (sp > XB_SPIN_CAP) { atomicAdd(&bar[XB_TMO], 1u); break; } }
    }
    nloc = mine > 0u ? mine : 1u; nx = cnt > 0u ? cnt : 1u;
}

__device__ __forceinline__ void xcd_barrier(const XcdBarrier& b, bool leader  ) {
    asm volatile("s_waitcnt vmcnt(0)" ::: "memory");
    __syncthreads();
    if (leader) {
        unsigned* bar = b.bar;
        __builtin_amdgcn_s_waitcnt(0);
        unsigned nloc = b.st[0], nx = b.st[1];
        if (nloc == 0u) { xcd_barrier_complete(bar, b.x, nloc, nx); b.st[0] = nloc; b.st[1] = nx; }
        const unsigned old = xb_add(&bar[XB_XSUB(b.x)], 1u);
        const unsigned gen = old / nloc;
        if (old + 1u == (gen + 1u) * nloc) {
            __builtin_amdgcn_fence(__ATOMIC_RELEASE, "agent");
            asm volatile("s_waitcnt vmcnt(0)" ::: "memory");
            const unsigned og = xb_add(&bar[XB_TOP], 1u);
            const unsigned tg = og / nx;
            if (og + 1u == (tg + 1u) * nx) xb_add(&bar[XB_TOPGEN], 1u);
            else XB_SPIN(xb_ld(&bar[XB_TOPGEN]) == tg, bar);
            __builtin_amdgcn_fence(__ATOMIC_ACQUIRE, "agent");
            xb_add(&bar[XB_XGEN(b.x)], 1u);
            asm volatile("s_waitcnt vmcnt(0)" ::: "memory");
        } else {
            XB_SPIN(xb_ld(&bar[XB_XGEN(b.x)]) == gen, bar);
            __builtin_amdgcn_fence(__ATOMIC_ACQUIRE, "agent");
            asm volatile("s_waitcnt vmcnt(0)" ::: "memory");
        }
    }
    __syncthreads();
}


constexpr int NWAVES = 8;
constexpr int LDS_BYTES = 160 * 1024;
constexpr int RING_BYTES = 131072, EPI_OFF = RING_BYTES  , TAB_OFF = RING_BYTES + 8192  , MISC_OFF = 160 * 1024 - 1024;
constexpr size_t CTL_ZERO_BYTES = 65536;
struct Args { const float* in[17]; float* out; unsigned char* ws; int ph_lo, ph_hi; };

__device__ __forceinline__ int rope_perm(int cp) { const int i = cp >> 3, j = cp & 7; return (j < 4) ? 4 * i + j : 32 + 4 * i + (j - 4); }
__device__ __forceinline__ void tr_item(const float* W, int ldw, int ksrc0, int srccol, const float* gain, int goff, bf16_t* WT, int Kd, int kd0, int nd0, LAS float* scr, int lane) {
    float wv_[32], gv_[32];
#pragma unroll
    for (int i = 0; i < 32; ++i) { const int kk = 2 * i + (lane >> 5); wv_[i] = (srccol >= 0) ? W[(size_t)(ksrc0 + kk) * ldw + srccol] : 0.f; gv_[i] = gain ? gain[ksrc0 + kk - goff] : 1.f; }
#pragma unroll
    for (int i = 0; i < 32; ++i) { const int kk = 2 * i + (lane >> 5); scr[kk * 33 + (lane & 31)] = wv_[i] * gv_[i]; }
    asm volatile("s_waitcnt lgkmcnt(0)" ::: "memory");
    const int c = lane & 7;
#pragma unroll
    for (int j = 0; j < 4; ++j) { const int n = (lane >> 3) + 8 * j; const LAS float* sp = scr + (8 * c) * 33 + n;
        u32x4 o; o.x = pk2(sp[0 * 33], sp[1 * 33]); o.y = pk2(sp[2 * 33], sp[3 * 33]); o.z = pk2(sp[4 * 33], sp[5 * 33]); o.w = pk2(sp[6 * 33], sp[7 * 33]);
        *(u32x4*)(WT + (size_t)(nd0 + n) * Kd + kd0 + 8 * c) = o; }
    asm volatile("s_waitcnt lgkmcnt(0)" ::: "memory");
}
template <int R, class F>
__device__ __forceinline__ void rows_to_bf16_rs(const float* x0, bf16_t* o0, float* rs0, size_t rstep, int lane, const F& between) {
    f32x4 v[R][4]; float s[R];
#pragma unroll
    for (int r = 0; r < R; ++r) { const f32x4* xr = (const f32x4*)(x0 + (size_t)r * rstep * DM) + lane;
#pragma unroll
        for (int j = 0; j < 4; ++j) v[r][j] = __builtin_nontemporal_load(&xr[64 * j]); }
    __builtin_amdgcn_sched_barrier(0); between(); __builtin_amdgcn_sched_barrier(0);
#pragma unroll
    for (int r = 0; r < R; ++r) { float a = 0.f;
#pragma unroll
        for (int j = 0; j < 4; ++j) a += (v[r][j].x * v[r][j].x + v[r][j].y * v[r][j].y) + (v[r][j].z * v[r][j].z + v[r][j].w * v[r][j].w);
        s[r] = a; }
#pragma unroll
    for (int o = 1; o < 64; o <<= 1) {
#pragma unroll
        for (int r = 0; r < R; ++r) s[r] += __shfl_xor(s[r], o); }
#pragma unroll
    for (int r = 0; r < R; ++r) { if (lane == 0) rs0[(size_t)r * rstep] = 1.f / sqrtf(s[r] * (1.f / DM) + EPS);
        u32x2* o8 = (u32x2*)(o0 + (size_t)r * rstep * DM) + lane;
#pragma unroll
        for (int j = 0; j < 4; ++j) { u32x2 w; w.x = cvtpk(v[r][j].x, v[r][j].y); w.y = cvtpk(v[r][j].z, v[r][j].w); o8[64 * j] = w; } }
}
__device__ __forceinline__ void sincos_acc(float ang, float& c, float& s) {
    const double x = (double)ang; const double kq = __builtin_rint(x * 0.6366197723675814); const double y = x - kq * 1.5707963267948966 - kq * 6.123233995736766e-17;
    const double y2 = y * y;
    double sp = -7.6471637318198164759e-13; sp = sp * y2 + 1.6059043836821614599e-10; sp = sp * y2 - 2.5052108385441718775e-8; sp = sp * y2 + 2.7557319223985890653e-6; sp = sp * y2 - 1.9841269841269841270e-4; sp = sp * y2 + 8.3333333333333333333e-3; sp = sp * y2 - 1.6666666666666666667e-1; sp = y + y * y2 * sp;
    double cp = 4.7794773323873852974e-14; cp = cp * y2 - 1.1470745597729724714e-11; cp = cp * y2 + 2.0876756987868098979e-9; cp = cp * y2 - 2.7557319223985890653e-7; cp = cp * y2 + 2.4801587301587301587e-5; cp = cp * y2 - 1.3888888888888888889e-3; cp = cp * y2 + 4.1666666666666666667e-2; cp = cp * y2 - 0.5; cp = 1.0 + y2 * cp;
    const int q = ((int)(long long)kq) & 3;
    const double sv = (q == 0) ? sp : (q == 1) ? cp : (q == 2) ? -sp : -cp;
    const double cv = (q == 0) ? cp : (q == 1) ? -sp : (q == 2) ? -cp : sp;
    c = (float)cv; s = (float)sv;
}

__global__ void __launch_bounds__(NWAVES * 64, 2) mk_fwd(Args args) {
    extern __shared__ __attribute__((aligned(16))) unsigned char lds[];
    const int g_wv = __builtin_amdgcn_readfirstlane(threadIdx.x >> 6);
#define TIDV() ({ int t_ = g_wv * 64 + lane_id(); asm volatile("" : "+v"(t_)); t_; })
    const int G = gridDim.x, bx = blockIdx.x;
    unsigned char* ws = args.ws;
    const float* x = args.in[0]; const int* positions = (const int*)args.in[1];
    const float* g_mix = args.in[2]; const float* w_in = args.in[3]; const float* lb_param = args.in[4]; const float* g_hgrn = args.in[5];
    const float* g_cq = args.in[6]; const float* w_q_up = args.in[7]; const float* g_ckv = args.in[8]; const float* w_kv_up = args.in[9];
    const float* g_qn = args.in[10]; const float* g_kn = args.in[11]; const float* g_mla_out = args.in[12]; const float* w_out = args.in[13];
    const float* g_ffn = args.in[14]; const float* w_up = args.in[15]; const float* w_down = args.in[16];
    float* out = args.out;
    float* RS0 = (float*)(ws + WS_RS0); float* SSQ1 = (float*)(ws + WS_SSQ1); float* SSQP = (float*)(ws + WS_SSQP); float* GQT = (float*)(ws + WS_GQT); float* GKT = (float*)(ws + WS_GKT); float* LBT = (float*)(ws + WS_LBT);
    float* COS = (float*)(ws + WS_COS); float* SIN = (float*)(ws + WS_SIN);
    bf16_t* WIN = (bf16_t*)(ws + WS_WIN); bf16_t* WQ = (bf16_t*)(ws + WS_WQ); bf16_t* WKV = (bf16_t*)(ws + WS_WKV); bf16_t* WOUT = (bf16_t*)(ws + WS_WOUT);
    bf16_t* WUP = (bf16_t*)(ws + WS_WUP); bf16_t* WDN = (bf16_t*)(ws + WS_WDN);
    bf16_t* XB = (bf16_t*)(ws + WS_XB); bf16_t* VB = (bf16_t*)(ws + WS_V); bf16_t* X1B = (bf16_t*)(ws + WS_X1B);
    bf16_t* PROJ = (bf16_t*)(ws + WS_PROJ); bf16_t* HB = (bf16_t*)(ws + WS_HB);
    bf16_t* MIX = (bf16_t*)(ws + WS_MIX); float* SSQA = (float*)(ws + WS_SSQA);
    bf16_t* LAT = (bf16_t*)(ws + WS_MIX);
    constexpr int LATP = 768;
    bf16_t* QB = (bf16_t*)(ws + WS_Q); bf16_t* KB = (bf16_t*)(ws + WS_K);
    const int lo = args.ph_lo, hi = args.ph_hi;
    cooperative_groups::grid_group grid = cooperative_groups::this_grid();
    volatile LAS unsigned* MISC = (volatile LAS unsigned*)((LAS unsigned char*)lds + MISC_OFF);
    { const int tid = TIDV(); if (tid < 32) MISC[tid] = 0u; }
    __syncthreads();
    XcdBarrier bar = xcd_barrier_post((unsigned*)(ws + WS_CTL) + 4096, MISC + 8, TIDV() == 0);
    if (args.ph_hi > 1000) grid.sync();
#define SEAM(k) do { if (lo <= (k) && (k) + 1 < hi) xcd_barrier(bar, TIDV() == 0); } while (0)
#ifndef PHMASK
#define PHMASK 0xFFF
#endif
#define IN(k) (((PHMASK >> (k)) & 1) && lo <= (k) && (k) < hi)
#ifndef REPMASK
#define REPMASK 0
#endif
#define REPS(k) for (int rep_ = 0; rep_ < ((((REPMASK) >> (k)) & 1) ? 2 : 1); ++rep_)

    if (IN(0)) REPS(0) {
        const int tid = TIDV(), lane = tid & 63, wave = g_wv;
        const int vcu = (G % 8 == 0) ? (bx % 8) * (G / 8) + bx / 8 : bx;
        const int gw = vcu * NWAVES + wave, NGW = G * NWAVES;
        LAS float* scr = (LAS float*)((LAS unsigned char*)lds + wave * 16384);
        constexpr int I_IN = 16 * 104, I_Q = 6 * 32, I_KV = 4 * 32, I_OUT = 16 * 32, I_UP = 16 * 128, I_DN = 64 * 32;
        constexpr int NITEMS = I_IN + I_Q + I_KV + I_OUT + I_UP + I_DN;
        const int l31 = lane & 31;
        for (int it = gw; it < NITEMS; it += NGW) {
            int r = it;
            if (r < I_IN) { const int kb = r / 104, nb = r % 104, nd = 32 * nb + l31; const int sc = nd < C_KR ? nd : (nd < DIN ? C_KR + rope_perm(nd - C_KR) : -1);
                tr_item(w_in, DIN, 64 * kb, sc, g_mix, 0, WIN, DM, 64 * kb, 32 * nb, scr, lane); continue; } r -= I_IN;
            if (r < I_Q) { const int kb = r / 32, nb = r % 32, nd = 32 * nb + l31, hh = nd >> 8, c = nd & 255; const int sc = c < 128 ? hh * 192 + c : (c < 192 ? hh * 192 + 128 + rope_perm(c - 128) : -1);
                tr_item(w_q_up, NQ, 64 * kb, sc, g_cq, 0, WQ, QLORA, 64 * kb, 32 * nb, scr, lane); continue; } r -= I_Q;
            if (r < I_KV) { const int kb = r / 32, nb = r % 32; tr_item(w_kv_up, NKV, 64 * kb, 32 * nb + l31, g_ckv, 0, WKV, KVLORA, 64 * kb, 32 * nb, scr, lane); continue; } r -= I_KV;
            if (r < I_OUT) { const int kb = r / 32, nb = r % 32; const int kd0 = 64 * kb, ks0 = kd0 < 512 ? kd0 + 512 : kd0 - 512;
                tr_item(w_out, DM, ks0, 32 * nb + l31, kd0 < 512 ? g_mla_out : nullptr, 512, WOUT, DM, kd0, 32 * nb, scr, lane); continue; } r -= I_OUT;
            if (r < I_UP) { const int kb = r / 128, nb = r % 128; tr_item(w_up, DFF, 64 * kb, 32 * nb + l31, g_ffn, 0, WUP, DM, 64 * kb, 32 * nb, scr, lane); continue; } r -= I_UP;
            { const int kb = r / 32, nb = r % 32; tr_item(w_down, DM, 64 * kb, 32 * nb + l31, nullptr, 0, WDN, DFF, 64 * kb, 32 * nb, scr, lane); }
        }
        for (int i = bx * 512 + tid; i < 512; i += G * 512) ((float*)(ws + WS_GHT))[i] = g_hgrn[i];
        for (int i = bx * 512 + tid; i < 512; i += G * 512) {
            if (i < 256) GQT[i] = i < 128 ? g_qn[i] * QSCALE : (i < 192 ? g_qn[128 + rope_perm(i - 128)] * QSCALE : 0.f);
            else { const int c = i - 256; if (c < 192) GKT[c] = c < 128 ? g_kn[c] : g_kn[128 + rope_perm(c - 128)]; } }
        { const int jf = tid & 31; const float invf = powf(10000.0f, -(float)(2 * jf) / 64.0f);
          int ti = bx * 512 + tid;
          const int TS = G * 512;
          int pn0 = (ti < M * 32) ? positions[ti >> 5] : 0, pn1 = (ti + TS < M * 32) ? positions[(ti + TS) >> 5] : 0;
          auto tab2 = [&]() {
              const int pc0 = pn0, pc1 = pn1, i0 = ti, i1 = ti + TS; ti += 2 * TS;
              pn0 = (ti < M * 32) ? positions[ti >> 5] : 0; pn1 = (ti + TS < M * 32) ? positions[(ti + TS) >> 5] : 0;
              if (i0 < M * 32) { float c, sn; sincos_acc((float)pc0 * invf, c, sn); COS[i0] = c; SIN[i0] = sn; }
              if (i1 < M * 32) { float c, sn; sincos_acc((float)pc1 * invf, c, sn); COS[i1] = c; SIN[i1] = sn; } };
          for (int m = gw; m < M; m += 4 * NGW) rows_to_bf16_rs<4>(x + (size_t)m * DM, XB + (size_t)m * DM, RS0 + m, (size_t)NGW, lane, tab2);
          for (; ti < M * 32; ti += G * 512) { const int row = ti >> 5; const float ang = (float)positions[row] * invf; float c, sn; sincos_acc(ang, c, sn); COS[ti] = c; SIN[ti] = sn; } }
        for (int i = bx * 512 + tid; i < 1024; i += G * 512) { const int dir = i >> 9, c = i & 511; const float p0 = lb_param[dir * 1024 + c], p1 = lb_param[dir * 1024 + 512 + c];
            LBT[i] = 1.f / (1.f + expf(p1 - p0)); }
    }
    SEAM(0);
    if (IN(1)) REPS(1) {
        pg8::Gemm g{XB, WIN, M, DINP, DM, DM}; pg8::StaticOrder S; S.init(M, DINP, G, bx);
        LAS float* rsT = (LAS float*)((LAS unsigned char*)lds + TAB_OFF);
        auto pre = [&]() { for (int ui = 0; ui < 16; ++ui) { pg8::Unit uu; if (!S.next(ui, uu)) break; const int tid = TIDV(); if (tid < 256) rsT[ui * 256 + tid] = RS0[uu.pm * 256 + tid]; } };
        pg8::EpiProj E{PROJ, DINP, rsT, LBT, SSQP, M, (LAS float*)((LAS unsigned char*)lds + EPI_OFF), LAT, LATP};
        pg8::gemm_phase<pg8::EpiProj, pg8::StaticOrder, true, true>((LAS unsigned char*)lds, g, S, E, g_wv, pre);
    }
    SEAM(1);
    if (IN(2)) REPS(2) {
        pg8::Gemm g{LAT, WQ, M, 1024, QLORA, LATP}; pg8::StaticOrder S; S.init(M, 1024, G, bx);
        LAS float* rsT = (LAS float*)((LAS unsigned char*)lds + TAB_OFF);
        for (int ui = 0; ui < 4; ++ui) { pg8::Unit uu; if (!S.next(ui, uu)) break;
            const int tid = TIDV(); if (tid < 256) { const int row = uu.pm * 256 + tid; rsT[ui * 256 + tid] = __builtin_amdgcn_rsqf(((SSQP[row] + SSQP[M + row]) + SSQP[2 * (size_t)M + row]) * (1.f / 384.f) + EPS); } }
        __syncthreads();
        pg8::EpiQ E{QB, rsT, GQT, COS, SIN, (LAS float*)((LAS unsigned char*)lds + EPI_OFF)};
        pg8::gemm_phase<pg8::EpiQ, pg8::StaticOrder, true, true>((LAS unsigned char*)lds, g, S, E, g_wv);
    }
    if (IN(3)) REPS(3) {
        pg8::Gemm g{LAT + (C_CKV - C_CQ), WKV, M, NKV, KVLORA, LATP}; pg8::StaticOrder S; S.init(M, NKV, G, bx);
        LAS float* rsT = (LAS float*)((LAS unsigned char*)lds + TAB_OFF + 8192); LAS float* skT = rsT + 1024;
        auto pre = [&]() { for (int ui = 0; ui < 4; ++ui) { pg8::Unit uu; if (!S.next(ui, uu)) break;
            const int tid = TIDV(); if (tid < 256) { const int row = uu.pm * 256 + tid; rsT[ui * 256 + tid] = __builtin_amdgcn_rsqf((SSQP[3 * (size_t)M + row] + SSQP[4 * (size_t)M + row]) * (1.f / 256.f) + EPS); skT[ui * 256 + tid] = SSQP[5 * (size_t)M + row]; } } };
        pg8::EpiKV E{KB, VB, LAT, LATP, C_KR - C_CQ, rsT, skT, GKT, COS, SIN, (LAS float*)((LAS unsigned char*)lds + EPI_OFF)};
        pg8::gemm_phase<pg8::EpiKV, pg8::StaticOrder, true, true>((LAS unsigned char*)lds, g, S, E, g_wv, pre);
    }
    SEAM(4);
    if (IN(5)) {
        if (bx < BATCH * 4) hg::hgrn_bh(bx >> 2, bx & 3, PROJ, MIX, (const float*)(ws + WS_GHT) + (bx & 3) * 128, (char*)lds, g_wv);
        { const int a = bx & 127, bhs = (a >> 6) * 8 + (a & 7), qb = (a >> 3) & 7;
          att::attn_chain(QB, KB, VB, MIX, DM, SSQA, bhs, qb, bx < BATCH * 4 ? 7 : 0, bx < BATCH * 4 ? 8 : 7, SEQ, M, (char*)lds, g_wv); }
    }
    SEAM(7);
    if (IN(8)) REPS(8) {
        pg8::Gemm g{MIX, WOUT, M, DM, DM, DM}; pg8::StaticOrder S; S.init(M, DM, G, bx);
        LAS float* rsbT = (LAS float*)((LAS unsigned char*)lds + EPI_OFF + 4096);
        auto pre = [&]() { for (int ui = 0; ui < 4; ++ui) { pg8::Unit uu; if (!S.next(ui, uu)) break;
            const int tid = TIDV(); if (tid < 256) { const int row = uu.pm * 256 + tid; rsbT[ui * 256 + tid] = 1.f / sqrtf(((SSQA[row] + SSQA[M + row]) + (SSQA[2 * (size_t)M + row] + SSQA[3 * (size_t)M + row])) * (1.f / 512.f) + EPS); } } };
        pg8::EpiResidX1 E{XB, X1B, SSQ1, DM, M, (LAS float*)((LAS unsigned char*)lds + EPI_OFF), rsbT};
        pg8::gemm_phase<pg8::EpiResidX1, pg8::StaticOrder, true, true>((LAS unsigned char*)lds, g, S, E, g_wv, pre);
    }
    SEAM(8);
    if (IN(10)) REPS(10) {
        pg8::Gemm g{X1B, WUP, M, DFF, DM, DM}; pg8::StaticOrder S; S.init(M, DFF, G, bx);
        LAS float* rsT = (LAS float*)((LAS unsigned char*)lds + TAB_OFF);
        auto pre = [&]() { for (int ui = 0; ui < 16; ++ui) { pg8::Unit uu; if (!S.next(ui, uu)) break;
            const int tid = TIDV(); if (tid < 256) { const int row = uu.pm * 256 + tid; rsT[ui * 256 + tid] = __builtin_amdgcn_rsqf(((SSQ1[row] + SSQ1[M + row]) + (SSQ1[2 * (size_t)M + row] + SSQ1[3 * (size_t)M + row])) * (1.f / 1024.f) + EPS); } } };
        pg8::EpiUp E{HB, DFF, rsT};
        pg8::gemm_phase<pg8::EpiUp, pg8::StaticOrder, true, true>((LAS unsigned char*)lds, g, S, E, g_wv, pre);
    }
    SEAM(10);
    if (IN(11)) {
        pg8::Gemm g{HB, WDN, M, DM, DFF, DFF}; pg8::StaticOrder S; S.init(M, DM, G, bx);
        pg8::EpiResidBf E{X1B, out, DM};
        pg8::gemm_phase<pg8::EpiResidBf, pg8::StaticOrder, true, true>((LAS unsigned char*)lds, g, S, E, g_wv);
    }
#undef IN
}

extern "C" void kernel_launch(void* const* d_in, const int* in_sizes, int n_in, void* d_out, int out_size, void* d_ws, size_t ws_size, hipStream_t stream) {
    static int ok = 0, grid_blocks = 0;
    if (ok == 0) {
        if (n_in != 17 || in_sizes[0] != M * DM || out_size != M * DM || ws_size < WS_END) {
            fprintf(stderr, "kernel_launch: shape mismatch n_in %d in0 %d out %d ws %zu (need %zu)\n", n_in, n_in > 0 ? in_sizes[0] : -1, out_size, ws_size, (size_t)WS_END); ok = -1; return; }
        if (hipFuncSetAttribute((const void*)mk_fwd, hipFuncAttributeMaxDynamicSharedMemorySize, LDS_BYTES) != hipSuccess) { fprintf(stderr, "kernel_launch: hipFuncSetAttribute failed\n"); ok = -1; return; }
        int dev = 0, cus = 0, per_cu = 0;
        (void)hipGetDevice(&dev); (void)hipDeviceGetAttribute(&cus, hipDeviceAttributeMultiprocessorCount, dev);
        (void)hipOccupancyMaxActiveBlocksPerMultiprocessor(&per_cu, (const void*)mk_fwd, NWAVES * 64, LDS_BYTES);
        if (per_cu < 1 || cus < 1) { fprintf(stderr, "kernel_launch: occupancy query gave %d blocks/CU on %d CUs\n", per_cu, cus); ok = -1; return; }
        grid_blocks = cus * (per_cu > 1 ? 1 : per_cu);
        ok = 1;
    }
    if (ok < 0) return;
    (void)hipMemsetAsync((char*)d_ws + WS_CTL, 0, CTL_ZERO_BYTES, stream);
    Args a{};
    for (int i = 0; i < 17; ++i) a.in[i] = (const float*)d_in[i];
    a.out = (float*)d_out; a.ws = (unsigned char*)d_ws;
    a.ph_lo = 0; a.ph_hi = 12;
    void* kargs[] = {&a};
    (void)hipLaunchCooperativeKernel((const void*)mk_fwd, dim3(grid_blocks), dim3(NWAVES * 64), kargs, LDS_BYTES, stream);
    const hipError_t le = hipPeekAtLastError();
    if (le != hipSuccess) fprintf(stderr, "kernel_launch: launch failed: %s\n", hipGetErrorName(le));
}
```
